# Optimizing an MI355X kernel written in HIP

```python
import jax
import jax.numpy as jnp
from jax import lax
import numpy as np

D_MODEL = 1024
BATCH = 8
SEQ = 2048
DEPTH = 2

GRID_W = 64
CTX_LEN = 256

CHUNK = 128
CM_GROUPS = 4
CM_WIDTH = 512
CM_GROUP_W = CM_WIDTH // CM_GROUPS

NA_HEADS = 8
NA_HEAD_DIM = 64
NA_WIDTH = NA_HEADS * NA_HEAD_DIM
WIN_R = 8
WIN_C = 16
Q_COLS = 16
KB_COLS = Q_COLS + WIN_C

RET_HEADS = 4
RET_DK = 64
RET_DV = 128
RET_QK_W = RET_HEADS * RET_DK
RET_V_W = RET_HEADS * RET_DV
ROPE_BASE = 10000.0

N_BRANCH = 3
BR_W = CM_WIDTH
IN_W = 2 * CM_WIDTH + 3 * NA_WIDTH + 2 * RET_QK_W + 2 * RET_V_W + N_BRANCH * D_MODEL

N_EXPERTS = 64
TOP_K = 8
N_GROUPS = 8
TOPK_GROUPS = 4
EXPERT_W = 256
SHARED_W = 256
ROUTED_SCALE = 2.5
MOE_BLOCK = 128

EPS = 1e-6
NEG = -1e30

kernel_name = 'hybrid_dit_gmlp_natten_retention_moe'


def rms_norm(x, g):
    x32 = x.astype(jnp.float32)
    y = x32 * lax.rsqrt(jnp.mean(x32 * x32, axis=-1, keepdims=True) + EPS)
    return (y * g.astype(jnp.float32)).astype(x.dtype)


def layer_norm(x, g, b):
    x32 = x.astype(jnp.float32)
    xc = x32 - jnp.mean(x32, axis=-1, keepdims=True)
    y = xc * lax.rsqrt(jnp.mean(xc * xc, axis=-1, keepdims=True) + EPS)
    return (y * g.astype(jnp.float32) + b.astype(jnp.float32)).astype(x.dtype)


def split_heads(t, n_heads):
    return t.reshape(t.shape[:-1] + (n_heads, t.shape[-1] // n_heads))


def split_in_proj(z):
    sizes = [CM_WIDTH, CM_WIDTH, NA_WIDTH, NA_WIDTH, NA_WIDTH, RET_QK_W, RET_QK_W, RET_V_W, RET_V_W,
             D_MODEL, D_MODEL, D_MODEL]
    return jnp.split(z, np.cumsum(sizes)[:-1].tolist(), axis=-1)


def chunk_spatial_gating(u, v, ln_g, ln_b, w_s, b_s):
    bsz, n, _ = u.shape
    u = jax.nn.gelu(u)
    v = layer_norm(jax.nn.gelu(v), ln_g, ln_b)
    v = v.reshape(bsz, n // CHUNK, CHUNK, CM_GROUPS, CM_GROUP_W)
    s = jnp.einsum('gpq,bnqgc->bnpgc', w_s, v) + jnp.transpose(b_s)[None, None, :, :, None]
    return u * s.reshape(bsz, n, CM_WIDTH)


def na_geometry(rows):
    wr = min(WIN_R, rows)
    r = np.arange(rows)
    row_start = np.clip(r - WIN_R // 2, 0, rows - wr)
    row_off = row_start[:, None] + np.arange(wr)[None, :] - r[:, None]
    nqb = GRID_W // Q_COLS
    qcol = np.arange(nqb)[:, None] * Q_COLS + np.arange(Q_COLS)[None, :]
    kb_start = np.clip(np.arange(nqb) * Q_COLS - WIN_C // 2, 0, GRID_W - KB_COLS)
    kcol = kb_start[:, None] + np.arange(KB_COLS)[None, :]
    col_start = np.clip(qcol - WIN_C // 2, 0, GRID_W - WIN_C)
    col_mask = ((kcol[:, None, :] >= col_start[:, :, None]) &
                (kcol[:, None, :] < col_start[:, :, None] + WIN_C))
    col_off = np.clip(kcol[:, None, :] - qcol[:, :, None], -(WIN_C - 1), WIN_C - 1)
    return wr, row_start, row_off, kcol, col_off, col_mask


def neighbourhood_attention(q, k, v, k_ctx, v_ctx, rpb):
    bsz, n, h, dh = q.shape
    rows = n // GRID_W
    wr, row_start, row_off, kcol, col_off, col_mask = na_geometry(rows)
    nqb = GRID_W // Q_COLS
    scale = dh ** -0.5
    kg = k.reshape(bsz, rows, GRID_W, h, dh)
    vg = v.reshape(bsz, rows, GRID_W, h, dh)
    bias = rpb[:, (row_off + WIN_R - 1)[:, None, None, :, None], (col_off + WIN_C - 1)[None, :, :, None, :]]
    bias = jnp.where(col_mask[None, None, :, :, None, :], bias.astype(jnp.float32), NEG)
    bias = jnp.moveaxis(bias, 0, 1)
    q_rows = jnp.moveaxis(q.reshape(bsz, rows, nqb, Q_COLS, h, dh), 1, 0)
    n_loc = wr * KB_COLS

    def one_row(args):
        r0, q_row, b_row = args
        k_win = lax.dynamic_slice_in_dim(kg, r0, wr, axis=1)[:, :, kcol]
        v_win = lax.dynamic_slice_in_dim(vg, r0, wr, axis=1)[:, :, kcol]
        s_loc = jnp.einsum('bjqhd,bijkhd->bhjqik', q_row, k_win,
                           preferred_element_type=jnp.float32) * scale + b_row[None]
        s_ctx = jnp.einsum('bjqhd,bmhd->bhjqm', q_row, k_ctx,
                           preferred_element_type=jnp.float32) * scale
        s = jnp.concatenate([s_loc.reshape(s_loc.shape[:4] + (n_loc,)), s_ctx], axis=-1)
        p = jax.nn.softmax(s, axis=-1).astype(v.dtype)
        p_loc = p[..., :n_loc].reshape(s_loc.shape)
        return (jnp.einsum('bhjqik,bijkhd->bjqhd', p_loc, v_win) +
                jnp.einsum('bhjqm,bmhd->bjqhd', p[..., n_loc:], v_ctx))

    out = lax.map(one_row, (jnp.asarray(row_start, dtype=jnp.int32), q_rows, bias))
    return jnp.moveaxis(out, 0, 1).reshape(bsz, n, h * dh)


def context_attention(q, k, v):
    scale = q.shape[-1] ** -0.5
    s = jnp.einsum('bqhd,bkhd->bhqk', q, k, preferred_element_type=jnp.float32) * scale
    p = jax.nn.softmax(s, axis=-1).astype(v.dtype)
    o = jnp.einsum('bhqk,bkhd->bqhd', p, v)
    return o.reshape(o.shape[:2] + (o.shape[2] * o.shape[3],))


def axial_rope(x):
    n, d = x.shape[1], x.shape[-1]
    half = d // 2
    nf = half // 2
    t = jnp.arange(n)
    inv = ROPE_BASE ** (-jnp.arange(nf, dtype=jnp.float32) / nf)

    def rotate(xp, pos):
        ang = pos.astype(jnp.float32)[:, None] * inv[None, :]
        cos = jnp.cos(ang)[None, :, None, :].astype(x.dtype)
        sin = jnp.sin(ang)[None, :, None, :].astype(x.dtype)
        x1, x2 = xp[..., :nf], xp[..., nf:]
        return jnp.concatenate([x1 * cos - x2 * sin, x1 * sin + x2 * cos], axis=-1)

    return jnp.concatenate([rotate(x[..., :half], t // GRID_W), rotate(x[..., half:], t % GRID_W)], axis=-1)


def retention_scan(q, k, v, log_gamma, state0, include_diag):
    bsz, n, h, _ = q.shape
    dv = v.shape[-1]
    pos = jnp.arange(CHUNK, dtype=jnp.float32)
    dist = pos[:, None] - pos[None, :]
    tri = np.tril(np.ones((CHUNK, CHUNK), dtype=bool), 0 if include_diag else -1)
    intra = jnp.where(tri[None], jnp.exp(jnp.maximum(dist, 0.0)[None] * log_gamma[:, None, None]), 0.0)
    q_decay = jnp.exp((pos + 1.0)[None, :] * log_gamma[:, None])
    k_decay = jnp.exp((CHUNK - 1.0 - pos)[None, :] * log_gamma[:, None])
    chunk_decay = jnp.exp(CHUNK * log_gamma)

    def to_chunks(t):
        return jnp.moveaxis(t.astype(jnp.float32).reshape(bsz, n // CHUNK, CHUNK, h, t.shape[-1]), 1, 0)

    def step(state, xs):
        qc, kc, vc = xs
        inner = jnp.einsum('bhij,bjhe->bihe', jnp.einsum('bihd,bjhd->bhij', qc, kc) * intra, vc)
        cross = jnp.einsum('bihd,bhde->bihe', qc, state) * q_decay.T[None, :, :, None]
        state = (state * chunk_decay[None, :, None, None] +
                 jnp.einsum('bjhd,bjhe->bhde', kc * k_decay.T[None, :, :, None], vc))
        return state, inner + cross

    state, out = lax.scan(step, state0, (to_chunks(q), to_chunks(k), to_chunks(v)))
    return jnp.moveaxis(out, 0, 1).reshape(bsz, n, h, dv), state


def flip_seq(t):
    return jnp.flip(t, axis=1)


def bidirectional_retention(q, k, v, q_c, k_c, v_c, decay_logit):
    log_g = jax.nn.log_sigmoid(decay_logit.astype(jnp.float32))
    k = k * RET_DK ** -0.5
    k_c = k_c * RET_DK ** -0.5
    state0 = jnp.zeros((q.shape[0], RET_HEADS, RET_DK, RET_DV), jnp.float32)
    out_cf, st_f = retention_scan(q_c, k_c, v_c, log_g[0], state0, True)
    out_cb, st_b = retention_scan(flip_seq(q_c), flip_seq(k_c), flip_seq(v_c), log_g[1], state0, False)
    out_f, _ = retention_scan(q, k, v, log_g[0], st_f, True)
    out_b, _ = retention_scan(flip_seq(q), flip_seq(k), flip_seq(v), log_g[1], st_b, False)
    return out_f + flip_seq(out_b), out_cf + flip_seq(out_cb)


def retention_readout(o, gate):
    o = o * lax.rsqrt(jnp.mean(o * o, axis=-1, keepdims=True) + EPS)
    return o.reshape(o.shape[:2] + (RET_V_W,)).astype(gate.dtype) * jax.nn.silu(gate)


def merge_branches(br_a, br_b, br_c, g_a, g_b, g_c, w_branch, w_out):
    m = (jax.nn.sigmoid(g_a) * (br_a @ w_branch[0]) +
         jax.nn.sigmoid(g_b) * (br_b @ w_branch[1]) +
         jax.nn.sigmoid(g_c) * (br_c @ w_branch[2]))
    return m @ w_out


def hybrid_mixer(z, zc, cm_ln_g, cm_ln_b, cm_w_s, cm_b_s, na_rpb, ret_decay_logit, w_branch, w_out, need_ctx):
    (a_u, a_v, n_q, n_k, n_v, r_q, r_k, r_v, r_g, g_a, g_b, g_c) = split_in_proj(z)
    (ca_u, ca_v, cn_q, cn_k, cn_v, cr_q, cr_k, cr_v, cr_g, cg_a, cg_b, cg_c) = split_in_proj(zc)
    k_ctx = split_heads(cn_k, NA_HEADS)
    v_ctx = split_heads(cn_v, NA_HEADS)
    a_lat = chunk_spatial_gating(a_u, a_v, cm_ln_g, cm_ln_b, cm_w_s, cm_b_s)
    b_lat = neighbourhood_attention(split_heads(n_q, NA_HEADS), split_heads(n_k, NA_HEADS),
                                    split_heads(n_v, NA_HEADS), k_ctx, v_ctx, na_rpb)
    ret_lat, ret_ctx = bidirectional_retention(
        axial_rope(split_heads(r_q, RET_HEADS)), axial_rope(split_heads(r_k, RET_HEADS)),
        split_heads(r_v, RET_HEADS), split_heads(cr_q, RET_HEADS), split_heads(cr_k, RET_HEADS),
        split_heads(cr_v, RET_HEADS), ret_decay_logit)
    c_lat = retention_readout(ret_lat, r_g)
    out = merge_branches(a_lat, b_lat, c_lat, g_a, g_b, g_c, w_branch, w_out)
    if not need_ctx:
        return out, None
    a_c = chunk_spatial_gating(ca_u, ca_v, cm_ln_g, cm_ln_b, cm_w_s, cm_b_s)
    b_c = context_attention(split_heads(cn_q, NA_HEADS), k_ctx, v_ctx)
    c_c = retention_readout(ret_ctx, cr_g)
    out_c = merge_branches(a_c, b_c, c_c, cg_a, cg_b, cg_c, w_branch, w_out)
    return out, out_c


def moe(h, router_w, router_bias, w_gate, w_up, w_down, s_gate, s_up, s_down):
    n, d = h.shape
    scores = jax.nn.sigmoid((h @ router_w).astype(jnp.float32))
    biased = scores + router_bias.astype(jnp.float32)
    grp = biased.reshape(n, N_GROUPS, N_EXPERTS // N_GROUPS)
    grp_score = jnp.sum(lax.top_k(grp, 2)[0], axis=-1)
    top_groups = lax.top_k(grp_score, TOPK_GROUPS)[1]
    grp_sel = jnp.any(top_groups[:, :, None] == jnp.arange(N_GROUPS)[None, None, :], axis=1)
    cand = jnp.where(grp_sel[:, :, None], grp, -jnp.inf).reshape(n, N_EXPERTS)
    idx = lax.top_k(cand, TOP_K)[1]
    w = jnp.take_along_axis(scores, idx, axis=-1)
    w = w / jnp.sum(w, axis=-1, keepdims=True) * ROUTED_SCALE
    combine = jnp.einsum('nk,nke->ne', w, jax.nn.one_hot(idx, N_EXPERTS, dtype=jnp.float32)).astype(h.dtype)
    hb = h.reshape(n // MOE_BLOCK, MOE_BLOCK, d)
    cb = combine.reshape(n // MOE_BLOCK, MOE_BLOCK, N_EXPERTS)

    def block(args):
        xb, gb = args
        a = jnp.einsum('td,edf->tef', xb, w_gate)
        u = jnp.einsum('td,edf->tef', xb, w_up)
        return jnp.einsum('tef,efd->td', jax.nn.silu(a) * u * gb[..., None], w_down)

    routed = lax.map(block, (hb, cb)).reshape(n, d)
    shared = (jax.nn.silu(h @ s_gate) * (h @ s_up)) @ s_down
    return routed + shared


def setup_inputs(seed: int = 0) -> dict:
    key = jax.random.key(seed)
    ks = jax.random.split(key, 32)
    f32 = jnp.float32
    D = D_MODEL

    def nrm(k, shape, scale):
        return jax.random.normal(k, shape, f32) * scale

    a = 5.0 + np.arange(RET_HEADS, dtype=np.float32)
    decay_base = jnp.asarray(np.log(2.0 ** a - 1.0), dtype=f32)
    return {
        'x': nrm(ks[0], (BATCH, SEQ, D), 1.0),
        'c': nrm(ks[1], (BATCH, D), 1.0),
        'ctx': nrm(ks[2], (BATCH, CTX_LEN, D), 1.0),
        'c_ctx': nrm(ks[3], (D,), 1.0),
        'w_ada': nrm(ks[4], (DEPTH, D, 6 * D), 0.5 * D ** -0.5),
        'b_ada': nrm(ks[5], (DEPTH, 6 * D), 0.02),
        'norm_mix_g': 1.0 + nrm(ks[6], (DEPTH, D), 0.02),
        'norm_ffn_g': 1.0 + nrm(ks[7], (DEPTH, D), 0.02),
        'w_in': nrm(ks[8], (DEPTH, D, IN_W), D ** -0.5),
        'cm_ln_g': 1.0 + nrm(ks[9], (DEPTH, CM_WIDTH), 0.02),
        'cm_ln_b': nrm(ks[10], (DEPTH, CM_WIDTH), 0.02),
        'cm_w_s': nrm(ks[11], (DEPTH, CM_GROUPS, CHUNK, CHUNK), CHUNK ** -0.5),
        'cm_b_s': 1.0 + nrm(ks[12], (DEPTH, CM_GROUPS, CHUNK), 0.02),
        'na_rpb': nrm(ks[13], (DEPTH, NA_HEADS, 2 * WIN_R - 1, 2 * WIN_C - 1), 0.02),
        'ret_decay_logit': decay_base + nrm(ks[14], (DEPTH, 2, RET_HEADS), 0.05),
        'w_branch': nrm(ks[15], (DEPTH, N_BRANCH, BR_W, D), BR_W ** -0.5),
        'w_out': nrm(ks[16], (DEPTH, D, D), D ** -0.5),
        'router_w': nrm(ks[17], (DEPTH, D, N_EXPERTS), D ** -0.5),
        'router_bias': nrm(ks[18], (DEPTH, N_EXPERTS), 0.01),
        'exp_w_gate': nrm(ks[19], (DEPTH, N_EXPERTS, D, EXPERT_W), D ** -0.5),
        'exp_w_up': nrm(ks[20], (DEPTH, N_EXPERTS, D, EXPERT_W), D ** -0.5),
        'exp_w_down': nrm(ks[21], (DEPTH, N_EXPERTS, EXPERT_W, D), EXPERT_W ** -0.5),
        'sh_w_gate': nrm(ks[22], (DEPTH, D, SHARED_W), D ** -0.5),
        'sh_w_up': nrm(ks[23], (DEPTH, D, SHARED_W), D ** -0.5),
        'sh_w_down': nrm(ks[24], (DEPTH, SHARED_W, D), SHARED_W ** -0.5),
        'final_g': 1.0 + nrm(ks[25], (D,), 0.02),
    }


def reference(x, c, ctx, c_ctx, w_ada, b_ada, norm_mix_g, norm_ffn_g, w_in, cm_ln_g, cm_ln_b, cm_w_s, cm_b_s,
              na_rpb, ret_decay_logit, w_branch, w_out, router_w, router_bias, exp_w_gate, exp_w_up, exp_w_down,
              sh_w_gate, sh_w_up, sh_w_down, final_g):
    bsz, n, d = x.shape
    xc = ctx
    for l in range(DEPTH):
        need_ctx = l < DEPTH - 1
        mod = jax.nn.silu(c) @ w_ada[l] + b_ada[l]
        mod_c = jax.nn.silu(c_ctx) @ w_ada[l] + b_ada[l]
        sh1, sc1, ga1, sh2, sc2, ga2 = jnp.split(mod[:, None, :], 6, axis=-1)
        sh1c, sc1c, ga1c, sh2c, sc2c, ga2c = jnp.split(mod_c, 6)
        h = rms_norm(x, norm_mix_g[l]) * (1.0 + sc1) + sh1
        hc = rms_norm(xc, norm_mix_g[l]) * (1.0 + sc1c) + sh1c
        mix, mix_c = hybrid_mixer(h @ w_in[l], hc @ w_in[l], cm_ln_g[l], cm_ln_b[l], cm_w_s[l], cm_b_s[l],
                                  na_rpb[l], ret_decay_logit[l], w_branch[l], w_out[l], need_ctx)
        x = x + ga1 * mix
        h = rms_norm(x, norm_ffn_g[l]) * (1.0 + sc2) + sh2
        y = moe(h.reshape(bsz * n, d), router_w[l], router_bias[l], exp_w_gate[l], exp_w_up[l], exp_w_down[l],
                sh_w_gate[l], sh_w_up[l], sh_w_down[l])
        x = x + ga2 * y.reshape(bsz, n, d)
        if need_ctx:
            xc = xc + ga1c * mix_c
            hc = rms_norm(xc, norm_ffn_g[l]) * (1.0 + sc2c) + sh2c
            yc = moe(hc.reshape(-1, d), router_w[l], router_bias[l], exp_w_gate[l], exp_w_up[l], exp_w_down[l],
                     sh_w_gate[l], sh_w_up[l], sh_w_down[l])
            xc = xc + ga2c * yc.reshape(xc.shape)
    return rms_norm(x, final_g)
```

```cpp
#include <hip/hip_runtime.h>
#include <stdint.h>
#include <stdio.h>

#define LAS __attribute__((address_space(3)))
typedef unsigned short bf16_t;
typedef short bf16x8 __attribute__((ext_vector_type(8)));
typedef short bf16x4 __attribute__((ext_vector_type(4)));
typedef float f32x4 __attribute__((ext_vector_type(4)));
typedef float f32x2 __attribute__((ext_vector_type(2)));
typedef unsigned u32x4 __attribute__((ext_vector_type(4)));
typedef unsigned u32x2 __attribute__((ext_vector_type(2)));

constexpr int D = 1024, NB = 8, SEQ = 2048, CTXL = 256, DEPTH = 2;
constexpr int NL = NB * SEQ;
constexpr int NC = NB * CTXL;
constexpr int NT = NL + NC;
constexpr int INW = 7168;
constexpr int ZC_AU = 0, ZC_AV = 512, ZC_NQ = 1024, ZC_NK = 1536, ZC_NV = 2048, ZC_RQ = 2560, ZC_RK = 2816, ZC_RV = 3072, ZC_RG = 3584,
              ZC_GA = 4096;
constexpr int BRW = 1536;
constexpr int NEXP = 64, TOPK = 8, EXPW = 256;
constexpr int NCHUNK = 18;
constexpr float EPS = 1e-6f;
constexpr int NTHREADS = 512, NWAVES = 8;
constexpr int LDS_BYTES = 159744;

constexpr size_t MiB = 1u << 20;
constexpr size_t WS_CTL = 0, CTL_BYTES = 1 * MiB;
constexpr size_t WS_MOD = 1 * MiB;
constexpr size_t WS_ROPE = 1 * MiB + 512 * 1024;
constexpr size_t WS_WM = 2 * MiB, WM_STRIDE = 21 * MiB;
constexpr size_t WM_IN = 0, WM_BR = 14680064, WM_OUT = WM_BR + 3145728, WM_SGU = WM_OUT + 2097152, WM_SD = WM_SGU + 1048576,
                 WM_RT = WM_SD + 524288, WM_CM = WM_RT + 131072, WM_END = WM_CM + 131072;
static_assert(WM_END <= WM_STRIDE, "misc weights");
constexpr size_t WS_WE = 44 * MiB;
constexpr size_t WE_GU = 0, WE_D = 67108864;
constexpr size_t WS_XC = 140 * MiB;
constexpr size_t WS_H = 148 * MiB;
constexpr size_t WS_LIST = 184 * MiB, WS_WL = 189 * MiB;
constexpr size_t WS_R = 194 * MiB;
constexpr size_t R_Z = 0, R_BR = 252 * MiB, R_KV = 306 * MiB;
constexpr size_t R_O = 0, R_ACT = 288 * MiB, R_ACTS = 368 * MiB;
constexpr size_t WS_END = WS_R + 377 * MiB;
static_assert(R_KV + 37748736 <= 377 * MiB && R_ACTS + 9437184 <= 377 * MiB && R_Z + 264241152 <= R_BR && R_BR + 56623104 <= R_KV, "region map");
static_assert(R_O + 301989888 <= R_ACT && R_ACT + 83886080 <= R_ACTS, "region map 2");
constexpr int CW_BAR = 4096;
constexpr int CW_CNT = 200000;

__device__ __forceinline__ float bf2f(unsigned short b) { return __uint_as_float(((unsigned)b) << 16); }
__device__ __forceinline__ unsigned f2bf(float f) { unsigned u = __float_as_uint(f); return (u + 0x7fffu + ((u >> 16) & 1u)) >> 16; }
__device__ __forceinline__ unsigned pk2(float lo, float hi) { return f2bf(lo) | (f2bf(hi) << 16); }
__device__ __forceinline__ float lo16(unsigned w) { return __uint_as_float(w << 16); }
__device__ __forceinline__ float hi16(unsigned w) { return __uint_as_float(w & 0xffff0000u); }
__device__ __forceinline__ float wave_sum(float v) {
#pragma unroll
    for (int o = 1; o < 64; o <<= 1) v += __shfl_xor(v, o);
    return v;
}
__device__ __forceinline__ float fast_exp(float x) { return __builtin_amdgcn_exp2f(x * 1.44269504089f); }
__device__ __forceinline__ float sigmoidf_(float x) { return __builtin_amdgcn_rcpf(1.0f + fast_exp(-x)); }
__device__ __forceinline__ float siluf_(float x) { return x * sigmoidf_(x); }
__device__ __forceinline__ float geluf_(float x) { const float u = 0.7978845608f * (x + 0.044715f * x * x * x); return x * sigmoidf_(2.0f * u); }
__device__ __forceinline__ f32x4 mfma16(bf16x8 a, bf16x8 b, f32x4 c) { return __builtin_amdgcn_mfma_f32_16x16x32_bf16(a, b, c, 0, 0, 0); }
__device__ __forceinline__ bf16x8 as_frag(u32x4 v) { return __builtin_bit_cast(bf16x8, v); }
__device__ __forceinline__ int launder(int v) { asm volatile("" : "+v"(v)); return v; }
__device__ __forceinline__ int launder_s(int v) { asm volatile("" : "+s"(v)); return v; }
template <class T> __device__ __forceinline__ T* launder_p(T* q) { asm volatile("" : "+s"(q)); return q; }
#define LDS_WAIT() asm volatile("s_waitcnt lgkmcnt(0)" ::: "memory")
#define VM_WAIT() asm volatile("s_waitcnt vmcnt(0)" ::: "memory")

__device__ __forceinline__ bf16x8 tr_frag(unsigned base, int stride, int r0, int r1, int c0, int lane) {
    const int q = (lane & 15) >> 2, p = lane & 3;
    const unsigned a0 = base + (unsigned)((r0 + q) * stride + (c0 + 4 * p) * 2), a1 = base + (unsigned)((r1 + q) * stride + (c0 + 4 * p) * 2);
    bf16x4 lo, hi;
    asm volatile("ds_read_b64_tr_b16 %0, %2\n\tds_read_b64_tr_b16 %1, %3\n\ts_waitcnt lgkmcnt(0)" : "=&v"(lo), "=&v"(hi) : "v"(a0), "v"(a1) : "memory");
    bf16x8 r; r[0] = lo[0]; r[1] = lo[1]; r[2] = lo[2]; r[3] = lo[3]; r[4] = hi[0]; r[5] = hi[1]; r[6] = hi[2]; r[7] = hi[3];
    return r;
}
__device__ __forceinline__ unsigned lds_addr(LAS unsigned char* p) { return (unsigned)(size_t)p; }
template <int O0, int O1> __device__ __forceinline__ bf16x8 tr_frag_i(unsigned a) {
    static_assert(O0 >= 0 && O0 < 65536 && O1 >= 0 && O1 < 65536, "ds offset field");
    bf16x4 lo, hi;
    asm volatile("ds_read_b64_tr_b16 %0, %2 offset:%3\n\tds_read_b64_tr_b16 %1, %2 offset:%4\n\ts_waitcnt lgkmcnt(0)" : "=&v"(lo), "=&v"(hi) : "v"(a), "n"(O0), "n"(O1) : "memory");
    bf16x8 r; r[0] = lo[0]; r[1] = lo[1]; r[2] = lo[2]; r[3] = lo[3]; r[4] = hi[0]; r[5] = hi[1]; r[6] = hi[2]; r[7] = hi[3];
    return r;
}
__device__ __forceinline__ unsigned tr_lane(unsigned base, int stride, int rmul, int lane) { return base + (unsigned)((rmul * (lane >> 4) + ((lane & 15) >> 2)) * stride + (lane & 3) * 8); }
template <int V> struct IC { static constexpr int value = V; };
template <int I, int N, class F> __device__ __forceinline__ void sfor(F&& f) { if constexpr (I < N) { f(IC<I>{}); sfor<I + 1, N>(f); } }


#define XB_TMO      128
#define XB_XCNT(j)  (256  + 64 * (j))
#define XB_XSUB(j)  (1280 + 64 * (j))
#define XB_XGEN(j)  (2304 + 64 * (j))
#define XB_TOP      3328
#define XB_TOPGEN   3392
#define XCD_BAR_WORDS 3456
#define XB_SPIN_CAP (1u << 21)
__device__ __forceinline__ unsigned xb_ld(unsigned* p)              { return __hip_atomic_load(p, __ATOMIC_RELAXED, __HIP_MEMORY_SCOPE_AGENT); }
__device__ __forceinline__ unsigned xb_add(unsigned* p, unsigned v) { return __hip_atomic_fetch_add(p, v, __ATOMIC_RELAXED, __HIP_MEMORY_SCOPE_AGENT); }
__device__ __forceinline__ unsigned xb_xcc_id() { return (unsigned)__builtin_amdgcn_s_getreg((3 << 11) | 20) & 0xFu; }
#define XB_SPIN(cond, bar) do { unsigned _sp = 0; while (cond) { __builtin_amdgcn_s_sleep(1); \
    if ((++_sp & 255u) == 0u) { if (xb_ld(&(bar)[XB_TMO])) break; if (_sp > XB_SPIN_CAP) { atomicAdd(&(bar)[XB_TMO], 1u); break; } } } } while (0)
struct XcdBarrier { unsigned* bar; unsigned x; volatile LAS unsigned* st; };
__device__ __forceinline__ XcdBarrier xcd_barrier_post(unsigned* bar, volatile LAS unsigned* st) {
    XcdBarrier b; b.bar = bar; b.x = xb_xcc_id(); b.st = st;
    if (threadIdx.x == 0) (void)xb_add(&bar[XB_XCNT(b.x)], 1u);
    return b;
}
__device__ __forceinline__ void xcd_barrier_complete(unsigned* bar, unsigned x, unsigned& nloc, unsigned& nx) {
    const unsigned G = gridDim.x * gridDim.y * gridDim.z;
    unsigned sum, cnt, mine, sp = 0u;
    for (;;) {
        sum = 0u; cnt = 0u; mine = 0u;
#pragma unroll
        for (unsigned j = 0; j < 16; ++j) { const unsigned c = xb_ld(&bar[XB_XCNT(j)]); sum += c; cnt += (c > 0u) ? 1u : 0u; mine = (j == x) ? c : mine; }
        if (sum == G) break;
        __builtin_amdgcn_s_sleep(1);
        if ((++sp & 255u) == 0u) { if (xb_ld(&bar[XB_TMO])) break; if (sp > XB_SPIN_CAP) { atomicAdd(&bar[XB_TMO], 1u); break; } }
    }
    nloc = mine > 0u ? mine : 1u; nx = cnt > 0u ? cnt : 1u;
}
__device__ __forceinline__ void xcd_barrier(const XcdBarrier& b) {
    asm volatile("s_waitcnt vmcnt(0)" ::: "memory");
    __syncthreads();
    if (threadIdx.x == 0) {
        unsigned* bar = b.bar;
        __builtin_amdgcn_s_waitcnt(0);
        unsigned nloc = b.st[0], nx = b.st[1];
        if (nloc == 0u) { xcd_barrier_complete(bar, b.x, nloc, nx); b.st[0] = nloc; b.st[1] = nx; }
        const unsigned old = xb_add(&bar[XB_XSUB(b.x)], 1u);
        const unsigned gen = old / nloc;
        if (old + 1u == (gen + 1u) * nloc) {
            __builtin_amdgcn_fence(__ATOMIC_RELEASE, "agent");
            asm volatile("s_waitcnt vmcnt(0)" ::: "memory");
            const unsigned og = xb_add(&bar[XB_TOP], 1u);
            const unsigned tg = og / nx;
            if (og + 1u == (tg + 1u) * nx) xb_add(&bar[XB_TOPGEN], 1u);
            else XB_SPIN(xb_ld(&bar[XB_TOPGEN]) == tg, bar);
            __builtin_amdgcn_fence(__ATOMIC_ACQUIRE, "agent");
            xb_add(&bar[XB_XGEN(b.x)], 1u);
            asm volatile("s_waitcnt vmcnt(0)" ::: "memory");
        } else {
            XB_SPIN(xb_ld(&bar[XB_XGEN(b.x)]) == gen, bar);
            __builtin_amdgcn_fence(__ATOMIC_ACQUIRE, "agent");
            asm volatile("s_waitcnt vmcnt(0)" ::: "memory");
        }
    }
    __syncthreads();
}

namespace pg8 {
constexpr int BM = 256, BK = 64, HALF = 128, HTB = HALF * BK * 2, STAGE_BYTES = 8 * HTB, NXCD = 8, WGM = 8;
constexpr int GATHER_SLOT_OFF = 133120;
__device__ __forceinline__ int lds_byte(int r, int c) { const int st = (r >> 4) * 2 + (c >> 5), rr = r & 15, cc = c & 31, ob = rr * 64 + cc * 2; return st * 1024 + (ob ^ (((ob >> 9) & 1) << 5)); }
__device__ __forceinline__ void stage_rc(int b, int& R, int& C) { const int st = b / 1024, sb = b % 1024, swz = sb ^ (((sb >> 9) & 1) << 5); R = (st >> 1) * 16 + swz / 64; C = (st & 1) * 32 + (swz % 64) / 2; }
__device__ __forceinline__ int perm32(int rho) { const int n = rho >> 4, i = rho & 15; return 8 * (i >> 2) + 4 * n + (i & 3); }

struct Unit { const char* A; const char* B; int e0, e1, e2, e3, e4; };

__device__ __forceinline__ bool static_tile(int i, int G, int c, int nM, int nN, int& pm, int& pn) {
    const int nwg = nM * nN; const long L = (long)i * G + c; if (L >= nwg) return false;
    int wgid = (int)L; { const int q = nwg / NXCD, r = nwg % NXCD, xcd = wgid % NXCD, off = wgid / NXCD; wgid = (xcd < r ? xcd * (q + 1) : r * (q + 1) + (xcd - r) * q) + off; }
    const int nig = WGM * nN, gid = wgid / nig, fm = gid * WGM, gsz = (nM - fm) < WGM ? (nM - fm) : WGM;
    pm = fm + ((wgid % nig) % gsz); pn = (wgid % nig) / gsz; return true;
}

template <class Epi, class Sched>
__device__ __forceinline__ void gemm_phase(LAS unsigned char* lds, const int tid, const int K, const int ldb  , const Sched& S, const Epi& E) {
    const int wid = __builtin_amdgcn_readfirstlane(tid >> 6), lane = tid & 63, wr = wid >> 2, wc = wid & 3, fr = lane & 15, fq = lane >> 4;
    const int nt = K / BK;
    unsigned voffB[2];
#pragma unroll
    for (int i = 0; i < 2; ++i) { int R, C; stage_rc(tid * 16 + i * 8192, R, C); const int Rb = Epi::PERM ? ((R & ~31) + perm32(R & 31)) : R; voffB[i] = (unsigned)(Rb * ldb + C) * 2u; }
    const size_t kstep = (size_t)(BK * 2);
    const size_t hstepB = (size_t)HALF * ldb * 2;
    const unsigned ldsw = (unsigned)wid * 1024u;
    const int aoff = lds_byte(wr * 64 + fr, fq * 8), boff = lds_byte(wc * 32 + fr, fq * 8);
#define PG8_SA(b, h) (((b) * 2 + (h)) * HTB)
#define PG8_SB(b, h) ((4 + (b) * 2 + (h)) * HTB)
#define PG8_STAGE(bufoff, gbase, voff) do { _Pragma("unroll") for (int _i = 0; _i < 2; ++_i) \
        __builtin_amdgcn_global_load_lds((const unsigned*)((const char*)(gbase) + (voff)[_i]), (LAS unsigned*)(lds + (bufoff) + ldsw + _i * 8192), 16, 0, 0); } while (0)
#define PG8_LDA(dst, b, h) do { _Pragma("unroll") for (int m = 0; m < 4; ++m) _Pragma("unroll") for (int k = 0; k < 2; ++k) dst[m][k] = *(const LAS bf16x8*)(lds + PG8_SA(b, h) + aoff + m * 2048 + k * 1024); } while (0)
#define PG8_LDB(dst, b, h) do { _Pragma("unroll") for (int n = 0; n < 2; ++n) _Pragma("unroll") for (int k = 0; k < 2; ++k) dst[n][k] = *(const LAS bf16x8*)(lds + PG8_SB(b, h) + boff + n * 2048 + k * 1024); } while (0)
#define PG8_MMA(ai, bj, At, Bt) do { __builtin_amdgcn_s_setprio(1); _Pragma("unroll") for (int m = 0; m < 4; ++m) _Pragma("unroll") for (int n = 0; n < 2; ++n) _Pragma("unroll") for (int k = 0; k < 2; ++k) \
        acc[ai][bj][m][n] = __builtin_amdgcn_mfma_f32_16x16x32_bf16(Bt[n][k], At[m][k], acc[ai][bj][m][n], 0, 0, 0); __builtin_amdgcn_s_setprio(0); } while (0)
#define PG8_WAIT_V(n) asm volatile("s_waitcnt vmcnt(" #n ")" ::: "memory")
#define PG8_WAIT_L(n) asm volatile("s_waitcnt lgkmcnt(" #n ")" ::: "memory")
#define PG8_BAR __builtin_amdgcn_s_barrier()
#define PG8_SCHED __builtin_amdgcn_sched_barrier(0)
    Unit cur, nxt; int ui = 0;
    if (!S.next(0, cur)) return;
    unsigned cvA[2][2], nvA[2][2];
    S.a_offs(cur, tid, cvA);
    LAS unsigned* const gslot = (LAS unsigned*)(lds + GATHER_SLOT_OFF) + tid * 4;
    if constexpr (Sched::GATHER) { *(LAS u32x4*)gslot = (u32x4){cvA[0][0], cvA[0][1], cvA[1][0], cvA[1][1]}; }
    f32x4 acc[2][2][4][2];
#pragma unroll
    for (int a = 0; a < 2; ++a)
#pragma unroll
        for (int b = 0; b < 2; ++b)
#pragma unroll
            for (int m = 0; m < 4; ++m)
#pragma unroll
                for (int n = 0; n < 2; ++n) acc[a][b][m][n] = (f32x4){0.f, 0.f, 0.f, 0.f};
    bf16x8 At[4][2], B0[2][2], B1[2][2];
    const char* cA = cur.A; const char* cB = cur.B;
    PG8_STAGE(PG8_SB(0, 0), cB, voffB); PG8_STAGE(PG8_SA(0, 0), cA, cvA[0]); PG8_STAGE(PG8_SB(0, 1), cB + hstepB, voffB); PG8_STAGE(PG8_SA(0, 1), cA, cvA[1]);
    if (wr == 1) PG8_BAR;
    PG8_WAIT_V(4); PG8_BAR;
    PG8_STAGE(PG8_SB(1, 0), cB + kstep, voffB); PG8_STAGE(PG8_SA(1, 0), cA + kstep, cvA[0]); PG8_STAGE(PG8_SB(1, 1), cB + hstepB + kstep, voffB);
    PG8_WAIT_V(6); PG8_BAR;
    for (;;) {
        const bool has_next = S.next(ui + 1, nxt);
        if (has_next) S.a_offs(nxt, tid, nvA);
        else {
#pragma unroll
            for (int h = 0; h < 2; ++h)
#pragma unroll
                for (int i = 0; i < 2; ++i) nvA[h][i] = cvA[h][i];
        }
        if constexpr (Sched::GATHER) { *(LAS u32x4*)(gslot + ((ui + 1) & 1) * 2048) = (u32x4){nvA[0][0], nvA[0][1], nvA[1][0], nvA[1][1]}; }
        const char* nA = has_next ? nxt.A : cA; const char* nB = has_next ? nxt.B : cB;
#pragma unroll 1
        for (int t = 0; t < nt; t += 2) {
            const bool last = (t == nt - 2);
            const char* a1 = cA + (size_t)(t + 1) * kstep;
            const char* a2 = last ? nA : cA + (size_t)(t + 2) * kstep; const char* b2 = last ? nB : cB + (size_t)(t + 2) * kstep;
            const char* a3 = a2 + kstep; const char* b3 = b2 + kstep;
            unsigned sA[2][2];
            if constexpr (Sched::GATHER) {
                const u32x4 cv = *(const LAS u32x4*)(gslot + (ui & 1) * 2048), sv = *(const LAS u32x4*)(gslot + ((ui + (last ? 1 : 0)) & 1) * 2048);
                cvA[0][0] = cv.x; cvA[0][1] = cv.y; cvA[1][0] = cv.z; cvA[1][1] = cv.w; sA[0][0] = sv.x; sA[0][1] = sv.y; sA[1][0] = sv.z; sA[1][1] = sv.w;
            } else {
#pragma unroll
                for (int h = 0; h < 2; ++h)
#pragma unroll
                    for (int i = 0; i < 2; ++i) sA[h][i] = last ? nvA[h][i] : cvA[h][i];
            }
            PG8_LDB(B0, 0, 0); PG8_SCHED; PG8_LDA(At, 0, 0); PG8_STAGE(PG8_SA(1, 1), a1, cvA[1]);
            PG8_WAIT_L(8); PG8_BAR; PG8_WAIT_L(0); PG8_MMA(0, 0, At, B0); PG8_BAR; PG8_SCHED;
            PG8_LDB(B1, 0, 1); PG8_STAGE(PG8_SB(0, 0), b2, voffB);
            PG8_BAR; PG8_WAIT_L(0); PG8_MMA(0, 1, At, B1); PG8_BAR;
            PG8_LDA(At, 0, 1); PG8_STAGE(PG8_SA(0, 0), a2, sA[0]);
            PG8_BAR; PG8_WAIT_L(0); PG8_MMA(1, 0, At, B0); PG8_BAR; PG8_SCHED;
            PG8_STAGE(PG8_SB(0, 1), b2 + hstepB, voffB);
            PG8_WAIT_V(6); PG8_BAR; PG8_MMA(1, 1, At, B1); PG8_BAR;
            PG8_LDB(B0, 1, 0); PG8_SCHED; PG8_LDA(At, 1, 0); PG8_STAGE(PG8_SA(0, 1), a2, sA[1]);
            PG8_WAIT_L(8); PG8_BAR; PG8_WAIT_L(0); PG8_MMA(0, 0, At, B0); PG8_BAR; PG8_SCHED;
            PG8_LDB(B1, 1, 1); PG8_STAGE(PG8_SB(1, 0), b3, voffB);
            PG8_BAR; PG8_WAIT_L(0); PG8_MMA(0, 1, At, B1); PG8_BAR;
            PG8_LDA(At, 1, 1); PG8_STAGE(PG8_SA(1, 0), a3, sA[0]);
            PG8_BAR; PG8_WAIT_L(0); PG8_MMA(1, 0, At, B0); PG8_BAR; PG8_SCHED;
            PG8_STAGE(PG8_SB(1, 1), b3 + hstepB, voffB);
            PG8_WAIT_V(6); PG8_BAR; PG8_MMA(1, 1, At, B1); PG8_BAR;
        }
        E(acc, cur, wr, wc, fr, fq);
        if (!has_next) break;
#pragma unroll
        for (int a = 0; a < 2; ++a)
#pragma unroll
            for (int b = 0; b < 2; ++b)
#pragma unroll
                for (int m = 0; m < 4; ++m)
#pragma unroll
                    for (int n = 0; n < 2; ++n) acc[a][b][m][n] = (f32x4){0.f, 0.f, 0.f, 0.f};
        cur = nxt; cA = nA; cB = nB; ++ui;
        if constexpr (!Sched::GATHER) {
#pragma unroll
            for (int h = 0; h < 2; ++h)
#pragma unroll
                for (int i = 0; i < 2; ++i) cvA[h][i] = nvA[h][i];
        }
    }
    PG8_WAIT_V(0);
    if (wr == 0) PG8_BAR;
    PG8_BAR;
#undef PG8_SA
#undef PG8_SB
#undef PG8_STAGE
#undef PG8_LDA
#undef PG8_LDB
#undef PG8_MMA
#undef PG8_WAIT_V
#undef PG8_WAIT_L
#undef PG8_BAR
#undef PG8_SCHED
}
}

using pg8::Unit;
struct DenseSched {
    static constexpr bool GATHER = false;
    const char* A; const char* B; int lda, ldb, nM, nN, G, c, nsub; size_t asub, bsub;
    __device__ __forceinline__ bool next(int i, Unit& u) const {
        const int sub = i % nsub, ti = i / nsub; int pm, pn;
        if (!pg8::static_tile(ti, G, c, nM, nN, pm, pn)) return false;
        u.A = A + (size_t)pm * 256 * lda * 2 + (size_t)sub * asub; u.B = B + (size_t)pn * 256 * ldb * 2 + (size_t)sub * bsub;
        u.e0 = pm; u.e1 = pn; u.e2 = sub; u.e3 = 0; u.e4 = 0; return true;
    }
    __device__ __forceinline__ void a_offs(const Unit&, int tid, unsigned (&vo)[2][2]) const {
#pragma unroll
        for (int i = 0; i < 2; ++i) { int R, C; pg8::stage_rc(tid * 16 + i * 8192, R, C);
#pragma unroll
            for (int h = 0; h < 2; ++h) vo[h][i] = (unsigned)((h * 128 + R) * lda + C) * 2u; }
    }
};
constexpr int MOE_TAB_OFF = 131072;
#define RFL(x) __builtin_amdgcn_readfirstlane(x)
__device__ __forceinline__ int moe_find_expert(const LAS int* tbase, int mt) {
    int lo = 0, hi = 63;
#pragma unroll
    for (int it = 0; it < 6; ++it) { const int mid = (lo + hi + 1) >> 1; if (RFL(tbase[mid]) <= mt) lo = mid; else hi = mid - 1; }
    return lo;
}
struct MoeGuSched {
    static constexpr bool GATHER = true;
    const char* H2; const char* WGU; const char* WSGU; const unsigned* list; const LAS int* tbase; const LAS int* cnt; int nMs, G, c;
    __device__ __forceinline__ bool next(int i, Unit& u) const {
        const int idx = i * G + c, ntr = RFL(tbase[64]);
        if (idx >= 2 * ntr + 2 * nMs) return false;
        if (idx < 2 * ntr) { const int mt = idx >> 1, nt = idx & 1, e = moe_find_expert(tbase, mt);
            u.A = H2; u.B = WGU + (size_t)e * (512 * 1024 * 2) + (size_t)nt * (256 * 1024 * 2); u.e0 = e; u.e1 = nt; u.e2 = (mt - RFL(tbase[e])) * 256; u.e3 = mt; u.e4 = RFL(cnt[e]); }
        else { const int s = idx - 2 * ntr, pm = s >> 1, nt = s & 1;
            u.A = H2 + (size_t)pm * 256 * 2048; u.B = WSGU + (size_t)nt * (256 * 1024 * 2); u.e0 = 64; u.e1 = nt; u.e2 = 0; u.e3 = pm; u.e4 = 0; }
        return true;
    }
    __device__ __forceinline__ void a_offs(const Unit& u, int tid, unsigned (&vo)[2][2]) const {
#pragma unroll
        for (int i = 0; i < 2; ++i) { int R, C; pg8::stage_rc(tid * 16 + i * 8192, R, C);
#pragma unroll
            for (int h = 0; h < 2; ++h) {
                if (u.e0 == 64) vo[h][i] = (unsigned)((h * 128 + R) * 1024 + C) * 2u;
                else { const int pos = u.e2 + h * 128 + R; unsigned tok = 0u; if (pos < u.e4) tok = list[(size_t)u.e0 * NT + pos] >> 3; vo[h][i] = tok * 2048u + (unsigned)C * 2u; } } }
    }
};
struct MoeDownSched {
    static constexpr bool GATHER = false;
    const char* ACT; const char* WD; const LAS int* tbase; const LAS int* cnt; int G, c;
    __device__ __forceinline__ bool next(int i, Unit& u) const {
        const int idx = i * G + c, ntr = RFL(tbase[64]);
        if (idx >= 4 * ntr) return false;
        const int mt = idx >> 2, pn = idx & 3, e = moe_find_expert(tbase, mt);
        u.A = ACT + (size_t)mt * (256 * 256 * 2); u.B = WD + (size_t)e * (1024 * 256 * 2) + (size_t)pn * (256 * 256 * 2);
        u.e0 = e; u.e1 = pn; u.e2 = (mt - RFL(tbase[e])) * 256; u.e3 = mt; u.e4 = RFL(cnt[e]); return true;
    }
    __device__ __forceinline__ void a_offs(const Unit&, int tid, unsigned (&vo)[2][2]) const {
#pragma unroll
        for (int i = 0; i < 2; ++i) { int R, C; pg8::stage_rc(tid * 16 + i * 8192, R, C);
#pragma unroll
            for (int h = 0; h < 2; ++h) vo[h][i] = (unsigned)((h * 128 + R) * 256 + C) * 2u; }
    }
};

struct EpiStoreBf16 {
    static constexpr bool PERM = true;
    bf16_t* O; int ldc;
    __device__ __forceinline__ void operator()(const f32x4 (&acc)[2][2][4][2], const Unit& u, int wr, int wc, int fr, int fq) const {
        const int row0 = u.e0 * 256 + launder(wr * 64 + fr), col0 = u.e1 * 256 + wc * 32 + 8 * fq;
#pragma unroll
        for (int ai = 0; ai < 2; ++ai)
#pragma unroll
            for (int m = 0; m < 4; ++m) { bf16_t* rowp = O + (size_t)(row0 + ai * 128 + m * 16) * ldc + col0;
#pragma unroll
                for (int bj = 0; bj < 2; ++bj) { const f32x4 v0 = acc[ai][bj][m][0], v1 = acc[ai][bj][m][1];
                    u32x4 w; w.x = pk2(v0[0], v0[1]); w.y = pk2(v0[2], v0[3]); w.z = pk2(v1[0], v1[1]); w.w = pk2(v1[2], v1[3]);
                    *(u32x4*)(rowp + bj * 128) = w; } }
    }
};
struct EpiMerge {
    static constexpr bool PERM = true;
    bf16_t* Mo; const bf16_t* Z;
    __device__ __forceinline__ void operator()(const f32x4 (&acc)[2][2][4][2], const Unit& u, int wr, int wc, int fr, int fq) const {
        const int row0 = u.e0 * 256 + launder(wr * 64 + fr), col0 = u.e1 * 256 + wc * 32 + 8 * fq, sub = u.e2;
#pragma unroll
        for (int ai = 0; ai < 2; ++ai)
#pragma unroll
            for (int m = 0; m < 4; ++m) { const size_t row = (size_t)(row0 + ai * 128 + m * 16);
#pragma unroll
                for (int bj = 0; bj < 2; ++bj) { const f32x4 v0 = acc[ai][bj][m][0], v1 = acc[ai][bj][m][1];
                    const u32x4 g = *(const u32x4*)(Z + row * INW + ZC_GA + 1024 * sub + col0 + bj * 128);
                    bf16_t* mp = Mo + row * 1024 + col0 + bj * 128;
                    u32x4 o = (u32x4){0u, 0u, 0u, 0u}; if (sub != 0) o = *(const u32x4*)mp;
                    float r[8];
                    r[0] = lo16(o.x) + sigmoidf_(lo16(g.x)) * v0[0]; r[1] = hi16(o.x) + sigmoidf_(hi16(g.x)) * v0[1];
                    r[2] = lo16(o.y) + sigmoidf_(lo16(g.y)) * v0[2]; r[3] = hi16(o.y) + sigmoidf_(hi16(g.y)) * v0[3];
                    r[4] = lo16(o.z) + sigmoidf_(lo16(g.z)) * v1[0]; r[5] = hi16(o.z) + sigmoidf_(hi16(g.z)) * v1[1];
                    r[6] = lo16(o.w) + sigmoidf_(lo16(g.w)) * v1[2]; r[7] = hi16(o.w) + sigmoidf_(hi16(g.w)) * v1[3];
                    u32x4 w; w.x = pk2(r[0], r[1]); w.y = pk2(r[2], r[3]); w.z = pk2(r[4], r[5]); w.w = pk2(r[6], r[7]);
                    *(u32x4*)mp = w; } }
    }
};
struct EpiResid {
    static constexpr bool PERM = false;
    const float* src_l; const float* src_c; float* dst_l; float* dst_c; const float* gate;
    __device__ __forceinline__ void operator()(const f32x4 (&acc)[2][2][4][2], const Unit& u, int wr, int wc, int fr, int fq) const {
        const int g0 = u.e0 * 256; const bool lat = g0 < NL;
        const float* src = lat ? src_l + (size_t)g0 * D : src_c + (size_t)(g0 - NL) * D;
        float* dst = lat ? dst_l + (size_t)g0 * D : dst_c + (size_t)(g0 - NL) * D;
        const float* gp = gate + (size_t)(lat ? (g0 >> 11) : 8) * 6144;
        const int row0 = launder(wr * 64 + fr), col0 = u.e1 * 256 + wc * 32 + 4 * fq;
        f32x4 gv[2][2];
#pragma unroll
        for (int bj = 0; bj < 2; ++bj)
#pragma unroll
            for (int n = 0; n < 2; ++n) gv[bj][n] = *(const f32x4*)(gp + col0 + bj * 128 + n * 16);
#pragma unroll
        for (int ai = 0; ai < 2; ++ai)
#pragma unroll
            for (int m = 0; m < 4; ++m) { const size_t ro = (size_t)(row0 + ai * 128 + m * 16) * D + col0;
#pragma unroll
                for (int bj = 0; bj < 2; ++bj)
#pragma unroll
                    for (int n = 0; n < 2; ++n) { const f32x4 s = *(const f32x4*)(src + ro + bj * 128 + n * 16);
                        *(f32x4*)(dst + ro + bj * 128 + n * 16) = s + gv[bj][n] * acc[ai][bj][m][n]; } }
    }
};
struct EpiGateUp {
    static constexpr bool PERM = true;
    bf16_t* ACT; bf16_t* ACTS; const float* wl;
    __device__ __forceinline__ void operator()(const f32x4 (&acc)[2][2][4][2], const Unit& u, int wr, int wc, int fr, int fq) const {
        const int row0 = launder(wr * 64 + fr), col0 = u.e1 * 128 + wc * 32 + 8 * fq;
        bf16_t* base = (u.e0 == 64 ? ACTS : ACT) + (size_t)u.e3 * 256 * 256;
#pragma unroll
        for (int ai = 0; ai < 2; ++ai)
#pragma unroll
            for (int m = 0; m < 4; ++m) { const int row = row0 + ai * 128 + m * 16; float w = 1.0f;
                if (u.e0 != 64) { const int pos = u.e2 + row; w = 0.0f; if (pos < u.e4) w = wl[(size_t)u.e0 * NT + pos]; }
                const f32x4 g0 = acc[ai][0][m][0], g1 = acc[ai][0][m][1], u0 = acc[ai][1][m][0], u1 = acc[ai][1][m][1];
                u32x4 o;
                o.x = pk2(siluf_(g0[0]) * u0[0] * w, siluf_(g0[1]) * u0[1] * w); o.y = pk2(siluf_(g0[2]) * u0[2] * w, siluf_(g0[3]) * u0[3] * w);
                o.z = pk2(siluf_(g1[0]) * u1[0] * w, siluf_(g1[1]) * u1[1] * w); o.w = pk2(siluf_(g1[2]) * u1[2] * w, siluf_(g1[3]) * u1[3] * w);
                *(u32x4*)(base + (size_t)row * 256 + col0) = o; }
    }
};
struct EpiDown {
    static constexpr bool PERM = true;
    bf16_t* O; const unsigned* list;
    __device__ __forceinline__ void operator()(const f32x4 (&acc)[2][2][4][2], const Unit& u, int wr, int wc, int fr, int fq) const {
        const int row0 = launder(wr * 64 + fr), col0 = u.e1 * 256 + wc * 32 + 8 * fq;
#pragma unroll
        for (int ai = 0; ai < 2; ++ai)
#pragma unroll
            for (int m = 0; m < 4; ++m) { const int pos = u.e2 + row0 + ai * 128 + m * 16;
                if (pos < u.e4) { const unsigned dest = list[(size_t)u.e0 * NT + pos]; bf16_t* rowp = O + (size_t)dest * 1024 + col0;
#pragma unroll
                    for (int bj = 0; bj < 2; ++bj) { const f32x4 v0 = acc[ai][bj][m][0], v1 = acc[ai][bj][m][1];
                        u32x4 w; w.x = pk2(v0[0], v0[1]); w.y = pk2(v0[2], v0[3]); w.z = pk2(v1[0], v1[1]); w.w = pk2(v1[2], v1[3]);
                        *(u32x4*)(rowp + bj * 128) = w; } } }
    }
};
struct EpiSharedDown {
    static constexpr bool PERM = true;
    float* x_l; float* x_c; const float* gate; const bf16_t* O;
    __device__ __forceinline__ void operator()(const f32x4 (&acc)[2][2][4][2], const Unit& u, int wr, int wc, int fr, int fq) const {
        const int g0 = u.e0 * 256; const bool lat = g0 < NL;
        float* xb = lat ? x_l + (size_t)g0 * D : x_c + (size_t)(g0 - NL) * D;
        const float* gp = gate + (size_t)(lat ? (g0 >> 11) : 8) * 6144;
        const int row0 = launder(wr * 64 + fr), col0 = u.e1 * 256 + wc * 32 + 8 * fq;
#pragma unroll
        for (int bj = 0; bj < 2; ++bj) { const f32x4 ga = *(const f32x4*)(gp + col0 + bj * 128), gb = *(const f32x4*)(gp + col0 + bj * 128 + 4);
#pragma unroll
            for (int ai = 0; ai < 2; ++ai)
#pragma unroll
                for (int m = 0; m < 4; ++m) { const int row = row0 + ai * 128 + m * 16;
                    f32x4 s0 = acc[ai][bj][m][0], s1 = acc[ai][bj][m][1];
                    const bf16_t* op = O + (size_t)(g0 + row) * 8 * 1024 + col0 + bj * 128;
#pragma unroll
                    for (int k = 0; k < 8; ++k) { const u32x4 v = *(const u32x4*)(op + (size_t)k * 1024);
                        s0[0] += lo16(v.x); s0[1] += hi16(v.x); s0[2] += lo16(v.y); s0[3] += hi16(v.y); s1[0] += lo16(v.z); s1[1] += hi16(v.z); s1[2] += lo16(v.w); s1[3] += hi16(v.w); }
                    float* xp = xb + (size_t)row * D + col0 + bj * 128;
                    const f32x4 x0 = *(const f32x4*)xp, x1 = *(const f32x4*)(xp + 4);
                    *(f32x4*)xp = x0 + ga * s0; *(f32x4*)(xp + 4) = x1 + gb * s1;
                    asm volatile("" ::: "memory"); } }
    }
};

struct Params {
    const float* in[26];
    float* out; unsigned char* ws;
    int ph_lo, ph_hi, li, pad;
};
enum { I_X = 0, I_C, I_CTX, I_CCTX, I_WADA, I_BADA, I_NMG, I_NFG, I_WIN, I_CMLNG, I_CMLNB, I_CMWS, I_CMBS, I_RPB, I_DECAY, I_WBR, I_WOUT, I_RW, I_RB,
       I_EG, I_EU, I_ED, I_SG, I_SU, I_SD, I_FG };

__device__ __forceinline__ void transpose_item(const float* W, int N, bf16_t* WT, int ldk, int extra, LAS float* scr, int kb, int nb, int lane) {
    const int k0 = 64 * kb, n0 = 32 * nb;
#pragma unroll 8
    for (int i = 0; i < 32; ++i) { const int kk = 2 * i + (lane >> 5); scr[kk * 33 + (lane & 31)] = W[(size_t)(k0 + kk) * N + n0 + (lane & 31)]; }
    LDS_WAIT(); asm volatile("" ::: "memory");
    const int c = lane & 7;
#pragma unroll
    for (int j = 0; j < 4; ++j) { const int n = (lane >> 3) + 8 * j; const LAS float* s = scr + (8 * c) * 33 + n;
        u32x4 o; o.x = pk2(s[0 * 33], s[1 * 33]); o.y = pk2(s[2 * 33], s[3 * 33]); o.z = pk2(s[4 * 33], s[5 * 33]); o.w = pk2(s[6 * 33], s[7 * 33]);
        *(u32x4*)(WT + (size_t)(n0 + n + extra) * ldk + k0 + 8 * c) = o; }
    LDS_WAIT(); asm volatile("" ::: "memory");
}
constexpr int IT_IN = 16 * 224, IT_BR = 3 * 8 * 32, IT_OUT = 16 * 32, IT_SG = 16 * 8, IT_SD = 4 * 32, IT_RT = 16 * 2, IT_CM = 128;
constexpr int MISC_ITEMS = IT_IN + IT_BR + IT_OUT + 2 * IT_SG + IT_SD + IT_RT + IT_CM;
__device__ __forceinline__ void misc_item(const Params& p, int l, int r, LAS float* scr, int lane) {
    unsigned char* wm = p.ws + WS_WM + (size_t)l * WM_STRIDE;
    if (r < IT_IN) { transpose_item(p.in[I_WIN] + (size_t)l * 1024 * 7168, 7168, (bf16_t*)(wm + WM_IN), 1024, 0, scr, r / 224, r % 224, lane); return; } r -= IT_IN;
    if (r < IT_BR) { const int i = r / 256, q = r % 256; transpose_item(p.in[I_WBR] + ((size_t)l * 3 + i) * 512 * 1024, 1024, (bf16_t*)(wm + WM_BR) + (size_t)i * 1024 * 512, 512, 0, scr, q / 32, q % 32, lane); return; } r -= IT_BR;
    if (r < IT_OUT) { transpose_item(p.in[I_WOUT] + (size_t)l * 1024 * 1024, 1024, (bf16_t*)(wm + WM_OUT), 1024, 0, scr, r / 32, r % 32, lane); return; } r -= IT_OUT;
    if (r < 2 * IT_SG) { const int up = r / IT_SG, q = r % IT_SG, nb = q % 8;
        transpose_item(p.in[up ? I_SU : I_SG] + (size_t)l * 1024 * 256, 256, (bf16_t*)(wm + WM_SGU), 1024, ((32 * nb) / 128) * 128 + up * 128, scr, q / 8, nb, lane); return; } r -= 2 * IT_SG;
    if (r < IT_SD) { transpose_item(p.in[I_SD] + (size_t)l * 256 * 1024, 1024, (bf16_t*)(wm + WM_SD), 256, 0, scr, r / 32, r % 32, lane); return; } r -= IT_SD;
    if (r < IT_RT) { transpose_item(p.in[I_RW] + (size_t)l * 1024 * 64, 64, (bf16_t*)(wm + WM_RT), 1024, 0, scr, r / 2, r % 2, lane); return; } r -= IT_RT;
    { const float* src = p.in[I_CMWS] + (size_t)l * 65536 + (size_t)r * 512 + lane * 8; const f32x4 a = *(const f32x4*)src, b = *(const f32x4*)(src + 4);
      u32x4 o; o.x = pk2(a[0], a[1]); o.y = pk2(a[2], a[3]); o.z = pk2(b[0], b[1]); o.w = pk2(b[2], b[3]);
      *(u32x4*)((bf16_t*)(wm + WM_CM) + (size_t)r * 512 + lane * 8) = o; }
}
constexpr int EXP_ITEMS = 3 * 64 * 128;
__device__ __forceinline__ void expert_item(const Params& p, int l, int r, LAS float* scr, int lane) {
    unsigned char* we = p.ws + WS_WE;
    const int which = r / 8192, q = r % 8192, e = q / 128, it = q % 128;
    if (which < 2) { const int kb = it / 8, nb = it % 8;
        transpose_item(p.in[which ? I_EU : I_EG] + ((size_t)l * 64 + e) * 1024 * 256, 256, (bf16_t*)(we + WE_GU) + (size_t)e * 512 * 1024, 1024, ((32 * nb) / 128) * 128 + which * 128, scr, kb, nb, lane); }
    else { const int kb = it / 32, nb = it % 32;
        transpose_item(p.in[I_ED] + ((size_t)l * 64 + e) * 256 * 1024, 1024, (bf16_t*)(we + WE_D) + (size_t)e * 1024 * 256, 256, 0, scr, kb, nb, lane); }
}
__device__ __forceinline__ void mod_unit(const Params& p, LAS unsigned char* lds, int u, int tid) {
    const int l = u / 96, cb = u % 96, wave = tid >> 6, lane = tid & 63;
    LAS float* sil = (LAS float*)lds;
    LAS float* part = (LAS float*)(lds + 36864);
    for (int idx = tid; idx < 9 * 1024; idx += NTHREADS) { const int r = idx >> 10, k = idx & 1023; const float v = r < 8 ? p.in[I_C][r * 1024 + k] : p.in[I_CCTX][k]; sil[idx] = v / (1.0f + expf(-v)); }
    __syncthreads();
    float acc[9];
#pragma unroll
    for (int r = 0; r < 9; ++r) acc[r] = 0.f;
    const float* wp = p.in[I_WADA] + ((size_t)l * 1024 + wave * 128) * 6144 + cb * 64 + lane;
#pragma unroll 4
    for (int k = 0; k < 128; ++k) { const float wv = wp[(size_t)k * 6144];
#pragma unroll
        for (int r = 0; r < 9; ++r) acc[r] += sil[r * 1024 + wave * 128 + k] * wv; }
#pragma unroll
    for (int r = 0; r < 9; ++r) part[(wave * 9 + r) * 64 + lane] = acc[r];
    __syncthreads();
    for (int idx = tid; idx < 576; idx += NTHREADS) { const int r = idx >> 6, ln = idx & 63; float s = p.in[I_BADA][l * 6144 + cb * 64 + ln];
#pragma unroll
        for (int w = 0; w < 8; ++w) s += part[(w * 9 + r) * 64 + ln];
        ((float*)(p.ws + WS_MOD))[((size_t)l * 9 + r) * 6144 + cb * 64 + ln] = s; }
    __syncthreads();
}

__device__ __forceinline__ void norm_mod_row(const float* xrow, const float* g, const float* sh, const float* sc, bf16_t* orow, bool to_lds, LAS unsigned char* ldst, int lane) {
    f32x4 v[4]; float ss = 0.f;
#pragma unroll
    for (int j = 0; j < 4; ++j) { v[j] = ((const f32x4*)xrow)[64 * j + lane]; ss += (v[j][0] * v[j][0] + v[j][1] * v[j][1]) + (v[j][2] * v[j][2] + v[j][3] * v[j][3]); }
    const float rstd = rsqrtf(wave_sum(ss) * (1.0f / 1024.0f) + EPS);
#pragma unroll
    for (int j = 0; j < 4; ++j) { const f32x4 gg = ((const f32x4*)g)[64 * j + lane], s_h = ((const f32x4*)sh)[64 * j + lane], s_c = ((const f32x4*)sc)[64 * j + lane];
        const f32x4 y = v[j] * rstd * gg * (s_c + 1.0f) + s_h;
        u32x2 o; o.x = pk2(y[0], y[1]); o.y = pk2(y[2], y[3]);
        ((u32x2*)orow)[64 * j + lane] = o;
        if (to_lds) *(LAS u32x2*)(ldst + (64 * j + lane) * 8) = o; }
}

constexpr int RT_TILE = 0, RT_PITCH = 2064, RT_LG = 64 * RT_PITCH  , RT_BIAS = RT_LG + 64 * 65 * 4  , RT_LCNT = RT_BIAS + 256, RT_LBASE = RT_LCNT + 256,
              RT_SELE = RT_LBASE + 256  , RT_SELW = RT_SELE + 2048, RT_SELR = RT_SELW + 2048, RT_END = RT_SELR + 2048;
static_assert(RT_END <= LDS_BYTES, "router LDS");
__device__ __forceinline__ void router_unit(const Params& p, LAS unsigned char* lds, int l, int u, const float* xl, const float* xc, int tid) {
    const int wave = tid >> 6, lane = tid & 63, g4 = lane >> 4, row0 = u * 64;
    const float* mod = (const float*)(p.ws + WS_MOD) + (size_t)l * 9 * 6144;
    bf16_t* H2 = (bf16_t*)(p.ws + WS_H);
    LAS float* lg = (LAS float*)(lds + RT_LG); LAS float* bias = (LAS float*)(lds + RT_BIAS);
    LAS int* lcnt = (LAS int*)(lds + RT_LCNT); LAS int* lbase = (LAS int*)(lds + RT_LBASE);
    LAS int* sele = (LAS int*)(lds + RT_SELE); LAS float* selw = (LAS float*)(lds + RT_SELW); LAS int* selr = (LAS int*)(lds + RT_SELR);
    if (tid < 64) { lcnt[tid] = 0; bias[tid] = p.in[I_RB][l * 64 + tid]; }
    for (int i = 0; i < 8; ++i) { const int rl = wave * 8 + i, g = row0 + rl; const bool lat = g < NL;
        const float* xr = lat ? xl + (size_t)g * D : xc + (size_t)(g - NL) * D; const float* mr = mod + (size_t)(lat ? (g >> 11) : 8) * 6144;
        norm_mod_row(xr, p.in[I_NFG] + l * 1024, mr + 3072, mr + 4096, H2 + (size_t)g * D, true, lds + RT_TILE + rl * RT_PITCH, lane); }
    __syncthreads();
    { const int rb = wave >> 1, eb0 = (wave & 1) * 2;
      const bf16_t* wrt = (const bf16_t*)(p.ws + WS_WM + (size_t)l * WM_STRIDE + WM_RT);
      f32x4 a0 = (f32x4){0.f, 0.f, 0.f, 0.f}, a1 = a0;
      const LAS unsigned char* hrow = lds + RT_TILE + (rb * 16 + (lane & 15)) * RT_PITCH + g4 * 16;
      const bf16_t* w0 = wrt + (size_t)(eb0 * 16 + (lane & 15)) * 1024 + g4 * 8; const bf16_t* w1 = w0 + 16 * 1024;
#pragma unroll 4
      for (int ks = 0; ks < 32; ++ks) { const bf16x8 b = *(const LAS bf16x8*)(hrow + ks * 64);
          a0 = mfma16(*(const bf16x8*)(w0 + ks * 32), b, a0); a1 = mfma16(*(const bf16x8*)(w1 + ks * 32), b, a1); }
      const int rr = rb * 16 + (lane & 15);
#pragma unroll
      for (int r = 0; r < 4; ++r) { lg[rr * 65 + eb0 * 16 + 4 * g4 + r] = sigmoidf_(a0[r]); lg[rr * 65 + (eb0 + 1) * 16 + 4 * g4 + r] = sigmoidf_(a1[r]); } }
    __syncthreads();
    if (tid < 64) { const LAS float* sr = lg + tid * 65;
        float gs[8];
#pragma unroll
        for (int g = 0; g < 8; ++g) { float m1 = -3e38f, m2 = -3e38f;
#pragma unroll
            for (int j = 0; j < 8; ++j) { const float s = sr[g * 8 + j] + bias[g * 8 + j]; if (s > m1) { m2 = m1; m1 = s; } else if (s > m2) m2 = s; }
            gs[g] = m1 + m2; }
        unsigned gsel = 0u;
#pragma unroll
        for (int it = 0; it < 4; ++it) { float best = -3e38f; int bi = 0;
#pragma unroll
            for (int g = 0; g < 8; ++g) if (!((gsel >> g) & 1u) && gs[g] > best) { best = gs[g]; bi = g; }
            gsel |= 1u << bi; }
        unsigned long long chosen = 0ull; float wsum = 0.f;
        for (int k = 0; k < 8; ++k) { float best = -3e38f; int bi = 0;
            for (int e = 0; e < 64; ++e) { if (((gsel >> (e >> 3)) & 1u) && !((chosen >> e) & 1ull)) { const float s = sr[e] + bias[e]; if (s > best) { best = s; bi = e; } } }
            chosen |= 1ull << bi; const float w = sr[bi]; wsum += w; sele[tid * 8 + k] = bi; selw[tid * 8 + k] = w; selr[tid * 8 + k] = __hip_atomic_fetch_add(&lcnt[bi], 1, __ATOMIC_RELAXED, __HIP_MEMORY_SCOPE_WORKGROUP); }
        const float sc = 2.5f / wsum;
        for (int k = 0; k < 8; ++k) selw[tid * 8 + k] *= sc; }
    __syncthreads();
    if (tid < 64) { const int n = lcnt[tid]; int base = 0; if (n > 0) base = (int)atomicAdd((unsigned*)(p.ws + WS_CTL) + CW_CNT + l * 2048 + tid * 16, (unsigned)n); lbase[tid] = base; }
    __syncthreads();
    { const int rl = tid >> 3, k = tid & 7, e = sele[rl * 8 + k], pos = lbase[e] + selr[rl * 8 + k];
      ((unsigned*)(p.ws + WS_LIST))[(size_t)e * NT + pos] = (unsigned)((row0 + rl) * 8 + k); ((float*)(p.ws + WS_WL))[(size_t)e * NT + pos] = selw[rl * 8 + k]; }
    __syncthreads();
}

__device__ __forceinline__ void mixA_unit(const Params& p, LAS unsigned char* lds, int l, int ch, int g, int tid) {
    const int wave = tid >> 6, lane = tid & 63, g4 = lane >> 4, rows0 = ch * 128;
    const bf16_t* Z = (const bf16_t*)(p.ws + WS_R + R_Z); bf16_t* BR = (bf16_t*)(p.ws + WS_R + R_BR);
    const bf16_t* WCM = (const bf16_t*)(p.ws + WS_WM + (size_t)l * WM_STRIDE + WM_CM);
    LAS float* stats = (LAS float*)lds; LAS unsigned char* vn = lds + 1024;
    for (int i = 0; i < 16; ++i) { const int tok = wave * 16 + i; const u32x4 v = *(const u32x4*)(Z + (size_t)(rows0 + tok) * INW + ZC_AV + lane * 8);
        const float x0 = geluf_(lo16(v.x)), x1 = geluf_(hi16(v.x)), x2 = geluf_(lo16(v.y)), x3 = geluf_(hi16(v.y)), x4 = geluf_(lo16(v.z)), x5 = geluf_(hi16(v.z)), x6 = geluf_(lo16(v.w)), x7 = geluf_(hi16(v.w));
        const float s1 = wave_sum(((x0 + x1) + (x2 + x3)) + ((x4 + x5) + (x6 + x7)));
        const float mean = s1 * (1.0f / 512.0f);
        const float d0 = x0 - mean, d1 = x1 - mean, d2 = x2 - mean, d3 = x3 - mean, d4 = x4 - mean, d5 = x5 - mean, d6 = x6 - mean, d7 = x7 - mean;
        const float s2 = wave_sum(((d0 * d0 + d1 * d1) + (d2 * d2 + d3 * d3)) + ((d4 * d4 + d5 * d5) + (d6 * d6 + d7 * d7)));
        if (lane == 0) { stats[2 * tok] = mean; stats[2 * tok + 1] = rsqrtf(s2 * (1.0f / 512.0f) + EPS); } }
    __syncthreads();
    { const int q = tid >> 2, cs = (tid & 3) * 32; const float mean = stats[2 * q], rstd = stats[2 * q + 1];
      const float* lg = p.in[I_CMLNG] + l * 512 + g * 128 + cs; const float* lb = p.in[I_CMLNB] + l * 512 + g * 128 + cs;
#pragma unroll
      for (int j = 0; j < 4; ++j) { const u32x4 v = *(const u32x4*)(Z + (size_t)(rows0 + q) * INW + ZC_AV + g * 128 + cs + 8 * j);
          const f32x4 ga = *(const f32x4*)(lg + 8 * j), gb = *(const f32x4*)(lg + 8 * j + 4), ba = *(const f32x4*)(lb + 8 * j), bb = *(const f32x4*)(lb + 8 * j + 4);
          u32x4 o;
          o.x = pk2((geluf_(lo16(v.x)) - mean) * rstd * ga[0] + ba[0], (geluf_(hi16(v.x)) - mean) * rstd * ga[1] + ba[1]);
          o.y = pk2((geluf_(lo16(v.y)) - mean) * rstd * ga[2] + ba[2], (geluf_(hi16(v.y)) - mean) * rstd * ga[3] + ba[3]);
          o.z = pk2((geluf_(lo16(v.z)) - mean) * rstd * gb[0] + bb[0], (geluf_(hi16(v.z)) - mean) * rstd * gb[1] + bb[1]);
          o.w = pk2((geluf_(lo16(v.w)) - mean) * rstd * gb[2] + bb[2], (geluf_(hi16(v.w)) - mean) * rstd * gb[3] + bb[3]);
          *(LAS u32x4*)(vn + q * 272 + (cs + 8 * j) * 2) = o; } }
    __syncthreads();
    { const int pb = wave, pp = pb * 16 + (lane & 15);
      bf16x8 bfr[4];
#pragma unroll
      for (int ks = 0; ks < 4; ++ks) bfr[ks] = *(const bf16x8*)(WCM + (size_t)(g * 128 + pp) * 128 + 32 * ks + 8 * g4);
      const unsigned vna = tr_lane(lds_addr(vn), 272, 8, lane);
      const float bs = p.in[I_CMBS][l * 512 + g * 128 + pp];
      const size_t row = (size_t)(rows0 + pp);
      sfor<0, 8>([&](auto cb_) { constexpr int cb = decltype(cb_)::value; f32x4 acc = (f32x4){0.f, 0.f, 0.f, 0.f};
          sfor<0, 4>([&](auto ks_) { constexpr int ks = decltype(ks_)::value; const bf16x8 a = tr_frag_i<32 * ks * 272 + 32 * cb, 32 * ks * 272 + 32 * cb + 4 * 272>(vna); acc = mfma16(a, bfr[ks], acc); });
          const int c = 16 * cb + 4 * g4;
          const u32x2 uu = *(const u32x2*)(Z + row * INW + ZC_AU + g * 128 + c);
          u32x2 o; o.x = pk2(geluf_(lo16(uu.x)) * (acc[0] + bs), geluf_(hi16(uu.x)) * (acc[1] + bs)); o.y = pk2(geluf_(lo16(uu.y)) * (acc[2] + bs), geluf_(hi16(uu.y)) * (acc[3] + bs));
          *(u32x2*)(BR + row * BRW + g * 128 + c) = o; }); }
    __syncthreads();
}

__device__ __forceinline__ void ret_stage_qk(const bf16_t* src  , const float* rope, bool do_rope, int tpos0, int mask  , LAS unsigned char* t0, LAS unsigned char* t1, LAS unsigned char* t2,
                                             float sc0, float l2a, float offa, float siga, float l2b, float offb, float sigb, int tid) {
    const int pp = tid >> 2, half = (tid >> 1) & 1, sub = tid & 1;
    const bf16_t* s = src + (size_t)pp * INW + 32 * half + 8 * sub;
    const u32x4 a = *(const u32x4*)s, b = *(const u32x4*)(s + 16);
    float x1[8] = {lo16(a.x), hi16(a.x), lo16(a.y), hi16(a.y), lo16(a.z), hi16(a.z), lo16(a.w), hi16(a.w)};
    float x2[8] = {lo16(b.x), hi16(b.x), lo16(b.y), hi16(b.y), lo16(b.z), hi16(b.z), lo16(b.w), hi16(b.w)};
    float o1[8], o2[8];
    if (do_rope) { const int t = tpos0 + pp, pos = half ? (t & 63) : (t >> 6); const f32x4* tb = (const f32x4*)(rope + (size_t)(pos * 16 + 8 * sub) * 2);
#pragma unroll
        for (int j = 0; j < 4; ++j) { const f32x4 cs = tb[j];
            o1[2 * j] = x1[2 * j] * cs[0] - x2[2 * j] * cs[1]; o2[2 * j] = x1[2 * j] * cs[1] + x2[2 * j] * cs[0];
            o1[2 * j + 1] = x1[2 * j + 1] * cs[2] - x2[2 * j + 1] * cs[3]; o2[2 * j + 1] = x1[2 * j + 1] * cs[3] + x2[2 * j + 1] * cs[2]; } }
    else {
#pragma unroll
        for (int j = 0; j < 8; ++j) { o1[j] = x1[j]; o2[j] = x2[j]; } }
    const int off = pp * 144 + (32 * half + 8 * sub) * 2;
    const float fp = (float)pp;
    const float sA = sc0 * __builtin_amdgcn_exp2f((offa + siga * fp) * l2a), sB = sc0 * __builtin_amdgcn_exp2f((offb + sigb * fp) * l2b);
    if (mask & 1) { u32x4 w; w.x = pk2(o1[0] * sc0, o1[1] * sc0); w.y = pk2(o1[2] * sc0, o1[3] * sc0); w.z = pk2(o1[4] * sc0, o1[5] * sc0); w.w = pk2(o1[6] * sc0, o1[7] * sc0); *(LAS u32x4*)(t0 + off) = w;
              w.x = pk2(o2[0] * sc0, o2[1] * sc0); w.y = pk2(o2[2] * sc0, o2[3] * sc0); w.z = pk2(o2[4] * sc0, o2[5] * sc0); w.w = pk2(o2[6] * sc0, o2[7] * sc0); *(LAS u32x4*)(t0 + off + 32) = w; }
    if (mask & 2) { u32x4 w; w.x = pk2(o1[0] * sA, o1[1] * sA); w.y = pk2(o1[2] * sA, o1[3] * sA); w.z = pk2(o1[4] * sA, o1[5] * sA); w.w = pk2(o1[6] * sA, o1[7] * sA); *(LAS u32x4*)(t1 + off) = w;
              w.x = pk2(o2[0] * sA, o2[1] * sA); w.y = pk2(o2[2] * sA, o2[3] * sA); w.z = pk2(o2[4] * sA, o2[5] * sA); w.w = pk2(o2[6] * sA, o2[7] * sA); *(LAS u32x4*)(t1 + off + 32) = w; }
    if (mask & 4) { u32x4 w; w.x = pk2(o1[0] * sB, o1[1] * sB); w.y = pk2(o1[2] * sB, o1[3] * sB); w.z = pk2(o1[4] * sB, o1[5] * sB); w.w = pk2(o1[6] * sB, o1[7] * sB); *(LAS u32x4*)(t2 + off) = w;
              w.x = pk2(o2[0] * sB, o2[1] * sB); w.y = pk2(o2[2] * sB, o2[3] * sB); w.z = pk2(o2[4] * sB, o2[5] * sB); w.w = pk2(o2[6] * sB, o2[7] * sB); *(LAS u32x4*)(t2 + off + 32) = w; }
}
__device__ __forceinline__ void ret_stage_v(const bf16_t* src  , LAS unsigned char* tv, int tid) {
    const int pp = tid >> 2, seg = (tid & 3) * 32;
#pragma unroll
    for (int j = 0; j < 4; ++j) *(LAS u32x4*)(tv + pp * 272 + (seg + 8 * j) * 2) = *(const u32x4*)(src + (size_t)pp * INW + seg + 8 * j);
}
__device__ __forceinline__ float log2_gamma(const Params& p, int l, int dir, int h) { const float x = p.in[I_DECAY][(l * 2 + dir) * 4 + h]; return -log2f(1.0f + expf(-x)); }
__device__ __forceinline__ int ret_row0(int b, int cc) { return cc < 2 ? NL + b * 256 + cc * 128 : b * 2048 + (cc - 2) * 128; }

__device__ __forceinline__ void retkv_unit(const Params& p, LAS unsigned char* lds, int l, int b, int h, int cc, int tid) {
    const int wave = tid >> 6, lane = tid & 63, g4 = lane >> 4, row0 = ret_row0(b, cc);
    const bf16_t* Z = (const bf16_t*)(p.ws + WS_R + R_Z); float* KV = (float*)(p.ws + WS_R + R_KV);
    const float l2f = log2_gamma(p, l, 0, h), l2b = log2_gamma(p, l, 1, h);
    LAS unsigned char* kf = lds; LAS unsigned char* kb = lds + 18432; LAS unsigned char* vv = lds + 36864;
    ret_stage_qk(Z + (size_t)row0 * INW + ZC_RK + h * 64, (const float*)(p.ws + WS_ROPE), cc >= 2, (cc - 2) * 128, 6, kf, kf, kb, 0.125f, l2f, 127.f, -1.f, l2b, 0.f, 1.f, tid);
    ret_stage_v(Z + (size_t)row0 * INW + ZC_RV + h * 128, vv, tid);
    __syncthreads();
    { const int dir = wave >> 2, db = wave & 3; const unsigned ka = tr_lane(lds_addr(dir ? kb : kf), 144, 8, lane) + 32 * db, va = tr_lane(lds_addr(vv), 272, 8, lane);
      bf16x8 afr[4];
      sfor<0, 4>([&](auto ks_) { constexpr int ks = decltype(ks_)::value; afr[ks] = tr_frag_i<32 * ks * 144, 32 * ks * 144 + 4 * 144>(ka); });
      float* dst = KV + ((((size_t)b * 4 + h) * NCHUNK + cc) * 2 + dir) * 8192;
      sfor<0, 8>([&](auto eb_) { constexpr int eb = decltype(eb_)::value; f32x4 acc = (f32x4){0.f, 0.f, 0.f, 0.f};
          sfor<0, 4>([&](auto ks_) { constexpr int ks = decltype(ks_)::value; const bf16x8 bq = tr_frag_i<32 * ks * 272 + 32 * eb, 32 * ks * 272 + 32 * eb + 4 * 272>(va); acc = mfma16(afr[ks], bq, acc); });
#pragma unroll
          for (int r = 0; r < 4; ++r) dst[(16 * db + 4 * g4 + r) * 128 + 16 * eb + (lane & 15)] = acc[r]; }); }
    __syncthreads();
}

__device__ __forceinline__ void retout_unit(const Params& p, LAS unsigned char* lds, int l, int b, int h, int cc, int tid) {
    const int wave = tid >> 6, lane = tid & 63, g4 = lane >> 4, row0 = ret_row0(b, cc);
    const bf16_t* Z = (const bf16_t*)(p.ws + WS_R + R_Z); bf16_t* BR = (bf16_t*)(p.ws + WS_R + R_BR); const float* KV = (const float*)(p.ws + WS_R + R_KV);
    const float l2f = log2_gamma(p, l, 0, h), l2b = log2_gamma(p, l, 1, h);
    LAS unsigned char* tq = lds; LAS unsigned char* tqf = lds + 18432; LAS unsigned char* tqb = lds + 36864; LAS unsigned char* tk = lds + 55296;
    LAS unsigned char* tv = lds + 73728; LAS unsigned char* st = lds + 108544;
    { const float* kvb = KV + (((size_t)b * 4 + h) * NCHUNK) * 2 * 8192;
      f32x4 sf[4], sb[4];
#pragma unroll
      for (int j = 0; j < 4; ++j) { sf[j] = (f32x4){0.f, 0.f, 0.f, 0.f}; sb[j] = sf[j]; }
      const int pbx = cc < 2 ? 1 - cc : 19 - cc;
      for (int y = 0; y < NCHUNK; ++y) {
          if (y < cc) { const float w = __builtin_amdgcn_exp2f(128.f * (float)(cc - 1 - y) * l2f);
#pragma unroll
              for (int j = 0; j < 4; ++j) sf[j] += w * *(const f32x4*)(kvb + ((size_t)y * 2 + 0) * 8192 + (tid + 512 * j) * 4); }
          const int pby = y < 2 ? 1 - y : 19 - y;
          if (pby < pbx) { const float w = __builtin_amdgcn_exp2f(128.f * (float)(pbx - 1 - pby) * l2b);
#pragma unroll
              for (int j = 0; j < 4; ++j) sb[j] += w * *(const f32x4*)(kvb + ((size_t)y * 2 + 1) * 8192 + (tid + 512 * j) * 4); } }
#pragma unroll
      for (int j = 0; j < 4; ++j) { const int idx = (tid + 512 * j) * 4, d = idx >> 7, e = idx & 127;
          u32x2 o; o.x = pk2(sf[j][0], sf[j][1]); o.y = pk2(sf[j][2], sf[j][3]); *(LAS u32x2*)(st + d * 272 + e * 2) = o;
          o.x = pk2(sb[j][0], sb[j][1]); o.y = pk2(sb[j][2], sb[j][3]); *(LAS u32x2*)(st + (64 + d) * 272 + e * 2) = o; } }
    const float* rope = (const float*)(p.ws + WS_ROPE);
    ret_stage_qk(Z + (size_t)row0 * INW + ZC_RQ + h * 64, rope, cc >= 2, (cc - 2) * 128, 7, tq, tqf, tqb, 1.0f, l2f, 1.f, 1.f, l2b, 128.f, -1.f, tid);
    ret_stage_qk(Z + (size_t)row0 * INW + ZC_RK + h * 64, rope, cc >= 2, (cc - 2) * 128, 1, tk, tk, tk, 0.125f, 0.f, 0.f, 0.f, 0.f, 0.f, 0.f, tid);
    ret_stage_v(Z + (size_t)row0 * INW + ZC_RV + h * 128, tv, tid);
    __syncthreads();
    const int ib = wave, ti = ib * 16 + (lane & 15);
    f32x4 oacc[8];
#pragma unroll
    for (int eb = 0; eb < 8; ++eb) oacc[eb] = (f32x4){0.f, 0.f, 0.f, 0.f};
    { bf16x8 bq[4];
#pragma unroll
      for (int ks = 0; ks < 4; ++ks) bq[ks] = *(const LAS bf16x8*)((ks < 2 ? tqf : tqb) + ti * 144 + (32 * (ks & 1) + 8 * g4) * 2);
      const unsigned sa = tr_lane(lds_addr(st), 272, 8, lane);
      sfor<0, 8>([&](auto eb_) { constexpr int eb = decltype(eb_)::value;
          sfor<0, 4>([&](auto ks_) { constexpr int ks = decltype(ks_)::value; const bf16x8 a = tr_frag_i<32 * ks * 272 + 32 * eb, 32 * ks * 272 + 32 * eb + 4 * 272>(sa); oacc[eb] = mfma16(a, bq[ks], oacc[eb]); }); }); }
    { bf16x8 bq[2];
#pragma unroll
      for (int ks = 0; ks < 2; ++ks) bq[ks] = *(const LAS bf16x8*)(tq + ti * 144 + (32 * ks + 8 * g4) * 2);
      f32x4 sacc[8];
#pragma unroll
      for (int jb = 0; jb < 8; ++jb) { sacc[jb] = (f32x4){0.f, 0.f, 0.f, 0.f};
#pragma unroll
          for (int ks = 0; ks < 2; ++ks) { const bf16x8 a = *(const LAS bf16x8*)(tk + (16 * jb + (lane & 15)) * 144 + (32 * ks + 8 * g4) * 2); sacc[jb] = mfma16(a, bq[ks], sacc[jb]); }
#pragma unroll
          for (int r = 0; r < 4; ++r) { const int dist = ti - (16 * jb + 4 * g4 + r);
              sacc[jb][r] *= dist >= 0 ? __builtin_amdgcn_exp2f((float)dist * l2f) : __builtin_amdgcn_exp2f((float)(-dist) * l2b); } }
      const unsigned va = tr_lane(lds_addr(tv), 272, 4, lane);
      sfor<0, 4>([&](auto kk_) { constexpr int kk = decltype(kk_)::value;
          u32x4 pw; pw.x = pk2(sacc[2 * kk][0], sacc[2 * kk][1]); pw.y = pk2(sacc[2 * kk][2], sacc[2 * kk][3]); pw.z = pk2(sacc[2 * kk + 1][0], sacc[2 * kk + 1][1]); pw.w = pk2(sacc[2 * kk + 1][2], sacc[2 * kk + 1][3]);
          const bf16x8 bp = as_frag(pw);
          sfor<0, 8>([&](auto eb_) { constexpr int eb = decltype(eb_)::value; const bf16x8 a = tr_frag_i<32 * kk * 272 + 32 * eb, 32 * kk * 272 + 32 * eb + 16 * 272>(va); oacc[eb] = mfma16(a, bp, oacc[eb]); }); }); }
    { float ss = 0.f;
#pragma unroll
      for (int eb = 0; eb < 8; ++eb) ss += (oacc[eb][0] * oacc[eb][0] + oacc[eb][1] * oacc[eb][1]) + (oacc[eb][2] * oacc[eb][2] + oacc[eb][3] * oacc[eb][3]);
      ss += __shfl_xor(ss, 16); ss += __shfl_xor(ss, 32);
      const float rstd = rsqrtf(ss * (1.0f / 128.0f) + EPS);
      const size_t row = (size_t)(row0 + ti);
#pragma unroll
      for (int eb = 0; eb < 8; ++eb) { const int e = 16 * eb + 4 * g4; const u32x2 gg = *(const u32x2*)(Z + row * INW + ZC_RG + h * 128 + e);
          u32x2 o; o.x = pk2(oacc[eb][0] * rstd * siluf_(lo16(gg.x)), oacc[eb][1] * rstd * siluf_(hi16(gg.x))); o.y = pk2(oacc[eb][2] * rstd * siluf_(lo16(gg.y)), oacc[eb][3] * rstd * siluf_(hi16(gg.y)));
          *(u32x2*)(BR + row * BRW + 1024 + h * 128 + e) = o; } }
    __syncthreads();
}

constexpr int NA_KL = 0, NA_VL = 73728, NA_TAB = 147456, NA_PITCH = 144;
__device__ __forceinline__ void na_unit(const Params& p, LAS unsigned char* lds, int l, int b, int h, int r, bool local, int tid) {
    const int wave = tid >> 6, lane = tid & 63, g4 = lane >> 4, qb = wave >> 1, half = wave & 1;
    const bf16_t* Z = (const bf16_t*)(p.ws + WS_R + R_Z); bf16_t* BR = (bf16_t*)(p.ws + WS_R + R_BR);
    LAS unsigned char* kl = lds + NA_KL; LAS unsigned char* vl = lds + NA_VL; LAS float* tab = (LAS float*)(lds + NA_TAB);
    const unsigned kla = lds_addr(kl), vla = lds_addr(vl);
    const int qc = 16 * qb + (lane & 15);
    const size_t qrow = local ? (size_t)b * 2048 + r * 64 + qc : (size_t)NL + b * 256 + r * 64 + qc;
    bf16x8 bq[2];
#pragma unroll
    for (int ks = 0; ks < 2; ++ks) bq[ks] = *(const bf16x8*)(Z + qrow * INW + ZC_NQ + h * 64 + 32 * ks + 8 * g4);
    const float L2E = 1.44269504089f;
    float m_run = -1e30f, l_run = 0.f;
    f32x4 oacc[4];
#pragma unroll
    for (int db = 0; db < 4; ++db) oacc[db] = (f32x4){0.f, 0.f, 0.f, 0.f};
    if (local) {
        const int rs = min(max(r - 4, 0), 24);
        { const int key = tid; const size_t krow = (size_t)b * 2048 + (rs + (key >> 6)) * 64 + (key & 63);
          const u32x4* ks_ = (const u32x4*)(Z + krow * INW + ZC_NK + h * 64); const u32x4* vs_ = (const u32x4*)(Z + krow * INW + ZC_NV + h * 64);
#pragma unroll
          for (int j = 0; j < 8; ++j) { *(LAS u32x4*)(kl + key * NA_PITCH + 16 * j) = ks_[j]; *(LAS u32x4*)(vl + key * NA_PITCH + 16 * j) = vs_[j]; } }
        if (tid < 465) tab[tid] = p.in[I_RPB][(size_t)(l * 8 + h) * 465 + tid];
        __syncthreads();
        const int kbs = min(max(16 * qb - 8, 0), 32), cst = min(max(qc - 8, 0), 48);
        f32x4 s[8]; float mx = -1e30f;
#pragma unroll
        for (int blk = 0; blk < 8; ++blk) { const int i = 4 * half + (blk >> 1), cb = blk & 1, kr0 = i * 64 + kbs + 16 * cb;
            f32x4 a = (f32x4){0.f, 0.f, 0.f, 0.f};
#pragma unroll
            for (int ks = 0; ks < 2; ++ks) a = mfma16(*(const LAS bf16x8*)(kl + (kr0 + (lane & 15)) * NA_PITCH + (32 * ks + 8 * g4) * 2), bq[ks], a);
            const int ro = rs + i - r + 7;
#pragma unroll
            for (int rg = 0; rg < 4; ++rg) { const int kc = kbs + 16 * cb + 4 * g4 + rg; const bool valid = kc >= cst && kc < cst + 16;
                const int co = min(max(kc - qc, -15), 15) + 15;
                const float v = valid ? a[rg] * 0.125f + tab[ro * 31 + co] : -1e30f; s[blk][rg] = v; mx = fmaxf(mx, v); } }
        mx = fmaxf(mx, __shfl_xor(mx, 16)); mx = fmaxf(mx, __shfl_xor(mx, 32));
        float ls = 0.f;
#pragma unroll
        for (int blk = 0; blk < 8; ++blk)
#pragma unroll
            for (int rg = 0; rg < 4; ++rg) { const float e = __builtin_amdgcn_exp2f((s[blk][rg] - mx) * L2E); s[blk][rg] = e; ls += e; }
        ls += __shfl_xor(ls, 16); ls += __shfl_xor(ls, 32);
        m_run = mx; l_run = ls;
#pragma unroll
        for (int kk = 0; kk < 4; ++kk) { u32x4 pw; pw.x = pk2(s[2 * kk][0], s[2 * kk][1]); pw.y = pk2(s[2 * kk][2], s[2 * kk][3]); pw.z = pk2(s[2 * kk + 1][0], s[2 * kk + 1][1]); pw.w = pk2(s[2 * kk + 1][2], s[2 * kk + 1][3]);
            const bf16x8 bp = as_frag(pw); const unsigned va = vla + (unsigned)(((4 * half + kk) * 64 + kbs + 4 * g4 + ((lane & 15) >> 2)) * NA_PITCH + (lane & 3) * 8);
            oacc[0] = mfma16(tr_frag_i<0, 16 * NA_PITCH>(va), bp, oacc[0]); oacc[1] = mfma16(tr_frag_i<32, 32 + 16 * NA_PITCH>(va), bp, oacc[1]);
            oacc[2] = mfma16(tr_frag_i<64, 64 + 16 * NA_PITCH>(va), bp, oacc[2]); oacc[3] = mfma16(tr_frag_i<96, 96 + 16 * NA_PITCH>(va), bp, oacc[3]); }
        __syncthreads();
    }
    { const int key = tid & 255; const size_t krow = (size_t)NL + b * 256 + key;
      const u32x4* src = (const u32x4*)(Z + krow * INW + (tid < 256 ? ZC_NK : ZC_NV) + h * 64); LAS unsigned char* dst = (tid < 256 ? kl : vl) + key * NA_PITCH;
#pragma unroll
      for (int j = 0; j < 8; ++j) *(LAS u32x4*)(dst + 16 * j) = src[j]; }
    __syncthreads();
    { f32x4 s[8]; float mx = -1e30f;
#pragma unroll
      for (int blk = 0; blk < 8; ++blk) { const int kr0 = half * 128 + 16 * blk;
          f32x4 a = (f32x4){0.f, 0.f, 0.f, 0.f};
#pragma unroll
          for (int ks = 0; ks < 2; ++ks) a = mfma16(*(const LAS bf16x8*)(kl + (kr0 + (lane & 15)) * NA_PITCH + (32 * ks + 8 * g4) * 2), bq[ks], a);
#pragma unroll
          for (int rg = 0; rg < 4; ++rg) { const float v = a[rg] * 0.125f; s[blk][rg] = v; mx = fmaxf(mx, v); } }
      mx = fmaxf(mx, __shfl_xor(mx, 16)); mx = fmaxf(mx, __shfl_xor(mx, 32));
      const float m2 = fmaxf(m_run, mx), alpha = __builtin_amdgcn_exp2f((m_run - m2) * L2E);
      float ls = 0.f;
#pragma unroll
      for (int blk = 0; blk < 8; ++blk)
#pragma unroll
          for (int rg = 0; rg < 4; ++rg) { const float e = __builtin_amdgcn_exp2f((s[blk][rg] - m2) * L2E); s[blk][rg] = e; ls += e; }
      ls += __shfl_xor(ls, 16); ls += __shfl_xor(ls, 32);
      l_run = l_run * alpha + ls; m_run = m2;
#pragma unroll
      for (int db = 0; db < 4; ++db) oacc[db] = oacc[db] * alpha;
#pragma unroll
      for (int kk = 0; kk < 4; ++kk) { u32x4 pw; pw.x = pk2(s[2 * kk][0], s[2 * kk][1]); pw.y = pk2(s[2 * kk][2], s[2 * kk][3]); pw.z = pk2(s[2 * kk + 1][0], s[2 * kk + 1][1]); pw.w = pk2(s[2 * kk + 1][2], s[2 * kk + 1][3]);
          const bf16x8 bp = as_frag(pw); const unsigned va = vla + (unsigned)((half * 128 + 32 * kk + 4 * g4 + ((lane & 15) >> 2)) * NA_PITCH + (lane & 3) * 8);
          oacc[0] = mfma16(tr_frag_i<0, 16 * NA_PITCH>(va), bp, oacc[0]); oacc[1] = mfma16(tr_frag_i<32, 32 + 16 * NA_PITCH>(va), bp, oacc[1]);
          oacc[2] = mfma16(tr_frag_i<64, 64 + 16 * NA_PITCH>(va), bp, oacc[2]); oacc[3] = mfma16(tr_frag_i<96, 96 + 16 * NA_PITCH>(va), bp, oacc[3]); } }
    __syncthreads();
    LAS float* mb = (LAS float*)(lds + NA_KL) + (qb * 64 + lane) * 18;
    if (half == 1) { mb[0] = m_run; mb[1] = l_run;
#pragma unroll
        for (int db = 0; db < 4; ++db)
#pragma unroll
            for (int rg = 0; rg < 4; ++rg) mb[2 + db * 4 + rg] = oacc[db][rg]; }
    __syncthreads();
    if (half == 0) { const float m1 = mb[0], l1 = mb[1], M = fmaxf(m_run, m1), a0 = __builtin_amdgcn_exp2f((m_run - M) * L2E), a1 = __builtin_amdgcn_exp2f((m1 - M) * L2E);
        const float inv = 1.0f / (l_run * a0 + l1 * a1);
#pragma unroll
        for (int db = 0; db < 4; ++db) { float o[4];
#pragma unroll
            for (int rg = 0; rg < 4; ++rg) o[rg] = (oacc[db][rg] * a0 + mb[2 + db * 4 + rg] * a1) * inv;
            u32x2 w; w.x = pk2(o[0], o[1]); w.y = pk2(o[2], o[3]);
            *(u32x2*)(BR + qrow * BRW + 512 + h * 64 + 16 * db + 4 * g4) = w; } }
    __syncthreads();
}

constexpr int PH_PER_LAYER = 11, PH_FINAL = 1 + 2 * PH_PER_LAYER, NPHASES = PH_FINAL + 1;
__device__ __forceinline__ void moe_tables(const Params& p, LAS unsigned char* lds, int l, int tid) {
    LAS int* tb = (LAS int*)(lds + MOE_TAB_OFF); LAS int* cn = tb + 128;
    if (tid < 64) { const unsigned c = ((const unsigned*)(p.ws + WS_CTL))[CW_CNT + l * 2048 + tid * 16]; cn[tid] = (int)(c < (unsigned)NT ? c : (unsigned)NT); }
    __syncthreads();
    if (tid == 0) { int s = 0; for (int e = 0; e < 64; ++e) { tb[e] = s; s += (cn[e] + 255) >> 8; } tb[64] = s; }
    __syncthreads();
}

__global__ void __launch_bounds__(NTHREADS, 2) fwd_kernel(Params p0) {
    extern __shared__ __attribute__((aligned(16))) unsigned char lds_raw[];
    LAS unsigned char* lds = (LAS unsigned char*)lds_raw;
    const int tid0 = threadIdx.x, G = gridDim.x, bid = blockIdx.x, NGW = G * NWAVES;
#define PHASE_IDS const int tid = launder(tid0), wave = __builtin_amdgcn_readfirstlane(tid >> 6), lane = tid & 63, gw = bid * NWAVES + wave; (void)lane; (void)gw; \
    Params p = p0; p.ws = launder_p(p0.ws); p.out = launder_p(p0.out)
    volatile LAS unsigned* xbw = (volatile LAS unsigned*)(lds + LDS_BYTES - 16);
    if (tid0 == 0) { xbw[0] = 0u; xbw[1] = 0u; xbw[2] = 0u; xbw[3] = 0u; }
    __syncthreads();
    XcdBarrier bar = xcd_barrier_post((unsigned*)(p0.ws + WS_CTL) + CW_BAR + p0.li * XCD_BAR_WORDS, xbw);
#ifdef TEST_PHASE
#define IN(k) ((((k) - 1) % PH_PER_LAYER == TEST_PHASE - 1 && (k) >= 1 && (k) < PH_FINAL && TEST_PHASE >= 1) || ((k) == 0 && TEST_PHASE == 0) || ((k) == PH_FINAL && TEST_PHASE == 99)) && (launder_s(p0.ph_lo) <= (k) && (k) < launder_s(p0.ph_hi))
#else
#define IN(k) (launder_s(p0.ph_lo) <= (k) && (k) < launder_s(p0.ph_hi))
#endif
#define SEAM(k) do { if (IN(k) && IN((k) + 1)) xcd_barrier(bar); } while (0)
#define Hb ((bf16_t*)(p.ws + WS_H))
#define Zb ((bf16_t*)(p.ws + WS_R + R_Z))
#define BRb ((bf16_t*)(p.ws + WS_R + R_BR))
#define XC ((float*)(p.ws + WS_XC))
#define xl (l == 0 ? p.in[I_X] : (const float*)p.out)
#define xc (l == 0 ? p.in[I_CTX] : (const float*)XC)
#define mod ((const float*)(p.ws + WS_MOD) + (size_t)l * 9 * 6144)
#define wm (p.ws + WS_WM + (size_t)l * WM_STRIDE)

    if (IN(0)) {
        PHASE_IDS;
        for (int u = bid; u < 192; u += G) mod_unit(p, lds, u, tid);
        if (bid == G - 1) { float* rope = (float*)(p.ws + WS_ROPE);
            for (int idx = tid; idx < 1024; idx += NTHREADS) { const int pos = idx >> 4, f = idx & 15; const float inv = exp2f(-(float)f * (13.287712379549449f / 16.0f));
                float x = (float)pos * inv * 0.15915494309189535f; x -= floorf(x);
                rope[idx * 2] = __builtin_amdgcn_cosf(x); rope[idx * 2 + 1] = __builtin_amdgcn_sinf(x); } }
        __syncthreads();
        LAS float* scr = (LAS float*)(lds + wave * 8448);
        for (int it = gw; it < 2 * MISC_ITEMS + EXP_ITEMS; it += NGW) {
            if (it < MISC_ITEMS) misc_item(p, 0, it, scr, lane);
            else if (it < 2 * MISC_ITEMS) misc_item(p, 1, it - MISC_ITEMS, scr, lane);
            else expert_item(p, 0, it - 2 * MISC_ITEMS, scr, lane); }
    }
    SEAM(0);

    for (int l = 0; l < DEPTH; ++l) {
        const int base = 1 + PH_PER_LAYER * l;
        const bool need_ctx = l < DEPTH - 1;
        const int Mrows = need_ctx ? NT : NL;

        if (IN(base + 0)) {
            PHASE_IDS;
            for (int row = gw; row < NT; row += NGW) { const bool lat = row < NL; const float* xr = lat ? xl + (size_t)row * D : xc + (size_t)(row - NL) * D;
                const float* mr = mod + (size_t)(lat ? (row >> 11) : 8) * 6144;
                norm_mod_row(xr, p.in[I_NMG] + l * 1024, mr, mr + 1024, Hb + (size_t)row * D, false, lds, lane); }
        }
        SEAM(base + 0);
        if (IN(base + 1)) {
            PHASE_IDS;
            DenseSched S{(const char*)Hb, (const char*)(wm + WM_IN), 1024, 1024, NT / 256, INW / 256, G, bid, 1, 0, 0};
            EpiStoreBf16 E{Zb, INW};
            pg8::gemm_phase(lds, tid, 1024, 1024, S, E);
        }
        SEAM(base + 1);
        if (IN(base + 2)) {
            PHASE_IDS;
            const int nA = (Mrows / 128) * 4;
            for (int u = bid; u < 2048; u += G) na_unit(p, lds, l, u >> 8, (u >> 5) & 7, u & 31, true, tid);
            if (need_ctx) for (int u = bid; u < 256; u += G) na_unit(p, lds, l, u >> 5, (u >> 2) & 7, u & 3, false, tid);
            for (int u = (bid + 64) % G; u < 576; u += G) retkv_unit(p, lds, l, u / 72, (u / 18) % 4, u % 18, tid);
            for (int u = (bid + 128) % G; u < nA; u += G) mixA_unit(p, lds, l, u >> 2, u & 3, tid);
        }
        SEAM(base + 2);
        if (IN(base + 3)) {
            PHASE_IDS;
            const int cc_lo = need_ctx ? 0 : 2, ncc = NCHUNK - cc_lo, total = 32 * ncc;
            for (int u = bid; u < total; u += G) retout_unit(p, lds, l, u / (4 * ncc), (u / ncc) % 4, cc_lo + u % ncc, tid);
        }
        SEAM(base + 3);
        if (IN(base + 4)) {
            PHASE_IDS;
            DenseSched S{(const char*)BRb, (const char*)(wm + WM_BR), BRW, 512, Mrows / 256, 4, G, bid, 3, 512 * 2, (size_t)1024 * 512 * 2};
            EpiMerge E{Hb, Zb};
            pg8::gemm_phase(lds, tid, 512, 512, S, E);
        }
        SEAM(base + 4);
        if (IN(base + 5)) {
            PHASE_IDS;
            DenseSched S{(const char*)Hb, (const char*)(wm + WM_OUT), 1024, 1024, Mrows / 256, 4, G, bid, 1, 0, 0};
            EpiResid E{xl, xc, p.out, XC, mod + 2048};
            pg8::gemm_phase(lds, tid, 1024, 1024, S, E);
        }
        SEAM(base + 5);
        if (IN(base + 6)) {
            PHASE_IDS;
            for (int u = bid; u < Mrows / 64; u += G) router_unit(p, lds, l, u, p.out, XC, tid);
        }
        SEAM(base + 6);
        if (IN(base + 7)) {
            PHASE_IDS;
            moe_tables(p, lds, l, tid);
            MoeGuSched S{(const char*)Hb, (const char*)(p.ws + WS_WE + WE_GU), (const char*)(wm + WM_SGU), (const unsigned*)(p.ws + WS_LIST),
                         (const LAS int*)(lds + MOE_TAB_OFF), (const LAS int*)(lds + MOE_TAB_OFF) + 128, Mrows / 256, G, bid};
            EpiGateUp E{(bf16_t*)(p.ws + WS_R + R_ACT), (bf16_t*)(p.ws + WS_R + R_ACTS), (const float*)(p.ws + WS_WL)};
            pg8::gemm_phase(lds, tid, 1024, 1024, S, E);
        }
        SEAM(base + 7);
        if (IN(base + 8)) {
            PHASE_IDS;
            moe_tables(p, lds, l, tid);
            MoeDownSched S{(const char*)(p.ws + WS_R + R_ACT), (const char*)(p.ws + WS_WE + WE_D), (const LAS int*)(lds + MOE_TAB_OFF), (const LAS int*)(lds + MOE_TAB_OFF) + 128, G, bid};
            EpiDown E{(bf16_t*)(p.ws + WS_R + R_O), (const unsigned*)(p.ws + WS_LIST)};
            pg8::gemm_phase(lds, tid, 256, 256, S, E);
        }
        SEAM(base + 8);
        if (IN(base + 9)) {
            PHASE_IDS;
            DenseSched S{(const char*)(p.ws + WS_R + R_ACTS), (const char*)(wm + WM_SD), 256, 256, Mrows / 256, 4, G, bid, 1, 0, 0};
            EpiSharedDown E{p.out, XC, mod + 5120, (const bf16_t*)(p.ws + WS_R + R_O)};
            pg8::gemm_phase(lds, tid, 256, 256, S, E);
        }
        SEAM(base + 9);
        if (IN(base + 10)) {
            PHASE_IDS;
            if (l + 1 < DEPTH) { LAS float* scr = (LAS float*)(lds + wave * 8448);
                for (int it = gw; it < EXP_ITEMS; it += NGW) expert_item(p, l + 1, it, scr, lane); }
        }
        SEAM(base + 10);
    }
    if (IN(PH_FINAL)) {
        PHASE_IDS;
        for (int row = gw; row < NL; row += NGW) { float* xr = p.out + (size_t)row * D;
            f32x4 v[4]; float ss = 0.f;
#pragma unroll
            for (int j = 0; j < 4; ++j) { v[j] = ((const f32x4*)xr)[64 * j + lane]; ss += (v[j][0] * v[j][0] + v[j][1] * v[j][1]) + (v[j][2] * v[j][2] + v[j][3] * v[j][3]); }
            const float rstd = rsqrtf(wave_sum(ss) * (1.0f / 1024.0f) + EPS);
#pragma unroll
            for (int j = 0; j < 4; ++j) ((f32x4*)xr)[64 * j + lane] = v[j] * rstd * ((const f32x4*)p.in[I_FG])[64 * j + lane]; }
    }
#undef IN
#undef SEAM
#undef Hb
#undef Zb
#undef BRb
#undef XC
#undef xl
#undef xc
#undef mod
#undef wm
}

#ifndef MK_PER_PHASE
#define MK_PER_PHASE 1
#endif
extern "C" void kernel_launch(void* const* d_in, const int* in_sizes, int n_in, void* d_out, int out_size, void* d_ws, size_t ws_size, hipStream_t stream) {
    static int grid = 0;
    if (grid == 0) {
        if (n_in != 26 || out_size != NL * D || ws_size < WS_END) { fprintf(stderr, "kernel_launch: unexpected shapes (n_in %d out %d ws %zu, need %zu)\n", n_in, out_size, ws_size, (size_t)WS_END); grid = -1; return; }
        int dev = 0, cus = 0;
        if (hipGetDevice(&dev) != hipSuccess || hipDeviceGetAttribute(&cus, hipDeviceAttributeMultiprocessorCount, dev) != hipSuccess) { grid = -1; return; }
        if (hipFuncSetAttribute((const void*)fwd_kernel, hipFuncAttributeMaxDynamicSharedMemorySize, LDS_BYTES) != hipSuccess) { fprintf(stderr, "kernel_launch: hipFuncSetAttribute failed\n"); grid = -1; return; }
        int per_cu = 0;
        if (hipOccupancyMaxActiveBlocksPerMultiprocessor(&per_cu, (const void*)fwd_kernel, NTHREADS, LDS_BYTES) != hipSuccess || per_cu < 1) { fprintf(stderr, "kernel_launch: occupancy query says %d\n", per_cu); }
        (void)hipGetLastError();
        grid = cus;
    }
    if (grid < 0) return;
    (void)hipMemsetAsync((char*)d_ws + WS_CTL, 0, CTL_BYTES, stream);
    Params p{};
    for (int i = 0; i < 26; ++i) p.in[i] = (const float*)d_in[i];
    p.out = (float*)d_out; p.ws = (unsigned char*)d_ws;
#if MK_PER_PHASE
    for (int k = 0; k < NPHASES; ++k) { p.ph_lo = k; p.ph_hi = k + 1; p.li = k;
        hipLaunchKernelGGL(fwd_kernel, dim3(grid), dim3(NTHREADS), LDS_BYTES, stream, p); }
#else
    p.ph_lo = 0; p.ph_hi = NPHASES; p.li = 0;
    hipLaunchKernelGGL(fwd_kernel, dim3(grid), dim3(NTHREADS), LDS_BYTES, stream, p);
#endif
}
```

```cpp
#include <hip/hip_runtime.h>
#include <stdint.h>
#include <stdio.h>

#define LAS __attribute__((address_space(3)))
typedef unsigned short bf16_t;
typedef short bf16x8 __attribute__((ext_vector_type(8)));
typedef short bf16x4 __attribute__((ext_vector_type(4)));
typedef float f32x4 __attribute__((ext_vector_type(4)));
typedef float f32x2 __attribute__((ext_vector_type(2)));
typedef unsigned u32x4 __attribute__((ext_vector_type(4)));
typedef unsigned u32x2 __attribute__((ext_vector_type(2)));

constexpr int D = 1024, NB = 8, SEQ = 2048, CTXL = 256, DEPTH = 2;
constexpr int NL = NB * SEQ;
constexpr int NC = NB * CTXL;
constexpr int NT = NL + NC;
constexpr int INW = 7168;
constexpr int ZC_AU = 0, ZC_AV = 512, ZC_NQ = 1024, ZC_NK = 1536, ZC_NV = 2048, ZC_RQ = 2560, ZC_RK = 2816, ZC_RV = 3072, ZC_RG = 3584,
              ZC_GA = 4096;
constexpr int BRW = 1536;
constexpr int NEXP = 64, TOPK = 8, EXPW = 256;
constexpr int NCHUNK = 18;
constexpr float EPS = 1e-6f;
constexpr int NTHREADS = 512, NWAVES = 8;
constexpr int LDS_BYTES = 159744;

constexpr size_t MiB = 1u << 20;
constexpr size_t WS_CTL = 0, CTL_BYTES = 1 * MiB;
constexpr size_t WS_MOD = 1 * MiB;
constexpr size_t WS_ROPE = 1 * MiB + 512 * 1024;
constexpr size_t WS_WM = 2 * MiB, WM_STRIDE = 21 * MiB;
constexpr size_t WM_IN = 0, WM_BR = 14680064, WM_OUT = WM_BR + 3145728, WM_SGU = WM_OUT + 2097152, WM_SD = WM_SGU + 1048576,
                 WM_RT = WM_SD + 524288, WM_CM = WM_RT + 131072, WM_END = WM_CM + 131072;
static_assert(WM_END <= WM_STRIDE, "misc weights");
constexpr size_t WS_WE = 44 * MiB;
constexpr size_t WE_GU = 0, WE_D = 67108864;
constexpr size_t WS_XC = 140 * MiB;
constexpr size_t WS_H = 148 * MiB;
constexpr size_t WS_LIST = 184 * MiB, WS_WL = 189 * MiB;
constexpr size_t WS_R = 194 * MiB;
constexpr size_t R_Z = 0, R_BR = 252 * MiB, R_KV = 306 * MiB;
constexpr size_t R_O = 0, R_ACT = 288 * MiB, R_ACTS = 368 * MiB;
constexpr size_t WS_END = WS_R + 377 * MiB;
static_assert(R_KV + 37748736 <= 377 * MiB && R_ACTS + 9437184 <= 377 * MiB && R_Z + 264241152 <= R_BR && R_BR + 56623104 <= R_KV, "region map");
static_assert(R_O + 301989888 <= R_ACT && R_ACT + 83886080 <= R_ACTS, "region map 2");
constexpr int CW_BAR = 4096;
constexpr int CW_CNT = 200000;

__device__ __forceinline__ float bf2f(unsigned short b) { return __uint_as_float(((unsigned)b) << 16); }
__device__ __forceinline__ unsigned f2bf(float f) { unsigned u = __float_as_uint(f); return (u + 0x7fffu + ((u >> 16) & 1u)) >> 16; }
__device__ __forceinline__ unsigned pk2(float lo, float hi) { return f2bf(lo) | (f2bf(hi) << 16); }
__device__ __forceinline__ float lo16(unsigned w) { return __uint_as_float(w << 16); }
__device__ __forceinline__ float hi16(unsigned w) { return __uint_as_float(w & 0xffff0000u); }
__device__ __forceinline__ float wave_sum(float v) {
#pragma unroll
    for (int o = 1; o < 64; o <<= 1) v += __shfl_xor(v, o);
    return v;
}
__device__ __forceinline__ float fast_exp(float x) { return __builtin_amdgcn_exp2f(x * 1.44269504089f); }
__device__ __forceinline__ float sigmoidf_(float x) { return __builtin_amdgcn_rcpf(1.0f + fast_exp(-x)); }
__device__ __forceinline__ float siluf_(float x) { return x * sigmoidf_(x); }
__device__ __forceinline__ float geluf_(float x) { const float u = 0.7978845608f * (x + 0.044715f * x * x * x); return x * sigmoidf_(2.0f * u); }
__device__ __forceinline__ f32x4 mfma16(bf16x8 a, bf16x8 b, f32x4 c) { return __builtin_amdgcn_mfma_f32_16x16x32_bf16(a, b, c, 0, 0, 0); }
__device__ __forceinline__ bf16x8 as_frag(u32x4 v) { return __builtin_bit_cast(bf16x8, v); }
__device__ __forceinline__ int launder(int v) { asm volatile("" : "+v"(v)); return v; }
__device__ __forceinline__ int launder_s(int v) { asm volatile("" : "+s"(v)); return v; }
template <class T> __device__ __forceinline__ T* launder_p(T* q) { asm volatile("" : "+s"(q)); return q; }
#define LDS_WAIT() asm volatile("s_waitcnt lgkmcnt(0)" ::: "memory")
#define VM_WAIT() asm volatile("s_waitcnt vmcnt(0)" ::: "memory")

__device__ __forceinline__ bf16x8 tr_frag(unsigned base, int stride, int r0, int r1, int c0, int lane) {
    const int q = (lane & 15) >> 2, p = lane & 3;
    const unsigned a0 = base + (unsigned)((r0 + q) * stride + (c0 + 4 * p) * 2), a1 = base + (unsigned)((r1 + q) * stride + (c0 + 4 * p) * 2);
    bf16x4 lo, hi;
    asm volatile("ds_read_b64_tr_b16 %0, %2\n\tds_read_b64_tr_b16 %1, %3\n\ts_waitcnt lgkmcnt(0)" : "=&v"(lo), "=&v"(hi) : "v"(a0), "v"(a1) : "memory");
    bf16x8 r; r[0] = lo[0]; r[1] = lo[1]; r[2] = lo[2]; r[3] = lo[3]; r[4] = hi[0]; r[5] = hi[1]; r[6] = hi[2]; r[7] = hi[3];
    return r;
}
__device__ __forceinline__ unsigned lds_addr(LAS unsigned char* p) { return (unsigned)(size_t)p; }
template <int O0, int O1> __device__ __forceinline__ bf16x8 tr_frag_i(unsigned a) {
    static_assert(O0 >= 0 && O0 < 65536 && O1 >= 0 && O1 < 65536, "ds offset field");
    bf16x4 lo, hi;
    asm volatile("ds_read_b64_tr_b16 %0, %2 offset:%3\n\tds_read_b64_tr_b16 %1, %2 offset:%4\n\ts_waitcnt lgkmcnt(0)" : "=&v"(lo), "=&v"(hi) : "v"(a), "n"(O0), "n"(O1) : "memory");
    bf16x8 r; r[0] = lo[0]; r[1] = lo[1]; r[2] = lo[2]; r[3] = lo[3]; r[4] = hi[0]; r[5] = hi[1]; r[6] = hi[2]; r[7] = hi[3];
    return r;
}
__device__ __forceinline__ unsigned tr_lane(unsigned base, int stride, int rmul, int lane) { return base + (unsigned)((rmul * (lane >> 4) + ((lane & 15) >> 2)) * stride + (lane & 3) * 8); }
template <int V> struct IC { static constexpr int value = V; };
template <int I, int N, class F> __device__ __forceinline__ void sfor(F&& f) { if constexpr (I < N) { f(IC<I>{}); sfor<I + 1, N>(f); } }


#define XB_TMO      128
#define XB_XCNT(j)  (256  + 64 * (j))
#define XB_XSUB(j)  (1280 + 64 * (j))
#define XB_XGEN(j)  (2304 + 64 * (j))
#define XB_TOP      3328
#define XB_TOPGEN   3392
#define XCD_BAR_WORDS 3456
#define XB_SPIN_CAP (1u << 21)
__device__ __forceinline__ unsigned xb_ld(unsigned* p)              { return __hip_atomic_load(p, __ATOMIC_RELAXED, __HIP_MEMORY_SCOPE_AGENT); }
__device__ __forceinline__ unsigned xb_add(unsigned* p, unsigned v) { return __hip_atomic_fetch_add(p, v, __ATOMIC_RELAXED, __HIP_MEMORY_SCOPE_AGENT); }
__device__ __forceinline__ unsigned xb_xcc_id() { return (unsigned)__builtin_amdgcn_s_getreg((3 << 11) | 20) & 0xFu; }
#define XB_SPIN(cond, bar) do { unsigned _sp = 0; while (cond) { __builtin_amdgcn_s_sleep(1); \
    if ((++_sp & 255u) == 0u) { if (xb_ld(&(bar)[XB_TMO])) break; if (_sp > XB_SPIN_CAP) { atomicAdd(&(bar)[XB_TMO], 1u); break; } } } } while (0)
struct XcdBarrier { unsigned* bar; unsigned x; volatile LAS unsigned* st; };
__device__ __forceinline__ XcdBarrier xcd_barrier_post(unsigned* bar, volatile LAS unsigned* st) {
    XcdBarrier b; b.bar = bar; b.x = xb_xcc_id(); b.st = st;
    if (threadIdx.x == 0) (void)xb_add(&bar[XB_XCNT(b.x)], 1u);
    return b;
}
__device__ __forceinline__ void xcd_barrier_complete(unsigned* bar, unsigned x, unsigned& nloc, unsigned& nx) {
    const unsigned G = gridDim.x * gridDim.y * gridDim.z;
    unsigned sum, cnt, mine, sp = 0u;
    for (;;) {
        sum = 0u; cnt = 0u; mine = 0u;
#pragma unroll
        for (unsigned j = 0; j < 16; ++j) { const unsigned c = xb_ld(&bar[XB_XCNT(j)]); sum += c; cnt += (c > 0u) ? 1u : 0u; mine = (j == x) ? c : mine; }
        if (sum == G) break;
        __builtin_amdgcn_s_sleep(1);
        if ((++sp & 255u) == 0u) { if (xb_ld(&bar[XB_TMO])) break; if (sp > XB_SPIN_CAP) { atomicAdd(&bar[XB_TMO], 1u); break; } }
    }
    nloc = mine > 0u ? mine : 1u; nx = cnt > 0u ? cnt : 1u;
}
__device__ __forceinline__ void xcd_barrier(const XcdBarrier& b) {
    asm volatile("s_waitcnt vmcnt(0)" ::: "memory");
    __syncthreads();
    if (threadIdx.x == 0) {
        unsigned* bar = b.bar;
        __builtin_amdgcn_s_waitcnt(0);
        unsigned nloc = b.st[0], nx = b.st[1];
        if (nloc == 0u) { xcd_barrier_complete(bar, b.x, nloc, nx); b.st[0] = nloc; b.st[1] = nx; }
        const unsigned old = xb_add(&bar[XB_XSUB(b.x)], 1u);
        const unsigned gen = old / nloc;
        if (old + 1u == (gen + 1u) * nloc) {
            __builtin_amdgcn_fence(__ATOMIC_RELEASE, "agent");
            asm volatile("s_waitcnt vmcnt(0)" ::: "memory");
            const unsigned og = xb_add(&bar[XB_TOP], 1u);
            const unsigned tg = og / nx;
            if (og + 1u == (tg + 1u) * nx) xb_add(&bar[XB_TOPGEN], 1u);
            else XB_SPIN(xb_ld(&bar[XB_TOPGEN]) == tg, bar);
            __builtin_amdgcn_fence(__ATOMIC_ACQUIRE, "agent");
            xb_add(&bar[XB_XGEN(b.x)], 1u);
            asm volatile("s_waitcnt vmcnt(0)" ::: "memory");
        } else {
            XB_SPIN(xb_ld(&bar[XB_XGEN(b.x)]) == gen, bar);
            __builtin_amdgcn_fence(__ATOMIC_ACQUIRE, "agent");
            asm volatile("s_waitcnt vmcnt(0)" ::: "memory");
        }
    }
    __syncthreads();
}

namespace pg8 {
constexpr int BM = 256, BK = 64, HALF = 128, HTB = HALF * BK * 2, STAGE_BYTES = 8 * HTB, NXCD = 8, WGM = 8;
constexpr int GATHER_SLOT_OFF = 133120;
__device__ __forceinline__ int lds_byte(int r, int c) { const int st = (r >> 4) * 2 + (c >> 5), rr = r & 15, cc = c & 31, ob = rr * 64 + cc * 2; return st * 1024 + (ob ^ (((ob >> 9) & 1) << 5)); }
__device__ __forceinline__ void stage_rc(int b, int& R, int& C) { const int st = b / 1024, sb = b % 1024, swz = sb ^ (((sb >> 9) & 1) << 5); R = (st >> 1) * 16 + swz / 64; C = (st & 1) * 32 + (swz % 64) / 2; }
__device__ __forceinline__ int perm32(int rho) { const int n = rho >> 4, i = rho & 15; return 8 * (i >> 2) + 4 * n + (i & 3); }

struct Unit { const char* A; const char* B; int e0, e1, e2, e3, e4; };

__device__ __forceinline__ bool static_tile(int i, int G, int c, int nM, int nN, int& pm, int& pn) {
    const int nwg = nM * nN; const long L = (long)i * G + c; if (L >= nwg) return false;
    int wgid = (int)L; { const int q = nwg / NXCD, r = nwg % NXCD, xcd = wgid % NXCD, off = wgid / NXCD; wgid = (xcd < r ? xcd * (q + 1) : r * (q + 1) + (xcd - r) * q) + off; }
    const int nig = WGM * nN, gid = wgid / nig, fm = gid * WGM, gsz = (nM - fm) < WGM ? (nM - fm) : WGM;
    pm = fm + ((wgid % nig) % gsz); pn = (wgid % nig) / gsz; return true;
}

template <class Epi, class Sched>
__device__ __forceinline__ void gemm_phase(LAS unsigned char* lds, const int tid, const int K, const int ldb  , const Sched& S, const Epi& E) {
    const int wid = __builtin_amdgcn_readfirstlane(tid >> 6), lane = tid & 63, wr = wid >> 2, wc = wid & 3, fr = lane & 15, fq = lane >> 4;
    const int nt = K / BK;
    unsigned voffB[2];
#pragma unroll
    for (int i = 0; i < 2; ++i) { int R, C; stage_rc(tid * 16 + i * 8192, R, C); const int Rb = Epi::PERM ? ((R & ~31) + perm32(R & 31)) : R; voffB[i] = (unsigned)(Rb * ldb + C) * 2u; }
    const size_t kstep = (size_t)(BK * 2);
    const size_t hstepB = (size_t)HALF * ldb * 2;
    const unsigned ldsw = (unsigned)wid * 1024u;
    const int aoff = lds_byte(wr * 64 + fr, fq * 8), boff = lds_byte(wc * 32 + fr, fq * 8);
#define PG8_SA(b, h) (((b) * 2 + (h)) * HTB)
#define PG8_SB(b, h) ((4 + (b) * 2 + (h)) * HTB)
#define PG8_STAGE(bufoff, gbase, voff) do { _Pragma("unroll") for (int _i = 0; _i < 2; ++_i) \
        __builtin_amdgcn_global_load_lds((const unsigned*)((const char*)(gbase) + (voff)[_i]), (LAS unsigned*)(lds + (bufoff) + ldsw + _i * 8192), 16, 0, 0); } while (0)
#define PG8_LDA(dst, b, h) do { _Pragma("unroll") for (int m = 0; m < 4; ++m) _Pragma("unroll") for (int k = 0; k < 2; ++k) dst[m][k] = *(const LAS bf16x8*)(lds + PG8_SA(b, h) + aoff + m * 2048 + k * 1024); } while (0)
#define PG8_LDB(dst, b, h) do { _Pragma("unroll") for (int n = 0; n < 2; ++n) _Pragma("unroll") for (int k = 0; k < 2; ++k) dst[n][k] = *(const LAS bf16x8*)(lds + PG8_SB(b, h) + boff + n * 2048 + k * 1024); } while (0)
#define PG8_MMA(ai, bj, At, Bt) do { __builtin_amdgcn_s_setprio(1); _Pragma("unroll") for (int m = 0; m < 4; ++m) _Pragma("unroll") for (int n = 0; n < 2; ++n) _Pragma("unroll") for (int k = 0; k < 2; ++k) \
        acc[ai][bj][m][n] = __builtin_amdgcn_mfma_f32_16x16x32_bf16(Bt[n][k], At[m][k], acc[ai][bj][m][n], 0, 0, 0); __builtin_amdgcn_s_setprio(0); } while (0)
#define PG8_WAIT_V(n) asm volatile("s_waitcnt vmcnt(" #n ")" ::: "memory")
#define PG8_WAIT_L(n) asm volatile("s_waitcnt lgkmcnt(" #n ")" ::: "memory")
#define PG8_BAR __builtin_amdgcn_s_barrier()
#define PG8_SCHED __builtin_amdgcn_sched_barrier(0)
    Unit cur, nxt; int ui = 0;
    if (!S.next(0, cur)) return;
    unsigned cvA[2][2], nvA[2][2];
    S.a_offs(cur, tid, cvA);
    LAS unsigned* const gslot = (LAS unsigned*)(lds + GATHER_SLOT_OFF) + tid * 4;
    if constexpr (Sched::GATHER) { *(LAS u32x4*)gslot = (u32x4){cvA[0][0], cvA[0][1], cvA[1][0], cvA[1][1]}; }
    f32x4 acc[2][2][4][2];
#pragma unroll
    for (int a = 0; a < 2; ++a)
#pragma unroll
        for (int b = 0; b < 2; ++b)
#pragma unroll
            for (int m = 0; m < 4; ++m)
#pragma unroll
                for (int n = 0; n < 2; ++n) acc[a][b][m][n] = (f32x4){0.f, 0.f, 0.f, 0.f};
    bf16x8 At[4][2], B0[2][2], B1[2][2];
    const char* cA = cur.A; const char* cB = cur.B;
    PG8_STAGE(PG8_SB(0, 0), cB, voffB); PG8_STAGE(PG8_SA(0, 0), cA, cvA[0]); PG8_STAGE(PG8_SB(0, 1), cB + hstepB, voffB); PG8_STAGE(PG8_SA(0, 1), cA, cvA[1]);
    if (wr == 1) PG8_BAR;
    PG8_WAIT_V(4); PG8_BAR;
    PG8_STAGE(PG8_SB(1, 0), cB + kstep, voffB); PG8_STAGE(PG8_SA(1, 0), cA + kstep, cvA[0]); PG8_STAGE(PG8_SB(1, 1), cB + hstepB + kstep, voffB);
    PG8_WAIT_V(6); PG8_BAR;
    for (;;) {
        const bool has_next = S.next(ui + 1, nxt);
        if (has_next) S.a_offs(nxt, tid, nvA);
        else {
#pragma unroll
            for (int h = 0; h < 2; ++h)
#pragma unroll
                for (int i = 0; i < 2; ++i) nvA[h][i] = cvA[h][i];
        }
        if constexpr (Sched::GATHER) { *(LAS u32x4*)(gslot + ((ui + 1) & 1) * 2048) = (u32x4){nvA[0][0], nvA[0][1], nvA[1][0], nvA[1][1]}; }
        const char* nA = has_next ? nxt.A : cA; const char* nB = has_next ? nxt.B : cB;
#pragma unroll 1
        for (int t = 0; t < nt; t += 2) {
            const bool last = (t == nt - 2);
            const char* a1 = cA + (size_t)(t + 1) * kstep;
            const char* a2 = last ? nA : cA + (size_t)(t + 2) * kstep; const char* b2 = last ? nB : cB + (size_t)(t + 2) * kstep;
            const char* a3 = a2 + kstep; const char* b3 = b2 + kstep;
            unsigned sA[2][2];
            if constexpr (Sched::GATHER) {
                const u32x4 cv = *(const LAS u32x4*)(gslot + (ui & 1) * 2048), sv = *(const LAS u32x4*)(gslot + ((ui + (last ? 1 : 0)) & 1) * 2048);
                cvA[0][0] = cv.x; cvA[0][1] = cv.y; cvA[1][0] = cv.z; cvA[1][1] = cv.w; sA[0][0] = sv.x; sA[0][1] = sv.y; sA[1][0] = sv.z; sA[1][1] = sv.w;
            } else {
#pragma unroll
                for (int h = 0; h < 2; ++h)
#pragma unroll
                    for (int i = 0; i < 2; ++i) sA[h][i] = last ? nvA[h][i] : cvA[h][i];
            }
            PG8_LDB(B0, 0, 0); PG8_SCHED; PG8_LDA(At, 0, 0); PG8_STAGE(PG8_SA(1, 1), a1, cvA[1]);
            PG8_WAIT_L(8); PG8_BAR; PG8_WAIT_L(0); PG8_MMA(0, 0, At, B0); PG8_BAR; PG8_SCHED;
            PG8_LDB(B1, 0, 1); PG8_STAGE(PG8_SB(0, 0), b2, voffB);
            PG8_BAR; PG8_WAIT_L(0); PG8_MMA(0, 1, At, B1); PG8_BAR;
            PG8_LDA(At, 0, 1); PG8_STAGE(PG8_SA(0, 0), a2, sA[0]);
            PG8_BAR; PG8_WAIT_L(0); PG8_MMA(1, 0, At, B0); PG8_BAR; PG8_SCHED;
            PG8_STAGE(PG8_SB(0, 1), b2 + hstepB, voffB);
            PG8_WAIT_V(6); PG8_BAR; PG8_MMA(1, 1, At, B1); PG8_BAR;
            PG8_LDB(B0, 1, 0); PG8_SCHED; PG8_LDA(At, 1, 0); PG8_STAGE(PG8_SA(0, 1), a2, sA[1]);
            PG8_WAIT_L(8); PG8_BAR; PG8_WAIT_L(0); PG8_MMA(0, 0, At, B0); PG8_BAR; PG8_SCHED;
            PG8_LDB(B1, 1, 1); PG8_STAGE(PG8_SB(1, 0), b3, voffB);
            PG8_BAR; PG8_WAIT_L(0); PG8_MMA(0, 1, At, B1); PG8_BAR;
            PG8_LDA(At, 1, 1); PG8_STAGE(PG8_SA(1, 0), a3, sA[0]);
            PG8_BAR; PG8_WAIT_L(0); PG8_MMA(1, 0, At, B0); PG8_BAR; PG8_SCHED;
            PG8_STAGE(PG8_SB(1, 1), b3 + hstepB, voffB);
            PG8_WAIT_V(6); PG8_BAR; PG8_MMA(1, 1, At, B1); PG8_BAR;
        }
        E(acc, cur, wr, wc, fr, fq);
        if (!has_next) break;
#pragma unroll
        for (int a = 0; a < 2; ++a)
#pragma unroll
            for (int b = 0; b < 2; ++b)
#pragma unroll
                for (int m = 0; m < 4; ++m)
#pragma unroll
                    for (int n = 0; n < 2; ++n) acc[a][b][m][n] = (f32x4){0.f, 0.f, 0.f, 0.f};
        cur = nxt; cA = nA; cB = nB; ++ui;
        if constexpr (!Sched::GATHER) {
#pragma unroll
            for (int h = 0; h < 2; ++h)
#pragma unroll
                for (int i = 0; i < 2; ++i) cvA[h][i] = nvA[h][i];
        }
    }
    PG8_WAIT_V(0);
    if (wr == 0) PG8_BAR;
    PG8_BAR;
#undef PG8_SA
#undef PG8_SB
#undef PG8_STAGE
#undef PG8_LDA
#undef PG8_LDB
#undef PG8_MMA
#undef PG8_WAIT_V
#undef PG8_WAIT_L
#undef PG8_BAR
#undef PG8_SCHED
}
}

using pg8::Unit;
struct DenseSched {
    static constexpr bool GATHER = false;
    const char* A; const char* B; int lda, ldb, nM, nN, G, c, nsub; size_t asub, bsub;
    __device__ __forceinline__ bool next(int i, Unit& u) const {
        const int sub = i % nsub, ti = i / nsub; int pm, pn;
        if (!pg8::static_tile(ti, G, c, nM, nN, pm, pn)) return false;
        u.A = A + (size_t)pm * 256 * lda * 2 + (size_t)sub * asub; u.B = B + (size_t)pn * 256 * ldb * 2 + (size_t)sub * bsub;
        u.e0 = pm; u.e1 = pn; u.e2 = sub; u.e3 = 0; u.e4 = 0; return true;
    }
    __device__ __forceinline__ void a_offs(const Unit&, int tid, unsigned (&vo)[2][2]) const {
#pragma unroll
        for (int i = 0; i < 2; ++i) { int R, C; pg8::stage_rc(tid * 16 + i * 8192, R, C);
#pragma unroll
            for (int h = 0; h < 2; ++h) vo[h][i] = (unsigned)((h * 128 + R) * lda + C) * 2u; }
    }
};
constexpr int MOE_TAB_OFF = 131072;
#define RFL(x) __builtin_amdgcn_readfirstlane(x)
__device__ __forceinline__ int moe_find_expert(const LAS int* tbase, int mt) {
    int lo = 0, hi = 63;
#pragma unroll
    for (int it = 0; it < 6; ++it) { const int mid = (lo + hi + 1) >> 1; if (RFL(tbase[mid]) <= mt) lo = mid; else hi = mid - 1; }
    return lo;
}
struct MoeGuSched {
    static constexpr bool GATHER = true;
    const char* H2; const char* WGU; const char* WSGU; const unsigned* list; const LAS int* tbase; const LAS int* cnt; int nMs, G, c;
    __device__ __forceinline__ bool next(int i, Unit& u) const {
        const int idx = i * G + c, ntr = RFL(tbase[64]);
        if (idx >= 2 * ntr + 2 * nMs) return false;
        if (idx < 2 * ntr) { const int mt = idx >> 1, nt = idx & 1, e = moe_find_expert(tbase, mt);
            u.A = H2; u.B = WGU + (size_t)e * (512 * 1024 * 2) + (size_t)nt * (256 * 1024 * 2); u.e0 = e; u.e1 = nt; u.e2 = (mt - RFL(tbase[e])) * 256; u.e3 = mt; u.e4 = RFL(cnt[e]); }
        else { const int s = idx - 2 * ntr, pm = s >> 1, nt = s & 1;
            u.A = H2 + (size_t)pm * 256 * 2048; u.B = WSGU + (size_t)nt * (256 * 1024 * 2); u.e0 = 64; u.e1 = nt; u.e2 = 0; u.e3 = pm; u.e4 = 0; }
        return true;
    }
    __device__ __forceinline__ void a_offs(const Unit& u, int tid, unsigned (&vo)[2][2]) const {
#pragma unroll
        for (int i = 0; i < 2; ++i) { int R, C; pg8::stage_rc(tid * 16 + i * 8192, R, C);
#pragma unroll
            for (int h = 0; h < 2; ++h) {
                if (u.e0 == 64) vo[h][i] = (unsigned)((h * 128 + R) * 1024 + C) * 2u;
                else { const int pos = u.e2 + h * 128 + R; unsigned tok = 0u; if (pos < u.e4) tok = list[(size_t)u.e0 * NT + pos] >> 3; vo[h][i] = tok * 2048u + (unsigned)C * 2u; } } }
    }
};
struct MoeDownSched {
    static constexpr bool GATHER = false;
    const char* ACT; const char* WD; const LAS int* tbase; const LAS int* cnt; int G, c;
    __device__ __forceinline__ bool next(int i, Unit& u) const {
        const int idx = i * G + c, ntr = RFL(tbase[64]);
        if (idx >= 4 * ntr) return false;
        const int mt = idx >> 2, pn = idx & 3, e = moe_find_expert(tbase, mt);
        u.A = ACT + (size_t)mt * (256 * 256 * 2); u.B = WD + (size_t)e * (1024 * 256 * 2) + (size_t)pn * (256 * 256 * 2);
        u.e0 = e; u.e1 = pn; u.e2 = (mt - RFL(tbase[e])) * 256; u.e3 = mt; u.e4 = RFL(cnt[e]); return true;
    }
    __device__ __forceinline__ void a_offs(const Unit&, int tid, unsigned (&vo)[2][2]) const {
#pragma unroll
        for (int i = 0; i < 2; ++i) { int R, C; pg8::stage_rc(tid * 16 + i * 8192, R, C);
#pragma unroll
            for (int h = 0; h < 2; ++h) vo[h][i] = (unsigned)((h * 128 + R) * 256 + C) * 2u; }
    }
};

struct EpiStoreBf16 {
    static constexpr bool PERM = true;
    bf16_t* O; int ldc;
    __device__ __forceinline__ void operator()(const f32x4 (&acc)[2][2][4][2], const Unit& u, int wr, int wc, int fr, int fq) const {
        const int row0 = u.e0 * 256 + launder(wr * 64 + fr), col0 = u.e1 * 256 + wc * 32 + 8 * fq;
#pragma unroll
        for (int ai = 0; ai < 2; ++ai)
#pragma unroll
            for (int m = 0; m < 4; ++m) { bf16_t* rowp = O + (size_t)(row0 + ai * 128 + m * 16) * ldc + col0;
#pragma unroll
                for (int bj = 0; bj < 2; ++bj) { const f32x4 v0 = acc[ai][bj][m][0], v1 = acc[ai][bj][m][1];
                    u32x4 w; w.x = pk2(v0[0], v0[1]); w.y = pk2(v0[2], v0[3]); w.z = pk2(v1[0], v1[1]); w.w = pk2(v1[2], v1[3]);
                    *(u32x4*)(rowp + bj * 128) = w; } }
    }
};
struct EpiMerge {
    static constexpr bool PERM = true;
    bf16_t* Mo; const bf16_t* Z;
    __device__ __forceinline__ void operator()(const f32x4 (&acc)[2][2][4][2], const Unit& u, int wr, int wc, int fr, int fq) const {
        const int row0 = u.e0 * 256 + launder(wr * 64 + fr), col0 = u.e1 * 256 + wc * 32 + 8 * fq, sub = u.e2;
#pragma unroll
        for (int ai = 0; ai < 2; ++ai)
#pragma unroll
            for (int m = 0; m < 4; ++m) { const size_t row = (size_t)(row0 + ai * 128 + m * 16);
#pragma unroll
                for (int bj = 0; bj < 2; ++bj) { const f32x4 v0 = acc[ai][bj][m][0], v1 = acc[ai][bj][m][1];
                    const u32x4 g = *(const u32x4*)(Z + row * INW + ZC_GA + 1024 * sub + col0 + bj * 128);
                    bf16_t* mp = Mo + row * 1024 + col0 + bj * 128;
                    u32x4 o = (u32x4){0u, 0u, 0u, 0u}; if (sub != 0) o = *(const u32x4*)mp;
                    float r[8];
                    r[0] = lo16(o.x) + sigmoidf_(lo16(g.x)) * v0[0]; r[1] = hi16(o.x) + sigmoidf_(hi16(g.x)) * v0[1];
                    r[2] = lo16(o.y) + sigmoidf_(lo16(g.y)) * v0[2]; r[3] = hi16(o.y) + sigmoidf_(hi16(g.y)) * v0[3];
                    r[4] = lo16(o.z) + sigmoidf_(lo16(g.z)) * v1[0]; r[5] = hi16(o.z) + sigmoidf_(hi16(g.z)) * v1[1];
                    r[6] = lo16(o.w) + sigmoidf_(lo16(g.w)) * v1[2]; r[7] = hi16(o.w) + sigmoidf_(hi16(g.w)) * v1[3];
                    u32x4 w; w.x = pk2(r[0], r[1]); w.y = pk2(r[2], r[3]); w.z = pk2(r[4], r[5]); w.w = pk2(r[6], r[7]);
                    *(u32x4*)mp = w; } }
    }
};
struct EpiResid {
    static constexpr bool PERM = false;
    const float* src_l; const float* src_c; float* dst_l; float* dst_c; const float* gate;
    __device__ __forceinline__ void operator()(const f32x4 (&acc)[2][2][4][2], const Unit& u, int wr, int wc, int fr, int fq) const {
        const int g0 = u.e0 * 256; const bool lat = g0 < NL;
        const float* src = lat ? src_l + (size_t)g0 * D : src_c + (size_t)(g0 - NL) * D;
        float* dst = lat ? dst_l + (size_t)g0 * D : dst_c + (size_t)(g0 - NL) * D;
        const float* gp = gate + (size_t)(lat ? (g0 >> 11) : 8) * 6144;
        const int row0 = launder(wr * 64 + fr), col0 = u.e1 * 256 + wc * 32 + 4 * fq;
        f32x4 gv[2][2];
#pragma unroll
        for (int bj = 0; bj < 2; ++bj)
#pragma unroll
            for (int n = 0; n < 2; ++n) gv[bj][n] = *(const f32x4*)(gp + col0 + bj * 128 + n * 16);
#pragma unroll
        for (int ai = 0; ai < 2; ++ai)
#pragma unroll
            for (int m = 0; m < 4; ++m) { const size_t ro = (size_t)(row0 + ai * 128 + m * 16) * D + col0;
#pragma unroll
                for (int bj = 0; bj < 2; ++bj)
#pragma unroll
                    for (int n = 0; n < 2; ++n) { const f32x4 s = *(const f32x4*)(src + ro + bj * 128 + n * 16);
                        *(f32x4*)(dst + ro + bj * 128 + n * 16) = s + gv[bj][n] * acc[ai][bj][m][n]; } }
    }
};
struct EpiGateUp {
    static constexpr bool PERM = true;
    bf16_t* ACT; bf16_t* ACTS; const float* wl;
    __device__ __forceinline__ void operator()(const f32x4 (&acc)[2][2][4][2], const Unit& u, int wr, int wc, int fr, int fq) const {
        const int row0 = launder(wr * 64 + fr), col0 = u.e1 * 128 + wc * 32 + 8 * fq;
        bf16_t* base = (u.e0 == 64 ? ACTS : ACT) + (size_t)u.e3 * 256 * 256;
#pragma unroll
        for (int ai = 0; ai < 2; ++ai)
#pragma unroll
            for (int m = 0; m < 4; ++m) { const int row = row0 + ai * 128 + m * 16; float w = 1.0f;
                if (u.e0 != 64) { const int pos = u.e2 + row; w = 0.0f; if (pos < u.e4) w = wl[(size_t)u.e0 * NT + pos]; }
                const f32x4 g0 = acc[ai][0][m][0], g1 = acc[ai][0][m][1], u0 = acc[ai][1][m][0], u1 = acc[ai][1][m][1];
                u32x4 o;
                o.x = pk2(siluf_(g0[0]) * u0[0] * w, siluf_(g0[1]) * u0[1] * w); o.y = pk2(siluf_(g0[2]) * u0[2] * w, siluf_(g0[3]) * u0[3] * w);
                o.z = pk2(siluf_(g1[0]) * u1[0] * w, siluf_(g1[1]) * u1[1] * w); o.w = pk2(siluf_(g1[2]) * u1[2] * w, siluf_(g1[3]) * u1[3] * w);
                *(u32x4*)(base + (size_t)row * 256 + col0) = o; }
    }
};
struct EpiDown {
    static constexpr bool PERM = true;
    bf16_t* O; const unsigned* list;
    __device__ __forceinline__ void operator()(const f32x4 (&acc)[2][2][4][2], const Unit& u, int wr, int wc, int fr, int fq) const {
        const int row0 = launder(wr * 64 + fr), col0 = u.e1 * 256 + wc * 32 + 8 * fq;
#pragma unroll
        for (int ai = 0; ai < 2; ++ai)
#pragma unroll
            for (int m = 0; m < 4; ++m) { const int pos = u.e2 + row0 + ai * 128 + m * 16;
                if (pos < u.e4) { const unsigned dest = list[(size_t)u.e0 * NT + pos]; bf16_t* rowp = O + (size_t)dest * 1024 + col0;
#pragma unroll
                    for (int bj = 0; bj < 2; ++bj) { const f32x4 v0 = acc[ai][bj][m][0], v1 = acc[ai][bj][m][1];
                        u32x4 w; w.x = pk2(v0[0], v0[1]); w.y = pk2(v0[2], v0[3]); w.z = pk2(v1[0], v1[1]); w.w = pk2(v1[2], v1[3]);
                        *(u32x4*)(rowp + bj * 128) = w; } } }
    }
};
struct EpiSharedDown {
    static constexpr bool PERM = true;
    float* x_l; float* x_c; const float* gate; const bf16_t* O;
    __device__ __forceinline__ void operator()(const f32x4 (&acc)[2][2][4][2], const Unit& u, int wr, int wc, int fr, int fq) const {
        const int g0 = u.e0 * 256; const bool lat = g0 < NL;
        float* xb = lat ? x_l + (size_t)g0 * D : x_c + (size_t)(g0 - NL) * D;
        const float* gp = gate + (size_t)(lat ? (g0 >> 11) : 8) * 6144;
        const int row0 = launder(wr * 64 + fr), col0 = u.e1 * 256 + wc * 32 + 8 * fq;
#pragma unroll
        for (int bj = 0; bj < 2; ++bj) { const f32x4 ga = *(const f32x4*)(gp + col0 + bj * 128), gb = *(const f32x4*)(gp + col0 + bj * 128 + 4);
#pragma unroll
            for (int ai = 0; ai < 2; ++ai)
#pragma unroll
                for (int m = 0; m < 4; ++m) { const int row = row0 + ai * 128 + m * 16;
                    f32x4 s0 = acc[ai][bj][m][0], s1 = acc[ai][bj][m][1];
                    const bf16_t* op = O + (size_t)(g0 + row) * 8 * 1024 + col0 + bj * 128;
#pragma unroll
                    for (int k = 0; k < 8; ++k) { const u32x4 v = *(const u32x4*)(op + (size_t)k * 1024);
                        s0[0] += lo16(v.x); s0[1] += hi16(v.x); s0[2] += lo16(v.y); s0[3] += hi16(v.y); s1[0] += lo16(v.z); s1[1] += hi16(v.z); s1[2] += lo16(v.w); s1[3] += hi16(v.w); }
                    float* xp = xb + (size_t)row * D + col0 + bj * 128;
                    const f32x4 x0 = *(const f32x4*)xp, x1 = *(const f32x4*)(xp + 4);
                    *(f32x4*)xp = x0 + ga * s0; *(f32x4*)(xp + 4) = x1 + gb * s1;
                    asm volatile("" ::: "memory"); } }
    }
};

struct Params {
    const float* in[26];
    float* out; unsigned char* ws;
    int ph_lo, ph_hi, li, pad;
};
enum { I_X = 0, I_C, I_CTX, I_CCTX, I_WADA, I_BADA, I_NMG, I_NFG, I_WIN, I_CMLNG, I_CMLNB, I_CMWS, I_CMBS, I_RPB, I_DECAY, I_WBR, I_WOUT, I_RW, I_RB,
       I_EG, I_EU, I_ED, I_SG, I_SU, I_SD, I_FG };

__device__ __forceinline__ void transpose_item(const float* W, int N, bf16_t* WT, int ldk, int extra, LAS float* scr, int kb, int nb, int lane) {
    const int k0 = 64 * kb, n0 = 32 * nb;
#pragma unroll 8
    for (int i = 0; i < 32; ++i) { const int kk = 2 * i + (lane >> 5); scr[kk * 33 + (lane & 31)] = W[(size_t)(k0 + kk) * N + n0 + (lane & 31)]; }
    LDS_WAIT(); asm volatile("" ::: "memory");
    const int c = lane & 7;
#pragma unroll
    for (int j = 0; j < 4; ++j) { const int n = (lane >> 3) + 8 * j; const LAS float* s = scr + (8 * c) * 33 + n;
        u32x4 o; o.x = pk2(s[0 * 33], s[1 * 33]); o.y = pk2(s[2 * 33], s[3 * 33]); o.z = pk2(s[4 * 33], s[5 * 33]); o.w = pk2(s[6 * 33], s[7 * 33]);
        *(u32x4*)(WT + (size_t)(n0 + n + extra) * ldk + k0 + 8 * c) = o; }
    LDS_WAIT(); asm volatile("" ::: "memory");
}
constexpr int IT_IN = 16 * 224, IT_BR = 3 * 8 * 32, IT_OUT = 16 * 32, IT_SG = 16 * 8, IT_SD = 4 * 32, IT_RT = 16 * 2, IT_CM = 128;
constexpr int MISC_ITEMS = IT_IN + IT_BR + IT_OUT + 2 * IT_SG + IT_SD + IT_RT + IT_CM;
__device__ __forceinline__ void misc_item(const Params& p, int l, int r, LAS float* scr, int lane) {
    unsigned char* wm = p.ws + WS_WM + (size_t)l * WM_STRIDE;
    if (r < IT_IN) { transpose_item(p.in[I_WIN] + (size_t)l * 1024 * 7168, 7168, (bf16_t*)(wm + WM_IN), 1024, 0, scr, r / 224, r % 224, lane); return; } r -= IT_IN;
    if (r < IT_BR) { const int i = r / 256, q = r % 256; transpose_item(p.in[I_WBR] + ((size_t)l * 3 + i) * 512 * 1024, 1024, (bf16_t*)(wm + WM_BR) + (size_t)i * 1024 * 512, 512, 0, scr, q / 32, q % 32, lane); return; } r -= IT_BR;
    if (r < IT_OUT) { transpose_item(p.in[I_WOUT] + (size_t)l * 1024 * 1024, 1024, (bf16_t*)(wm + WM_OUT), 1024, 0, scr, r / 32, r % 32, lane); return; } r -= IT_OUT;
    if (r < 2 * IT_SG) { const int up = r / IT_SG, q = r % IT_SG, nb = q % 8;
        transpose_item(p.in[up ? I_SU : I_SG] + (size_t)l * 1024 * 256, 256, (bf16_t*)(wm + WM_SGU), 1024, ((32 * nb) / 128) * 128 + up * 128, scr, q / 8, nb, lane); return; } r -= 2 * IT_SG;
    if (r < IT_SD) { transpose_item(p.in[I_SD] + (size_t)l * 256 * 1024, 1024, (bf16_t*)(wm + WM_SD), 256, 0, scr, r / 32, r % 32, lane); return; } r -= IT_SD;
    if (r < IT_RT) { transpose_item(p.in[I_RW] + (size_t)l * 1024 * 64, 64, (bf16_t*)(wm + WM_RT), 1024, 0, scr, r / 2, r % 2, lane); return; } r -= IT_RT;
    { const float* src = p.in[I_CMWS] + (size_t)l * 65536 + (size_t)r * 512 + lane * 8; const f32x4 a = *(const f32x4*)src, b = *(const f32x4*)(src + 4);
      u32x4 o; o.x = pk2(a[0], a[1]); o.y = pk2(a[2], a[3]); o.z = pk2(b[0], b[1]); o.w = pk2(b[2], b[3]);
      *(u32x4*)((bf16_t*)(wm + WM_CM) + (size_t)r * 512 + lane * 8) = o; }
}
constexpr int EXP_ITEMS = 3 * 64 * 128;
__device__ __forceinline__ void expert_item(const Params& p, int l, int r, LAS float* scr, int lane) {
    unsigned char* we = p.ws + WS_WE;
    const int which = r / 8192, q = r % 8192, e = q / 128, it = q % 128;
    if (which < 2) { const int kb = it / 8, nb = it % 8;
        transpose_item(p.in[which ? I_EU : I_EG] + ((size_t)l * 64 + e) * 1024 * 256, 256, (bf16_t*)(we + WE_GU) + (size_t)e * 512 * 1024, 1024, ((32 * nb) / 128) * 128 + which * 128, scr, kb, nb, lane); }
    else { const int kb = it / 32, nb = it % 32;
        transpose_item(p.in[I_ED] + ((size_t)l * 64 + e) * 256 * 1024, 1024, (bf16_t*)(we + WE_D) + (size_t)e * 1024 * 256, 256, 0, scr, kb, nb, lane); }
}
__device__ __forceinline__ void mod_unit(const Params& p, LAS unsigned char* lds, int u, int tid) {
    const int l = u / 96, cb = u % 96, wave = tid >> 6, lane = tid & 63;
    LAS float* sil = (LAS float*)lds;
    LAS float* part = (LAS float*)(lds + 36864);
    for (int idx = tid; idx < 9 * 1024; idx += NTHREADS) { const int r = idx >> 10, k = idx & 1023; const float v = r < 8 ? p.in[I_C][r * 1024 + k] : p.in[I_CCTX][k]; sil[idx] = v / (1.0f + expf(-v)); }
    __syncthreads();
    float acc[9];
#pragma unroll
    for (int r = 0; r < 9; ++r) acc[r] = 0.f;
    const float* wp = p.in[I_WADA] + ((size_t)l * 1024 + wave * 128) * 6144 + cb * 64 + lane;
#pragma unroll 4
    for (int k = 0; k < 128; ++k) { const float wv = wp[(size_t)k * 6144];
#pragma unroll
        for (int r = 0; r < 9; ++r) acc[r] += sil[r * 1024 + wave * 128 + k] * wv; }
#pragma unroll
    for (int r = 0; r < 9; ++r) part[(wave * 9 + r) * 64 + lane] = acc[r];
    __syncthreads();
    for (int idx = tid; idx < 576; idx += NTHREADS) { const int r = idx >> 6, ln = idx & 63; float s = p.in[I_BADA][l * 6144 + cb * 64 + ln];
#pragma unroll
        for (int w = 0; w < 8; ++w) s += part[(w * 9 + r) * 64 + ln];
        ((float*)(p.ws + WS_MOD))[((size_t)l * 9 + r) * 6144 + cb * 64 + ln] = s; }
    __syncthreads();
}

__device__ __forceinline__ void norm_mod_row(const float* xrow, const float* g, const float* sh, const float* sc, bf16_t* orow, bool to_lds, LAS unsigned char* ldst, int lane) {
    f32x4 v[4]; float ss = 0.f;
#pragma unroll
    for (int j = 0; j < 4; ++j) { v[j] = ((const f32x4*)xrow)[64 * j + lane]; ss += (v[j][0] * v[j][0] + v[j][1] * v[j][1]) + (v[j][2] * v[j][2] + v[j][3] * v[j][3]); }
    const float rstd = rsqrtf(wave_sum(ss) * (1.0f / 1024.0f) + EPS);
#pragma unroll
    for (int j = 0; j < 4; ++j) { const f32x4 gg = ((const f32x4*)g)[64 * j + lane], s_h = ((const f32x4*)sh)[64 * j + lane], s_c = ((const f32x4*)sc)[64 * j + lane];
        const f32x4 y = v[j] * rstd * gg * (s_c + 1.0f) + s_h;
        u32x2 o; o.x = pk2(y[0], y[1]); o.y = pk2(y[2], y[3]);
        ((u32x2*)orow)[64 * j + lane] = o;
        if (to_lds) *(LAS u32x2*)(ldst + (64 * j + lane) * 8) = o; }
}

constexpr int RT_TILE = 0, RT_PITCH = 2064, RT_LG = 64 * RT_PITCH  , RT_BIAS = RT_LG + 64 * 65 * 4  , RT_LCNT = RT_BIAS + 256, RT_LBASE = RT_LCNT + 256,
              RT_SELE = RT_LBASE + 256  , RT_SELW = RT_SELE + 2048, RT_SELR = RT_SELW + 2048, RT_END = RT_SELR + 2048;
static_assert(RT_END <= LDS_BYTES, "router LDS");
__device__ __forceinline__ void router_unit(const Params& p, LAS unsigned char* lds, int l, int u, const float* xl, const float* xc, int tid) {
    const int wave = tid >> 6, lane = tid & 63, g4 = lane >> 4, row0 = u * 64;
    const float* mod = (const float*)(p.ws + WS_MOD) + (size_t)l * 9 * 6144;
    bf16_t* H2 = (bf16_t*)(p.ws + WS_H);
    LAS float* lg = (LAS float*)(lds + RT_LG); LAS float* bias = (LAS float*)(lds + RT_BIAS);
    LAS int* lcnt = (LAS int*)(lds + RT_LCNT); LAS int* lbase = (LAS int*)(lds + RT_LBASE);
    LAS int* sele = (LAS int*)(lds + RT_SELE); LAS float* selw = (LAS float*)(lds + RT_SELW); LAS int* selr = (LAS int*)(lds + RT_SELR);
    if (tid < 64) { lcnt[tid] = 0; bias[tid] = p.in[I_RB][l * 64 + tid]; }
    for (int i = 0; i < 8; ++i) { const int rl = wave * 8 + i, g = row0 + rl; const bool lat = g < NL;
        const float* xr = lat ? xl + (size_t)g * D : xc + (size_t)(g - NL) * D; const float* mr = mod + (size_t)(lat ? (g >> 11) : 8) * 6144;
        norm_mod_row(xr, p.in[I_NFG] + l * 1024, mr + 3072, mr + 4096, H2 + (size_t)g * D, true, lds + RT_TILE + rl * RT_PITCH, lane); }
    __syncthreads();
    { const int rb = wave >> 1, eb0 = (wave & 1) * 2;
      const bf16_t* wrt = (const bf16_t*)(p.ws + WS_WM + (size_t)l * WM_STRIDE + WM_RT);
      f32x4 a0 = (f32x4){0.f, 0.f, 0.f, 0.f}, a1 = a0;
      const LAS unsigned char* hrow = lds + RT_TILE + (rb * 16 + (lane & 15)) * RT_PITCH + g4 * 16;
      const bf16_t* w0 = wrt + (size_t)(eb0 * 16 + (lane & 15)) * 1024 + g4 * 8; const bf16_t* w1 = w0 + 16 * 1024;
#pragma unroll 4
      for (int ks = 0; ks < 32; ++ks) { const bf16x8 b = *(const LAS bf16x8*)(hrow + ks * 64);
          a0 = mfma16(*(const bf16x8*)(w0 + ks * 32), b, a0); a1 = mfma16(*(const bf16x8*)(w1 + ks * 32), b, a1); }
      const int rr = rb * 16 + (lane & 15);
#pragma unroll
      for (int r = 0; r < 4; ++r) { lg[rr * 65 + eb0 * 16 + 4 * g4 + r] = sigmoidf_(a0[r]); lg[rr * 65 + (eb0 + 1) * 16 + 4 * g4 + r] = sigmoidf_(a1[r]); } }
    __syncthreads();
    if (tid < 64) { const LAS float* sr = lg + tid * 65;
        float gs[8];
#pragma unroll
        for (int g = 0; g < 8; ++g) { float m1 = -3e38f, m2 = -3e38f;
#pragma unroll
            for (int j = 0; j < 8; ++j) { const float s = sr[g * 8 + j] + bias[g * 8 + j]; if (s > m1) { m2 = m1; m1 = s; } else if (s > m2) m2 = s; }
            gs[g] = m1 + m2; }
        unsigned gsel = 0u;
#pragma unroll
        for (int it = 0; it < 4; ++it) { float best = -3e38f; int bi = 0;
#pragma unroll
            for (int g = 0; g < 8; ++g) if (!((gsel >> g) & 1u) && gs[g] > best) { best = gs[g]; bi = g; }
            gsel |= 1u << bi; }
        unsigned long long chosen = 0ull; float wsum = 0.f;
        for (int k = 0; k < 8; ++k) { float best = -3e38f; int bi = 0;
            for (int e = 0; e < 64; ++e) { if (((gsel >> (e >> 3)) & 1u) && !((chosen >> e) & 1ull)) { const float s = sr[e] + bias[e]; if (s > best) { best = s; bi = e; } } }
            chosen |= 1ull << bi; const float w = sr[bi]; wsum += w; sele[tid * 8 + k] = bi; selw[tid * 8 + k] = w; selr[tid * 8 + k] = __hip_atomic_fetch_add(&lcnt[bi], 1, __ATOMIC_RELAXED, __HIP_MEMORY_SCOPE_WORKGROUP); }
        const float sc = 2.5f / wsum;
        for (int k = 0; k < 8; ++k) selw[tid * 8 + k] *= sc; }
    __syncthreads();
    if (tid < 64) { const int n = lcnt[tid]; int base = 0; if (n > 0) base = (int)atomicAdd((unsigned*)(p.ws + WS_CTL) + CW_CNT + l * 2048 + tid * 16, (unsigned)n); lbase[tid] = base; }
    __syncthreads();
    { const int rl = tid >> 3, k = tid & 7, e = sele[rl * 8 + k], pos = lbase[e] + selr[rl * 8 + k];
      ((unsigned*)(p.ws + WS_LIST))[(size_t)e * NT + pos] = (unsigned)((row0 + rl) * 8 + k); ((float*)(p.ws + WS_WL))[(size_t)e * NT + pos] = selw[rl * 8 + k]; }
    __syncthreads();
}

__device__ __forceinline__ void mixA_unit(const Params& p, LAS unsigned char* lds, int l, int ch, int g, int tid) {
    const int wave = tid >> 6, lane = tid & 63, g4 = lane >> 4, rows0 = ch * 128;
    const bf16_t* Z = (const bf16_t*)(p.ws + WS_R + R_Z); bf16_t* BR = (bf16_t*)(p.ws + WS_R + R_BR);
    const bf16_t* WCM = (const bf16_t*)(p.ws + WS_WM + (size_t)l * WM_STRIDE + WM_CM);
    LAS float* stats = (LAS float*)lds; LAS unsigned char* vn = lds + 1024;
    for (int i = 0; i < 16; ++i) { const int tok = wave * 16 + i; const u32x4 v = *(const u32x4*)(Z + (size_t)(rows0 + tok) * INW + ZC_AV + lane * 8);
        const float x0 = geluf_(lo16(v.x)), x1 = geluf_(hi16(v.x)), x2 = geluf_(lo16(v.y)), x3 = geluf_(hi16(v.y)), x4 = geluf_(lo16(v.z)), x5 = geluf_(hi16(v.z)), x6 = geluf_(lo16(v.w)), x7 = geluf_(hi16(v.w));
        const float s1 = wave_sum(((x0 + x1) + (x2 + x3)) + ((x4 + x5) + (x6 + x7)));
        const float mean = s1 * (1.0f / 512.0f);
        const float d0 = x0 - mean, d1 = x1 - mean, d2 = x2 - mean, d3 = x3 - mean, d4 = x4 - mean, d5 = x5 - mean, d6 = x6 - mean, d7 = x7 - mean;
        const float s2 = wave_sum(((d0 * d0 + d1 * d1) + (d2 * d2 + d3 * d3)) + ((d4 * d4 + d5 * d5) + (d6 * d6 + d7 * d7)));
        if (lane == 0) { stats[2 * tok] = mean; stats[2 * tok + 1] = rsqrtf(s2 * (1.0f / 512.0f) + EPS); } }
    __syncthreads();
    { const int q = tid >> 2, cs = (tid & 3) * 32; const float mean = stats[2 * q], rstd = stats[2 * q + 1];
      const float* lg = p.in[I_CMLNG] + l * 512 + g * 128 + cs; const float* lb = p.in[I_CMLNB] + l * 512 + g * 128 + cs;
#pragma unroll
      for (int j = 0; j < 4; ++j) { const u32x4 v = *(const u32x4*)(Z + (size_t)(rows0 + q) * INW + ZC_AV + g * 128 + cs + 8 * j);
          const f32x4 ga = *(const f32x4*)(lg + 8 * j), gb = *(const f32x4*)(lg + 8 * j + 4), ba = *(const f32x4*)(lb + 8 * j), bb = *(const f32x4*)(lb + 8 * j + 4);
          u32x4 o;
          o.x = pk2((geluf_(lo16(v.x)) - mean) * rstd * ga[0] + ba[0], (geluf_(hi16(v.x)) - mean) * rstd * ga[1] + ba[1]);
          o.y = pk2((geluf_(lo16(v.y)) - mean) * rstd * ga[2] + ba[2], (geluf_(hi16(v.y)) - mean) * rstd * ga[3] + ba[3]);
          o.z = pk2((geluf_(lo16(v.z)) - mean) * rstd * gb[0] + bb[0], (geluf_(hi16(v.z)) - mean) * rstd * gb[1] + bb[1]);
          o.w = pk2((geluf_(lo16(v.w)) - mean) * rstd * gb[2] + bb[2], (geluf_(hi16(v.w)) - mean) * rstd * gb[3] + bb[3]);
          *(LAS u32x4*)(vn + q * 272 + (cs + 8 * j) * 2) = o; } }
    __syncthreads();
    { const int pb = wave, pp = pb * 16 + (lane & 15);
      bf16x8 bfr[4];
#pragma unroll
      for (int ks = 0; ks < 4; ++ks) bfr[ks] = *(const bf16x8*)(WCM + (size_t)(g * 128 + pp) * 128 + 32 * ks + 8 * g4);
      const unsigned vna = tr_lane(lds_addr(vn), 272, 8, lane);
      const float bs = p.in[I_CMBS][l * 512 + g * 128 + pp];
      const size_t row = (size_t)(rows0 + pp);
      sfor<0, 8>([&](auto cb_) { constexpr int cb = decltype(cb_)::value; f32x4 acc = (f32x4){0.f, 0.f, 0.f, 0.f};
          sfor<0, 4>([&](auto ks_) { constexpr int ks = decltype(ks_)::value; const bf16x8 a = tr_frag_i<32 * ks * 272 + 32 * cb, 32 * ks * 272 + 32 * cb + 4 * 272>(vna); acc = mfma16(a, bfr[ks], acc); });
          const int c = 16 * cb + 4 * g4;
          const u32x2 uu = *(const u32x2*)(Z + row * INW + ZC_AU + g * 128 + c);
          u32x2 o; o.x = pk2(geluf_(lo16(uu.x)) * (acc[0] + bs), geluf_(hi16(uu.x)) * (acc[1] + bs)); o.y = pk2(geluf_(lo16(uu.y)) * (acc[2] + bs), geluf_(hi16(uu.y)) * (acc[3] + bs));
          *(u32x2*)(BR + row * BRW + g * 128 + c) = o; }); }
    __syncthreads();
}

__device__ __forceinline__ void ret_stage_qk(const bf16_t* src  , const float* rope, bool do_rope, int tpos0, int mask  , LAS unsigned char* t0, LAS unsigned char* t1, LAS unsigned char* t2,
                                             float sc0, float l2a, float offa, float siga, float l2b, float offb, float sigb, int tid) {
    const int pp = tid >> 2, half = (tid >> 1) & 1, sub = tid & 1;
    const bf16_t* s = src + (size_t)pp * INW + 32 * half + 8 * sub;
    const u32x4 a = *(const u32x4*)s, b = *(const u32x4*)(s + 16);
    float x1[8] = {lo16(a.x), hi16(a.x), lo16(a.y), hi16(a.y), lo16(a.z), hi16(a.z), lo16(a.w), hi16(a.w)};
    float x2[8] = {lo16(b.x), hi16(b.x), lo16(b.y), hi16(b.y), lo16(b.z), hi16(b.z), lo16(b.w), hi16(b.w)};
    float o1[8], o2[8];
    if (do_rope) { const int t = tpos0 + pp, pos = half ? (t & 63) : (t >> 6); const f32x4* tb = (const f32x4*)(rope + (size_t)(pos * 16 + 8 * sub) * 2);
#pragma unroll
        for (int j = 0; j < 4; ++j) { const f32x4 cs = tb[j];
            o1[2 * j] = x1[2 * j] * cs[0] - x2[2 * j] * cs[1]; o2[2 * j] = x1[2 * j] * cs[1] + x2[2 * j] * cs[0];
            o1[2 * j + 1] = x1[2 * j + 1] * cs[2] - x2[2 * j + 1] * cs[3]; o2[2 * j + 1] = x1[2 * j + 1] * cs[3] + x2[2 * j + 1] * cs[2]; } }
    else {
#pragma unroll
        for (int j = 0; j < 8; ++j) { o1[j] = x1[j]; o2[j] = x2[j]; } }
    const int off = pp * 144 + (32 * half + 8 * sub) * 2;
    const float fp = (float)pp;
    const float sA = sc0 * __builtin_amdgcn_exp2f((offa + siga * fp) * l2a), sB = sc0 * __builtin_amdgcn_exp2f((offb + sigb * fp) * l2b);
    if (mask & 1) { u32x4 w; w.x = pk2(o1[0] * sc0, o1[1] * sc0); w.y = pk2(o1[2] * sc0, o1[3] * sc0); w.z = pk2(o1[4] * sc0, o1[5] * sc0); w.w = pk2(o1[6] * sc0, o1[7] * sc0); *(LAS u32x4*)(t0 + off) = w;
              w.x = pk2(o2[0] * sc0, o2[1] * sc0); w.y = pk2(o2[2] * sc0, o2[3] * sc0); w.z = pk2(o2[4] * sc0, o2[5] * sc0); w.w = pk2(o2[6] * sc0, o2[7] * sc0); *(LAS u32x4*)(t0 + off + 32) = w; }
    if (mask & 2) { u32x4 w; w.x = pk2(o1[0] * sA, o1[1] * sA); w.y = pk2(o1[2] * sA, o1[3] * sA); w.z = pk2(o1[4] * sA, o1[5] * sA); w.w = pk2(o1[6] * sA, o1[7] * sA); *(LAS u32x4*)(t1 + off) = w;
              w.x = pk2(o2[0] * sA, o2[1] * sA); w.y = pk2(o2[2] * sA, o2[3] * sA); w.z = pk2(o2[4] * sA, o2[5] * sA); w.w = pk2(o2[6] * sA, o2[7] * sA); *(LAS u32x4*)(t1 + off + 32) = w; }
    if (mask & 4) { u32x4 w; w.x = pk2(o1[0] * sB, o1[1] * sB); w.y = pk2(o1[2] * sB, o1[3] * sB); w.z = pk2(o1[4] * sB, o1[5] * sB); w.w = pk2(o1[6] * sB, o1[7] * sB); *(LAS u32x4*)(t2 + off) = w;
              w.x = pk2(o2[0] * sB, o2[1] * sB); w.y = pk2(o2[2] * sB, o2[3] * sB); w.z = pk2(o2[4] * sB, o2[5] * sB); w.w = pk2(o2[6] * sB, o2[7] * sB); *(LAS u32x4*)(t2 + off + 32) = w; }
}
__device__ __forceinline__ void ret_stage_v(const bf16_t* src  , LAS unsigned char* tv, int tid) {
    const int pp = tid >> 2, seg = (tid & 3) * 32;
#pragma unroll
    for (int j = 0; j < 4; ++j) *(LAS u32x4*)(tv + pp * 272 + (seg + 8 * j) * 2) = *(const u32x4*)(src + (size_t)pp * INW + seg + 8 * j);
}
__device__ __forceinline__ float log2_gamma(const Params& p, int l, int dir, int h) { const float x = p.in[I_DECAY][(l * 2 + dir) * 4 + h]; return -log2f(1.0f + expf(-x)); }
__device__ __forceinline__ int ret_row0(int b, int cc) { return cc < 2 ? NL + b * 256 + cc * 128 : b * 2048 + (cc - 2) * 128; }

__device__ __forceinline__ void retkv_unit(const Params& p, LAS unsigned char* lds, int l, int b, int h, int cc, int tid) {
    const int wave = tid >> 6, lane = tid & 63, g4 = lane >> 4, row0 = ret_row0(b, cc);
    const bf16_t* Z = (const bf16_t*)(p.ws + WS_R + R_Z); float* KV = (float*)(p.ws + WS_R + R_KV);
    const float l2f = log2_gamma(p, l, 0, h), l2b = log2_gamma(p, l, 1, h);
    LAS unsigned char* kf = lds; LAS unsigned char* kb = lds + 18432; LAS unsigned char* vv = lds + 36864;
    ret_stage_qk(Z + (size_t)row0 * INW + ZC_RK + h * 64, (const float*)(p.ws + WS_ROPE), cc >= 2, (cc - 2) * 128, 6, kf, kf, kb, 0.125f, l2f, 127.f, -1.f, l2b, 0.f, 1.f, tid);
    ret_stage_v(Z + (size_t)row0 * INW + ZC_RV + h * 128, vv, tid);
    __syncthreads();
    { const int dir = wave >> 2, db = wave & 3; const unsigned ka = tr_lane(lds_addr(dir ? kb : kf), 144, 8, lane) + 32 * db, va = tr_lane(lds_addr(vv), 272, 8, lane);
      bf16x8 afr[4];
      sfor<0, 4>([&](auto ks_) { constexpr int ks = decltype(ks_)::value; afr[ks] = tr_frag_i<32 * ks * 144, 32 * ks * 144 + 4 * 144>(ka); });
      float* dst = KV + ((((size_t)b * 4 + h) * NCHUNK + cc) * 2 + dir) * 8192;
      sfor<0, 8>([&](auto eb_) { constexpr int eb = decltype(eb_)::value; f32x4 acc = (f32x4){0.f, 0.f, 0.f, 0.f};
          sfor<0, 4>([&](auto ks_) { constexpr int ks = decltype(ks_)::value; const bf16x8 bq = tr_frag_i<32 * ks * 272 + 32 * eb, 32 * ks * 272 + 32 * eb + 4 * 272>(va); acc = mfma16(afr[ks], bq, acc); });
#pragma unroll
          for (int r = 0; r < 4; ++r) dst[(16 * db + 4 * g4 + r) * 128 + 16 * eb + (lane & 15)] = acc[r]; }); }
    __syncthreads();
}

__device__ __forceinline__ void retout_unit(const Params& p, LAS unsigned char* lds, int l, int b, int h, int cc, int tid) {
    const int wave = tid >> 6, lane = tid & 63, g4 = lane >> 4, row0 = ret_row0(b, cc);
    const bf16_t* Z = (const bf16_t*)(p.ws + WS_R + R_Z); bf16_t* BR = (bf16_t*)(p.ws + WS_R + R_BR); const float* KV = (const float*)(p.ws + WS_R + R_KV);
    const float l2f = log2_gamma(p, l, 0, h), l2b = log2_gamma(p, l, 1, h);
    LAS unsigned char* tq = lds; LAS unsigned char* tqf = lds + 18432; LAS unsigned char* tqb = lds + 36864; LAS unsigned char* tk = lds + 55296;
    LAS unsigned char* tv = lds + 73728; LAS unsigned char* st = lds + 108544;
    { const float* kvb = KV + (((size_t)b * 4 + h) * NCHUNK) * 2 * 8192;
      f32x4 sf[4], sb[4];
#pragma unroll
      for (int j = 0; j < 4; ++j) { sf[j] = (f32x4){0.f, 0.f, 0.f, 0.f}; sb[j] = sf[j]; }
      const int pbx = cc < 2 ? 1 - cc : 19 - cc;
      for (int y = 0; y < NCHUNK; ++y) {
          if (y < cc) { const float w = __builtin_amdgcn_exp2f(128.f * (float)(cc - 1 - y) * l2f);
#pragma unroll
              for (int j = 0; j < 4; ++j) sf[j] += w * *(const f32x4*)(kvb + ((size_t)y * 2 + 0) * 8192 + (tid + 512 * j) * 4); }
          const int pby = y < 2 ? 1 - y : 19 - y;
          if (pby < pbx) { const float w = __builtin_amdgcn_exp2f(128.f * (float)(pbx - 1 - pby) * l2b);
#pragma unroll
              for (int j = 0; j < 4; ++j) sb[j] += w * *(const f32x4*)(kvb + ((size_t)y * 2 + 1) * 8192 + (tid + 512 * j) * 4); } }
#pragma unroll
      for (int j = 0; j < 4; ++j) { const int idx = (tid + 512 * j) * 4, d = idx >> 7, e = idx & 127;
          u32x2 o; o.x = pk2(sf[j][0], sf[j][1]); o.y = pk2(sf[j][2], sf[j][3]); *(LAS u32x2*)(st + d * 272 + e * 2) = o;
          o.x = pk2(sb[j][0], sb[j][1]); o.y = pk2(sb[j][2], sb[j][3]); *(LAS u32x2*)(st + (64 + d) * 272 + e * 2) = o; } }
    const float* rope = (const float*)(p.ws + WS_ROPE);
    ret_stage_qk(Z + (size_t)row0 * INW + ZC_RQ + h * 64, rope, cc >= 2, (cc - 2) * 128, 7, tq, tqf, tqb, 1.0f, l2f, 1.f, 1.f, l2b, 128.f, -1.f, tid);
    ret_stage_qk(Z + (size_t)row0 * INW + ZC_RK + h * 64, rope, cc >= 2, (cc - 2) * 128, 1, tk, tk, tk, 0.125f, 0.f, 0.f, 0.f, 0.f, 0.f, 0.f, tid);
    ret_stage_v(Z + (size_t)row0 * INW + ZC_RV + h * 128, tv, tid);
    __syncthreads();
    const int ib = wave, ti = ib * 16 + (lane & 15);
    f32x4 oacc[8];
#pragma unroll
    for (int eb = 0; eb < 8; ++eb) oacc[eb] = (f32x4){0.f, 0.f, 0.f, 0.f};
    { bf16x8 bq[4];
#pragma unroll
      for (int ks = 0; ks < 4; ++ks) bq[ks] = *(const LAS bf16x8*)((ks < 2 ? tqf : tqb) + ti * 144 + (32 * (ks & 1) + 8 * g4) * 2);
      const unsigned sa = tr_lane(lds_addr(st), 272, 8, lane);
      sfor<0, 8>([&](auto eb_) { constexpr int eb = decltype(eb_)::value;
          sfor<0, 4>([&](auto ks_) { constexpr int ks = decltype(ks_)::value; const bf16x8 a = tr_frag_i<32 * ks * 272 + 32 * eb, 32 * ks * 272 + 32 * eb + 4 * 272>(sa); oacc[eb] = mfma16(a, bq[ks], oacc[eb]); }); }); }
    { bf16x8 bq[2];
#pragma unroll
      for (int ks = 0; ks < 2; ++ks) bq[ks] = *(const LAS bf16x8*)(tq + ti * 144 + (32 * ks + 8 * g4) * 2);
      f32x4 sacc[8];
#pragma unroll
      for (int jb = 0; jb < 8; ++jb) { sacc[jb] = (f32x4){0.f, 0.f, 0.f, 0.f};
#pragma unroll
          for (int ks = 0; ks < 2; ++ks) { const bf16x8 a = *(const LAS bf16x8*)(tk + (16 * jb + (lane & 15)) * 144 + (32 * ks + 8 * g4) * 2); sacc[jb] = mfma16(a, bq[ks], sacc[jb]); }
#pragma unroll
          for (int r = 0; r < 4; ++r) { const int dist = ti - (16 * jb + 4 * g4 + r);
              sacc[jb][r] *= dist >= 0 ? __builtin_amdgcn_exp2f((float)dist * l2f) : __builtin_amdgcn_exp2f((float)(-dist) * l2b); } }
      const unsigned va = tr_lane(lds_addr(tv), 272, 4, lane);
      sfor<0, 4>([&](auto kk_) { constexpr int kk = decltype(kk_)::value;
          u32x4 pw; pw.x = pk2(sacc[2 * kk][0], sacc[2 * kk][1]); pw.y = pk2(sacc[2 * kk][2], sacc[2 * kk][3]); pw.z = pk2(sacc[2 * kk + 1][0], sacc[2 * kk + 1][1]); pw.w = pk2(sacc[2 * kk + 1][2], sacc[2 * kk + 1][3]);
          const bf16x8 bp = as_frag(pw);
          sfor<0, 8>([&](auto eb_) { constexpr int eb = decltype(eb_)::value; const bf16x8 a = tr_frag_i<32 * kk * 272 + 32 * eb, 32 * kk * 272 + 32 * eb + 16 * 272>(va); oacc[eb] = mfma16(a, bp, oacc[eb]); }); }); }
    { float ss = 0.f;
#pragma unroll
      for (int eb = 0; eb < 8; ++eb) ss += (oacc[eb][0] * oacc[eb][0] + oacc[eb][1] * oacc[eb][1]) + (oacc[eb][2] * oacc[eb][2] + oacc[eb][3] * oacc[eb][3]);
      ss += __shfl_xor(ss, 16); ss += __shfl_xor(ss, 32);
      const float rstd = rsqrtf(ss * (1.0f / 128.0f) + EPS);
      const size_t row = (size_t)(row0 + ti);
#pragma unroll
      for (int eb = 0; eb < 8; ++eb) { const int e = 16 * eb + 4 * g4; const u32x2 gg = *(const u32x2*)(Z + row * INW + ZC_RG + h * 128 + e);
          u32x2 o; o.x = pk2(oacc[eb][0] * rstd * siluf_(lo16(gg.x)), oacc[eb][1] * rstd * siluf_(hi16(gg.x))); o.y = pk2(oacc[eb][2] * rstd * siluf_(lo16(gg.y)), oacc[eb][3] * rstd * siluf_(hi16(gg.y)));
          *(u32x2*)(BR + row * BRW + 1024 + h * 128 + e) = o; } }
    __syncthreads();
}

constexpr int NA_KL = 0, NA_VL = 73728, NA_TAB = 147456, NA_PITCH = 144;
__device__ __forceinline__ void na_unit(const Params& p, LAS unsigned char* lds, int l, int b, int h, int r, bool local, int tid) {
    const int wave = tid >> 6, lane = tid & 63, g4 = lane >> 4, qb = wave >> 1, half = wave & 1;
    const bf16_t* Z = (const bf16_t*)(p.ws + WS_R + R_Z); bf16_t* BR = (bf16_t*)(p.ws + WS_R + R_BR);
    LAS unsigned char* kl = lds + NA_KL; LAS unsigned char* vl = lds + NA_VL; LAS float* tab = (LAS float*)(lds + NA_TAB);
    const unsigned kla = lds_addr(kl), vla = lds_addr(vl);
    const int qc = 16 * qb + (lane & 15);
    const size_t qrow = local ? (size_t)b * 2048 + r * 64 + qc : (size_t)NL + b * 256 + r * 64 + qc;
    bf16x8 bq[2];
#pragma unroll
    for (int ks = 0; ks < 2; ++ks) bq[ks] = *(const bf16x8*)(Z + qrow * INW + ZC_NQ + h * 64 + 32 * ks + 8 * g4);
    const float L2E = 1.44269504089f;
    float m_run = -1e30f, l_run = 0.f;
    f32x4 oacc[4];
#pragma unroll
    for (int db = 0; db < 4; ++db) oacc[db] = (f32x4){0.f, 0.f, 0.f, 0.f};
    if (local) {
        const int rs = min(max(r - 4, 0), 24);
        { const int key = tid; const size_t krow = (size_t)b * 2048 + (rs + (key >> 6)) * 64 + (key & 63);
          const u32x4* ks_ = (const u32x4*)(Z + krow * INW + ZC_NK + h * 64); const u32x4* vs_ = (const u32x4*)(Z + krow * INW + ZC_NV + h * 64);
#pragma unroll
          for (int j = 0; j < 8; ++j) { *(LAS u32x4*)(kl + key * NA_PITCH + 16 * j) = ks_[j]; *(LAS u32x4*)(vl + key * NA_PITCH + 16 * j) = vs_[j]; } }
        if (tid < 465) tab[tid] = p.in[I_RPB][(size_t)(l * 8 + h) * 465 + tid];
        __syncthreads();
        const int kbs = min(max(16 * qb - 8, 0), 32), cst = min(max(qc - 8, 0), 48);
        f32x4 s[8]; float mx = -1e30f;
#pragma unroll
        for (int blk = 0; blk < 8; ++blk) { const int i = 4 * half + (blk >> 1), cb = blk & 1, kr0 = i * 64 + kbs + 16 * cb;
            f32x4 a = (f32x4){0.f, 0.f, 0.f, 0.f};
#pragma unroll
            for (int ks = 0; ks < 2; ++ks) a = mfma16(*(const LAS bf16x8*)(kl + (kr0 + (lane & 15)) * NA_PITCH + (32 * ks + 8 * g4) * 2), bq[ks], a);
            const int ro = rs + i - r + 7;
#pragma unroll
            for (int rg = 0; rg < 4; ++rg) { const int kc = kbs + 16 * cb + 4 * g4 + rg; const bool valid = kc >= cst && kc < cst + 16;
                const int co = min(max(kc - qc, -15), 15) + 15;
                const float v = valid ? a[rg] * 0.125f + tab[ro * 31 + co] : -1e30f; s[blk][rg] = v; mx = fmaxf(mx, v); } }
        mx = fmaxf(mx, __shfl_xor(mx, 16)); mx = fmaxf(mx, __shfl_xor(mx, 32));
        float ls = 0.f;
#pragma unroll
        for (int blk = 0; blk < 8; ++blk)
#pragma unroll
            for (int rg = 0; rg < 4; ++rg) { const float e = __builtin_amdgcn_exp2f((s[blk][rg] - mx) * L2E); s[blk][rg] = e; ls += e; }
        ls += __shfl_xor(ls, 16); ls += __shfl_xor(ls, 32);
        m_run = mx; l_run = ls;
#pragma unroll
        for (int kk = 0; kk < 4; ++kk) { u32x4 pw; pw.x = pk2(s[2 * kk][0], s[2 * kk][1]); pw.y = pk2(s[2 * kk][2], s[2 * kk][3]); pw.z = pk2(s[2 * kk + 1][0], s[2 * kk + 1][1]); pw.w = pk2(s[2 * kk + 1][2], s[2 * kk + 1][3]);
            const bf16x8 bp = as_frag(pw); const unsigned va = vla + (unsigned)(((4 * half + kk) * 64 + kbs + 4 * g4 + ((lane & 15) >> 2)) * NA_PITCH + (lane & 3) * 8);
            oacc[0] = mfma16(tr_frag_i<0, 16 * NA_PITCH>(va), bp, oacc[0]); oacc[1] = mfma16(tr_frag_i<32, 32 + 16 * NA_PITCH>(va), bp, oacc[1]);
            oacc[2] = mfma16(tr_frag_i<64, 64 + 16 * NA_PITCH>(va), bp, oacc[2]); oacc[3] = mfma16(tr_frag_i<96, 96 + 16 * NA_PITCH>(va), bp, oacc[3]); }
        __syncthreads();
    }
    { const int key = tid & 255; const size_t krow = (size_t)NL + b * 256 + key;
      const u32x4* src = (const u32x4*)(Z + krow * INW + (tid < 256 ? ZC_NK : ZC_NV) + h * 64); LAS unsigned char* dst = (tid < 256 ? kl : vl) + key * NA_PITCH;
#pragma unroll
      for (int j = 0; j < 8; ++j) *(LAS u32x4*)(dst + 16 * j) = src[j]; }
    __syncthreads();
    { f32x4 s[8]; float mx = -1e30f;
#pragma unroll
      for (int blk = 0; blk < 8; ++blk) { const int kr0 = half * 128 + 16 * blk;
          f32x4 a = (f32x4){0.f, 0.f, 0.f, 0.f};
#pragma unroll
          for (int ks = 0; ks < 2; ++ks) a = mfma16(*(const LAS bf16x8*)(kl + (kr0 + (lane & 15)) * NA_PITCH + (32 * ks + 8 * g4) * 2), bq[ks], a);
#pragma unroll
          for (int rg = 0; rg < 4; ++rg) { const float v = a[rg] * 0.125f; s[blk][rg] = v; mx = fmaxf(mx, v); } }
      mx = fmaxf(mx, __shfl_xor(mx, 16)); mx = fmaxf(mx, __shfl_xor(mx, 32));
      const float m2 = fmaxf(m_run, mx), alpha = __builtin_amdgcn_exp2f((m_run - m2) * L2E);
      float ls = 0.f;
#pragma unroll
      for (int blk = 0; blk < 8; ++blk)
#pragma unroll
          for (int rg = 0; rg < 4; ++rg) { const float e = __builtin_amdgcn_exp2f((s[blk][rg] - m2) * L2E); s[blk][rg] = e; ls += e; }
      ls += __shfl_xor(ls, 16); ls += __shfl_xor(ls, 32);
      l_run = l_run * alpha + ls; m_run = m2;
#pragma unroll
      for (int db = 0; db < 4; ++db) oacc[db] = oacc[db] * alpha;
#pragma unroll
      for (int kk = 0; kk < 4; ++kk) { u32x4 pw; pw.x = pk2(s[2 * kk][0], s[2 * kk][1]); pw.y = pk2(s[2 * kk][2], s[2 * kk][3]); pw.z = pk2(s[2 * kk + 1][0], s[2 * kk + 1][1]); pw.w = pk2(s[2 * kk + 1][2], s[2 * kk + 1][3]);
          const bf16x8 bp = as_frag(pw); const unsigned va = vla + (unsigned)((half * 128 + 32 * kk + 4 * g4 + ((lane & 15) >> 2)) * NA_PITCH + (lane & 3) * 8);
          oacc[0] = mfma16(tr_frag_i<0, 16 * NA_PITCH>(va), bp, oacc[0]); oacc[1] = mfma16(tr_frag_i<32, 32 + 16 * NA_PITCH>(va), bp, oacc[1]);
          oacc[2] = mfma16(tr_frag_i<64, 64 + 16 * NA_PITCH>(va), bp, oacc[2]); oacc[3] = mfma16(tr_frag_i<96, 96 + 16 * NA_PITCH>(va), bp, oacc[3]); } }
    __syncthreads();
    LAS float* mb = (LAS float*)(lds + NA_KL) + (qb * 64 + lane) * 18;
    if (half == 1) { mb[0] = m_run; mb[1] = l_run;
#pragma unroll
        for (int db = 0; db < 4; ++db)
#pragma unroll
            for (int rg = 0; rg < 4; ++rg) mb[2 + db * 4 + rg] = oacc[db][rg]; }
    __syncthreads();
    if (half == 0) { const float m1 = mb[0], l1 = mb[1], M = fmaxf(m_run, m1), a0 = __builtin_amdgcn_exp2f((m_run - M) * L2E), a1 = __builtin_amdgcn_exp2f((m1 - M) * L2E);
        const float inv = 1.0f / (l_run * a0 + l1 * a1);
#pragma unroll
        for (int db = 0; db < 4; ++db) { float o[4];
#pragma unroll
            for (int rg = 0; rg < 4; ++rg) o[rg] = (oacc[db][rg] * a0 + mb[2 + db * 4 + rg] * a1) * inv;
            u32x2 w; w.x = pk2(o[0], o[1]); w.y = pk2(o[2], o[3]);
            *(u32x2*)(BR + qrow * BRW + 512 + h * 64 + 16 * db + 4 * g4) = w; } }
    __syncthreads();
}

constexpr int PH_PER_LAYER = 11, PH_FINAL = 1 + 2 * PH_PER_LAYER, NPHASES = PH_FINAL + 1;
__device__ __forceinline__ void moe_tables(const Params& p, LAS unsigned char* lds, int l, int tid) {
    LAS int* tb = (LAS int*)(lds + MOE_TAB_OFF); LAS int* cn = tb + 128;
    if (tid < 64) { const unsigned c = ((const unsigned*)(p.ws + WS_CTL))[CW_CNT + l * 2048 + tid * 16]; cn[tid] = (int)(c < (unsigned)NT ? c : (unsigned)NT); }
    __syncthreads();
    if (tid == 0) { int s = 0; for (int e = 0; e < 64; ++e) { tb[e] = s; s += (cn[e] + 255) >> 8; } tb[64] = s; }
    __syncthreads();
}

__global__ void __launch_bounds__(NTHREADS, 2) fwd_kernel(Params p0) {
    extern __shared__ __attribute__((aligned(16))) unsigned char lds_raw[];
    LAS unsigned char* lds = (LAS unsigned char*)lds_raw;
    const int tid0 = threadIdx.x, G = gridDim.x, bid = blockIdx.x, NGW = G * NWAVES;
#define PHASE_IDS const int tid = launder(tid0), wave = __builtin_amdgcn_readfirstlane(tid >> 6), lane = tid & 63, gw = bid * NWAVES + wave; (void)lane; (void)gw; \
    Params p = p0; p.ws = launder_p(p0.ws); p.out = launder_p(p0.out)
    volatile LAS unsigned* xbw = (volatile LAS unsigned*)(lds + LDS_BYTES - 16);
    if (tid0 == 0) { xbw[0] = 0u; xbw[1] = 0u; xbw[2] = 0u; xbw[3] = 0u; }
    __syncthreads();
    XcdBarrier bar = xcd_barrier_post((unsigned*)(p0.ws + WS_CTL) + CW_BAR + p0.li * XCD_BAR_WORDS, xbw);
#ifdef TEST_PHASE
#define IN(k) ((((k) - 1) % PH_PER_LAYER == TEST_PHASE - 1 && (k) >= 1 && (k) < PH_FINAL && TEST_PHASE >= 1) || ((k) == 0 && TEST_PHASE == 0) || ((k) == PH_FINAL && TEST_PHASE == 99)) && (launder_s(p0.ph_lo) <= (k) && (k) < launder_s(p0.ph_hi))
#else
#define IN(k) (launder_s(p0.ph_lo) <= (k) && (k) < launder_s(p0.ph_hi))
#endif
#define SEAM(k) do { if (IN(k) && IN((k) + 1)) xcd_barrier(bar); } while (0)
#define Hb ((bf16_t*)(p.ws + WS_H))
#define Zb ((bf16_t*)(p.ws + WS_R + R_Z))
#define BRb ((bf16_t*)(p.ws + WS_R + R_BR))
#define XC ((float*)(p.ws + WS_XC))
#define xl (l == 0 ? p.in[I_X] : (const float*)p.out)
#define xc (l == 0 ? p.in[I_CTX] : (const float*)XC)
#define mod ((const float*)(p.ws + WS_MOD) + (size_t)l * 9 * 6144)
#define wm (p.ws + WS_WM + (size_t)l * WM_STRIDE)

    if (IN(0)) {
        PHASE_IDS;
        for (int u = bid; u < 192; u += G) mod_unit(p, lds, u, tid);
        if (bid == G - 1) { float* rope = (float*)(p.ws + WS_ROPE);
            for (int idx = tid; idx < 1024; idx += NTHREADS) { const int pos = idx >> 4, f = idx & 15; const float inv = exp2f(-(float)f * (13.287712379549449f / 16.0f));
                float x = (float)pos * inv * 0.15915494309189535f; x -= floorf(x);
                rope[idx * 2] = __builtin_amdgcn_cosf(x); rope[idx * 2 + 1] = __builtin_amdgcn_sinf(x); } }
        __syncthreads();
        LAS float* scr = (LAS float*)(lds + wave * 8448);
        for (int it = gw; it < 2 * MISC_ITEMS + EXP_ITEMS; it += NGW) {
            if (it < MISC_ITEMS) misc_item(p, 0, it, scr, lane);
            else if (it < 2 * MISC_ITEMS) misc_item(p, 1, it - MISC_ITEMS, scr, lane);
            else expert_item(p, 0, it - 2 * MISC_ITEMS, scr, lane); }
    }
    SEAM(0);

    for (int l = 0; l < DEPTH; ++l) {
        const int base = 1 + PH_PER_LAYER * l;
        const bool need_ctx = l < DEPTH - 1;
        const int Mrows = need_ctx ? NT : NL;

        if (IN(base + 0)) {
            PHASE_IDS;
            for (int row = gw; row < NT; row += NGW) { const bool lat = row < NL; const float* xr = lat ? xl + (size_t)row * D : xc + (size_t)(row - NL) * D;
                const float* mr = mod + (size_t)(lat ? (row >> 11) : 8) * 6144;
                norm_mod_row(xr, p.in[I_NMG] + l * 1024, mr, mr + 1024, Hb + (size_t)row * D, false, lds, lane); }
        }
        SEAM(base + 0);
        if (IN(base + 1)) {
            PHASE_IDS;
            DenseSched S{(const char*)Hb, (const char*)(wm + WM_IN), 1024, 1024, NT / 256, INW / 256, G, bid, 1, 0, 0};
            EpiStoreBf16 E{Zb, INW};
            pg8::gemm_phase(lds, tid, 1024, 1024, S, E);
        }
        SEAM(base + 1);
        if (IN(base + 2)) {
            PHASE_IDS;
            const int nA = (Mrows / 128) * 4;
            for (int u = bid; u < 2048; u += G) na_unit(p, lds, l, u >> 8, (u >> 5) & 7, u & 31, true, tid);
            if (need_ctx) for (int u = bid; u < 256; u += G) na_unit(p, lds, l, u >> 5, (u >> 2) & 7, u & 3, false, tid);
            for (int u = (bid + 64) % G; u < 576; u += G) retkv_unit(p, lds, l, u / 72, (u / 18) % 4, u % 18, tid);
            for (int u = (bid + 128) % G; u < nA; u += G) mixA_unit(p, lds, l, u >> 2, u & 3, tid);
        }
        SEAM(base + 2);
        if (IN(base + 3)) {
            PHASE_IDS;
            const int cc_lo = need_ctx ? 0 : 2, ncc = NCHUNK - cc_lo, total = 32 * ncc;
            for (int u = bid; u < total; u += G) retout_unit(p, lds, l, u / (4 * ncc), (u / ncc) % 4, cc_lo + u % ncc, tid);
        }
        SEAM(base + 3);
        if (IN(base + 4)) {
            PHASE_IDS;
            DenseSched S{(const char*)BRb, (const char*)(wm + WM_BR), BRW, 512, Mrows / 256, 4, G, bid, 3, 512 * 2, (size_t)1024 * 512 * 2};
            EpiMerge E{Hb, Zb};
            pg8::gemm_phase(lds, tid, 512, 512, S, E);
        }
        SEAM(base + 4);
        if (IN(base + 5)) {
            PHASE_IDS;
            DenseSched S{(const char*)Hb, (const char*)(wm + WM_OUT), 1024, 1024, Mrows / 256, 4, G, bid, 1, 0, 0};
            EpiResid E{xl, xc, p.out, XC, mod + 2048};
            pg8::gemm_phase(lds, tid, 1024, 1024, S, E);
        }
        SEAM(base + 5);
        if (IN(base + 6)) {
            PHASE_IDS;
            for (int u = bid; u < Mrows / 64; u += G) router_unit(p, lds, l, u, p.out, XC, tid);
        }
        SEAM(base + 6);
        if (IN(base + 7)) {
            PHASE_IDS;
            moe_tables(p, lds, l, tid);
            MoeGuSched S{(const char*)Hb, (const char*)(p.ws + WS_WE + WE_GU), (const char*)(wm + WM_SGU), (const unsigned*)(p.ws + WS_LIST),
                         (const LAS int*)(lds + MOE_TAB_OFF), (const LAS int*)(lds + MOE_TAB_OFF) + 128, Mrows / 256, G, bid};
            EpiGateUp E{(bf16_t*)(p.ws + WS_R + R_ACT), (bf16_t*)(p.ws + WS_R + R_ACTS), (const float*)(p.ws + WS_WL)};
            pg8::gemm_phase(lds, tid, 1024, 1024, S, E);
        }
        SEAM(base + 7);
        if (IN(base + 8)) {
            PHASE_IDS;
            moe_tables(p, lds, l, tid);
            MoeDownSched S{(const char*)(p.ws + WS_R + R_ACT), (const char*)(p.ws + WS_WE + WE_D), (const LAS int*)(lds + MOE_TAB_OFF), (const LAS int*)(lds + MOE_TAB_OFF) + 128, G, bid};
            EpiDown E{(bf16_t*)(p.ws + WS_R + R_O), (const unsigned*)(p.ws + WS_LIST)};
            pg8::gemm_phase(lds, tid, 256, 256, S, E);
        }
        SEAM(base + 8);
        if (IN(base + 9)) {
            PHASE_IDS;
            DenseSched S{(const char*)(p.ws + WS_R + R_ACTS), (const char*)(wm + WM_SD), 256, 256, Mrows / 256, 4, G, bid, 1, 0, 0};
            EpiSharedDown E{p.out, XC, mod + 5120, (const bf16_t*)(p.ws + WS_R + R_O)};
            pg8::gemm_phase(lds, tid, 256, 256, S, E);
        }
        SEAM(base + 9);
        if (IN(base + 10)) {
            PHASE_IDS;
            if (l + 1 < DEPTH) { LAS float* scr = (LAS float*)(lds + wave * 8448);
                for (int it = gw; it < EXP_ITEMS; it += NGW) expert_item(p, l + 1, it, scr, lane); }
        }
        SEAM(base + 10);
    }
    if (IN(PH_FINAL)) {
        PHASE_IDS;
        for (int row = gw; row < NL; row += NGW) { float* xr = p.out + (size_t)row * D;
            f32x4 v[4]; float ss = 0.f;
#pragma unroll
            for (int j = 0; j < 4; ++j) { v[j] = ((const f32x4*)xr)[64 * j + lane]; ss += (v[j][0] * v[j][0] + v[j][1] * v[j][1]) + (v[j][2] * v[j][2] + v[j][3] * v[j][3]); }
            const float rstd = rsqrtf(wave_sum(ss) * (1.0f / 1024.0f) + EPS);
#pragma unroll
            for (int j = 0; j < 4; ++j) ((f32x4*)xr)[64 * j + lane] = v[j] * rstd * ((const f32x4*)p.in[I_FG])[64 * j + lane]; }
    }
#undef IN
#undef SEAM
#undef Hb
#undef Zb
#undef BRb
#undef XC
#undef xl
#undef xc
#undef mod
#undef wm
}

#ifndef MK_PER_PHASE
#define MK_PER_PHASE 0
#endif
extern "C" void kernel_launch(void* const* d_in, const int* in_sizes, int n_in, void* d_out, int out_size, void* d_ws, size_t ws_size, hipStream_t stream) {
    static int grid = 0;
    if (grid == 0) {
        if (n_in != 26 || out_size != NL * D || ws_size < WS_END) { fprintf(stderr, "kernel_launch: unexpected shapes (n_in %d out %d ws %zu, need %zu)\n", n_in, out_size, ws_size, (size_t)WS_END); grid = -1; return; }
        int dev = 0, cus = 0;
        if (hipGetDevice(&dev) != hipSuccess || hipDeviceGetAttribute(&cus, hipDeviceAttributeMultiprocessorCount, dev) != hipSuccess) { grid = -1; return; }
        if (hipFuncSetAttribute((const void*)fwd_kernel, hipFuncAttributeMaxDynamicSharedMemorySize, LDS_BYTES) != hipSuccess) { fprintf(stderr, "kernel_launch: hipFuncSetAttribute failed\n"); grid = -1; return; }
        int per_cu = 0;
        if (hipOccupancyMaxActiveBlocksPerMultiprocessor(&per_cu, (const void*)fwd_kernel, NTHREADS, LDS_BYTES) != hipSuccess || per_cu < 1) { fprintf(stderr, "kernel_launch: occupancy query says %d\n", per_cu); }
        (void)hipGetLastError();
        grid = cus;
    }
    if (grid < 0) return;
    (void)hipMemsetAsync((char*)d_ws + WS_CTL, 0, CTL_BYTES, stream);
    Params p{};
    for (int i = 0; i < 26; ++i) p.in[i] = (const float*)d_in[i];
    p.out = (float*)d_out; p.ws = (unsigned char*)d_ws;
#if MK_PER_PHASE
    for (int k = 0; k < NPHASES; ++k) { p.ph_lo = k; p.ph_hi = k + 1; p.li = k;
        hipLaunchKernelGGL(fwd_kernel, dim3(grid), dim3(NTHREADS), LDS_BYTES, stream, p); }
#else
    p.ph_lo = 0; p.ph_hi = NPHASES; p.li = 0;
    hipLaunchKernelGGL(fwd_kernel, dim3(grid), dim3(NTHREADS), LDS_BYTES, stream, p);
#endif
}
```

```cpp
#include <hip/hip_runtime.h>
#include <stdint.h>
#include <stdio.h>

#define LAS __attribute__((address_space(3)))
#define GAS __attribute__((address_space(1)))
template <class T> __device__ __forceinline__ T* as_global(T* q) { return (T*)(GAS T*)q; }
typedef unsigned short bf16_t;
typedef short bf16x8 __attribute__((ext_vector_type(8)));
typedef short bf16x4 __attribute__((ext_vector_type(4)));
typedef float f32x4 __attribute__((ext_vector_type(4)));
typedef float f32x2 __attribute__((ext_vector_type(2)));
typedef unsigned u32x4 __attribute__((ext_vector_type(4)));
typedef unsigned u32x2 __attribute__((ext_vector_type(2)));
typedef long i64x2 __attribute__((ext_vector_type(2)));

constexpr int D = 1024, NB = 8, SEQ = 2048, CTXL = 256, DEPTH = 2;
constexpr int NL = NB * SEQ;
constexpr int NC = NB * CTXL;
constexpr int NT = NL + NC;
constexpr int INW = 7168;
constexpr int ZW = 4096;
constexpr int ZC_AU = 0, ZC_AV = 512, ZC_NQ = 1024, ZC_NK = 1536, ZC_NV = 2048, ZC_RQ = 2560, ZC_RK = 2816, ZC_RV = 3072, ZC_RG = 3584,
              ZC_GA = 4096;
constexpr int BRW = 1536;
constexpr int NEXP = 64, TOPK = 8, EXPW = 256;
constexpr int NCHUNK = 18;
constexpr float EPS = 1e-6f;
constexpr int NTHREADS = 512, NWAVES = 8;
constexpr int LDS_BYTES = 159744;

constexpr size_t MiB = 1u << 20;
constexpr size_t WS_CTL = 0, CTL_BYTES = 1 * MiB;
constexpr size_t WS_MOD = 1 * MiB;
constexpr size_t WS_ROPE = 1 * MiB + 512 * 1024;
constexpr size_t WS_WM = 2 * MiB, WM_STRIDE = 21 * MiB;
constexpr size_t WM_IN = 0, WM_BR = 14680064, WM_OUT = WM_BR + 3145728, WM_SGU = WM_OUT + 2097152, WM_SD = WM_SGU + 1048576,
                 WM_RT = WM_SD + 524288, WM_CM = WM_RT + 131072, WM_END = WM_CM + 131072;
static_assert(WM_END <= WM_STRIDE, "misc weights");
constexpr size_t WS_WE = 44 * MiB;
constexpr size_t WE_GU = 0, WE_D = 33554432, WE_LAYER = 50331648;
constexpr size_t WS_XC = 140 * MiB;
constexpr size_t WS_H = 148 * MiB;
constexpr size_t WS_LIST = 184 * MiB, WS_WL = 189 * MiB;
constexpr size_t WS_R = 194 * MiB;
constexpr size_t R_Z = 0, R_G8 = 144 * MiB, R_BR = 252 * MiB, R_KV = 306 * MiB, R_ST = 342 * MiB, R_STAT = 360 * MiB;
constexpr size_t R_O = 0, R_ACT = 288 * MiB, R_ACTS = 368 * MiB;
constexpr size_t WS_END = WS_R + 377 * MiB;
static_assert(R_KV + 37748736 <= 377 * MiB && R_ACTS + 9437184 <= 377 * MiB && R_Z + 150994944 <= R_G8 && R_G8 + 56623104 <= R_BR && R_BR + 56623104 <= R_KV, "region map");
static_assert(R_O + 301989888 <= R_ACT && R_ACT + 83886080 <= R_ACTS, "region map 2");
constexpr int CW_BAR = 4096;
constexpr int CW_CNT = 200000;

__device__ __forceinline__ float bf2f(unsigned short b) { return __uint_as_float(((unsigned)b) << 16); }
__device__ __forceinline__ unsigned f2bf(float f) { unsigned u = __float_as_uint(f); return (u + 0x7fffu + ((u >> 16) & 1u)) >> 16; }
__device__ __forceinline__ unsigned pk2(float lo, float hi) { unsigned r; asm("v_cvt_pk_bf16_f32 %0, %1, %2" : "=v"(r) : "v"(lo), "v"(hi)); return r; }
__device__ __forceinline__ float lo16(unsigned w) { return __uint_as_float(w << 16); }
__device__ __forceinline__ float hi16(unsigned w) { return __uint_as_float(w & 0xffff0000u); }
__device__ __forceinline__ float shx(float v, int o, int lane) { return __int_as_float(__builtin_amdgcn_ds_bpermute((lane ^ o) << 2, __float_as_int(v))); }
__device__ __forceinline__ int shxi(int v, int o, int lane) { return __builtin_amdgcn_ds_bpermute((lane ^ o) << 2, v); }
__device__ __forceinline__ float dpp_f(float v, const int ctrl_tag) {
    const int x = __float_as_int(v);
    switch (ctrl_tag) {
        case 0: return __int_as_float(__builtin_amdgcn_update_dpp(x, x, 0xB1, 0xF, 0xF, false));
        case 1: return __int_as_float(__builtin_amdgcn_update_dpp(x, x, 0x4E, 0xF, 0xF, false));
        case 2: return __int_as_float(__builtin_amdgcn_update_dpp(x, x, 0x141, 0xF, 0xF, false));
        default: return __int_as_float(__builtin_amdgcn_update_dpp(x, x, 0x140, 0xF, 0xF, false));
    }
}
__device__ __forceinline__ float wave_sum(float v, int  ) {
    v += dpp_f(v, 0); v += dpp_f(v, 1); v += dpp_f(v, 2); v += dpp_f(v, 3);
    const int x = __float_as_int(v);
    return (__int_as_float(__builtin_amdgcn_readlane(x, 0)) + __int_as_float(__builtin_amdgcn_readlane(x, 16))) + (__int_as_float(__builtin_amdgcn_readlane(x, 32)) + __int_as_float(__builtin_amdgcn_readlane(x, 48)));
}
__device__ __forceinline__ float fast_exp(float x) { return __builtin_amdgcn_exp2f(x * 1.44269504089f); }
__device__ __forceinline__ float sigmoidf_(float x) { return __builtin_amdgcn_rcpf(1.0f + fast_exp(-x)); }
__device__ __forceinline__ float siluf_(float x) { return x * sigmoidf_(x); }
__device__ __forceinline__ float geluf_(float x) { const float u = 0.7978845608f * (x + 0.044715f * x * x * x); return x * sigmoidf_(2.0f * u); }
__device__ __forceinline__ f32x4 mfma16(bf16x8 a, bf16x8 b, f32x4 c) { return __builtin_amdgcn_mfma_f32_16x16x32_bf16(a, b, c, 0, 0, 0); }
__device__ __forceinline__ bf16x8 as_frag(u32x4 v) { return __builtin_bit_cast(bf16x8, v); }
__device__ __forceinline__ int launder(int v) { asm volatile("" : "+v"(v)); return v; }
__device__ __forceinline__ int lane_id_here() { unsigned m = ~0u; asm volatile("" : "+s"(m)); return (int)__builtin_amdgcn_mbcnt_hi(m, __builtin_amdgcn_mbcnt_lo(m, 0u)); }
__device__ __forceinline__ int launder_s(int v) { asm volatile("" : "+s"(v)); return v; }
template <class T> __device__ __forceinline__ T* launder_p(T* q) { asm volatile("" : "+s"(q)); return q; }
template <class T> __device__ __forceinline__ T* launder_vp(T* q) { asm volatile("" : "+v"(q)); return q; }
#define LDS_WAIT() asm volatile("s_waitcnt lgkmcnt(0)" ::: "memory")
#define VM_WAIT() asm volatile("s_waitcnt vmcnt(0)" ::: "memory")

__device__ __forceinline__ bf16x8 tr_frag(unsigned base, int stride, int r0, int r1, int c0, int lane) {
    const int q = (lane & 15) >> 2, p = lane & 3;
    const unsigned a0 = base + (unsigned)((r0 + q) * stride + (c0 + 4 * p) * 2), a1 = base + (unsigned)((r1 + q) * stride + (c0 + 4 * p) * 2);
    bf16x4 lo, hi;
    asm volatile("ds_read_b64_tr_b16 %0, %2\n\tds_read_b64_tr_b16 %1, %3\n\ts_waitcnt lgkmcnt(0)" : "=&v"(lo), "=&v"(hi) : "v"(a0), "v"(a1) : "memory");
    bf16x8 r; r[0] = lo[0]; r[1] = lo[1]; r[2] = lo[2]; r[3] = lo[3]; r[4] = hi[0]; r[5] = hi[1]; r[6] = hi[2]; r[7] = hi[3];
    return r;
}
__device__ __forceinline__ unsigned lds_addr(LAS unsigned char* p) { return (unsigned)(size_t)p; }
template <int O0, int O1> __device__ __forceinline__ bf16x8 tr_frag_i(unsigned a) {
    static_assert(O0 >= 0 && O0 < 65536 && O1 >= 0 && O1 < 65536, "ds offset field");
    bf16x4 lo, hi;
    asm volatile("ds_read_b64_tr_b16 %0, %2 offset:%3\n\tds_read_b64_tr_b16 %1, %2 offset:%4\n\ts_waitcnt lgkmcnt(0)" : "=&v"(lo), "=&v"(hi) : "v"(a), "n"(O0), "n"(O1) : "memory");
    bf16x8 r; r[0] = lo[0]; r[1] = lo[1]; r[2] = lo[2]; r[3] = lo[3]; r[4] = hi[0]; r[5] = hi[1]; r[6] = hi[2]; r[7] = hi[3];
    return r;
}
template <int OB, int R1> __device__ __forceinline__ void tr_frag4_i(unsigned a, bf16x8 (&f)[4]) {
    static_assert(OB >= 0 && OB + R1 + 96 < 65536, "ds offset field");
    bf16x4 l0, h0, l1, h1, l2, h2, l3, h3;
    asm volatile("ds_read_b64_tr_b16 %0, %8 offset:%9\n\tds_read_b64_tr_b16 %1, %8 offset:%10\n\tds_read_b64_tr_b16 %2, %8 offset:%11\n\tds_read_b64_tr_b16 %3, %8 offset:%12\n\t"
                 "ds_read_b64_tr_b16 %4, %8 offset:%13\n\tds_read_b64_tr_b16 %5, %8 offset:%14\n\tds_read_b64_tr_b16 %6, %8 offset:%15\n\tds_read_b64_tr_b16 %7, %8 offset:%16\n\ts_waitcnt lgkmcnt(0)"
                 : "=&v"(l0), "=&v"(h0), "=&v"(l1), "=&v"(h1), "=&v"(l2), "=&v"(h2), "=&v"(l3), "=&v"(h3)
                 : "v"(a), "n"(OB), "n"(OB + R1), "n"(OB + 32), "n"(OB + 32 + R1), "n"(OB + 64), "n"(OB + 64 + R1), "n"(OB + 96), "n"(OB + 96 + R1) : "memory");
    f[0][0] = l0[0]; f[0][1] = l0[1]; f[0][2] = l0[2]; f[0][3] = l0[3]; f[0][4] = h0[0]; f[0][5] = h0[1]; f[0][6] = h0[2]; f[0][7] = h0[3];
    f[1][0] = l1[0]; f[1][1] = l1[1]; f[1][2] = l1[2]; f[1][3] = l1[3]; f[1][4] = h1[0]; f[1][5] = h1[1]; f[1][6] = h1[2]; f[1][7] = h1[3];
    f[2][0] = l2[0]; f[2][1] = l2[1]; f[2][2] = l2[2]; f[2][3] = l2[3]; f[2][4] = h2[0]; f[2][5] = h2[1]; f[2][6] = h2[2]; f[2][7] = h2[3];
    f[3][0] = l3[0]; f[3][1] = l3[1]; f[3][2] = l3[2]; f[3][3] = l3[3]; f[3][4] = h3[0]; f[3][5] = h3[1]; f[3][6] = h3[2]; f[3][7] = h3[3];
}
__device__ __forceinline__ unsigned tr_lane(unsigned base, int stride, int rmul, int lane) { return base + (unsigned)((rmul * (lane >> 4) + ((lane & 15) >> 2)) * stride + (lane & 3) * 8); }
template <int V> struct IC { static constexpr int value = V; };
template <int I, int N, class F> __device__ __forceinline__ void sfor(F&& f) { if constexpr (I < N) { f(IC<I>{}); sfor<I + 1, N>(f); } }


#define XB_TMO      128
#define XB_XCNT(j)  (256  + 64 * (j))
#define XB_XSUB(j)  (1280 + 64 * (j))
#define XB_XGEN(j)  (2304 + 64 * (j))
#define XB_TOP      3328
#define XB_TOPGEN   3392
#define XCD_BAR_WORDS 3456
#define XB_SPIN_CAP (1u << 21)
__device__ __forceinline__ unsigned xb_ld(unsigned* p)              { return __hip_atomic_load(p, __ATOMIC_RELAXED, __HIP_MEMORY_SCOPE_AGENT); }
__device__ __forceinline__ unsigned xb_add(unsigned* p, unsigned v) { return __hip_atomic_fetch_add(p, v, __ATOMIC_RELAXED, __HIP_MEMORY_SCOPE_AGENT); }
__device__ __forceinline__ unsigned xb_xcc_id() { return (unsigned)__builtin_amdgcn_s_getreg((3 << 11) | 20) & 0xFu; }
#define XB_SPIN(cond, bar) do { unsigned _sp = 0; while (cond) { __builtin_amdgcn_s_sleep(1); \
    if ((++_sp & 255u) == 0u) { if (xb_ld(&(bar)[XB_TMO])) break; if (_sp > XB_SPIN_CAP) { atomicAdd(&(bar)[XB_TMO], 1u); break; } } } } while (0)
struct XcdBarrier { unsigned* bar; unsigned x; volatile LAS unsigned* st; };
__device__ __forceinline__ XcdBarrier xcd_barrier_post(unsigned* bar, volatile LAS unsigned* st) {
    XcdBarrier b; b.bar = bar; b.x = xb_xcc_id(); b.st = st;
    if (threadIdx.x == 0) (void)xb_add(&bar[XB_XCNT(b.x)], 1u);
    return b;
}
__device__ __forceinline__ void xcd_barrier_complete(unsigned* bar, unsigned x, unsigned& nloc, unsigned& nx) {
    const unsigned G = gridDim.x * gridDim.y * gridDim.z;
    unsigned sum, cnt, mine, sp = 0u;
    for (;;) {
        sum = 0u; cnt = 0u; mine = 0u;
#pragma unroll
        for (unsigned j = 0; j < 16; ++j) { const unsigned c = xb_ld(&bar[XB_XCNT(j)]); sum += c; cnt += (c > 0u) ? 1u : 0u; mine = (j == x) ? c : mine; }
        if (sum == G) break;
        __builtin_amdgcn_s_sleep(1);
        if ((++sp & 255u) == 0u) { if (xb_ld(&bar[XB_TMO])) break; if (sp > XB_SPIN_CAP) { atomicAdd(&bar[XB_TMO], 1u); break; } }
    }
    nloc = mine > 0u ? mine : 1u; nx = cnt > 0u ? cnt : 1u;
}
__device__ __forceinline__ void xcd_barrier(const XcdBarrier& b, const bool leader) {
    asm volatile("s_waitcnt vmcnt(0)" ::: "memory");
    __syncthreads();
    if (leader) {
        unsigned* bar = b.bar;
        __builtin_amdgcn_s_waitcnt(0);
        unsigned nloc = b.st[0], nx = b.st[1];
        if (nloc == 0u) { xcd_barrier_complete(bar, b.x, nloc, nx); b.st[0] = nloc; b.st[1] = nx; }
        const unsigned old = xb_add(&bar[XB_XSUB(b.x)], 1u);
        const unsigned gen = old / nloc;
        if (old + 1u == (gen + 1u) * nloc) {
            __builtin_amdgcn_fence(__ATOMIC_RELEASE, "agent");
            asm volatile("s_waitcnt vmcnt(0)" ::: "memory");
            const unsigned og = xb_add(&bar[XB_TOP], 1u);
            const unsigned tg = og / nx;
            if (og + 1u == (tg + 1u) * nx) xb_add(&bar[XB_TOPGEN], 1u);
            else XB_SPIN(xb_ld(&bar[XB_TOPGEN]) == tg, bar);
            __builtin_amdgcn_fence(__ATOMIC_ACQUIRE, "agent");
            xb_add(&bar[XB_XGEN(b.x)], 1u);
            asm volatile("s_waitcnt vmcnt(0)" ::: "memory");
        } else {
            XB_SPIN(xb_ld(&bar[XB_XGEN(b.x)]) == gen, bar);
            __builtin_amdgcn_fence(__ATOMIC_ACQUIRE, "agent");
            asm volatile("s_waitcnt vmcnt(0)" ::: "memory");
        }
    }
    __syncthreads();
}

namespace pg8 {
constexpr int BM = 256, BK = 64, HALF = 128, HTB = HALF * BK * 2, STAGE_BYTES = 8 * HTB, NXCD = 8, WGM = 8;
constexpr int ROWTAB_OFF = 149504;
constexpr int GATHER_SLOT_OFF = 133120;
__device__ __forceinline__ int lds_byte(int r, int c) { const int st = (r >> 4) * 2 + (c >> 5), rr = r & 15, cc = c & 31, ob = rr * 64 + cc * 2; return st * 1024 + (ob ^ (((ob >> 9) & 1) << 5)); }
__device__ __forceinline__ void stage_rc(int b, int& R, int& C) { const int st = b / 1024, sb = b % 1024, swz = sb ^ (((sb >> 9) & 1) << 5); R = (st >> 1) * 16 + swz / 64; C = (st & 1) * 32 + (swz % 64) / 2; }
__device__ __forceinline__ int perm32(int rho) { const int n = rho >> 4, i = rho & 15; return 8 * (i >> 2) + 4 * n + (i & 3); }

struct Unit { const char* A; const char* B; int e0, e1, e2, e3, e4; };

__device__ __forceinline__ bool static_tile(int i, int G, int c, int nM, int nN, int& pm, int& pn) {
    const int nwg = nM * nN; const long L = (long)i * G + c; if (L >= nwg) return false;
    int wgid = (int)L; { const int q = nwg / NXCD, r = nwg % NXCD, xcd = wgid % NXCD, off = wgid / NXCD; wgid = (xcd < r ? xcd * (q + 1) : r * (q + 1) + (xcd - r) * q) + off; }
    const int nig = WGM * nN, gid = wgid / nig, fm = gid * WGM, gsz = (nM - fm) < WGM ? (nM - fm) : WGM;
    pm = fm + ((wgid % nig) % gsz); pn = (wgid % nig) / gsz; return true;
}

template <bool F8 = false, class Epi, class Sched>
__device__ __forceinline__ void gemm_phase(LAS unsigned char* lds, const int tid, const int K, const int ldb  , const Sched& S, const Epi& E, const int stamp_base = -1) {
#ifdef TIMING
#define GSTAMP(k) do { if (stamp_base >= 0 && tid == 0 && (k) < 31) ((volatile LAS unsigned long long*)(lds + LDS_BYTES - 16 - 512))[stamp_base + (k)] = __builtin_amdgcn_s_memrealtime(); } while (0)
#else
#define GSTAMP(k) do { } while (0)
#endif
    GSTAMP(-1);
    const int wid = __builtin_amdgcn_readfirstlane(tid >> 6), lane = tid & 63, wr = wid >> 2, wc = wid & 3, fr = lane & 15, fq = lane >> 4;
    const int nt = K / (F8 ? 2 * BK : BK);
    unsigned voffB[2];
#pragma unroll
    for (int i = 0; i < 2; ++i) { int R, C; stage_rc(tid * 16 + i * 8192, R, C); const int Rb = Epi::PERM ? ((R & ~31) + perm32(R & 31)) : R; voffB[i] = F8 ? (unsigned)(Rb * ldb + C * 2) : (unsigned)(Rb * ldb + C) * 2u; }
    const size_t kstep = (size_t)(BK * 2);
    const size_t hstepB = (size_t)HALF * ldb * (F8 ? 1 : 2);
    const unsigned ldsw = (unsigned)wid * 1024u;
    const int aoff = lds_byte(wr * 64 + fr, fq * 8), boff = lds_byte(wc * 32 + fr, fq * 8);
#define PG8_SA(b, h) (((b) * 2 + (h)) * HTB)
#define PG8_SB(b, h) ((4 + (b) * 2 + (h)) * HTB)
#define PG8_STAGE(bufoff, gbase, voff) do { _Pragma("unroll") for (int _i = 0; _i < 2; ++_i) \
        __builtin_amdgcn_global_load_lds((const unsigned*)((const char*)(gbase) + (voff)[_i]), (LAS unsigned*)(lds + (bufoff) + ldsw + _i * 8192), 16, 0, 0); } while (0)
#define PG8_LDA(dst, b, h) do { _Pragma("unroll") for (int m = 0; m < 4; ++m) _Pragma("unroll") for (int k = 0; k < 2; ++k) dst[m][k] = *(const LAS bf16x8*)(lds + PG8_SA(b, h) + aoff + m * 2048 + k * 1024); } while (0)
#define PG8_LDB(dst, b, h) do { _Pragma("unroll") for (int n = 0; n < 2; ++n) _Pragma("unroll") for (int k = 0; k < 2; ++k) dst[n][k] = *(const LAS bf16x8*)(lds + PG8_SB(b, h) + boff + n * 2048 + k * 1024); } while (0)
#define PG8_MMA(ai, bj, At, Bt) do { __builtin_amdgcn_s_setprio(1); _Pragma("unroll") for (int m = 0; m < 4; ++m) _Pragma("unroll") for (int n = 0; n < 2; ++n) _Pragma("unroll") for (int k = 0; k < 2; ++k) { \
        if constexpr (F8) { const i64x2 b2_ = __builtin_bit_cast(i64x2, Bt[n][k]), a2_ = __builtin_bit_cast(i64x2, At[m][k]); \
            acc[ai][bj][m][n] = __builtin_amdgcn_mfma_f32_16x16x32_fp8_fp8(b2_[0], a2_[0], acc[ai][bj][m][n], 0, 0, 0); \
            acc[ai][bj][m][n] = __builtin_amdgcn_mfma_f32_16x16x32_fp8_fp8(b2_[1], a2_[1], acc[ai][bj][m][n], 0, 0, 0); } \
        else acc[ai][bj][m][n] = __builtin_amdgcn_mfma_f32_16x16x32_bf16(Bt[n][k], At[m][k], acc[ai][bj][m][n], 0, 0, 0); } __builtin_amdgcn_s_setprio(0); } while (0)
#define PG8_WAIT_V(n) asm volatile("s_waitcnt vmcnt(" #n ")" ::: "memory")
#define PG8_WAIT_L(n) asm volatile("s_waitcnt lgkmcnt(" #n ")" ::: "memory")
#define PG8_BAR __builtin_amdgcn_s_barrier()
#define PG8_SCHED __builtin_amdgcn_sched_barrier(0)
    Unit cur, nxt; int ui = 0;
    if (!S.next(0, cur)) return;
    unsigned cvA[2][2], nvA[2][2];
    S.a_offs(cur, tid, cvA);
    LAS unsigned* const gslot = (LAS unsigned*)(lds + GATHER_SLOT_OFF) + tid * 4;
    if constexpr (Sched::GATHER) { *(LAS u32x4*)gslot = (u32x4){cvA[0][0], cvA[0][1], cvA[1][0], cvA[1][1]}; }
    f32x4 acc[2][2][4][2];
#pragma unroll
    for (int a = 0; a < 2; ++a)
#pragma unroll
        for (int b = 0; b < 2; ++b)
#pragma unroll
            for (int m = 0; m < 4; ++m)
#pragma unroll
                for (int n = 0; n < 2; ++n) acc[a][b][m][n] = (f32x4){0.f, 0.f, 0.f, 0.f};
    bf16x8 At[4][2], B0[2][2], B1[2][2];
    const char* cA = cur.A; const char* cB = cur.B;
    PG8_STAGE(PG8_SB(0, 0), cB, voffB); PG8_STAGE(PG8_SA(0, 0), cA, cvA[0]); PG8_STAGE(PG8_SB(0, 1), cB + hstepB, voffB); PG8_STAGE(PG8_SA(0, 1), cA, cvA[1]);
    if (wr == 1) PG8_BAR;
    PG8_WAIT_V(4); PG8_BAR;
    PG8_STAGE(PG8_SB(1, 0), cB + kstep, voffB); PG8_STAGE(PG8_SA(1, 0), cA + kstep, cvA[0]); PG8_STAGE(PG8_SB(1, 1), cB + hstepB + kstep, voffB);
    PG8_WAIT_V(6); PG8_BAR;
    for (;;) {
        if constexpr (Epi::STAGES) { if (wid < 4) E.stage(cur, (LAS unsigned*)(lds + ROWTAB_OFF) + (ui & 1) * 256 + wid * 64, wid * 64 + lane); }
        const bool has_next = S.next(ui + 1, nxt);
        if (has_next) S.a_offs(nxt, tid, nvA);
        else {
#pragma unroll
            for (int h = 0; h < 2; ++h)
#pragma unroll
                for (int i = 0; i < 2; ++i) nvA[h][i] = cvA[h][i];
        }
        if constexpr (Sched::GATHER) { *(LAS u32x4*)(gslot + ((ui + 1) & 1) * 2048) = (u32x4){nvA[0][0], nvA[0][1], nvA[1][0], nvA[1][1]}; }
        const char* nA = has_next ? nxt.A : cA; const char* nB = has_next ? nxt.B : cB;
#pragma unroll 1
        for (int t = 0; t < nt; t += 2) {
            const bool last = (t == nt - 2);
            const char* a1 = cA + (size_t)(t + 1) * kstep;
            const char* a2 = last ? nA : cA + (size_t)(t + 2) * kstep; const char* b2 = last ? nB : cB + (size_t)(t + 2) * kstep;
            const char* a3 = a2 + kstep; const char* b3 = b2 + kstep;
            unsigned sA[2][2];
            if constexpr (Sched::GATHER) {
                const u32x4 cv = *(const LAS u32x4*)(gslot + (ui & 1) * 2048), sv = *(const LAS u32x4*)(gslot + ((ui + (last ? 1 : 0)) & 1) * 2048);
                cvA[0][0] = cv.x; cvA[0][1] = cv.y; cvA[1][0] = cv.z; cvA[1][1] = cv.w; sA[0][0] = sv.x; sA[0][1] = sv.y; sA[1][0] = sv.z; sA[1][1] = sv.w;
            } else {
#pragma unroll
                for (int h = 0; h < 2; ++h)
#pragma unroll
                    for (int i = 0; i < 2; ++i) sA[h][i] = last ? nvA[h][i] : cvA[h][i];
            }
            PG8_LDB(B0, 0, 0); PG8_SCHED; PG8_LDA(At, 0, 0); PG8_STAGE(PG8_SA(1, 1), a1, cvA[1]);
            PG8_WAIT_L(8); PG8_BAR; PG8_WAIT_L(0); PG8_MMA(0, 0, At, B0); PG8_BAR; PG8_SCHED;
            PG8_LDB(B1, 0, 1); PG8_STAGE(PG8_SB(0, 0), b2, voffB);
            PG8_BAR; PG8_WAIT_L(0); PG8_MMA(0, 1, At, B1); PG8_BAR;
            PG8_LDA(At, 0, 1); PG8_STAGE(PG8_SA(0, 0), a2, sA[0]);
            PG8_BAR; PG8_WAIT_L(0); PG8_MMA(1, 0, At, B0); PG8_BAR; PG8_SCHED;
            PG8_STAGE(PG8_SB(0, 1), b2 + hstepB, voffB);
            PG8_WAIT_V(6); PG8_BAR; PG8_MMA(1, 1, At, B1); PG8_BAR;
            PG8_LDB(B0, 1, 0); PG8_SCHED; PG8_LDA(At, 1, 0); PG8_STAGE(PG8_SA(0, 1), a2, sA[1]);
            PG8_WAIT_L(8); PG8_BAR; PG8_WAIT_L(0); PG8_MMA(0, 0, At, B0); PG8_BAR; PG8_SCHED;
            PG8_LDB(B1, 1, 1); PG8_STAGE(PG8_SB(1, 0), b3, voffB);
            PG8_BAR; PG8_WAIT_L(0); PG8_MMA(0, 1, At, B1); PG8_BAR;
            PG8_LDA(At, 1, 1); PG8_STAGE(PG8_SA(1, 0), a3, sA[0]);
            PG8_BAR; PG8_WAIT_L(0); PG8_MMA(1, 0, At, B0); PG8_BAR; PG8_SCHED;
            PG8_STAGE(PG8_SB(1, 1), b3 + hstepB, voffB);
            PG8_WAIT_V(6); PG8_BAR; PG8_MMA(1, 1, At, B1); PG8_BAR;
        }
        GSTAMP(2 * ui);
        if constexpr (Epi::STAGES) E(acc, cur, wr, wc, fr, fq, (const LAS unsigned*)(lds + ROWTAB_OFF) + (ui & 1) * 256); else E(acc, cur, wr, wc, fr, fq);
        GSTAMP(2 * ui + 1);
        if (!has_next) break;
        if (!(Epi::KEEPS && E.keep(cur))) {
#pragma unroll
        for (int a = 0; a < 2; ++a)
#pragma unroll
            for (int b = 0; b < 2; ++b)
#pragma unroll
                for (int m = 0; m < 4; ++m)
#pragma unroll
                    for (int n = 0; n < 2; ++n) acc[a][b][m][n] = (f32x4){0.f, 0.f, 0.f, 0.f};
        }
        cur = nxt; cA = nA; cB = nB; ++ui;
        if constexpr (!Sched::GATHER) {
#pragma unroll
            for (int h = 0; h < 2; ++h)
#pragma unroll
                for (int i = 0; i < 2; ++i) cvA[h][i] = nvA[h][i];
        }
    }
    PG8_WAIT_V(0);
    if (wr == 0) PG8_BAR;
    PG8_BAR;
#undef PG8_SA
#undef PG8_SB
#undef PG8_STAGE
#undef PG8_LDA
#undef PG8_LDB
#undef PG8_MMA
#undef PG8_WAIT_V
#undef PG8_WAIT_L
#undef PG8_BAR
#undef PG8_SCHED
}
}

using pg8::Unit;
struct DenseSched {
    static constexpr bool GATHER = false;
    const char* A; const char* B; int lda, ldb, nM, nN, G, c, nsub; size_t asub, bsub;
    __device__ __forceinline__ bool next(int i, Unit& u) const {
        const int sub = i % nsub, ti = i / nsub; int pm, pn;
        if (!pg8::static_tile(ti, G, c, nM, nN, pm, pn)) return false;
        u.A = A + (size_t)pm * 256 * lda * 2 + (size_t)sub * asub; u.B = B + (size_t)pn * 256 * ldb * 2 + (size_t)sub * bsub;
        u.e0 = pm; u.e1 = pn; u.e2 = sub; u.e3 = 0; u.e4 = 0; return true;
    }
    __device__ __forceinline__ void a_offs(const Unit&, int tid, unsigned (&vo)[2][2]) const {
#pragma unroll
        for (int i = 0; i < 2; ++i) { int R, C; pg8::stage_rc(tid * 16 + i * 8192, R, C);
#pragma unroll
            for (int h = 0; h < 2; ++h) vo[h][i] = (unsigned)((h * 128 + R) * lda + C) * 2u; }
    }
};
constexpr int MOE_TAB_OFF = 131072;
constexpr int MOE_UL_OFF = MOE_TAB_OFF + 1024, MOE_UL_MAX = 24;
#define RFL(x) __builtin_amdgcn_readfirstlane(x)
__device__ __forceinline__ int moe_find_expert(const LAS int* tbase, int mt) {
    int lo = 0, hi = 63;
#pragma unroll
    for (int it = 0; it < 6; ++it) { const int mid = (lo + hi + 1) >> 1; if (RFL(tbase[mid]) <= mt) lo = mid; else hi = mid - 1; }
    return lo;
}
struct MoeGuSched {
    static constexpr bool GATHER = true;
    const char* H2; const char* WGU; const char* WSGU; const unsigned* list; const LAS int* tbase; const LAS int* cnt; int nMs, G, c;
    __device__ __forceinline__ bool next(int i, Unit& u) const {
        if (i >= MOE_UL_MAX) return false;
        const LAS int* ul = tbase + (MOE_UL_OFF - MOE_TAB_OFF) / 4 + i * 8;
        const int e = RFL(ul[0]), nt = RFL(ul[1]), p0 = RFL(ul[2]), t3 = RFL(ul[3]), cn_ = RFL(ul[4]);
        if (e < 0) return false;
        u.e0 = e; u.e1 = nt; u.e2 = p0; u.e3 = t3; u.e4 = cn_;
        if (e != 64) { u.A = H2; u.B = WGU + (size_t)e * (512 * 1024) + (size_t)nt * (256 * 1024); }
        else { u.A = H2 + (size_t)t3 * 256 * 1024; u.B = WSGU + (size_t)nt * (256 * 1024); }
        return true;
    }
    __device__ __forceinline__ void a_offs(const Unit& u, int tid, unsigned (&vo)[2][2]) const {
#pragma unroll
        for (int i = 0; i < 2; ++i) { int R, C; pg8::stage_rc(tid * 16 + i * 8192, R, C); R = launder(R);
#pragma unroll
            for (int h = 0; h < 2; ++h) {
                if (u.e0 == 64) vo[h][i] = (unsigned)((h * 128 + R) * 1024 + C * 2);
                else { const int pos = u.e2 + h * 128 + R; unsigned tok = 0u; if (pos < u.e4) tok = list[(size_t)u.e0 * NT + pos] >> 3; vo[h][i] = tok * 1024u + (unsigned)C * 2u; } } }
    }
};
struct MoeDownSched {
    static constexpr bool GATHER = false;
    const char* ACT; const char* WD; const char* ACTS; const char* WSD; const LAS int* tbase; const LAS int* cnt; int nMs, G, c;
    __device__ __forceinline__ bool next(int i, Unit& u) const {
        if (i >= MOE_UL_MAX) return false;
        const LAS int* ul = tbase + (MOE_UL_OFF - MOE_TAB_OFF) / 4 + i * 8;
        const int e = RFL(ul[0]), pn = RFL(ul[1]), p0 = RFL(ul[2]), t3 = RFL(ul[3]), cn_ = RFL(ul[4]);
        if (e < 0) return false;
        u.e0 = e; u.e1 = pn; u.e2 = p0; u.e3 = t3; u.e4 = cn_;
        if (e != 64) { u.A = ACT + (size_t)t3 * (256 * 256); u.B = WD + (size_t)e * (1024 * 256) + (size_t)pn * (256 * 256); }
        else { u.A = ACTS + (size_t)t3 * (256 * 256); u.B = WSD + (size_t)pn * (256 * 256); }
        return true;
    }
    __device__ __forceinline__ void a_offs(const Unit&, int tid, unsigned (&vo)[2][2]) const {
#pragma unroll
        for (int i = 0; i < 2; ++i) { int R, C; pg8::stage_rc(tid * 16 + i * 8192, R, C);
#pragma unroll
            for (int h = 0; h < 2; ++h) vo[h][i] = (unsigned)((h * 128 + R) * 256 + C * 2); }
    }
};

struct EpiStoreBf16 {
    static constexpr bool STAGES = false;
    static constexpr bool KEEPS = false; __device__ __forceinline__ bool keep(const Unit&) const { return false; }
    static constexpr bool PERM = true;
    bf16_t* O; int ldc; int gate_tile0; unsigned char* G8;
    __device__ __forceinline__ void operator()(const f32x4 (&acc)[2][2][4][2], const Unit& u, int wr, int wc, int fr, int fq) const {
        const int row0 = u.e0 * 256 + launder(wr * 64 + fr), col0 = u.e1 * 256 + wc * 32 + 8 * fq;
        if (u.e1 >= gate_tile0) {
            const int gi = (u.e1 - gate_tile0) >> 2, pn = (u.e1 - gate_tile0) & 3, tidx = launder(((wr * 4 + wc) * 64) + fq * 16 + fr);
            unsigned char* gp = G8 + ((size_t)((u.e0 * 4 + pn) * 3 + gi) * 65536) + (size_t)tidx * 128;
#pragma unroll
            for (int ai = 0; ai < 2; ++ai)
#pragma unroll
                for (int m = 0; m < 4; ++m) { u32x4 w;
#pragma unroll
                    for (int bj = 0; bj < 2; ++bj) { const f32x4 v0 = acc[ai][bj][m][0], v1 = acc[ai][bj][m][1];
                        float q[8] = {v0[0], v0[1], v0[2], v0[3], v1[0], v1[1], v1[2], v1[3]}; unsigned qb[8];
#pragma unroll
                        for (int j = 0; j < 8; ++j) { const float t = fminf(fmaxf(sigmoidf_(q[j]) * 255.0f + 0.5f, 1.0f), 255.0f); qb[j] = (unsigned)t; }
                        const unsigned lo = qb[0] | (qb[1] << 8) | (qb[2] << 16) | (qb[3] << 24), hi = qb[4] | (qb[5] << 8) | (qb[6] << 16) | (qb[7] << 24);
                        if (bj == 0) { w.x = lo; w.y = hi; } else { w.z = lo; w.w = hi; } }
                    *(u32x4*)(gp + (ai * 4 + m) * 16) = w; }
            return;
        }
#pragma unroll
        for (int ai = 0; ai < 2; ++ai)
#pragma unroll
            for (int m = 0; m < 4; ++m) { bf16_t* rowp = O + (size_t)(row0 + ai * 128 + m * 16) * ldc + col0;
#pragma unroll
                for (int bj = 0; bj < 2; ++bj) { const f32x4 v0 = acc[ai][bj][m][0], v1 = acc[ai][bj][m][1];
                    u32x4 w; w.x = pk2(v0[0], v0[1]); w.y = pk2(v0[2], v0[3]); w.z = pk2(v1[0], v1[1]); w.w = pk2(v1[2], v1[3]);
                    *(u32x4*)(rowp + bj * 128) = w; } }
    }
};
struct EpiMerge {
    static constexpr bool PERM = true, KEEPS = true, STAGES = false;
    bf16_t* Mo; const unsigned char* G8;
    __device__ __forceinline__ bool keep(const Unit& u) const { return u.e2 < 2; }
    __device__ __forceinline__ void operator()(f32x4 (&acc)[2][2][4][2], const Unit& u, int wr, int wc, int fr, int fq) const {
        const int row0 = u.e0 * 256 + launder(wr * 64 + fr), col0 = u.e1 * 256 + wc * 32 + 8 * fq, sub = u.e2, tidx = launder(((wr * 4 + wc) * 64) + fq * 16 + fr);
        const unsigned char* gp = G8 + ((size_t)((u.e0 * 4 + u.e1) * 3 + sub) * 65536) + (size_t)tidx * 128;
        u32x4 gq[8], hq[8];
        const unsigned char* hp = gp + (sub < 2 ? 65536 : 0);
#pragma unroll
        for (int k = 0; k < 8; ++k) { gq[k] = *(const u32x4*)(gp + k * 16); hq[k] = *(const u32x4*)(hp + k * 16); }
#pragma unroll
        for (int ai = 0; ai < 2; ++ai)
#pragma unroll
            for (int m = 0; m < 4; ++m)
#pragma unroll
                for (int bj = 0; bj < 2; ++bj) { const u32x4 g4v = gq[ai * 4 + m], h4v = hq[ai * 4 + m];
                    const unsigned g0 = bj ? g4v.z : g4v.x, g1 = bj ? g4v.w : g4v.y, h0 = bj ? h4v.z : h4v.x, h1 = bj ? h4v.w : h4v.y;
                    float f[8];
#pragma unroll
                    for (int j = 0; j < 8; ++j) { const float qg = (float)(((j < 4 ? g0 : g1) >> (8 * (j & 3))) & 255u), qh = (float)(((j < 4 ? h0 : h1) >> (8 * (j & 3))) & 255u);
                        f[j] = sub < 2 ? qg * __builtin_amdgcn_rcpf(qh) : qg * (1.0f / 255.0f); }
                    acc[ai][bj][m][0] = acc[ai][bj][m][0] * (f32x4){f[0], f[1], f[2], f[3]}; acc[ai][bj][m][1] = acc[ai][bj][m][1] * (f32x4){f[4], f[5], f[6], f[7]};
                    if (sub == 2) { const size_t row = (size_t)(row0 + ai * 128 + m * 16); const f32x4 v0 = acc[ai][bj][m][0], v1 = acc[ai][bj][m][1];
                        u32x4 w; w.x = pk2(v0[0], v0[1]); w.y = pk2(v0[2], v0[3]); w.z = pk2(v1[0], v1[1]); w.w = pk2(v1[2], v1[3]);
                        *(u32x4*)(Mo + row * 1024 + col0 + bj * 128) = w; } }
    }
};
struct EpiResid {
    static constexpr bool STAGES = false;
    static constexpr bool KEEPS = false; __device__ __forceinline__ bool keep(const Unit&) const { return false; }
    static constexpr bool PERM = false;
    const float* src_l; const float* src_c; float* dst_l; float* dst_c; const float* gate;
    __device__ __forceinline__ void operator()(const f32x4 (&acc)[2][2][4][2], const Unit& u, int wr, int wc, int fr, int fq) const {
        const int g0 = u.e0 * 256; const bool lat = g0 < NL;
        const float* src = lat ? src_l + (size_t)g0 * D : src_c + (size_t)(g0 - NL) * D;
        float* dst = lat ? dst_l + (size_t)g0 * D : dst_c + (size_t)(g0 - NL) * D;
        const float* gp = gate + (size_t)(lat ? (g0 >> 11) : 8) * 6144;
        const int row0 = launder(wr * 64 + fr), col0 = u.e1 * 256 + wc * 32 + 4 * fq;
        f32x4 gv[2][2];
#pragma unroll
        for (int bj = 0; bj < 2; ++bj)
#pragma unroll
            for (int n = 0; n < 2; ++n) gv[bj][n] = *(const f32x4*)(gp + col0 + bj * 128 + n * 16);
#pragma unroll
        for (int am = 0; am < 4; ++am) { const int ai = am >> 1, mh = (am & 1) * 2;
            f32x4 sq[2][2][2];
#pragma unroll
            for (int mm = 0; mm < 2; ++mm)
#pragma unroll
                for (int bj = 0; bj < 2; ++bj)
#pragma unroll
                    for (int n = 0; n < 2; ++n) sq[mm][bj][n] = *(const f32x4*)(src + (size_t)(row0 + ai * 128 + (mh + mm) * 16) * D + col0 + bj * 128 + n * 16);
#pragma unroll
            for (int mm = 0; mm < 2; ++mm)
#pragma unroll
                for (int bj = 0; bj < 2; ++bj)
#pragma unroll
                    for (int n = 0; n < 2; ++n) *(f32x4*)(dst + (size_t)(row0 + ai * 128 + (mh + mm) * 16) * D + col0 + bj * 128 + n * 16) = sq[mm][bj][n] + gv[bj][n] * acc[ai][bj][mh + mm][n];
            if (am == 1) asm volatile("" ::: "memory");
        }
    }
};
struct EpiGateUp {
    static constexpr bool KEEPS = false; __device__ __forceinline__ bool keep(const Unit&) const { return false; }
    static constexpr bool PERM = true, STAGES = true;
    bf16_t* ACT; bf16_t* ACTS; const float* wl;
    __device__ __forceinline__ void stage(const Unit& u, LAS unsigned* dst_wave, int entry) const {
        if (u.e0 != 64) __builtin_amdgcn_global_load_lds((const unsigned*)(wl + (size_t)u.e0 * NT + u.e2 + entry), dst_wave, 4, 0, 0);
    }
    __device__ __forceinline__ void operator()(const f32x4 (&acc)[2][2][4][2], const Unit& u, int wr, int wc, int fr, int fq, const LAS unsigned* tab) const {
        const int row0 = launder(wr * 64 + fr), col0 = u.e1 * 128 + wc * 32 + 8 * fq;
        unsigned char* base = (unsigned char*)(u.e0 == 64 ? ACTS : ACT) + (size_t)u.e3 * 256 * 256;
#pragma unroll
        for (int ai = 0; ai < 2; ++ai)
#pragma unroll
            for (int m = 0; m < 4; ++m) { const int row = row0 + ai * 128 + m * 16; float w = 1.0f;
                if (u.e0 != 64) { w = 0.0f; if (u.e2 + row < u.e4) w = __uint_as_float(tab[row]); }
                const f32x4 g0 = acc[ai][0][m][0] * 0.03125f, g1 = acc[ai][0][m][1] * 0.03125f, u0 = acc[ai][1][m][0] * (0.03125f * 8.0f * w), u1 = acc[ai][1][m][1] * (0.03125f * 8.0f * w);
                int lo = 0, hi = 0;
                lo = __builtin_amdgcn_cvt_pk_fp8_f32(siluf_(g0[0]) * u0[0], siluf_(g0[1]) * u0[1], lo, false); lo = __builtin_amdgcn_cvt_pk_fp8_f32(siluf_(g0[2]) * u0[2], siluf_(g0[3]) * u0[3], lo, true);
                hi = __builtin_amdgcn_cvt_pk_fp8_f32(siluf_(g1[0]) * u1[0], siluf_(g1[1]) * u1[1], hi, false); hi = __builtin_amdgcn_cvt_pk_fp8_f32(siluf_(g1[2]) * u1[2], siluf_(g1[3]) * u1[3], hi, true);
                *(u32x2*)(base + (size_t)row * 256 + col0) = (u32x2){(unsigned)lo, (unsigned)hi}; }
    }
};
struct EpiDown {
    static constexpr bool KEEPS = false; __device__ __forceinline__ bool keep(const Unit&) const { return false; }
    static constexpr bool PERM = true, STAGES = true;
    bf16_t* O; const unsigned* list; bf16_t* Hs;
    __device__ __forceinline__ void stage(const Unit& u, LAS unsigned* dst_wave, int entry) const {
        if (u.e0 != 64) __builtin_amdgcn_global_load_lds(list + (size_t)u.e0 * NT + u.e2 + entry, dst_wave, 4, 0, 0);
    }
    __device__ __forceinline__ void operator()(const f32x4 (&acc)[2][2][4][2], const Unit& u, int wr, int wc, int fr, int fq, const LAS unsigned* tab) const {
        const int row0 = launder(wr * 64 + fr), col0 = u.e1 * 256 + wc * 32 + 8 * fq;
#pragma unroll
        for (int ai = 0; ai < 2; ++ai)
#pragma unroll
            for (int m = 0; m < 4; ++m) { const int row = row0 + ai * 128 + m * 16; long dq;
                if (u.e0 == 64) dq = (long)(u.e3 * 256 + row);
                else { dq = -1; if (u.e2 + row < u.e4) dq = (long)tab[row]; }
                if (dq >= 0) {
                    if (u.e0 == 64) { bf16_t* rowp = Hs + (size_t)dq * 1024 + col0;
#pragma unroll
                        for (int bj = 0; bj < 2; ++bj) { const f32x4 v0 = acc[ai][bj][m][0] * 0.0078125f, v1 = acc[ai][bj][m][1] * 0.0078125f;
                            u32x4 w; w.x = pk2(v0[0], v0[1]); w.y = pk2(v0[2], v0[3]); w.z = pk2(v1[0], v1[1]); w.w = pk2(v1[2], v1[3]);
                            *(u32x4*)(rowp + bj * 128) = w; } }
                    else { unsigned char* rowp = (unsigned char*)O + (size_t)dq * 1024 + col0;
#pragma unroll
                        for (int bj = 0; bj < 2; ++bj) { const f32x4 v0 = acc[ai][bj][m][0] * 0.0078125f, v1 = acc[ai][bj][m][1] * 0.0078125f;
                            int lo = 0, hi = 0;
                            lo = __builtin_amdgcn_cvt_pk_fp8_f32(v0[0], v0[1], lo, false); lo = __builtin_amdgcn_cvt_pk_fp8_f32(v0[2], v0[3], lo, true);
                            hi = __builtin_amdgcn_cvt_pk_fp8_f32(v1[0], v1[1], hi, false); hi = __builtin_amdgcn_cvt_pk_fp8_f32(v1[2], v1[3], hi, true);
                            *(u32x2*)(rowp + bj * 128) = (u32x2){(unsigned)lo, (unsigned)hi}; } } }
                asm volatile("" ::: "memory"); }
    }
};

struct Params {
    const float* in[26];
    float* out; unsigned char* ws;
    int ph_lo, ph_hi, li, pad;
};
enum { I_X = 0, I_C, I_CTX, I_CCTX, I_WADA, I_BADA, I_NMG, I_NFG, I_WIN, I_CMLNG, I_CMLNB, I_CMWS, I_CMBS, I_RPB, I_DECAY, I_WBR, I_WOUT, I_RW, I_RB,
       I_EG, I_EU, I_ED, I_SG, I_SU, I_SD, I_FG };

__device__ __forceinline__ const float* kin(int i) {
    unsigned off = (unsigned)i * 8u; asm volatile("" : "+s"(off));
    const __attribute__((address_space(4))) char* ka = (const __attribute__((address_space(4))) char*)__builtin_amdgcn_kernarg_segment_ptr();
    return (const float*)*(GAS const float* const __attribute__((address_space(4)))*)(ka + off);
}
__device__ __forceinline__ float* kout_ptr() { unsigned off = 208u; asm volatile("" : "+s"(off));
    const __attribute__((address_space(4))) char* ka = (const __attribute__((address_space(4))) char*)__builtin_amdgcn_kernarg_segment_ptr();
    return (float*)*(GAS float* const __attribute__((address_space(4)))*)(ka + off); }
__device__ __forceinline__ unsigned char* kws_ptr() { unsigned off = 216u; asm volatile("" : "+s"(off));
    const __attribute__((address_space(4))) char* ka = (const __attribute__((address_space(4))) char*)__builtin_amdgcn_kernarg_segment_ptr();
    return (unsigned char*)*(GAS unsigned char* const __attribute__((address_space(4)))*)(ka + off); }
static_assert(__builtin_offsetof(Params, out) == 208 && __builtin_offsetof(Params, ws) == 216, "kernarg offsets");
static_assert(__builtin_offsetof(Params, in) == 0, "kin() reads Params::in at kernarg offset 0");
__device__ __forceinline__ void transpose_item(const float* W, int N, bf16_t* WT, int ldk, int extra, LAS float* scr, int kb, int nb, int lane) {
    const int k0 = 64 * kb, n0 = 32 * nb;
    float wv[32];
#pragma unroll
    for (int i = 0; i < 32; ++i) wv[i] = W[(size_t)(k0 + 2 * i + (lane >> 5)) * N + n0 + (lane & 31)];
#pragma unroll
    for (int i = 0; i < 32; ++i) scr[(2 * i + (lane >> 5)) * 33 + (lane & 31)] = wv[i];
    LDS_WAIT(); asm volatile("" ::: "memory");
    const int c = lane & 7;
#pragma unroll
    for (int j = 0; j < 4; ++j) { const int n = (lane >> 3) + 8 * j; const LAS float* s = scr + (8 * c) * 33 + n;
        u32x4 o; o.x = pk2(s[0 * 33], s[1 * 33]); o.y = pk2(s[2 * 33], s[3 * 33]); o.z = pk2(s[4 * 33], s[5 * 33]); o.w = pk2(s[6 * 33], s[7 * 33]);
        *(u32x4*)(WT + (size_t)(n0 + n + extra) * ldk + k0 + 8 * c) = o; }
    LDS_WAIT(); asm volatile("" ::: "memory");
}
__device__ __forceinline__ void transpose_item_f8(const float* W, int N, unsigned char* WT, int ldk, int extra, float scale, LAS float* scr, int kb, int nb, int lane) {
    const int k0 = 64 * kb, n0 = 32 * nb;
    float wv[32];
#pragma unroll
    for (int i = 0; i < 32; ++i) wv[i] = W[(size_t)(k0 + 2 * i + (lane >> 5)) * N + n0 + (lane & 31)];
#pragma unroll
    for (int i = 0; i < 32; ++i) scr[(2 * i + (lane >> 5)) * 33 + (lane & 31)] = wv[i];
    LDS_WAIT(); asm volatile("" ::: "memory");
    const int c = lane & 7;
#pragma unroll
    for (int j = 0; j < 4; ++j) { const int n = (lane >> 3) + 8 * j; const LAS float* s = scr + (8 * c) * 33 + n;
        int lo = 0, hi = 0;
        lo = __builtin_amdgcn_cvt_pk_fp8_f32(s[0 * 33] * scale, s[1 * 33] * scale, lo, false); lo = __builtin_amdgcn_cvt_pk_fp8_f32(s[2 * 33] * scale, s[3 * 33] * scale, lo, true);
        hi = __builtin_amdgcn_cvt_pk_fp8_f32(s[4 * 33] * scale, s[5 * 33] * scale, hi, false); hi = __builtin_amdgcn_cvt_pk_fp8_f32(s[6 * 33] * scale, s[7 * 33] * scale, hi, true);
        *(u32x2*)(WT + (size_t)(n0 + n + extra) * ldk + k0 + 8 * c) = (u32x2){(unsigned)lo, (unsigned)hi}; }
    LDS_WAIT(); asm volatile("" ::: "memory");
}
constexpr int IT_IN = 16 * 224, IT_BR = 3 * 8 * 32, IT_OUT = 16 * 32, IT_SG = 16 * 8, IT_SD = 4 * 32, IT_RT = 16 * 2, IT_CM = 128;
constexpr int MISC_ITEMS = IT_IN + IT_BR + IT_OUT + 2 * IT_SG + IT_SD + IT_RT + IT_CM;
__device__ __forceinline__ void misc_item(const Params& p, int l, int r, LAS float* scr, int lane) {
    unsigned char* wm = p.ws + WS_WM + (size_t)l * WM_STRIDE;
    if (r < IT_IN) { transpose_item(kin(I_WIN) + (size_t)l * 1024 * 7168, 7168, (bf16_t*)(wm + WM_IN), 1024, 0, scr, r / 224, r % 224, lane); return; } r -= IT_IN;
    if (r < IT_BR) { const int i = r / 256, q = r % 256; transpose_item(kin(I_WBR) + ((size_t)l * 3 + i) * 512 * 1024, 1024, (bf16_t*)(wm + WM_BR) + (size_t)i * 1024 * 512, 512, 0, scr, q / 32, q % 32, lane); return; } r -= IT_BR;
    if (r < IT_OUT) { transpose_item(kin(I_WOUT) + (size_t)l * 1024 * 1024, 1024, (bf16_t*)(wm + WM_OUT), 1024, 0, scr, r / 32, r % 32, lane); return; } r -= IT_OUT;
    if (r < 2 * IT_SG) { const int up = r / IT_SG, q = r % IT_SG, nb = q % 8;
        transpose_item_f8(kin(up ? I_SU : I_SG) + (size_t)l * 1024 * 256, 256, (unsigned char*)(wm + WM_SGU), 1024, ((32 * nb) / 128) * 128 + up * 128, 32.0f, scr, q / 8, nb, lane); return; } r -= 2 * IT_SG;
    if (r < IT_SD) { transpose_item_f8(kin(I_SD) + (size_t)l * 256 * 1024, 1024, (unsigned char*)(wm + WM_SD), 256, 0, 16.0f, scr, r / 32, r % 32, lane); return; } r -= IT_SD;
    if (r < IT_RT) { transpose_item(kin(I_RW) + (size_t)l * 1024 * 64, 64, (bf16_t*)(wm + WM_RT), 1024, 0, scr, r / 2, r % 2, lane); return; } r -= IT_RT;
    { const float* src = kin(I_CMWS) + (size_t)l * 65536 + (size_t)r * 512 + lane * 8; const f32x4 a = *(const f32x4*)src, b = *(const f32x4*)(src + 4);
      u32x4 o; o.x = pk2(a[0], a[1]); o.y = pk2(a[2], a[3]); o.z = pk2(b[0], b[1]); o.w = pk2(b[2], b[3]);
      *(u32x4*)((bf16_t*)(wm + WM_CM) + (size_t)r * 512 + lane * 8) = o; }
}
constexpr int EXP_ITEMS = 3 * 64 * 128;
constexpr int FILL_SPLIT = 34000;
__device__ __forceinline__ void expert_item(const Params& p, int l, int r, LAS float* scr, int lane) {
    unsigned char* we = p.ws + WS_WE + (size_t)l * WE_LAYER;
    const int which = r / 8192, q = r % 8192, e = q / 128, it = q % 128;
    if (which < 2) { const int kb = it / 8, nb = it % 8;
        transpose_item_f8(kin(which ? I_EU : I_EG) + ((size_t)l * 64 + e) * 1024 * 256, 256, (unsigned char*)(we + WE_GU) + (size_t)e * 512 * 1024, 1024, ((32 * nb) / 128) * 128 + which * 128, 32.0f, scr, kb, nb, lane); }
    else { const int kb = it / 32, nb = it % 32;
        transpose_item_f8(kin(I_ED) + ((size_t)l * 64 + e) * 256 * 1024, 1024, (unsigned char*)(we + WE_D) + (size_t)e * 1024 * 256, 256, 0, 16.0f, scr, kb, nb, lane); }
}
__device__ __forceinline__ void mod_unit(const Params& p, LAS unsigned char* lds, int u, int tid) {
    const int l = u / 96, cb = u % 96, wave = __builtin_amdgcn_readfirstlane(tid >> 6), lane = tid & 63;
    LAS float* sil = (LAS float*)lds;
    LAS float* part = (LAS float*)(lds + 36864);
    for (int idx = tid; idx < 9 * 1024; idx += NTHREADS) { const int r = idx >> 10, k = idx & 1023; const float v = r < 8 ? kin(I_C)[r * 1024 + k] : kin(I_CCTX)[k]; sil[idx] = v / (1.0f + expf(-v)); }
    __syncthreads();
    float acc[9];
#pragma unroll
    for (int r = 0; r < 9; ++r) acc[r] = 0.f;
    const float* wp = kin(I_WADA) + ((size_t)l * 1024 + wave * 128) * 6144 + cb * 64 + lane;
#pragma unroll 4
    for (int k = 0; k < 128; ++k) { const float wv = wp[(size_t)k * 6144];
#pragma unroll
        for (int r = 0; r < 9; ++r) acc[r] += sil[r * 1024 + wave * 128 + k] * wv; }
#pragma unroll
    for (int r = 0; r < 9; ++r) part[(wave * 9 + r) * 64 + lane] = acc[r];
    __syncthreads();
    for (int idx = tid; idx < 576; idx += NTHREADS) { const int r = idx >> 6, ln = idx & 63; float s = kin(I_BADA)[l * 6144 + cb * 64 + ln];
#pragma unroll
        for (int w = 0; w < 8; ++w) s += part[(w * 9 + r) * 64 + ln];
        ((float*)(p.ws + WS_MOD))[((size_t)l * 9 + r) * 6144 + cb * 64 + ln] = s; }
    __syncthreads();
}

__device__ __forceinline__ void norm_mod_vals(const f32x4 (&v)[4], const float* g, const float* sh, const float* sc, bf16_t* orow, bool to_lds, LAS unsigned char* ldst, int lane) {
    float ss = 0.f;
#pragma unroll
    for (int j = 0; j < 4; ++j) ss += (v[j][0] * v[j][0] + v[j][1] * v[j][1]) + (v[j][2] * v[j][2] + v[j][3] * v[j][3]);
    const float rstd = rsqrtf(wave_sum(ss, lane) * (1.0f / 1024.0f) + EPS);
#pragma unroll
    for (int j = 0; j < 4; ++j) { const f32x4 gg = ((const f32x4*)g)[64 * j + lane], s_h = ((const f32x4*)sh)[64 * j + lane], s_c = ((const f32x4*)sc)[64 * j + lane];
        const f32x4 y = v[j] * rstd * gg * (s_c + 1.0f) + s_h;
        u32x2 o; o.x = pk2(y[0], y[1]); o.y = pk2(y[2], y[3]);
        ((u32x2*)orow)[64 * j + lane] = o;
        if (to_lds) *(LAS u32x2*)(ldst + (64 * j + lane) * 8) = o; }
}
__device__ __forceinline__ void norm_mod_row(const float* xrow, const float* g, const float* sh, const float* sc, bf16_t* orow, bool to_lds, LAS unsigned char* ldst, int lane) {
    f32x4 v[4];
#pragma unroll
    for (int j = 0; j < 4; ++j) v[j] = ((const f32x4*)xrow)[64 * j + lane];
    norm_mod_vals(v, g, sh, sc, orow, to_lds, ldst, lane);
}
__device__ __forceinline__ void combine_row(f32x4 (&v)[4], const float* xrow, const float* ga2, const bf16_t* shrow, const unsigned char* o8, int lane) {
    u32x2 sq[4]; unsigned oq[8][4];
#pragma unroll
    for (int j = 0; j < 4; ++j) { v[j] = ((const f32x4*)xrow)[64 * j + lane]; sq[j] = ((const u32x2*)shrow)[64 * j + lane]; }
#pragma unroll
    for (int k = 0; k < 8; ++k)
#pragma unroll
        for (int j = 0; j < 4; ++j) oq[k][j] = ((const unsigned*)(o8 + (size_t)k * 1024))[64 * j + lane];
#pragma unroll
    for (int j = 0; j < 4; ++j) { f32x4 t = (f32x4){lo16(sq[j].x), hi16(sq[j].x), lo16(sq[j].y), hi16(sq[j].y)};
#pragma unroll
        for (int k = 0; k < 8; ++k) { const int w = (int)oq[k][j];
            t[0] += __builtin_amdgcn_cvt_f32_fp8(w, 0); t[1] += __builtin_amdgcn_cvt_f32_fp8(w, 1); t[2] += __builtin_amdgcn_cvt_f32_fp8(w, 2); t[3] += __builtin_amdgcn_cvt_f32_fp8(w, 3); }
        v[j] += ((const f32x4*)ga2)[64 * j + lane] * t; }
}

constexpr int RT_TILE = 0, RT_PITCH = 2064, RT_LG = 64 * RT_PITCH  , RT_BIAS = RT_LG + 64 * 65 * 4  , RT_LCNT = RT_BIAS + 256, RT_LBASE = RT_LCNT + 256,
              RT_SELE = RT_LBASE + 256  , RT_SELW = RT_SELE + 2048, RT_SELR = RT_SELW + 2048, RT_END = RT_SELR + 2048;
static_assert(RT_END <= LDS_BYTES, "router LDS");
#ifdef TIMING
#define RSTAMP(k) do { if (stamp && tid == 0) ((volatile LAS unsigned long long*)(lds + LDS_BYTES - 16 - 512))[24 + (k)] = __builtin_amdgcn_s_memrealtime(); } while (0)
#else
#define RSTAMP(k) do { } while (0)
#endif
__device__ __forceinline__ void router_unit(const Params& p, LAS unsigned char* lds, int l, int u, const float* xl, const float* xc, int tid, bool commit, bool stamp = false) {
    const int wave = __builtin_amdgcn_readfirstlane(tid >> 6), lane = tid & 63, g4 = lane >> 4, row0 = u * 64;
    const bool lat = row0 < NL;
    const float* mr = (const float*)(p.ws + WS_MOD) + (size_t)l * 9 * 6144 + (size_t)(lat ? (row0 >> 11) : 8) * 6144;
    const float* xbase = lat ? xl + (size_t)row0 * D : xc + (size_t)(row0 - NL) * D;
    unsigned char* H2 = (unsigned char*)(p.ws + WS_H) + (size_t)row0 * D;
    LAS float* lg = (LAS float*)(lds + RT_LG); LAS float* bias = (LAS float*)(lds + RT_BIAS);
    LAS int* lcnt = (LAS int*)(lds + RT_LCNT); LAS int* lbase = (LAS int*)(lds + RT_LBASE);
    LAS int* sele = (LAS int*)(lds + RT_SELE); LAS float* selw = (LAS float*)(lds + RT_SELW); LAS int* selr = (LAS int*)(lds + RT_SELR);
    RSTAMP(0);
    if (tid < 64) { lcnt[tid] = 0; bias[tid] = kin(I_RB)[l * 64 + tid]; }
    const int rb = wave >> 1, eb0 = (wave & 1) * 2;
    const bf16_t* w0 = launder_vp((const bf16_t*)(p.ws + WS_WM + (size_t)l * WM_STRIDE + WM_RT) + (size_t)(eb0 * 16 + (lane & 15)) * 1024 + g4 * 8); const bf16_t* w1 = launder_vp(w0 + 16 * 1024);
    bf16x8 qa0[4], qa1[4];
#pragma unroll
    for (int ks = 0; ks < 4; ++ks) { qa0[ks] = *(const bf16x8*)(w0 + ks * 32); qa1[ks] = *(const bf16x8*)(w1 + ks * 32); }
    { f32x4 gg[4], s_h[4], s_c[4];
#pragma unroll
      for (int j = 0; j < 4; ++j) { gg[j] = ((const f32x4*)(kin(I_NFG) + l * 1024))[64 * j + lane]; s_h[j] = ((const f32x4*)(mr + 3072))[64 * j + lane]; s_c[j] = ((const f32x4*)(mr + 4096))[64 * j + lane] + 1.0f; }
#pragma unroll
      for (int hb = 0; hb < 2; ++hb) { f32x4 v[4][4];
#pragma unroll
          for (int i = 0; i < 4; ++i)
#pragma unroll
              for (int j = 0; j < 4; ++j) v[i][j] = ((const f32x4*)(xbase + (size_t)(wave * 8 + hb * 4 + i) * D))[64 * j + lane];
#pragma unroll
          for (int i = 0; i < 4; ++i) { const int rl = wave * 8 + hb * 4 + i; float ss = 0.f;
#pragma unroll
              for (int j = 0; j < 4; ++j) ss += (v[i][j][0] * v[i][j][0] + v[i][j][1] * v[i][j][1]) + (v[i][j][2] * v[i][j][2] + v[i][j][3] * v[i][j][3]);
              const float rstd = rsqrtf(wave_sum(ss, lane) * (1.0f / 1024.0f) + EPS);
#pragma unroll
              for (int j = 0; j < 4; ++j) { const f32x4 y = v[i][j] * rstd * gg[j] * s_c[j] + s_h[j];
                  u32x2 o; o.x = pk2(y[0], y[1]); o.y = pk2(y[2], y[3]);
                  int q8 = 0; q8 = __builtin_amdgcn_cvt_pk_fp8_f32(y[0], y[1], q8, false); q8 = __builtin_amdgcn_cvt_pk_fp8_f32(y[2], y[3], q8, true);
                  ((unsigned*)(H2 + (size_t)rl * D))[64 * j + lane] = (unsigned)q8; *(LAS u32x2*)(lds + RT_TILE + rl * RT_PITCH + (64 * j + lane) * 8) = o; } } } }
    __syncthreads();
    RSTAMP(1);
    { f32x4 a0 = (f32x4){0.f, 0.f, 0.f, 0.f}, a1 = a0;
      const LAS unsigned char* hrow = lds + RT_TILE + (rb * 16 + (lane & 15)) * RT_PITCH + g4 * 16;
      bf16x8 qb0[4], qb1[4];
      sfor<0, 4>([&](auto it_) { constexpr int it = decltype(it_)::value;
#pragma unroll
          for (int ks = 0; ks < 4; ++ks) { qb0[ks] = *(const bf16x8*)(w0 + ((2 * it + 1) * 4 + ks) * 32); qb1[ks] = *(const bf16x8*)(w1 + ((2 * it + 1) * 4 + ks) * 32); }
#pragma unroll
          for (int ks = 0; ks < 4; ++ks) { const bf16x8 bq = *(const LAS bf16x8*)(hrow + ((2 * it) * 4 + ks) * 64); a0 = mfma16(qa0[ks], bq, a0); a1 = mfma16(qa1[ks], bq, a1); }
          if constexpr (it < 3) {
#pragma unroll
              for (int ks = 0; ks < 4; ++ks) { qa0[ks] = *(const bf16x8*)(w0 + ((2 * it + 2) * 4 + ks) * 32); qa1[ks] = *(const bf16x8*)(w1 + ((2 * it + 2) * 4 + ks) * 32); } }
#pragma unroll
          for (int ks = 0; ks < 4; ++ks) { const bf16x8 bq = *(const LAS bf16x8*)(hrow + ((2 * it + 1) * 4 + ks) * 64); a0 = mfma16(qb0[ks], bq, a0); a1 = mfma16(qb1[ks], bq, a1); } });
      const int rr = rb * 16 + (lane & 15);
#pragma unroll
      for (int r = 0; r < 4; ++r) { lg[rr * 65 + eb0 * 16 + 4 * g4 + r] = sigmoidf_(a0[r]); lg[rr * 65 + (eb0 + 1) * 16 + 4 * g4 + r] = sigmoidf_(a1[r]); } }
    __syncthreads();
    RSTAMP(2);
    { const int row = tid >> 3, g = tid & 7;
      float sv[8]; unsigned key[8];
#pragma unroll
      for (int j = 0; j < 8; ++j) { sv[j] = lg[row * 65 + 8 * g + j]; const unsigned ub = __float_as_uint(sv[j] + bias[8 * g + j]);
          key[j] = ((ub ^ ((ub >> 31) ? 0xffffffffu : 0x80000000u)) & ~63u) | (unsigned)(63 - (8 * g + j)); }
      float m1 = -3e38f, m2 = -3e38f;
#pragma unroll
      for (int j = 0; j < 8; ++j) { const float c = sv[j] + bias[8 * g + j]; if (c > m1) { m2 = m1; m1 = c; } else if (c > m2) m2 = c; }
      const unsigned ug = __float_as_uint(m1 + m2); const unsigned gkey = ((ug ^ ((ug >> 31) ? 0xffffffffu : 0x80000000u)) & ~7u) | (unsigned)(7 - g);
      int grank = 0;
      sfor<1, 8>([&](auto d_) { constexpr int d = decltype(d_)::value; grank += (int)((unsigned)shxi((int)gkey, d, lane) > gkey); });
      const bool gsel = grank < 4;
#pragma unroll
      for (int j = 0; j < 8; ++j) if (!gsel) key[j] = (unsigned)(63 - (8 * g + j));
      int rk[8];
#pragma unroll
      for (int j = 0; j < 8; ++j) { int r = 0;
#pragma unroll
          for (int j2 = 0; j2 < 8; ++j2) r += (int)(key[j2] > key[j]);
          rk[j] = r; }
      sfor<1, 8>([&](auto d_) { constexpr int d = decltype(d_)::value;
          sfor<0, 8>([&](auto j2_) { constexpr int j2 = decltype(j2_)::value; const unsigned ok = (unsigned)shxi((int)key[j2], d, lane);
#pragma unroll
              for (int j = 0; j < 8; ++j) rk[j] += (int)(ok > key[j]); });
          __builtin_amdgcn_sched_barrier(0); });
      float wsum = 0.f;
#pragma unroll
      for (int j = 0; j < 8; ++j) if (gsel && rk[j] < 8) wsum += sv[j];
      wsum += shx(wsum, 1, lane); wsum += shx(wsum, 2, lane); wsum += shx(wsum, 4, lane);
      const float sc = 2.5f / wsum;
#pragma unroll
      for (int j = 0; j < 8; ++j) if (gsel && rk[j] < 8) { const int e = 8 * g + j, k = rk[j];
          sele[row * 8 + k] = e; selw[row * 8 + k] = sv[j] * sc; selr[row * 8 + k] = __hip_atomic_fetch_add(&lcnt[e], 1, __ATOMIC_RELAXED, __HIP_MEMORY_SCOPE_WORKGROUP); } }
    __syncthreads();
    RSTAMP(3);
    if (tid < 64) { const int n = lcnt[tid]; int base = 0; if (n > 0 && commit) base = (int)atomicAdd((unsigned*)(p.ws + WS_CTL) + CW_CNT + l * 2048 + tid * 16, (unsigned)n); lbase[tid] = base; }
    __syncthreads();
    RSTAMP(4);
    { const int rl = tid >> 3, k = tid & 7, e = sele[rl * 8 + k], pos = lbase[e] + selr[rl * 8 + k];
      if (commit) { ((unsigned*)(p.ws + WS_LIST))[(size_t)e * NT + pos] = (unsigned)((row0 + rl) * 8 + k); ((float*)(p.ws + WS_WL))[(size_t)e * NT + pos] = selw[rl * 8 + k]; } }
    __syncthreads();
    RSTAMP(5);
}

__device__ __forceinline__ void mixA_unit(const Params& p, LAS unsigned char* lds, int l, int ch, int g, int tid) {
    const int wave = __builtin_amdgcn_readfirstlane(tid >> 6), lane = tid & 63, g4 = lane >> 4, rows0 = ch * 128;
    const bf16_t* Z = (const bf16_t*)(p.ws + WS_R + R_Z); bf16_t* BR = (bf16_t*)(p.ws + WS_R + R_BR);
    const bf16_t* WCM = (const bf16_t*)(p.ws + WS_WM + (size_t)l * WM_STRIDE + WM_CM);
    LAS unsigned char* vn = lds + 1024;
    { const int q = tid >> 2, cs = (tid & 3) * 32; const f32x2 st2 = *(const f32x2*)((const float*)(p.ws + WS_R + R_STAT) + (size_t)(rows0 + q) * 2); const float mean = st2[0], rstd = st2[1];
      const float* lg = kin(I_CMLNG) + l * 512 + g * 128 + cs; const float* lb = kin(I_CMLNB) + l * 512 + g * 128 + cs;
#pragma unroll
      for (int j = 0; j < 4; ++j) { const u32x4 v = *(const u32x4*)(Z + (size_t)(rows0 + q) * ZW + ZC_AV + g * 128 + cs + 8 * j);
          const f32x4 ga = *(const f32x4*)(lg + 8 * j), gb = *(const f32x4*)(lg + 8 * j + 4), ba = *(const f32x4*)(lb + 8 * j), bb = *(const f32x4*)(lb + 8 * j + 4);
          u32x4 o;
          o.x = pk2((geluf_(lo16(v.x)) - mean) * rstd * ga[0] + ba[0], (geluf_(hi16(v.x)) - mean) * rstd * ga[1] + ba[1]);
          o.y = pk2((geluf_(lo16(v.y)) - mean) * rstd * ga[2] + ba[2], (geluf_(hi16(v.y)) - mean) * rstd * ga[3] + ba[3]);
          o.z = pk2((geluf_(lo16(v.z)) - mean) * rstd * gb[0] + bb[0], (geluf_(hi16(v.z)) - mean) * rstd * gb[1] + bb[1]);
          o.w = pk2((geluf_(lo16(v.w)) - mean) * rstd * gb[2] + bb[2], (geluf_(hi16(v.w)) - mean) * rstd * gb[3] + bb[3]);
          *(LAS u32x4*)(vn + q * 272 + (cs + 8 * j) * 2) = o; } }
    __syncthreads();
    { const int pb = wave, pp = pb * 16 + (lane & 15);
      bf16x8 bfr[4];
#pragma unroll
      for (int ks = 0; ks < 4; ++ks) bfr[ks] = *(const bf16x8*)(WCM + (size_t)(g * 128 + pp) * 128 + 32 * ks + 8 * g4);
      const unsigned vna = tr_lane(lds_addr(vn), 272, 8, lane);
      const float bs = kin(I_CMBS)[l * 512 + g * 128 + pp];
      const size_t row = (size_t)(rows0 + pp);
      sfor<0, 2>([&](auto cg_) { constexpr int cg = decltype(cg_)::value; f32x4 acc[4];
#pragma unroll
          for (int i = 0; i < 4; ++i) acc[i] = (f32x4){0.f, 0.f, 0.f, 0.f};
          sfor<0, 4>([&](auto ks_) { constexpr int ks = decltype(ks_)::value; bf16x8 af[4]; tr_frag4_i<32 * ks * 272 + 128 * cg, 4 * 272>(vna, af);
#pragma unroll
              for (int i = 0; i < 4; ++i) acc[i] = mfma16(af[i], bfr[ks], acc[i]); });
#pragma unroll
          for (int i = 0; i < 4; ++i) { const int c = 16 * (4 * cg + i) + 4 * g4;
          const u32x2 uu = *(const u32x2*)(Z + row * ZW + ZC_AU + g * 128 + c);
          u32x2 o; o.x = pk2(geluf_(lo16(uu.x)) * (acc[i][0] + bs), geluf_(hi16(uu.x)) * (acc[i][1] + bs)); o.y = pk2(geluf_(lo16(uu.y)) * (acc[i][2] + bs), geluf_(hi16(uu.y)) * (acc[i][3] + bs));
          *(u32x2*)(BR + row * BRW + g * 128 + c) = o; } }); }
    __syncthreads();
}

__device__ __forceinline__ void ret_stage_qk(const bf16_t* src  , const float* rope, bool do_rope, int tpos0, int mask  , LAS unsigned char* t0, LAS unsigned char* t1, LAS unsigned char* t2,
                                             float sc0, float l2a, float offa, float siga, float l2b, float offb, float sigb, int tid) {
    const int pp = tid >> 2, half = (tid >> 1) & 1, sub = tid & 1;
    const bf16_t* s = src + (size_t)pp * ZW + 32 * half + 8 * sub;
    const u32x4 a = *(const u32x4*)s, b = *(const u32x4*)(s + 16);
    float x1[8] = {lo16(a.x), hi16(a.x), lo16(a.y), hi16(a.y), lo16(a.z), hi16(a.z), lo16(a.w), hi16(a.w)};
    float x2[8] = {lo16(b.x), hi16(b.x), lo16(b.y), hi16(b.y), lo16(b.z), hi16(b.z), lo16(b.w), hi16(b.w)};
    float o1[8], o2[8];
    if (do_rope) { const int t = tpos0 + pp, pos = half ? (t & 63) : (t >> 6); const f32x4* tb = (const f32x4*)(rope + (size_t)(pos * 16 + 8 * sub) * 2);
#pragma unroll
        for (int j = 0; j < 4; ++j) { const f32x4 cs = tb[j];
            o1[2 * j] = x1[2 * j] * cs[0] - x2[2 * j] * cs[1]; o2[2 * j] = x1[2 * j] * cs[1] + x2[2 * j] * cs[0];
            o1[2 * j + 1] = x1[2 * j + 1] * cs[2] - x2[2 * j + 1] * cs[3]; o2[2 * j + 1] = x1[2 * j + 1] * cs[3] + x2[2 * j + 1] * cs[2]; } }
    else {
#pragma unroll
        for (int j = 0; j < 8; ++j) { o1[j] = x1[j]; o2[j] = x2[j]; } }
    const int off = pp * 144 + (32 * half + 8 * sub) * 2;
    const float fp = (float)pp;
    const float sA = sc0 * __builtin_amdgcn_exp2f((offa + siga * fp) * l2a), sB = sc0 * __builtin_amdgcn_exp2f((offb + sigb * fp) * l2b);
    if (mask & 1) { u32x4 w; w.x = pk2(o1[0] * sc0, o1[1] * sc0); w.y = pk2(o1[2] * sc0, o1[3] * sc0); w.z = pk2(o1[4] * sc0, o1[5] * sc0); w.w = pk2(o1[6] * sc0, o1[7] * sc0); *(LAS u32x4*)(t0 + off) = w;
              w.x = pk2(o2[0] * sc0, o2[1] * sc0); w.y = pk2(o2[2] * sc0, o2[3] * sc0); w.z = pk2(o2[4] * sc0, o2[5] * sc0); w.w = pk2(o2[6] * sc0, o2[7] * sc0); *(LAS u32x4*)(t0 + off + 32) = w; }
    if (mask & 2) { u32x4 w; w.x = pk2(o1[0] * sA, o1[1] * sA); w.y = pk2(o1[2] * sA, o1[3] * sA); w.z = pk2(o1[4] * sA, o1[5] * sA); w.w = pk2(o1[6] * sA, o1[7] * sA); *(LAS u32x4*)(t1 + off) = w;
              w.x = pk2(o2[0] * sA, o2[1] * sA); w.y = pk2(o2[2] * sA, o2[3] * sA); w.z = pk2(o2[4] * sA, o2[5] * sA); w.w = pk2(o2[6] * sA, o2[7] * sA); *(LAS u32x4*)(t1 + off + 32) = w; }
    if (mask & 4) { u32x4 w; w.x = pk2(o1[0] * sB, o1[1] * sB); w.y = pk2(o1[2] * sB, o1[3] * sB); w.z = pk2(o1[4] * sB, o1[5] * sB); w.w = pk2(o1[6] * sB, o1[7] * sB); *(LAS u32x4*)(t2 + off) = w;
              w.x = pk2(o2[0] * sB, o2[1] * sB); w.y = pk2(o2[2] * sB, o2[3] * sB); w.z = pk2(o2[4] * sB, o2[5] * sB); w.w = pk2(o2[6] * sB, o2[7] * sB); *(LAS u32x4*)(t2 + off + 32) = w; }
}
__device__ __forceinline__ void ret_stage_v(const bf16_t* src  , LAS unsigned char* tv, int tid) {
    const int pp = tid >> 2, seg = (tid & 3) * 32;
#pragma unroll
    for (int j = 0; j < 4; ++j) *(LAS u32x4*)(tv + pp * 272 + (seg + 8 * j) * 2) = *(const u32x4*)(src + (size_t)pp * ZW + seg + 8 * j);
}
__device__ __forceinline__ float log2_gamma(const Params& p, int l, int dir, int h) { const float x = kin(I_DECAY)[(l * 2 + dir) * 4 + h]; return -log2f(1.0f + expf(-x)); }
__device__ __forceinline__ int ret_row0(int b, int cc) { return cc < 2 ? NL + b * 256 + cc * 128 : b * 2048 + (cc - 2) * 128; }

__device__ __forceinline__ void retkv_unit(const Params& p, LAS unsigned char* lds, int l, int b, int h, int cc, int tid) {
    const int wave = __builtin_amdgcn_readfirstlane(tid >> 6), lane = tid & 63, g4 = lane >> 4, row0 = ret_row0(b, cc);
    const bf16_t* Z = (const bf16_t*)(p.ws + WS_R + R_Z); float* KV = (float*)(p.ws + WS_R + R_KV);
    const float l2f = log2_gamma(p, l, 0, h), l2b = log2_gamma(p, l, 1, h);
    LAS unsigned char* kf = lds; LAS unsigned char* kb = lds + 18432; LAS unsigned char* vv = lds + 36864;
    ret_stage_qk(Z + (size_t)row0 * ZW + ZC_RK + h * 64, (const float*)(p.ws + WS_ROPE), cc >= 2, (cc - 2) * 128, 6, kf, kf, kb, 0.125f, l2f, 127.f, -1.f, l2b, 0.f, 1.f, tid);
    ret_stage_v(Z + (size_t)row0 * ZW + ZC_RV + h * 128, vv, tid);
    __syncthreads();
    { const int dir = wave >> 2, db = wave & 3; const unsigned ka = tr_lane(lds_addr(dir ? kb : kf), 144, 8, lane) + 32 * db, va = tr_lane(lds_addr(vv), 272, 8, lane);
      bf16x8 afr[4];
      sfor<0, 4>([&](auto ks_) { constexpr int ks = decltype(ks_)::value; afr[ks] = tr_frag_i<32 * ks * 144, 32 * ks * 144 + 4 * 144>(ka); });
      float* dst = KV + ((((size_t)b * 4 + h) * NCHUNK + cc) * 2 + dir) * 8192;
      sfor<0, 2>([&](auto eg_) { constexpr int eg = decltype(eg_)::value; f32x4 acc[4];
#pragma unroll
          for (int i = 0; i < 4; ++i) acc[i] = (f32x4){0.f, 0.f, 0.f, 0.f};
          sfor<0, 4>([&](auto ks_) { constexpr int ks = decltype(ks_)::value; bf16x8 bf[4]; tr_frag4_i<32 * ks * 272 + 128 * eg, 4 * 272>(va, bf);
#pragma unroll
              for (int i = 0; i < 4; ++i) acc[i] = mfma16(afr[ks], bf[i], acc[i]); });
#pragma unroll
          for (int i = 0; i < 4; ++i)
#pragma unroll
              for (int r = 0; r < 4; ++r) dst[(16 * db + 4 * g4 + r) * 128 + 16 * (4 * eg + i) + (lane & 15)] = acc[i][r]; }); }
    __syncthreads();
}

__device__ __forceinline__ void retout_unit(const Params& p, LAS unsigned char* lds, int l, int b, int h, int cc, int tid) {
    const int wave = __builtin_amdgcn_readfirstlane(tid >> 6), lane = tid & 63, g4 = lane >> 4, row0 = ret_row0(b, cc);
    const bf16_t* Z = (const bf16_t*)(p.ws + WS_R + R_Z); bf16_t* BR = (bf16_t*)(p.ws + WS_R + R_BR);
    const float l2f = log2_gamma(p, l, 0, h), l2b = log2_gamma(p, l, 1, h);
    LAS unsigned char* tq = lds; LAS unsigned char* tqf = lds + 18432; LAS unsigned char* tqb = lds + 36864; LAS unsigned char* tk = lds + 55296;
    LAS unsigned char* tv = lds + 73728; LAS unsigned char* st = lds + 108544;
    { const u32x4* src = (const u32x4*)((const bf16_t*)(p.ws + WS_R + R_ST) + (((size_t)b * 4 + h) * NCHUNK + cc) * 2 * 8192);
#pragma unroll
      for (int j = 0; j < 4; ++j) { const int c = tid + 512 * j; *(LAS u32x4*)(st + (c >> 4) * 272 + (c & 15) * 16) = src[c]; } }
    const float* rope = (const float*)(p.ws + WS_ROPE);
    ret_stage_qk(Z + (size_t)row0 * ZW + ZC_RQ + h * 64, rope, cc >= 2, (cc - 2) * 128, 7, tq, tqf, tqb, 1.0f, l2f, 1.f, 1.f, l2b, 128.f, -1.f, tid);
    ret_stage_qk(Z + (size_t)row0 * ZW + ZC_RK + h * 64, rope, cc >= 2, (cc - 2) * 128, 1, tk, tk, tk, 0.125f, 0.f, 0.f, 0.f, 0.f, 0.f, 0.f, tid);
    ret_stage_v(Z + (size_t)row0 * ZW + ZC_RV + h * 128, tv, tid);
    __syncthreads();
    const int ib = wave, ti = ib * 16 + (lane & 15);
    f32x4 oacc[8];
#pragma unroll
    for (int eb = 0; eb < 8; ++eb) oacc[eb] = (f32x4){0.f, 0.f, 0.f, 0.f};
    { bf16x8 bq[4];
#pragma unroll
      for (int ks = 0; ks < 4; ++ks) bq[ks] = *(const LAS bf16x8*)((ks < 2 ? tqf : tqb) + ti * 144 + (32 * (ks & 1) + 8 * g4) * 2);
      const unsigned sa = tr_lane(lds_addr(st), 272, 8, lane);
      sfor<0, 4>([&](auto ks_) { constexpr int ks = decltype(ks_)::value;
          sfor<0, 2>([&](auto eg_) { constexpr int eg = decltype(eg_)::value; bf16x8 af[4]; tr_frag4_i<32 * ks * 272 + 128 * eg, 4 * 272>(sa, af);
#pragma unroll
              for (int i = 0; i < 4; ++i) oacc[4 * eg + i] = mfma16(af[i], bq[ks], oacc[4 * eg + i]); }); }); }
    { bf16x8 bq[2];
#pragma unroll
      for (int ks = 0; ks < 2; ++ks) bq[ks] = *(const LAS bf16x8*)(tq + ti * 144 + (32 * ks + 8 * g4) * 2);
      f32x4 sacc[8];
#pragma unroll
      for (int jb = 0; jb < 8; ++jb) { sacc[jb] = (f32x4){0.f, 0.f, 0.f, 0.f};
#pragma unroll
          for (int ks = 0; ks < 2; ++ks) { const bf16x8 a = *(const LAS bf16x8*)(tk + (16 * jb + (lane & 15)) * 144 + (32 * ks + 8 * g4) * 2); sacc[jb] = mfma16(a, bq[ks], sacc[jb]); }
#pragma unroll
          for (int r = 0; r < 4; ++r) { const int dist = ti - (16 * jb + 4 * g4 + r);
              sacc[jb][r] *= dist >= 0 ? __builtin_amdgcn_exp2f((float)dist * l2f) : __builtin_amdgcn_exp2f((float)(-dist) * l2b); } }
      const unsigned va = tr_lane(lds_addr(tv), 272, 4, lane);
      sfor<0, 4>([&](auto kk_) { constexpr int kk = decltype(kk_)::value;
          u32x4 pw; pw.x = pk2(sacc[2 * kk][0], sacc[2 * kk][1]); pw.y = pk2(sacc[2 * kk][2], sacc[2 * kk][3]); pw.z = pk2(sacc[2 * kk + 1][0], sacc[2 * kk + 1][1]); pw.w = pk2(sacc[2 * kk + 1][2], sacc[2 * kk + 1][3]);
          const bf16x8 bp = as_frag(pw);
          sfor<0, 2>([&](auto eg_) { constexpr int eg = decltype(eg_)::value; bf16x8 af[4]; tr_frag4_i<32 * kk * 272 + 128 * eg, 16 * 272>(va, af);
#pragma unroll
              for (int i = 0; i < 4; ++i) oacc[4 * eg + i] = mfma16(af[i], bp, oacc[4 * eg + i]); }); }); }
    { float ss = 0.f;
#pragma unroll
      for (int eb = 0; eb < 8; ++eb) ss += (oacc[eb][0] * oacc[eb][0] + oacc[eb][1] * oacc[eb][1]) + (oacc[eb][2] * oacc[eb][2] + oacc[eb][3] * oacc[eb][3]);
      ss += shx(ss, 16, lane); ss += shx(ss, 32, lane);
      const float rstd = rsqrtf(ss * (1.0f / 128.0f) + EPS);
      const size_t row = (size_t)(row0 + ti);
#pragma unroll
      for (int eb = 0; eb < 8; ++eb) { const int e = 16 * eb + 4 * g4; const u32x2 gg = *(const u32x2*)(Z + row * ZW + ZC_RG + h * 128 + e);
          u32x2 o; o.x = pk2(oacc[eb][0] * rstd * siluf_(lo16(gg.x)), oacc[eb][1] * rstd * siluf_(hi16(gg.x))); o.y = pk2(oacc[eb][2] * rstd * siluf_(lo16(gg.y)), oacc[eb][3] * rstd * siluf_(hi16(gg.y)));
          *(u32x2*)(BR + row * BRW + 1024 + h * 128 + e) = o; } }
    __syncthreads();
}

constexpr int NA_V = 0, NA_PITCH = 144, NA_CTXROW = 576, NA_TAB = (576 + 256) * NA_PITCH  , NA_MB = NA_TAB + 2048  , NA_MB_SZ = 18432;
static_assert(NA_MB + NA_MB_SZ <= LDS_BYTES - 1024, "NA LDS");
__device__ __forceinline__ void na_unit(const Params& p, LAS unsigned char* lds, int l, int b, int h, int rp, bool local, int tid) {
    const int wave = __builtin_amdgcn_readfirstlane(tid >> 6), lane = tid & 63, g4 = lane >> 4, qb = wave >> 1, half = wave & 1;
    const bf16_t* Z = (const bf16_t*)(p.ws + WS_R + R_Z); bf16_t* BR = (bf16_t*)(p.ws + WS_R + R_BR);
    LAS unsigned char* vl = lds + NA_V; LAS float* tab = (LAS float*)(lds + NA_TAB);
    const int qc = 16 * qb + (lane & 15);
    const int r0 = 2 * rp, rsA = min(max(r0 - 4, 0), 24), nwr = min(9, 32 - rsA);
    const int kbs = min(max(16 * qb - 8, 0), 32), cst = min(max(qc - 8, 0), 48);
    if (local) {
        for (int key = tid; key < nwr * 64; key += NTHREADS) { const size_t krow = (size_t)b * 2048 + (rsA + (key >> 6)) * 64 + (key & 63);
            const u32x4* vs_ = (const u32x4*)(Z + krow * ZW + ZC_NV + h * 64);
#pragma unroll
            for (int j = 0; j < 8; ++j) *(LAS u32x4*)(vl + key * NA_PITCH + 16 * j) = vs_[j]; }
        if (tid < 465) tab[tid] = kin(I_RPB)[(size_t)(l * 8 + h) * 465 + tid]; }
    { const int key = tid >> 1, hb = (tid & 1) * 4; const u32x4* vs_ = (const u32x4*)(Z + ((size_t)NL + b * 256 + key) * ZW + ZC_NV + h * 64) + hb;
#pragma unroll
      for (int j = 0; j < 4; ++j) *(LAS u32x4*)(vl + (NA_CTXROW + key) * NA_PITCH + 16 * (hb + j)) = vs_[j]; }
    __syncthreads();
    const float L2E = 1.44269504089f;
    const unsigned vla = lds_addr(vl);
    const unsigned lane_off = (unsigned)((4 * g4 + ((lane & 15) >> 2)) * NA_PITCH + (lane & 3) * 8);
#pragma unroll 1
    for (int jr = 0; jr < 2; ++jr) {
        const int r = r0 + jr, rs = min(max(r - 4, 0), 24), wofs = rs - rsA;
        const size_t qrow = local ? (size_t)b * 2048 + r * 64 + qc : (size_t)NL + b * 256 + r * 64 + qc;
        bf16x8 bq[2];
#pragma unroll
        for (int ks = 0; ks < 2; ++ks) bq[ks] = *(const bf16x8*)(Z + qrow * ZW + ZC_NQ + h * 64 + 32 * ks + 8 * g4);
        bf16x8 kf[16];
        if (local) {
#pragma unroll
            for (int blk = 0; blk < 8; ++blk) { const size_t krow = (size_t)b * 2048 + (rs + 4 * half + (blk >> 1)) * 64 + kbs + 16 * (blk & 1) + (lane & 15);
#pragma unroll
                for (int ks = 0; ks < 2; ++ks) kf[blk * 2 + ks] = *(const bf16x8*)(Z + krow * ZW + ZC_NK + h * 64 + 32 * ks + 8 * g4); } }
        f32x4 s[16]; float mx = -1e30f;
        if (local) {
#pragma unroll
            for (int blk = 0; blk < 8; ++blk) { const int i = 4 * half + (blk >> 1), cb = blk & 1;
                f32x4 a = (f32x4){0.f, 0.f, 0.f, 0.f};
#pragma unroll
                for (int ks = 0; ks < 2; ++ks) a = mfma16(kf[blk * 2 + ks], bq[ks], a);
                const int ro = rs + i - r + 7;
#pragma unroll
                for (int rg = 0; rg < 4; ++rg) { const int kc = kbs + 16 * cb + 4 * g4 + rg; const bool valid = kc >= cst && kc < cst + 16;
                    const int co = min(max(kc - qc, -15), 15) + 15;
                    const float bv = tab[ro * 31 + co];
                const float v = valid ? a[rg] * 0.125f + bv : -1e30f; s[blk][rg] = v; mx = fmaxf(mx, v); } }
        } else {
#pragma unroll
            for (int blk = 0; blk < 8; ++blk) s[blk] = (f32x4){-1e30f, -1e30f, -1e30f, -1e30f};
        }
#pragma unroll
        for (int blk = 0; blk < 8; ++blk) { const size_t krow = (size_t)NL + b * 256 + half * 128 + 16 * blk + (lane & 15);
#pragma unroll
            for (int ks = 0; ks < 2; ++ks) kf[blk * 2 + ks] = *(const bf16x8*)(Z + krow * ZW + ZC_NK + h * 64 + 32 * ks + 8 * g4); }
#pragma unroll
        for (int blk = 0; blk < 8; ++blk) { f32x4 a = (f32x4){0.f, 0.f, 0.f, 0.f};
#pragma unroll
            for (int ks = 0; ks < 2; ++ks) a = mfma16(kf[blk * 2 + ks], bq[ks], a);
#pragma unroll
            for (int rg = 0; rg < 4; ++rg) { const float v = a[rg] * 0.125f; s[8 + blk][rg] = v; mx = fmaxf(mx, v); } }
        mx = fmaxf(mx, shx(mx, 16, lane)); mx = fmaxf(mx, shx(mx, 32, lane));
        float ls = 0.f;
#pragma unroll
        for (int blk = 0; blk < 16; ++blk)
#pragma unroll
            for (int rg = 0; rg < 4; ++rg) { const float e = __builtin_amdgcn_exp2f((s[blk][rg] - mx) * L2E); s[blk][rg] = e; ls += e; }
        ls += shx(ls, 16, lane); ls += shx(ls, 32, lane);
        f32x4 oacc[4];
#pragma unroll
        for (int db = 0; db < 4; ++db) oacc[db] = (f32x4){0.f, 0.f, 0.f, 0.f};
        if (local) { const unsigned va = vla + (unsigned)(((wofs + 4 * half) * 64 + kbs) * NA_PITCH) + lane_off;
            sfor<0, 4>([&](auto kk_) { constexpr int kk = decltype(kk_)::value;
                u32x4 pw; pw.x = pk2(s[2 * kk][0], s[2 * kk][1]); pw.y = pk2(s[2 * kk][2], s[2 * kk][3]); pw.z = pk2(s[2 * kk + 1][0], s[2 * kk + 1][1]); pw.w = pk2(s[2 * kk + 1][2], s[2 * kk + 1][3]);
                const bf16x8 bp = as_frag(pw); bf16x8 vf[4]; tr_frag4_i<kk * 64 * NA_PITCH, 16 * NA_PITCH>(va, vf);
#pragma unroll
                for (int db = 0; db < 4; ++db) oacc[db] = mfma16(vf[db], bp, oacc[db]); }); }
        { const unsigned va = vla + (unsigned)((NA_CTXROW + half * 128) * NA_PITCH) + lane_off;
          sfor<0, 4>([&](auto kk_) { constexpr int kk = decltype(kk_)::value;
              u32x4 pw; pw.x = pk2(s[8 + 2 * kk][0], s[8 + 2 * kk][1]); pw.y = pk2(s[8 + 2 * kk][2], s[8 + 2 * kk][3]); pw.z = pk2(s[9 + 2 * kk][0], s[9 + 2 * kk][1]); pw.w = pk2(s[9 + 2 * kk][2], s[9 + 2 * kk][3]);
              const bf16x8 bp = as_frag(pw); bf16x8 vf[4]; tr_frag4_i<kk * 32 * NA_PITCH, 16 * NA_PITCH>(va, vf);
#pragma unroll
              for (int db = 0; db < 4; ++db) oacc[db] = mfma16(vf[db], bp, oacc[db]); }); }
        LAS float* mb = (LAS float*)(lds + NA_MB) + (qb * 64 + lane) * 18;
        if (half == 1) { mb[0] = mx; mb[1] = ls;
#pragma unroll
            for (int db = 0; db < 4; ++db)
#pragma unroll
                for (int rg = 0; rg < 4; ++rg) mb[2 + db * 4 + rg] = oacc[db][rg]; }
        __syncthreads();
        if (half == 0) { const float m1 = mb[0], l1 = mb[1], M = fmaxf(mx, m1), a0 = __builtin_amdgcn_exp2f((mx - M) * L2E), a1 = __builtin_amdgcn_exp2f((m1 - M) * L2E);
            const float inv = 1.0f / (ls * a0 + l1 * a1);
#pragma unroll
            for (int db = 0; db < 4; ++db) { float o[4];
#pragma unroll
                for (int rg = 0; rg < 4; ++rg) o[rg] = (oacc[db][rg] * a0 + mb[2 + db * 4 + rg] * a1) * inv;
                u32x2 w; w.x = pk2(o[0], o[1]); w.y = pk2(o[2], o[3]);
                *(u32x2*)(BR + qrow * BRW + 512 + h * 64 + 16 * db + 4 * g4) = w; } }
        __syncthreads();
    }
}

#ifndef STAMP_PHASE
#define STAMP_PHASE -1
#endif
constexpr int PH_PER_LAYER = 10, PH_FINAL = 1 + 2 * PH_PER_LAYER, NPHASES = PH_FINAL + 1;
__device__ __forceinline__ void moe_tables(const Params& p, LAS unsigned char* lds, int l, int tid, int nsplit, int nMs, int G, int c) {
    LAS int* tb = (LAS int*)(lds + MOE_TAB_OFF); LAS int* cn = tb + 128;
    if (tid < 64) { const unsigned c = ((const unsigned*)(p.ws + WS_CTL))[CW_CNT + l * 2048 + tid * 16]; cn[tid] = (int)(c < (unsigned)NT ? c : (unsigned)NT); }
    __syncthreads();
    if (tid == 0) { int s = 0; for (int e = 0; e < 64; ++e) { tb[e] = s; s += (cn[e] + 255) >> 8; } tb[64] = s; }
    __syncthreads();
    if (tid < MOE_UL_MAX) { LAS int* ul = (LAS int*)(lds + MOE_UL_OFF) + tid * 8; const int ntr = tb[64];
        const int idx = tid * G + ((G & 7) == 0 ? (c & 7) * (G >> 3) + (c >> 3) : c);
        if (idx >= nsplit * (ntr + nMs)) ul[0] = -1;
        else if (idx < nsplit * ntr) { const int mt = idx / nsplit, pn = idx % nsplit; int lo = 0, hi = 63;
            for (int it = 0; it < 6; ++it) { const int mid = (lo + hi + 1) >> 1; if (tb[mid] <= mt) lo = mid; else hi = mid - 1; }
            ul[0] = lo; ul[1] = pn; ul[2] = (mt - tb[lo]) * 256; ul[3] = mt; ul[4] = cn[lo]; }
        else { const int s_ = idx - nsplit * ntr; ul[0] = 64; ul[1] = s_ % nsplit; ul[2] = 0; ul[3] = s_ / nsplit; ul[4] = 0; } }
    __syncthreads();
}

__global__ void __launch_bounds__(NTHREADS, 2) fwd_kernel(Params p0) {
    extern __shared__ __attribute__((aligned(16))) unsigned char lds_raw[];
    LAS unsigned char* const lds0 = (LAS unsigned char*)lds_raw;
    const int tid0 = threadIdx.x, G = gridDim.x, bid = blockIdx.x, NGW = G * NWAVES;
    const int wave0 = __builtin_amdgcn_readfirstlane(tid0 >> 6);
#define PHASE_IDS const int tid = launder(wave0 * 64 + lane_id_here()), wave = __builtin_amdgcn_readfirstlane(tid >> 6), lane = tid & 63, gw = bid * NWAVES + wave; (void)lane; (void)gw; \
    Params p = p0; p.ws = kws_ptr(); p.out = kout_ptr(); \
    LAS unsigned char* lds; { unsigned la_ = (unsigned)(size_t)lds0; asm volatile("" : "+s"(la_)); lds = (LAS unsigned char*)(size_t)la_; }
    volatile LAS unsigned* xbw = (volatile LAS unsigned*)(lds0 + LDS_BYTES - 16);
    if (tid0 == 0) { xbw[0] = 0u; xbw[1] = 0u; xbw[2] = 0u; xbw[3] = 0u; }
    __syncthreads();
    XcdBarrier bar = xcd_barrier_post((unsigned*)(p0.ws + WS_CTL) + CW_BAR + p0.li * XCD_BAR_WORDS, xbw);
#ifdef TEST_PHASE
#define IN(k) ((((k) - 1) % PH_PER_LAYER == TEST_PHASE - 1 && (k) >= 1 && (k) < PH_FINAL && TEST_PHASE >= 1) || ((k) == 0 && TEST_PHASE == 0) || ((k) == PH_FINAL && TEST_PHASE == 99)) && (launder_s(p0.ph_lo) <= (k) && (k) < launder_s(p0.ph_hi))
#else
#define IN(k) (launder_s(p0.ph_lo) <= (k) && (k) < launder_s(p0.ph_hi))
#endif
#ifndef DUP_PHASE
#define DUP_PHASE -1
#endif
#define DUP(k) for (int rep_ = 0; rep_ < ((DUP_PHASE) == (k) ? 2 : 1); ++rep_)
#ifdef TIMING
    volatile LAS unsigned long long* tst = (volatile LAS unsigned long long*)(lds0 + LDS_BYTES - 16 - 512);
    if (wave0 == 0 && lane_id_here() == 0) tst[0] = __builtin_amdgcn_s_memrealtime();
#define SEAM(k) do { if (IN(k) && IN((k) + 1)) { xcd_barrier(bar, wave0 == 0 && lane_id_here() == 0); if (wave0 == 0 && lane_id_here() == 0) tst[(k) + 1] = __builtin_amdgcn_s_memrealtime(); } } while (0)
#else
#define SEAM(k) do { if (IN(k) && IN((k) + 1)) xcd_barrier(bar, wave0 == 0 && lane_id_here() == 0); } while (0)
#endif
#define Hb ((bf16_t*)(p.ws + WS_H))
#define Zb ((bf16_t*)(p.ws + WS_R + R_Z))
#define BRb ((bf16_t*)(p.ws + WS_R + R_BR))
#define XC ((float*)(p.ws + WS_XC))
#define xl (l == 0 ? kin(I_X) : (const float*)p.out)
#define xc (l == 0 ? kin(I_CTX) : (const float*)XC)
#define mod ((const float*)(p.ws + WS_MOD) + (size_t)l * 9 * 6144)
#define wm (p.ws + WS_WM + (size_t)l * WM_STRIDE)

    if (IN(0)) { DUP(100) {
        PHASE_IDS;
        for (int u = bid; u < 192; u += G) mod_unit(p, lds, u, tid);
        if (bid == G - 1) { float* rope = (float*)(p.ws + WS_ROPE);
            for (int idx = tid; idx < 1024; idx += NTHREADS) { const int pos = idx >> 4, f = idx & 15; const float inv = exp2f(-(float)f * (13.287712379549449f / 16.0f));
                float x = (float)pos * inv * 0.15915494309189535f; x -= floorf(x);
                rope[idx * 2] = __builtin_amdgcn_cosf(x); rope[idx * 2 + 1] = __builtin_amdgcn_sinf(x); } }
        __syncthreads();
        LAS float* scr = (LAS float*)(lds + wave * 8448);
        for (int it = gw; it < 2 * MISC_ITEMS; it += NGW) {
            if (it < MISC_ITEMS) misc_item(p, 0, it, scr, lane);
            else misc_item(p, 1, it - MISC_ITEMS, scr, lane); }
        __syncthreads();
    } }
    SEAM(0);

    for (int l = 0; l < DEPTH; ++l) {
        const int base = 1 + PH_PER_LAYER * l;
        const bool need_ctx = l < DEPTH - 1;
        const int Mrows = need_ctx ? NT : NL;

        if (IN(base + 0)) { DUP(0) {
            PHASE_IDS;
            for (int row = gw; row < NT; row += NGW) { const bool lat = row < NL;
                const float* mr = mod + (size_t)(lat ? (row >> 11) : 8) * 6144;
                f32x4 v[4];
                if (l == 0) { const float* xr = lat ? kin(I_X) + (size_t)row * D : kin(I_CTX) + (size_t)(row - NL) * D;
#pragma unroll
                    for (int j = 0; j < 4; ++j) v[j] = ((const f32x4*)xr)[64 * j + lane]; }
                else { float* xr = lat ? p.out + (size_t)row * D : XC + (size_t)(row - NL) * D;
                    combine_row(v, xr, mr - 9 * 6144 + 5120, Hb + (size_t)row * D, (const unsigned char*)(p.ws + WS_R + R_O) + (size_t)row * 8 * 1024, lane);
#pragma unroll
                    for (int j = 0; j < 4; ++j) ((f32x4*)xr)[64 * j + lane] = v[j]; }
                norm_mod_vals(v, kin(I_NMG) + l * 1024, mr, mr + 1024, Hb + (size_t)row * D, false, lds, lane); }
        } }
        SEAM(base + 0);
        if (IN(base + 1)) { DUP(1) {
            PHASE_IDS;
            DenseSched S{(const char*)Hb, (const char*)(wm + WM_IN), 1024, 1024, NT / 256, INW / 256, G, bid, 1, 0, 0};
            EpiStoreBf16 E{Zb, ZW, 16, (unsigned char*)(p.ws + WS_R + R_G8)};
            pg8::gemm_phase(lds, tid, 1024, 1024, S, E, (STAMP_PHASE == 2 && l == 0 && bid == 0) ? 25 : -1);
        } }
        SEAM(base + 1);
        if (IN(base + 2)) { DUP(2) {
            PHASE_IDS;
#ifndef DUP_SUB
#define DUP_SUB -1
#endif
            for (int rs_ = 0; rs_ < (DUP_SUB == 0 ? 2 : 1); ++rs_) for (int u = bid; u < 1024; u += G) na_unit(p, lds, l, u >> 7, (u >> 4) & 7, u & 15, true, tid);
            if (need_ctx) for (int u = bid; u < 128; u += G) na_unit(p, lds, l, u >> 4, (u >> 1) & 7, u & 1, false, tid);
            for (int rs_ = 0; rs_ < (DUP_SUB == 1 ? 2 : 1); ++rs_) for (int u = (bid + 64) % G; u < 576; u += G) retkv_unit(p, lds, l, u / 72, (u / 18) % 4, u % 18, tid);
        } }
        SEAM(base + 2);
        if (IN(base + 3)) { DUP(3) {
            PHASE_IDS;
            const float* KV = (const float*)(p.ws + WS_R + R_KV); bf16_t* ST = (bf16_t*)(p.ws + WS_R + R_ST);
            for (int gi = bid * NTHREADS + tid; gi < 64 * 2048; gi += G * NTHREADS) {
                const int combo = gi >> 11, e4 = (gi & 2047) * 4, bh = combo >> 1, dir = combo & 1, h = bh & 3;
                const float dec = __builtin_amdgcn_exp2f(128.f * log2_gamma(p, l, dir, h));
                const float* kv = KV + (size_t)bh * NCHUNK * 2 * 8192 + (size_t)dir * 8192 + e4; bf16_t* st = ST + (size_t)bh * NCHUNK * 2 * 8192 + (size_t)dir * 8192 + e4;
                f32x4 q[NCHUNK];
#pragma unroll
                for (int y = 0; y < NCHUNK; ++y) q[y] = *(const f32x4*)(kv + (size_t)y * 2 * 8192);
                f32x4 sacc = (f32x4){0.f, 0.f, 0.f, 0.f};
#pragma unroll
                for (int i = 0; i < NCHUNK; ++i) { const int y = dir == 0 ? i : (i == 0 ? 1 : (i == 1 ? 0 : 19 - i));
                    u32x2 o; o.x = pk2(sacc[0], sacc[1]); o.y = pk2(sacc[2], sacc[3]); *(u32x2*)(st + (size_t)y * 2 * 8192) = o;
                    f32x4 kvy = q[0];
#pragma unroll
                    for (int j = 1; j < NCHUNK; ++j) kvy = (j == y) ? q[j] : kvy;
                    sacc = sacc * dec + kvy; } }
            { const bf16_t* Z = (const bf16_t*)(p.ws + WS_R + R_Z); float* STAT = (float*)(p.ws + WS_R + R_STAT);
              for (int row = gw; row < Mrows; row += NGW) { const u32x4 v = *(const u32x4*)(Z + (size_t)row * ZW + ZC_AV + lane * 8);
                  const float x0 = geluf_(lo16(v.x)), x1 = geluf_(hi16(v.x)), x2 = geluf_(lo16(v.y)), x3 = geluf_(hi16(v.y)), x4 = geluf_(lo16(v.z)), x5 = geluf_(hi16(v.z)), x6 = geluf_(lo16(v.w)), x7 = geluf_(hi16(v.w));
                  const float mean = wave_sum(((x0 + x1) + (x2 + x3)) + ((x4 + x5) + (x6 + x7)), lane) * (1.0f / 512.0f);
                  const float d0 = x0 - mean, d1 = x1 - mean, d2 = x2 - mean, d3 = x3 - mean, d4 = x4 - mean, d5 = x5 - mean, d6 = x6 - mean, d7 = x7 - mean;
                  const float s2 = wave_sum(((d0 * d0 + d1 * d1) + (d2 * d2 + d3 * d3)) + ((d4 * d4 + d5 * d5) + (d6 * d6 + d7 * d7)), lane);
                  if (lane == 0) *(f32x2*)(STAT + (size_t)row * 2) = (f32x2){mean, rsqrtf(s2 * (1.0f / 512.0f) + EPS)}; } }
        } }
        SEAM(base + 3);
        if (IN(base + 4)) { DUP(4) {
            PHASE_IDS;
            const int cc_lo = need_ctx ? 0 : 2, ncc = NCHUNK - cc_lo, total = 32 * ncc;
            for (int u = bid; u < total; u += G) retout_unit(p, lds, l, u / (4 * ncc), (u / ncc) % 4, cc_lo + u % ncc, tid);
            const int nA = (Mrows / 128) * 4;
            for (int rs_ = 0; rs_ < (DUP_SUB == 2 ? 2 : 1); ++rs_) for (int u = (bid + 64) % G; u < nA; u += G) mixA_unit(p, lds, l, u >> 2, u & 3, tid);
        } }
        SEAM(base + 4);
        if (IN(base + 5)) { DUP(5) {
            PHASE_IDS;
            DenseSched S{(const char*)BRb, (const char*)(wm + WM_BR), BRW, 512, Mrows / 256, 4, G, bid, 3, 512 * 2, (size_t)1024 * 512 * 2};
#ifdef MERGE_PLAIN_DUP
            if (rep_ == 1) { EpiStoreBf16 E2{(bf16_t*)(p.ws + WS_R + R_KV), 1024, 1000, (unsigned char*)0}; pg8::gemm_phase(lds, tid, 512, 512, S, E2); } else
#endif
            { EpiMerge E{Hb, (const unsigned char*)(p.ws + WS_R + R_G8)};
            pg8::gemm_phase(lds, tid, 512, 512, S, E, (STAMP_PHASE == 6 && l == 0 && bid == 0) ? 25 : -1); }
            if (l == 0 && rep_ == 0 && G == 256 && bid >= 32) { LAS float* scr = (LAS float*)(lds + wave * 8448); const int fw = (bid - 32) * NWAVES + wave;
                for (int it = fw; it < FILL_SPLIT; it += 224 * NWAVES) expert_item(p, it / EXP_ITEMS, it % EXP_ITEMS, scr, lane); }
            if (l == 0 && rep_ == 0 && G != 256) { LAS float* scr = (LAS float*)(lds + wave * 8448);
                for (int it = gw; it < 2 * EXP_ITEMS; it += NGW) expert_item(p, it / EXP_ITEMS, it % EXP_ITEMS, scr, lane); }
        } }
        SEAM(base + 5);
        if (IN(base + 6)) { DUP(6) {
            PHASE_IDS;
            DenseSched S{(const char*)Hb, (const char*)(wm + WM_OUT), 1024, 1024, Mrows / 256, 4, G, bid, 1, 0, 0};
            float* const dummy = (float*)(p.ws + WS_R + R_ACT);
            EpiResid E{xl, xc, rep_ == 0 ? p.out : dummy, rep_ == 0 ? XC : dummy + (size_t)NL * D, mod + 2048};
            pg8::gemm_phase(lds, tid, 1024, 1024, S, E, (STAMP_PHASE == 7 && l == 0 && bid == 0) ? 25 : -1);
            if (l == 0 && rep_ == 0 && G == 256 && bid >= 32) { LAS float* scr = (LAS float*)(lds + wave * 8448); const int fw = (bid - 32) * NWAVES + wave;
                for (int it = FILL_SPLIT + fw; it < 2 * EXP_ITEMS; it += 224 * NWAVES) expert_item(p, it / EXP_ITEMS, it % EXP_ITEMS, scr, lane); }
        } }
        SEAM(base + 6);
        if (IN(base + 7)) { DUP(7) {
            PHASE_IDS;
            for (int u = bid; u < Mrows / 64; u += G) router_unit(p, lds, l, u, p.out, XC, tid, rep_ == 0, l == 0 && u == 0);
        } }
        SEAM(base + 7);
        if (IN(base + 8)) { DUP(8) {
            PHASE_IDS;
            moe_tables(p, lds, l, tid, 2, Mrows / 256, G, bid);
            MoeGuSched S{(const char*)Hb, (const char*)(p.ws + WS_WE + (size_t)l * WE_LAYER + WE_GU), (const char*)(wm + WM_SGU), (const unsigned*)(p.ws + WS_LIST),
                         (const LAS int*)(lds + MOE_TAB_OFF), (const LAS int*)(lds + MOE_TAB_OFF) + 128, Mrows / 256, G, bid};
            EpiGateUp E{(bf16_t*)(p.ws + WS_R + R_ACT), (bf16_t*)(p.ws + WS_R + R_ACTS), (const float*)(p.ws + WS_WL)};
            pg8::gemm_phase<true>(lds, tid, 1024, 1024, S, E, (STAMP_PHASE == 9 && l == 0 && bid == 0) ? 25 : -1);
        } }
        SEAM(base + 8);
        if (IN(base + 9)) { DUP(9) {
            PHASE_IDS;
            moe_tables(p, lds, l, tid, 4, Mrows / 256, G, bid);
            MoeDownSched S{(const char*)(p.ws + WS_R + R_ACT), (const char*)(p.ws + WS_WE + (size_t)l * WE_LAYER + WE_D), (const char*)(p.ws + WS_R + R_ACTS), (const char*)(wm + WM_SD),
                           (const LAS int*)(lds + MOE_TAB_OFF), (const LAS int*)(lds + MOE_TAB_OFF) + 128, Mrows / 256, G, bid};
            EpiDown E{(bf16_t*)(p.ws + WS_R + R_O), (const unsigned*)(p.ws + WS_LIST), Hb};
            pg8::gemm_phase<true>(lds, tid, launder_s(256), 256, S, E, (STAMP_PHASE == 10 && l == 0 && bid == 0) ? 25 : -1);
        } }
        SEAM(base + 9);
    }
#ifdef EXTRA_BARRIERS
    if (IN(PH_FINAL) && IN(PH_FINAL - 1)) for (int xb_ = 0; xb_ < EXTRA_BARRIERS; ++xb_) xcd_barrier(bar, wave0 == 0 && lane_id_here() == 0);
#endif
#ifdef TIMING
    float t_scale = 1.0f, t_add = 0.0f;
    { float* tw = (float*)(p0.ws + WS_CTL) + 1024;
      if (bid == 0 && wave0 == 0 && lane_id_here() == 0) { tw[0] = (float)(tst[TA_HI] - tst[TA_LO]) * 0.01f; }
      xcd_barrier(bar, wave0 == 0 && lane_id_here() == 0);
      t_scale = 1.0f + tw[0] / (float)(TA_DIV); t_add = 0.0f; }
#endif
    if (IN(PH_FINAL)) {
        PHASE_IDS;
        const int l = DEPTH - 1;
        for (int row = gw; row < NL; row += NGW) { float* xr = p.out + (size_t)row * D;
            f32x4 v[4]; float ss = 0.f;
            combine_row(v, xr, mod + (size_t)(row >> 11) * 6144 + 5120, Hb + (size_t)row * D, (const unsigned char*)(p.ws + WS_R + R_O) + (size_t)row * 8 * 1024, lane);
#pragma unroll
            for (int j = 0; j < 4; ++j) ss += (v[j][0] * v[j][0] + v[j][1] * v[j][1]) + (v[j][2] * v[j][2] + v[j][3] * v[j][3]);
            const float rstd = rsqrtf(wave_sum(ss, lane) * (1.0f / 1024.0f) + EPS);
#pragma unroll
            for (int j = 0; j < 4; ++j) { f32x4 ov = v[j] * rstd * ((const f32x4*)kin(I_FG))[64 * j + lane];
#ifdef TIMING
                ov = ov * t_scale; if (row == 0 && j == 0 && lane == 0) ov[0] += t_add;
#endif
                ((f32x4*)xr)[64 * j + lane] = ov; } }
    }
#undef IN
#undef SEAM
#undef Hb
#undef Zb
#undef BRb
#undef XC
#undef xl
#undef xc
#undef mod
#undef wm
}

#ifndef STAMP_PHASE_DEFINED
#endif
#ifndef MK_PER_PHASE
#define MK_PER_PHASE 0
#endif
extern "C" void kernel_launch(void* const* d_in, const int* in_sizes, int n_in, void* d_out, int out_size, void* d_ws, size_t ws_size, hipStream_t stream) {
    static int grid = 0;
    if (grid == 0) {
        if (n_in != 26 || out_size != NL * D || ws_size < WS_END) { fprintf(stderr, "kernel_launch: unexpected shapes (n_in %d out %d ws %zu, need %zu)\n", n_in, out_size, ws_size, (size_t)WS_END); grid = -1; return; }
        int dev = 0, cus = 0;
        if (hipGetDevice(&dev) != hipSuccess || hipDeviceGetAttribute(&cus, hipDeviceAttributeMultiprocessorCount, dev) != hipSuccess) { grid = -1; return; }
        if (hipFuncSetAttribute((const void*)fwd_kernel, hipFuncAttributeMaxDynamicSharedMemorySize, LDS_BYTES) != hipSuccess) { fprintf(stderr, "kernel_launch: hipFuncSetAttribute failed\n"); grid = -1; return; }
        int per_cu = 0;
        if (hipOccupancyMaxActiveBlocksPerMultiprocessor(&per_cu, (const void*)fwd_kernel, NTHREADS, LDS_BYTES) != hipSuccess || per_cu < 1) { fprintf(stderr, "kernel_launch: occupancy query says %d\n", per_cu); }
        (void)hipGetLastError();
        grid = cus;
    }
    if (grid < 0) return;
    (void)hipMemsetAsync((char*)d_ws + WS_CTL, 0, CTL_BYTES, stream);
    Params p{};
    for (int i = 0; i < 26; ++i) p.in[i] = (const float*)d_in[i];
    p.out = (float*)d_out; p.ws = (unsigned char*)d_ws;
#if MK_PER_PHASE
    for (int k = 0; k < NPHASES; ++k) { p.ph_lo = k; p.ph_hi = k + 1; p.li = k;
        hipLaunchKernelGGL(fwd_kernel, dim3(grid), dim3(NTHREADS), LDS_BYTES, stream, p); }
#else
    p.ph_lo = 0; p.ph_hi = NPHASES; p.li = 0;
    hipLaunchKernelGGL(fwd_kernel, dim3(grid), dim3(NTHREADS), LDS_BYTES, stream, p);
#endif
}
```

```cpp
#include <hip/hip_runtime.h>
#include <stdint.h>
#include <stdio.h>

#define LAS __attribute__((address_space(3)))
#define GAS __attribute__((address_space(1)))
template <class T> __device__ __forceinline__ T* as_global(T* q) { return (T*)(GAS T*)q; }
typedef unsigned short bf16_t;
typedef short bf16x8 __attribute__((ext_vector_type(8)));
typedef short bf16x4 __attribute__((ext_vector_type(4)));
typedef float f32x4 __attribute__((ext_vector_type(4)));
typedef float f32x2 __attribute__((ext_vector_type(2)));
typedef unsigned u32x4 __attribute__((ext_vector_type(4)));
typedef unsigned u32x2 __attribute__((ext_vector_type(2)));
typedef long i64x2 __attribute__((ext_vector_type(2)));

constexpr int D = 1024, NB = 8, SEQ = 2048, CTXL = 256, DEPTH = 2;
constexpr int NL = NB * SEQ;
constexpr int NC = NB * CTXL;
constexpr int NT = NL + NC;
constexpr int INW = 7168;
constexpr int ZW = 4096;
constexpr int ZC_AU = 0, ZC_AV = 512, ZC_NQ = 1024, ZC_NK = 1536, ZC_NV = 2048, ZC_RQ = 2560, ZC_RK = 2816, ZC_RV = 3072, ZC_RG = 3584,
              ZC_GA = 4096;
constexpr int BRW = 1536;
constexpr int NEXP = 64, TOPK = 8, EXPW = 256;
constexpr int NCHUNK = 18;
constexpr float EPS = 1e-6f;
constexpr int NTHREADS = 512, NWAVES = 8;
constexpr int LDS_BYTES = 159744;

constexpr size_t MiB = 1u << 20;
constexpr size_t WS_CTL = 0, CTL_BYTES = 1 * MiB;
constexpr size_t WS_MOD = 1 * MiB;
constexpr size_t WS_ROPE = 1 * MiB + 512 * 1024;
constexpr size_t WS_WM = 2 * MiB, WM_STRIDE = 21 * MiB;
constexpr size_t WM_IN = 0, WM_BR = 14680064, WM_OUT = WM_BR + 3145728, WM_SGU = WM_OUT + 2097152, WM_SD = WM_SGU + 1048576,
                 WM_RT = WM_SD + 524288, WM_CM = WM_RT + 131072, WM_END = WM_CM + 131072;
static_assert(WM_END <= WM_STRIDE, "misc weights");
constexpr size_t WS_WE = 44 * MiB;
constexpr size_t WE_GU = 0, WE_D = 33554432, WE_LAYER = 50331648;
constexpr size_t WS_XC = 140 * MiB;
constexpr size_t WS_H = 148 * MiB;
constexpr size_t WS_LIST = 184 * MiB, WS_WL = 189 * MiB;
constexpr size_t WS_R = 194 * MiB;
constexpr size_t R_Z = 0, R_G8 = 144 * MiB, R_BR = 252 * MiB, R_KV = 306 * MiB, R_ST = 342 * MiB, R_STAT = 360 * MiB;
constexpr size_t R_O = 0, R_ACT = 288 * MiB, R_ACTS = 368 * MiB;
constexpr size_t WS_END = WS_R + 377 * MiB;
static_assert(R_KV + 37748736 <= 377 * MiB && R_ACTS + 9437184 <= 377 * MiB && R_Z + 150994944 <= R_G8 && R_G8 + 56623104 <= R_BR && R_BR + 56623104 <= R_KV, "region map");
static_assert(R_O + 301989888 <= R_ACT && R_ACT + 83886080 <= R_ACTS, "region map 2");
constexpr int CW_BAR = 4096;
constexpr int CW_CNT = 200000;

__device__ __forceinline__ float bf2f(unsigned short b) { return __uint_as_float(((unsigned)b) << 16); }
__device__ __forceinline__ unsigned f2bf(float f) { unsigned u = __float_as_uint(f); return (u + 0x7fffu + ((u >> 16) & 1u)) >> 16; }
__device__ __forceinline__ unsigned pk2(float lo, float hi) { unsigned r; asm("v_cvt_pk_bf16_f32 %0, %1, %2" : "=v"(r) : "v"(lo), "v"(hi)); return r; }
__device__ __forceinline__ float lo16(unsigned w) { return __uint_as_float(w << 16); }
__device__ __forceinline__ float hi16(unsigned w) { return __uint_as_float(w & 0xffff0000u); }
__device__ __forceinline__ float shx(float v, int o, int lane) { return __int_as_float(__builtin_amdgcn_ds_bpermute((lane ^ o) << 2, __float_as_int(v))); }
__device__ __forceinline__ int shxi(int v, int o, int lane) { return __builtin_amdgcn_ds_bpermute((lane ^ o) << 2, v); }
__device__ __forceinline__ float dpp_f(float v, const int ctrl_tag) {
    const int x = __float_as_int(v);
    switch (ctrl_tag) {
        case 0: return __int_as_float(__builtin_amdgcn_update_dpp(x, x, 0xB1, 0xF, 0xF, false));
        case 1: return __int_as_float(__builtin_amdgcn_update_dpp(x, x, 0x4E, 0xF, 0xF, false));
        case 2: return __int_as_float(__builtin_amdgcn_update_dpp(x, x, 0x141, 0xF, 0xF, false));
        default: return __int_as_float(__builtin_amdgcn_update_dpp(x, x, 0x140, 0xF, 0xF, false));
    }
}
__device__ __forceinline__ float wave_sum(float v, int  ) {
    v += dpp_f(v, 0); v += dpp_f(v, 1); v += dpp_f(v, 2); v += dpp_f(v, 3);
    const int x = __float_as_int(v);
    return (__int_as_float(__builtin_amdgcn_readlane(x, 0)) + __int_as_float(__builtin_amdgcn_readlane(x, 16))) + (__int_as_float(__builtin_amdgcn_readlane(x, 32)) + __int_as_float(__builtin_amdgcn_readlane(x, 48)));
}
__device__ __forceinline__ float fast_exp(float x) { return __builtin_amdgcn_exp2f(x * 1.44269504089f); }
__device__ __forceinline__ float sigmoidf_(float x) { return __builtin_amdgcn_rcpf(1.0f + fast_exp(-x)); }
__device__ __forceinline__ float siluf_(float x) { return x * sigmoidf_(x); }
__device__ __forceinline__ float geluf_(float x) { const float u = 0.7978845608f * (x + 0.044715f * x * x * x); return x * sigmoidf_(2.0f * u); }
__device__ __forceinline__ f32x4 mfma16(bf16x8 a, bf16x8 b, f32x4 c) { return __builtin_amdgcn_mfma_f32_16x16x32_bf16(a, b, c, 0, 0, 0); }
__device__ __forceinline__ bf16x8 as_frag(u32x4 v) { return __builtin_bit_cast(bf16x8, v); }
__device__ __forceinline__ int launder(int v) { asm volatile("" : "+v"(v)); return v; }
__device__ __forceinline__ int lane_id_here() { unsigned m = ~0u; asm volatile("" : "+s"(m)); return (int)__builtin_amdgcn_mbcnt_hi(m, __builtin_amdgcn_mbcnt_lo(m, 0u)); }
__device__ __forceinline__ int launder_s(int v) { asm volatile("" : "+s"(v)); return v; }
template <class T> __device__ __forceinline__ T* launder_p(T* q) { asm volatile("" : "+s"(q)); return q; }
template <class T> __device__ __forceinline__ T* launder_vp(T* q) { asm volatile("" : "+v"(q)); return q; }
#define LDS_WAIT() asm volatile("s_waitcnt lgkmcnt(0)" ::: "memory")
#define VM_WAIT() asm volatile("s_waitcnt vmcnt(0)" ::: "memory")

__device__ __forceinline__ bf16x8 tr_frag(unsigned base, int stride, int r0, int r1, int c0, int lane) {
    const int q = (lane & 15) >> 2, p = lane & 3;
    const unsigned a0 = base + (unsigned)((r0 + q) * stride + (c0 + 4 * p) * 2), a1 = base + (unsigned)((r1 + q) * stride + (c0 + 4 * p) * 2);
    bf16x4 lo, hi;
    asm volatile("ds_read_b64_tr_b16 %0, %2\n\tds_read_b64_tr_b16 %1, %3\n\ts_waitcnt lgkmcnt(0)" : "=&v"(lo), "=&v"(hi) : "v"(a0), "v"(a1) : "memory");
    bf16x8 r; r[0] = lo[0]; r[1] = lo[1]; r[2] = lo[2]; r[3] = lo[3]; r[4] = hi[0]; r[5] = hi[1]; r[6] = hi[2]; r[7] = hi[3];
    return r;
}
__device__ __forceinline__ unsigned lds_addr(LAS unsigned char* p) { return (unsigned)(size_t)p; }
template <int O0, int O1> __device__ __forceinline__ bf16x8 tr_frag_i(unsigned a) {
    static_assert(O0 >= 0 && O0 < 65536 && O1 >= 0 && O1 < 65536, "ds offset field");
    bf16x4 lo, hi;
    asm volatile("ds_read_b64_tr_b16 %0, %2 offset:%3\n\tds_read_b64_tr_b16 %1, %2 offset:%4\n\ts_waitcnt lgkmcnt(0)" : "=&v"(lo), "=&v"(hi) : "v"(a), "n"(O0), "n"(O1) : "memory");
    bf16x8 r; r[0] = lo[0]; r[1] = lo[1]; r[2] = lo[2]; r[3] = lo[3]; r[4] = hi[0]; r[5] = hi[1]; r[6] = hi[2]; r[7] = hi[3];
    return r;
}
template <int OB, int R1> __device__ __forceinline__ void tr_frag4_i(unsigned a, bf16x8 (&f)[4]) {
    static_assert(OB >= 0 && OB + R1 + 96 < 65536, "ds offset field");
    bf16x4 l0, h0, l1, h1, l2, h2, l3, h3;
    asm volatile("ds_read_b64_tr_b16 %0, %8 offset:%9\n\tds_read_b64_tr_b16 %1, %8 offset:%10\n\tds_read_b64_tr_b16 %2, %8 offset:%11\n\tds_read_b64_tr_b16 %3, %8 offset:%12\n\t"
                 "ds_read_b64_tr_b16 %4, %8 offset:%13\n\tds_read_b64_tr_b16 %5, %8 offset:%14\n\tds_read_b64_tr_b16 %6, %8 offset:%15\n\tds_read_b64_tr_b16 %7, %8 offset:%16\n\ts_waitcnt lgkmcnt(0)"
                 : "=&v"(l0), "=&v"(h0), "=&v"(l1), "=&v"(h1), "=&v"(l2), "=&v"(h2), "=&v"(l3), "=&v"(h3)
                 : "v"(a), "n"(OB), "n"(OB + R1), "n"(OB + 32), "n"(OB + 32 + R1), "n"(OB + 64), "n"(OB + 64 + R1), "n"(OB + 96), "n"(OB + 96 + R1) : "memory");
    f[0][0] = l0[0]; f[0][1] = l0[1]; f[0][2] = l0[2]; f[0][3] = l0[3]; f[0][4] = h0[0]; f[0][5] = h0[1]; f[0][6] = h0[2]; f[0][7] = h0[3];
    f[1][0] = l1[0]; f[1][1] = l1[1]; f[1][2] = l1[2]; f[1][3] = l1[3]; f[1][4] = h1[0]; f[1][5] = h1[1]; f[1][6] = h1[2]; f[1][7] = h1[3];
    f[2][0] = l2[0]; f[2][1] = l2[1]; f[2][2] = l2[2]; f[2][3] = l2[3]; f[2][4] = h2[0]; f[2][5] = h2[1]; f[2][6] = h2[2]; f[2][7] = h2[3];
    f[3][0] = l3[0]; f[3][1] = l3[1]; f[3][2] = l3[2]; f[3][3] = l3[3]; f[3][4] = h3[0]; f[3][5] = h3[1]; f[3][6] = h3[2]; f[3][7] = h3[3];
}
__device__ __forceinline__ unsigned tr_lane(unsigned base, int stride, int rmul, int lane) { return base + (unsigned)((rmul * (lane >> 4) + ((lane & 15) >> 2)) * stride + (lane & 3) * 8); }
template <int V> struct IC { static constexpr int value = V; };
template <int I, int N, class F> __device__ __forceinline__ void sfor(F&& f) { if constexpr (I < N) { f(IC<I>{}); sfor<I + 1, N>(f); } }


#define XB_TMO      128
#define XB_XCNT(j)  (256  + 64 * (j))
#define XB_XSUB(j)  (1280 + 64 * (j))
#define XB_XGEN(j)  (2304 + 64 * (j))
#define XB_TOP      3328
#define XB_TOPGEN   3392
#define XCD_BAR_WORDS 3456
#define XB_SPIN_CAP (1u << 21)
__device__ __forceinline__ unsigned xb_ld(unsigned* p)              { return __hip_atomic_load(p, __ATOMIC_RELAXED, __HIP_MEMORY_SCOPE_AGENT); }
__device__ __forceinline__ unsigned xb_add(unsigned* p, unsigned v) { return __hip_atomic_fetch_add(p, v, __ATOMIC_RELAXED, __HIP_MEMORY_SCOPE_AGENT); }
__device__ __forceinline__ unsigned xb_xcc_id() { return (unsigned)__builtin_amdgcn_s_getreg((3 << 11) | 20) & 0xFu; }
#define XB_SPIN(cond, bar) do { unsigned _sp = 0; while (cond) { __builtin_amdgcn_s_sleep(1); \
    if ((++_sp & 255u) == 0u) { if (xb_ld(&(bar)[XB_TMO])) break; if (_sp > XB_SPIN_CAP) { atomicAdd(&(bar)[XB_TMO], 1u); break; } } } } while (0)
struct XcdBarrier { unsigned* bar; unsigned x; volatile LAS unsigned* st; };
__device__ __forceinline__ XcdBarrier xcd_barrier_post(unsigned* bar, volatile LAS unsigned* st) {
    XcdBarrier b; b.bar = bar; b.x = xb_xcc_id(); b.st = st;
    if (threadIdx.x == 0) (void)xb_add(&bar[XB_XCNT(b.x)], 1u);
    return b;
}
__device__ __forceinline__ void xcd_barrier_complete(unsigned* bar, unsigned x, unsigned& nloc, unsigned& nx) {
    const unsigned G = gridDim.x * gridDim.y * gridDim.z;
    unsigned sum, cnt, mine, sp = 0u;
    for (;;) {
        sum = 0u; cnt = 0u; mine = 0u;
#pragma unroll
        for (unsigned j = 0; j < 16; ++j) { const unsigned c = xb_ld(&bar[XB_XCNT(j)]); sum += c; cnt += (c > 0u) ? 1u : 0u; mine = (j == x) ? c : mine; }
        if (sum == G) break;
        __builtin_amdgcn_s_sleep(1);
        if ((++sp & 255u) == 0u) { if (xb_ld(&bar[XB_TMO])) break; if (sp > XB_SPIN_CAP) { atomicAdd(&bar[XB_TMO], 1u); break; } }
    }
    nloc = mine > 0u ? mine : 1u; nx = cnt > 0u ? cnt : 1u;
}
__device__ __forceinline__ void xcd_barrier(const XcdBarrier& b, const bool leader) {
    asm volatile("s_waitcnt vmcnt(0)" ::: "memory");
    __syncthreads();
    if (leader) {
        unsigned* bar = b.bar;
        __builtin_amdgcn_s_waitcnt(0);
        unsigned nloc = b.st[0], nx = b.st[1];
        if (nloc == 0u) { xcd_barrier_complete(bar, b.x, nloc, nx); b.st[0] = nloc; b.st[1] = nx; }
        const unsigned old = xb_add(&bar[XB_XSUB(b.x)], 1u);
        const unsigned gen = old / nloc;
        if (old + 1u == (gen + 1u) * nloc) {
            __builtin_amdgcn_fence(__ATOMIC_RELEASE, "agent");
            asm volatile("s_waitcnt vmcnt(0)" ::: "memory");
            const unsigned og = xb_add(&bar[XB_TOP], 1u);
            const unsigned tg = og / nx;
            if (og + 1u == (tg + 1u) * nx) xb_add(&bar[XB_TOPGEN], 1u);
            else XB_SPIN(xb_ld(&bar[XB_TOPGEN]) == tg, bar);
            __builtin_amdgcn_fence(__ATOMIC_ACQUIRE, "agent");
            xb_add(&bar[XB_XGEN(b.x)], 1u);
            asm volatile("s_waitcnt vmcnt(0)" ::: "memory");
        } else {
            XB_SPIN(xb_ld(&bar[XB_XGEN(b.x)]) == gen, bar);
            __builtin_amdgcn_fence(__ATOMIC_ACQUIRE, "agent");
            asm volatile("s_waitcnt vmcnt(0)" ::: "memory");
        }
    }
    __syncthreads();
}

namespace pg8 {
constexpr int BM = 256, BK = 64, HALF = 128, HTB = HALF * BK * 2, STAGE_BYTES = 8 * HTB, NXCD = 8, WGM = 8;
constexpr int ROWTAB_OFF = 149504;
constexpr int GATHER_SLOT_OFF = 133120;
__device__ __forceinline__ int lds_byte(int r, int c) { const int st = (r >> 4) * 2 + (c >> 5), rr = r & 15, cc = c & 31, ob = rr * 64 + cc * 2; return st * 1024 + (ob ^ (((ob >> 9) & 1) << 5)); }
__device__ __forceinline__ void stage_rc(int b, int& R, int& C) { const int st = b / 1024, sb = b % 1024, swz = sb ^ (((sb >> 9) & 1) << 5); R = (st >> 1) * 16 + swz / 64; C = (st & 1) * 32 + (swz % 64) / 2; }
__device__ __forceinline__ int perm32(int rho) { const int n = rho >> 4, i = rho & 15; return 8 * (i >> 2) + 4 * n + (i & 3); }

struct Unit { const char* A; const char* B; int e0, e1, e2, e3, e4; };

__device__ __forceinline__ bool static_tile(int i, int G, int c, int nM, int nN, int& pm, int& pn) {
    const int nwg = nM * nN; const long L = (long)i * G + c; if (L >= nwg) return false;
    int wgid = (int)L; { const int q = nwg / NXCD, r = nwg % NXCD, xcd = wgid % NXCD, off = wgid / NXCD; wgid = (xcd < r ? xcd * (q + 1) : r * (q + 1) + (xcd - r) * q) + off; }
    const int nig = WGM * nN, gid = wgid / nig, fm = gid * WGM, gsz = (nM - fm) < WGM ? (nM - fm) : WGM;
    pm = fm + ((wgid % nig) % gsz); pn = (wgid % nig) / gsz; return true;
}

template <bool F8 = false, class Epi, class Sched>
__device__ __forceinline__ void gemm_phase(LAS unsigned char* lds, const int tid, const int K, const int ldb  , const Sched& S, const Epi& E, const int stamp_base = -1) {
#ifdef TIMING
#define GSTAMP(k) do { if (stamp_base >= 0 && tid == 0 && (k) < 31) ((volatile LAS unsigned long long*)(lds + LDS_BYTES - 16 - 512))[stamp_base + (k)] = __builtin_amdgcn_s_memrealtime(); } while (0)
#else
#define GSTAMP(k) do { } while (0)
#endif
    GSTAMP(-1);
    const int wid = __builtin_amdgcn_readfirstlane(tid >> 6), lane = tid & 63, wr = wid >> 2, wc = wid & 3, fr = lane & 15, fq = lane >> 4;
    const int nt = K / (F8 ? 2 * BK : BK);
    unsigned voffB[2];
#pragma unroll
    for (int i = 0; i < 2; ++i) { int R, C; stage_rc(tid * 16 + i * 8192, R, C); const int Rb = Epi::PERM ? ((R & ~31) + perm32(R & 31)) : R; voffB[i] = F8 ? (unsigned)(Rb * ldb + C * 2) : (unsigned)(Rb * ldb + C) * 2u; }
    const size_t kstep = (size_t)(BK * 2);
    const size_t hstepB = (size_t)HALF * ldb * (F8 ? 1 : 2);
    const unsigned ldsw = (unsigned)wid * 1024u;
    const int aoff = lds_byte(wr * 64 + fr, fq * 8), boff = lds_byte(wc * 32 + fr, fq * 8);
#define PG8_SA(b, h) (((b) * 2 + (h)) * HTB)
#define PG8_SB(b, h) ((4 + (b) * 2 + (h)) * HTB)
#define PG8_STAGE(bufoff, gbase, voff) do { _Pragma("unroll") for (int _i = 0; _i < 2; ++_i) \
        __builtin_amdgcn_global_load_lds((const unsigned*)((const char*)(gbase) + (voff)[_i]), (LAS unsigned*)(lds + (bufoff) + ldsw + _i * 8192), 16, 0, 0); } while (0)
#define PG8_LDA(dst, b, h) do { _Pragma("unroll") for (int m = 0; m < 4; ++m) _Pragma("unroll") for (int k = 0; k < 2; ++k) dst[m][k] = *(const LAS bf16x8*)(lds + PG8_SA(b, h) + aoff + m * 2048 + k * 1024); } while (0)
#define PG8_LDB(dst, b, h) do { _Pragma("unroll") for (int n = 0; n < 2; ++n) _Pragma("unroll") for (int k = 0; k < 2; ++k) dst[n][k] = *(const LAS bf16x8*)(lds + PG8_SB(b, h) + boff + n * 2048 + k * 1024); } while (0)
#define PG8_MMA(ai, bj, At, Bt) do { __builtin_amdgcn_s_setprio(1); _Pragma("unroll") for (int m = 0; m < 4; ++m) _Pragma("unroll") for (int n = 0; n < 2; ++n) _Pragma("unroll") for (int k = 0; k < 2; ++k) { \
        if constexpr (F8) { const i64x2 b2_ = __builtin_bit_cast(i64x2, Bt[n][k]), a2_ = __builtin_bit_cast(i64x2, At[m][k]); \
            acc[ai][bj][m][n] = __builtin_amdgcn_mfma_f32_16x16x32_fp8_fp8(b2_[0], a2_[0], acc[ai][bj][m][n], 0, 0, 0); \
            acc[ai][bj][m][n] = __builtin_amdgcn_mfma_f32_16x16x32_fp8_fp8(b2_[1], a2_[1], acc[ai][bj][m][n], 0, 0, 0); } \
        else acc[ai][bj][m][n] = __builtin_amdgcn_mfma_f32_16x16x32_bf16(Bt[n][k], At[m][k], acc[ai][bj][m][n], 0, 0, 0); } __builtin_amdgcn_s_setprio(0); } while (0)
#define PG8_WAIT_V(n) asm volatile("s_waitcnt vmcnt(" #n ")" ::: "memory")
#define PG8_WAIT_L(n) asm volatile("s_waitcnt lgkmcnt(" #n ")" ::: "memory")
#define PG8_BAR __builtin_amdgcn_s_barrier()
#define PG8_SCHED __builtin_amdgcn_sched_barrier(0)
    Unit cur, nxt; int ui = 0;
    if (!S.next(0, cur)) return;
    unsigned cvA[2][2], nvA[2][2];
    S.a_offs(cur, tid, cvA);
    LAS unsigned* const gslot = (LAS unsigned*)(lds + GATHER_SLOT_OFF) + tid * 4;
    if constexpr (Sched::GATHER) { *(LAS u32x4*)gslot = (u32x4){cvA[0][0], cvA[0][1], cvA[1][0], cvA[1][1]}; }
    f32x4 acc[2][2][4][2];
#pragma unroll
    for (int a = 0; a < 2; ++a)
#pragma unroll
        for (int b = 0; b < 2; ++b)
#pragma unroll
            for (int m = 0; m < 4; ++m)
#pragma unroll
                for (int n = 0; n < 2; ++n) acc[a][b][m][n] = (f32x4){0.f, 0.f, 0.f, 0.f};
    bf16x8 At[4][2], B0[2][2], B1[2][2];
    const char* cA = cur.A; const char* cB = cur.B;
    PG8_STAGE(PG8_SB(0, 0), cB, voffB); PG8_STAGE(PG8_SA(0, 0), cA, cvA[0]); PG8_STAGE(PG8_SB(0, 1), cB + hstepB, voffB); PG8_STAGE(PG8_SA(0, 1), cA, cvA[1]);
    if (wr == 1) PG8_BAR;
    PG8_WAIT_V(4); PG8_BAR;
    PG8_STAGE(PG8_SB(1, 0), cB + kstep, voffB); PG8_STAGE(PG8_SA(1, 0), cA + kstep, cvA[0]); PG8_STAGE(PG8_SB(1, 1), cB + hstepB + kstep, voffB);
    PG8_WAIT_V(6); PG8_BAR;
    for (;;) {
        if constexpr (Epi::STAGES) { if (wid < 4) E.stage(cur, (LAS unsigned*)(lds + ROWTAB_OFF) + (ui & 1) * 256 + wid * 64, wid * 64 + lane); }
        const bool has_next = S.next(ui + 1, nxt);
        if (has_next) S.a_offs(nxt, tid, nvA);
        else {
#pragma unroll
            for (int h = 0; h < 2; ++h)
#pragma unroll
                for (int i = 0; i < 2; ++i) nvA[h][i] = cvA[h][i];
        }
        if constexpr (Sched::GATHER) { *(LAS u32x4*)(gslot + ((ui + 1) & 1) * 2048) = (u32x4){nvA[0][0], nvA[0][1], nvA[1][0], nvA[1][1]}; }
        const char* nA = has_next ? nxt.A : cA; const char* nB = has_next ? nxt.B : cB;
#pragma unroll 1
        for (int t = 0; t < nt; t += 2) {
            const bool last = (t == nt - 2);
            const char* a1 = cA + (size_t)(t + 1) * kstep;
            const char* a2 = last ? nA : cA + (size_t)(t + 2) * kstep; const char* b2 = last ? nB : cB + (size_t)(t + 2) * kstep;
            const char* a3 = a2 + kstep; const char* b3 = b2 + kstep;
            unsigned sA[2][2];
            if constexpr (Sched::GATHER) {
                const u32x4 cv = *(const LAS u32x4*)(gslot + (ui & 1) * 2048), sv = *(const LAS u32x4*)(gslot + ((ui + (last ? 1 : 0)) & 1) * 2048);
                cvA[0][0] = cv.x; cvA[0][1] = cv.y; cvA[1][0] = cv.z; cvA[1][1] = cv.w; sA[0][0] = sv.x; sA[0][1] = sv.y; sA[1][0] = sv.z; sA[1][1] = sv.w;
            } else {
#pragma unroll
                for (int h = 0; h < 2; ++h)
#pragma unroll
                    for (int i = 0; i < 2; ++i) sA[h][i] = last ? nvA[h][i] : cvA[h][i];
            }
            PG8_LDB(B0, 0, 0); PG8_SCHED; PG8_LDA(At, 0, 0); PG8_STAGE(PG8_SA(1, 1), a1, cvA[1]);
            PG8_WAIT_L(8); PG8_BAR; PG8_WAIT_L(0); PG8_MMA(0, 0, At, B0); PG8_BAR; PG8_SCHED;
            PG8_LDB(B1, 0, 1); PG8_STAGE(PG8_SB(0, 0), b2, voffB);
            PG8_BAR; PG8_WAIT_L(0); PG8_MMA(0, 1, At, B1); PG8_BAR;
            PG8_LDA(At, 0, 1); PG8_STAGE(PG8_SA(0, 0), a2, sA[0]);
            PG8_BAR; PG8_WAIT_L(0); PG8_MMA(1, 0, At, B0); PG8_BAR; PG8_SCHED;
            PG8_STAGE(PG8_SB(0, 1), b2 + hstepB, voffB);
            PG8_WAIT_V(6); PG8_BAR; PG8_MMA(1, 1, At, B1); PG8_BAR;
            PG8_LDB(B0, 1, 0); PG8_SCHED; PG8_LDA(At, 1, 0); PG8_STAGE(PG8_SA(0, 1), a2, sA[1]);
            PG8_WAIT_L(8); PG8_BAR; PG8_WAIT_L(0); PG8_MMA(0, 0, At, B0); PG8_BAR; PG8_SCHED;
            PG8_LDB(B1, 1, 1); PG8_STAGE(PG8_SB(1, 0), b3, voffB);
            PG8_BAR; PG8_WAIT_L(0); PG8_MMA(0, 1, At, B1); PG8_BAR;
            PG8_LDA(At, 1, 1); PG8_STAGE(PG8_SA(1, 0), a3, sA[0]);
            PG8_BAR; PG8_WAIT_L(0); PG8_MMA(1, 0, At, B0); PG8_BAR; PG8_SCHED;
            PG8_STAGE(PG8_SB(1, 1), b3 + hstepB, voffB);
            PG8_WAIT_V(6); PG8_BAR; PG8_MMA(1, 1, At, B1); PG8_BAR;
        }
        GSTAMP(2 * ui);
        if constexpr (Epi::STAGES) E(acc, cur, wr, wc, fr, fq, (const LAS unsigned*)(lds + ROWTAB_OFF) + (ui & 1) * 256); else E(acc, cur, wr, wc, fr, fq);
        GSTAMP(2 * ui + 1);
        if (!has_next) break;
        if (!(Epi::KEEPS && E.keep(cur))) {
#pragma unroll
        for (int a = 0; a < 2; ++a)
#pragma unroll
            for (int b = 0; b < 2; ++b)
#pragma unroll
                for (int m = 0; m < 4; ++m)
#pragma unroll
                    for (int n = 0; n < 2; ++n) acc[a][b][m][n] = (f32x4){0.f, 0.f, 0.f, 0.f};
        }
        cur = nxt; cA = nA; cB = nB; ++ui;
        if constexpr (!Sched::GATHER) {
#pragma unroll
            for (int h = 0; h < 2; ++h)
#pragma unroll
                for (int i = 0; i < 2; ++i) cvA[h][i] = nvA[h][i];
        }
    }
    PG8_WAIT_V(0);
    if (wr == 0) PG8_BAR;
    PG8_BAR;
#undef PG8_SA
#undef PG8_SB
#undef PG8_STAGE
#undef PG8_LDA
#undef PG8_LDB
#undef PG8_MMA
#undef PG8_WAIT_V
#undef PG8_WAIT_L
#undef PG8_BAR
#undef PG8_SCHED
}
}

using pg8::Unit;
struct DenseSched {
    static constexpr bool GATHER = false;
    const char* A; const char* B; int lda, ldb, nM, nN, G, c, nsub; size_t asub, bsub;
    __device__ __forceinline__ bool next(int i, Unit& u) const {
        const int sub = i % nsub, ti = i / nsub; int pm, pn;
        if (!pg8::static_tile(ti, G, c, nM, nN, pm, pn)) return false;
        u.A = A + (size_t)pm * 256 * lda * 2 + (size_t)sub * asub; u.B = B + (size_t)pn * 256 * ldb * 2 + (size_t)sub * bsub;
        u.e0 = pm; u.e1 = pn; u.e2 = sub; u.e3 = 0; u.e4 = 0; return true;
    }
    __device__ __forceinline__ void a_offs(const Unit&, int tid, unsigned (&vo)[2][2]) const {
#pragma unroll
        for (int i = 0; i < 2; ++i) { int R, C; pg8::stage_rc(tid * 16 + i * 8192, R, C);
#pragma unroll
            for (int h = 0; h < 2; ++h) vo[h][i] = (unsigned)((h * 128 + R) * lda + C) * 2u; }
    }
};
constexpr int MOE_TAB_OFF = 131072;
constexpr int MOE_UL_OFF = MOE_TAB_OFF + 1024, MOE_UL_MAX = 24;
#define RFL(x) __builtin_amdgcn_readfirstlane(x)
__device__ __forceinline__ int moe_find_expert(const LAS int* tbase, int mt) {
    int lo = 0, hi = 63;
#pragma unroll
    for (int it = 0; it < 6; ++it) { const int mid = (lo + hi + 1) >> 1; if (RFL(tbase[mid]) <= mt) lo = mid; else hi = mid - 1; }
    return lo;
}
struct MoeGuSched {
    static constexpr bool GATHER = true;
    const char* H2; const char* WGU; const char* WSGU; const unsigned* list; const LAS int* tbase; const LAS int* cnt; int nMs, G, c;
    __device__ __forceinline__ bool next(int i, Unit& u) const {
        if (i >= MOE_UL_MAX) return false;
        const LAS int* ul = tbase + (MOE_UL_OFF - MOE_TAB_OFF) / 4 + i * 8;
        const int e = RFL(ul[0]), nt = RFL(ul[1]), p0 = RFL(ul[2]), t3 = RFL(ul[3]), cn_ = RFL(ul[4]);
        if (e < 0) return false;
        u.e0 = e; u.e1 = nt; u.e2 = p0; u.e3 = t3; u.e4 = cn_;
        if (e != 64) { u.A = H2; u.B = WGU + (size_t)e * (512 * 1024) + (size_t)nt * (256 * 1024); }
        else { u.A = H2 + (size_t)t3 * 256 * 1024; u.B = WSGU + (size_t)nt * (256 * 1024); }
        return true;
    }
    __device__ __forceinline__ void a_offs(const Unit& u, int tid, unsigned (&vo)[2][2]) const {
#pragma unroll
        for (int i = 0; i < 2; ++i) { int R, C; pg8::stage_rc(tid * 16 + i * 8192, R, C); R = launder(R);
#pragma unroll
            for (int h = 0; h < 2; ++h) {
                if (u.e0 == 64) vo[h][i] = (unsigned)((h * 128 + R) * 1024 + C * 2);
                else { const int pos = u.e2 + h * 128 + R; const unsigned tv = list[(size_t)u.e0 * NT + pos] >> 3;
                    vo[h][i] = (pos < u.e4 ? tv : 0u) * 1024u + (unsigned)C * 2u; } } }
    }
};
struct MoeDownSched {
    static constexpr bool GATHER = false;
    const char* ACT; const char* WD; const char* ACTS; const char* WSD; const LAS int* tbase; const LAS int* cnt; int nMs, G, c;
    __device__ __forceinline__ bool next(int i, Unit& u) const {
        if (i >= MOE_UL_MAX) return false;
        const LAS int* ul = tbase + (MOE_UL_OFF - MOE_TAB_OFF) / 4 + i * 8;
        const int e = RFL(ul[0]), pn = RFL(ul[1]), p0 = RFL(ul[2]), t3 = RFL(ul[3]), cn_ = RFL(ul[4]);
        if (e < 0) return false;
        u.e0 = e; u.e1 = pn; u.e2 = p0; u.e3 = t3; u.e4 = cn_;
        if (e != 64) { u.A = ACT + (size_t)t3 * (256 * 256); u.B = WD + (size_t)e * (1024 * 256) + (size_t)pn * (256 * 256); }
        else { u.A = ACTS + (size_t)t3 * (256 * 256); u.B = WSD + (size_t)pn * (256 * 256); }
        return true;
    }
    __device__ __forceinline__ void a_offs(const Unit&, int tid, unsigned (&vo)[2][2]) const {
#pragma unroll
        for (int i = 0; i < 2; ++i) { int R, C; pg8::stage_rc(tid * 16 + i * 8192, R, C);
#pragma unroll
            for (int h = 0; h < 2; ++h) vo[h][i] = (unsigned)((h * 128 + R) * 256 + C * 2); }
    }
};

struct EpiStoreBf16 {
    static constexpr bool STAGES = false;
    static constexpr bool KEEPS = false; __device__ __forceinline__ bool keep(const Unit&) const { return false; }
    static constexpr bool PERM = true;
    bf16_t* O; int ldc; int gate_tile0; unsigned char* G8;
    __device__ __forceinline__ void operator()(const f32x4 (&acc)[2][2][4][2], const Unit& u, int wr, int wc, int fr, int fq) const {
        const int row0 = u.e0 * 256 + launder(wr * 64 + fr), col0 = u.e1 * 256 + wc * 32 + 8 * fq;
        if (u.e1 >= gate_tile0) {
            const int gi = (u.e1 - gate_tile0) >> 2, pn = (u.e1 - gate_tile0) & 3, tidx = launder(((wr * 4 + wc) * 64) + fq * 16 + fr);
            unsigned char* gp = G8 + ((size_t)((u.e0 * 4 + pn) * 3 + gi) * 65536) + (size_t)tidx * 128;
#pragma unroll
            for (int ai = 0; ai < 2; ++ai)
#pragma unroll
                for (int m = 0; m < 4; ++m) { u32x4 w;
#pragma unroll
                    for (int bj = 0; bj < 2; ++bj) { const f32x4 v0 = acc[ai][bj][m][0], v1 = acc[ai][bj][m][1];
                        float q[8] = {v0[0], v0[1], v0[2], v0[3], v1[0], v1[1], v1[2], v1[3]}; unsigned qb[8];
#pragma unroll
                        for (int j = 0; j < 8; ++j) { const float t = fminf(fmaxf(sigmoidf_(q[j]) * 255.0f + 0.5f, 1.0f), 255.0f); qb[j] = (unsigned)t; }
                        const unsigned lo = qb[0] | (qb[1] << 8) | (qb[2] << 16) | (qb[3] << 24), hi = qb[4] | (qb[5] << 8) | (qb[6] << 16) | (qb[7] << 24);
                        if (bj == 0) { w.x = lo; w.y = hi; } else { w.z = lo; w.w = hi; } }
                    *(u32x4*)(gp + (ai * 4 + m) * 16) = w; }
            return;
        }
#pragma unroll
        for (int ai = 0; ai < 2; ++ai)
#pragma unroll
            for (int m = 0; m < 4; ++m) { bf16_t* rowp = O + (size_t)(row0 + ai * 128 + m * 16) * ldc + col0;
#pragma unroll
                for (int bj = 0; bj < 2; ++bj) { const f32x4 v0 = acc[ai][bj][m][0], v1 = acc[ai][bj][m][1];
                    u32x4 w; w.x = pk2(v0[0], v0[1]); w.y = pk2(v0[2], v0[3]); w.z = pk2(v1[0], v1[1]); w.w = pk2(v1[2], v1[3]);
                    *(u32x4*)(rowp + bj * 128) = w; } }
    }
};
struct EpiMerge {
    static constexpr bool PERM = true, KEEPS = true, STAGES = false;
    bf16_t* Mo; const unsigned char* G8;
    __device__ __forceinline__ bool keep(const Unit& u) const { return u.e2 < 2; }
    __device__ __forceinline__ void operator()(f32x4 (&acc)[2][2][4][2], const Unit& u, int wr, int wc, int fr, int fq) const {
        const int row0 = u.e0 * 256 + launder(wr * 64 + fr), col0 = u.e1 * 256 + wc * 32 + 8 * fq, sub = u.e2, tidx = launder(((wr * 4 + wc) * 64) + fq * 16 + fr);
        const unsigned char* gp = G8 + ((size_t)((u.e0 * 4 + u.e1) * 3 + sub) * 65536) + (size_t)tidx * 128;
        u32x4 gq[8], hq[8];
        const unsigned char* hp = gp + (sub < 2 ? 65536 : 0);
#pragma unroll
        for (int k = 0; k < 8; ++k) { gq[k] = *(const u32x4*)(gp + k * 16); hq[k] = *(const u32x4*)(hp + k * 16); }
        if (sub < 2) {
#pragma unroll
            for (int ai = 0; ai < 2; ++ai)
#pragma unroll
                for (int m = 0; m < 4; ++m)
#pragma unroll
                    for (int bj = 0; bj < 2; ++bj) { const u32x4 g4v = gq[ai * 4 + m], h4v = hq[ai * 4 + m];
                        const unsigned g0 = bj ? g4v.z : g4v.x, g1 = bj ? g4v.w : g4v.y, h0 = bj ? h4v.z : h4v.x, h1 = bj ? h4v.w : h4v.y;
                        float f[8];
#pragma unroll
                        for (int j = 0; j < 8; ++j) { const float qg = (float)(((j < 4 ? g0 : g1) >> (8 * (j & 3))) & 255u), qh = (float)(((j < 4 ? h0 : h1) >> (8 * (j & 3))) & 255u);
                            f[j] = qg * __builtin_amdgcn_rcpf(qh); }
                        acc[ai][bj][m][0] = acc[ai][bj][m][0] * (f32x4){f[0], f[1], f[2], f[3]}; acc[ai][bj][m][1] = acc[ai][bj][m][1] * (f32x4){f[4], f[5], f[6], f[7]}; }
        } else {
#pragma unroll
            for (int ai = 0; ai < 2; ++ai)
#pragma unroll
                for (int m = 0; m < 4; ++m)
#pragma unroll
                    for (int bj = 0; bj < 2; ++bj) { const u32x4 g4v = gq[ai * 4 + m];
                        const unsigned g0 = bj ? g4v.z : g4v.x, g1 = bj ? g4v.w : g4v.y;
                        float f[8];
#pragma unroll
                        for (int j = 0; j < 8; ++j) f[j] = (float)(((j < 4 ? g0 : g1) >> (8 * (j & 3))) & 255u) * (1.0f / 255.0f);
                        const f32x4 v0 = acc[ai][bj][m][0] * (f32x4){f[0], f[1], f[2], f[3]}, v1 = acc[ai][bj][m][1] * (f32x4){f[4], f[5], f[6], f[7]};
                        const size_t row = (size_t)(row0 + ai * 128 + m * 16);
                        u32x4 w; w.x = pk2(v0[0], v0[1]); w.y = pk2(v0[2], v0[3]); w.z = pk2(v1[0], v1[1]); w.w = pk2(v1[2], v1[3]);
                        *(u32x4*)(Mo + row * 1024 + col0 + bj * 128) = w; }
        }
    }
};
struct EpiResid {
    static constexpr bool STAGES = false;
    static constexpr bool KEEPS = false; __device__ __forceinline__ bool keep(const Unit&) const { return false; }
    static constexpr bool PERM = false;
    const float* src_l; const float* src_c; float* dst_l; float* dst_c; const float* gate;
    __device__ __forceinline__ void operator()(const f32x4 (&acc)[2][2][4][2], const Unit& u, int wr, int wc, int fr, int fq) const {
        const int g0 = u.e0 * 256; const bool lat = g0 < NL;
        const float* src = lat ? src_l + (size_t)g0 * D : src_c + (size_t)(g0 - NL) * D;
        float* dst = lat ? dst_l + (size_t)g0 * D : dst_c + (size_t)(g0 - NL) * D;
        const float* gp = gate + (size_t)(lat ? (g0 >> 11) : 8) * 6144;
        const int row0 = launder(wr * 64 + fr), col0 = u.e1 * 256 + wc * 32 + 4 * fq;
        f32x4 gv[2][2];
#pragma unroll
        for (int bj = 0; bj < 2; ++bj)
#pragma unroll
            for (int n = 0; n < 2; ++n) gv[bj][n] = *(const f32x4*)(gp + col0 + bj * 128 + n * 16);
#pragma unroll
        for (int am = 0; am < 4; ++am) { const int ai = am >> 1, mh = (am & 1) * 2;
            f32x4 sq[2][2][2];
#pragma unroll
            for (int mm = 0; mm < 2; ++mm)
#pragma unroll
                for (int bj = 0; bj < 2; ++bj)
#pragma unroll
                    for (int n = 0; n < 2; ++n) sq[mm][bj][n] = *(const f32x4*)(src + (size_t)(row0 + ai * 128 + (mh + mm) * 16) * D + col0 + bj * 128 + n * 16);
#pragma unroll
            for (int mm = 0; mm < 2; ++mm)
#pragma unroll
                for (int bj = 0; bj < 2; ++bj)
#pragma unroll
                    for (int n = 0; n < 2; ++n) *(f32x4*)(dst + (size_t)(row0 + ai * 128 + (mh + mm) * 16) * D + col0 + bj * 128 + n * 16) = sq[mm][bj][n] + gv[bj][n] * acc[ai][bj][mh + mm][n];
            if (am == 1) asm volatile("" ::: "memory");
        }
    }
};
struct EpiGateUp {
    static constexpr bool KEEPS = false; __device__ __forceinline__ bool keep(const Unit&) const { return false; }
    static constexpr bool PERM = true, STAGES = true;
    bf16_t* ACT; bf16_t* ACTS; const float* wl;
    __device__ __forceinline__ void stage(const Unit& u, LAS unsigned* dst_wave, int entry) const {
        if (u.e0 != 64) __builtin_amdgcn_global_load_lds((const unsigned*)(wl + (size_t)u.e0 * NT + u.e2 + entry), dst_wave, 4, 0, 0);
    }
    __device__ __forceinline__ void operator()(const f32x4 (&acc)[2][2][4][2], const Unit& u, int wr, int wc, int fr, int fq, const LAS unsigned* tab) const {
        const int row0 = launder(wr * 64 + fr), col0 = u.e1 * 128 + wc * 32 + 8 * fq;
        unsigned char* base = (unsigned char*)(u.e0 == 64 ? ACTS : ACT) + (size_t)u.e3 * 256 * 256;
#pragma unroll
        for (int ai = 0; ai < 2; ++ai)
#pragma unroll
            for (int m = 0; m < 4; ++m) { const int row = row0 + ai * 128 + m * 16; const float tw = __uint_as_float(tab[row]);
                const float w = u.e0 == 64 ? 1.0f : (u.e2 + row < u.e4 ? tw : 0.0f);
                const f32x4 g0 = acc[ai][0][m][0] * 0.03125f, g1 = acc[ai][0][m][1] * 0.03125f, u0 = acc[ai][1][m][0] * (0.03125f * 8.0f * w), u1 = acc[ai][1][m][1] * (0.03125f * 8.0f * w);
                int lo = 0, hi = 0;
                lo = __builtin_amdgcn_cvt_pk_fp8_f32(siluf_(g0[0]) * u0[0], siluf_(g0[1]) * u0[1], lo, false); lo = __builtin_amdgcn_cvt_pk_fp8_f32(siluf_(g0[2]) * u0[2], siluf_(g0[3]) * u0[3], lo, true);
                hi = __builtin_amdgcn_cvt_pk_fp8_f32(siluf_(g1[0]) * u1[0], siluf_(g1[1]) * u1[1], hi, false); hi = __builtin_amdgcn_cvt_pk_fp8_f32(siluf_(g1[2]) * u1[2], siluf_(g1[3]) * u1[3], hi, true);
                *(u32x2*)(base + (size_t)row * 256 + col0) = (u32x2){(unsigned)lo, (unsigned)hi}; }
    }
};
struct EpiDown {
    static constexpr bool KEEPS = false; __device__ __forceinline__ bool keep(const Unit&) const { return false; }
    static constexpr bool PERM = true, STAGES = true;
    bf16_t* O; const unsigned* list; bf16_t* Hs;
    __device__ __forceinline__ void stage(const Unit& u, LAS unsigned* dst_wave, int entry) const {
        if (u.e0 != 64) __builtin_amdgcn_global_load_lds(list + (size_t)u.e0 * NT + u.e2 + entry, dst_wave, 4, 0, 0);
    }
    __device__ __forceinline__ void operator()(const f32x4 (&acc)[2][2][4][2], const Unit& u, int wr, int wc, int fr, int fq, const LAS unsigned* tab) const {
        const int row0 = launder(wr * 64 + fr), col0 = u.e1 * 256 + wc * 32 + 8 * fq;
        if (u.e0 == 64) {
#pragma unroll
            for (int ai = 0; ai < 2; ++ai)
#pragma unroll
                for (int m = 0; m < 4; ++m) { bf16_t* rowp = Hs + (size_t)(u.e3 * 256 + row0 + ai * 128 + m * 16) * 1024 + col0;
#pragma unroll
                    for (int bj = 0; bj < 2; ++bj) { const f32x4 v0 = acc[ai][bj][m][0] * 0.0078125f, v1 = acc[ai][bj][m][1] * 0.0078125f;
                        u32x4 w; w.x = pk2(v0[0], v0[1]); w.y = pk2(v0[2], v0[3]); w.z = pk2(v1[0], v1[1]); w.w = pk2(v1[2], v1[3]);
                        *(u32x4*)(rowp + bj * 128) = w; } }
        } else {
            unsigned dq[2][4];
#pragma unroll
            for (int ai = 0; ai < 2; ++ai)
#pragma unroll
                for (int m = 0; m < 4; ++m) dq[ai][m] = tab[row0 + ai * 128 + m * 16];
#pragma unroll
            for (int ai = 0; ai < 2; ++ai)
#pragma unroll
                for (int m = 0; m < 4; ++m) {
                    if (u.e2 + row0 + ai * 128 + m * 16 < u.e4) { unsigned char* rowp = (unsigned char*)O + (size_t)dq[ai][m] * 1024 + col0;
#pragma unroll
                        for (int bj = 0; bj < 2; ++bj) { const f32x4 v0 = acc[ai][bj][m][0] * 0.0078125f, v1 = acc[ai][bj][m][1] * 0.0078125f;
                            int lo = 0, hi = 0;
                            lo = __builtin_amdgcn_cvt_pk_fp8_f32(v0[0], v0[1], lo, false); lo = __builtin_amdgcn_cvt_pk_fp8_f32(v0[2], v0[3], lo, true);
                            hi = __builtin_amdgcn_cvt_pk_fp8_f32(v1[0], v1[1], hi, false); hi = __builtin_amdgcn_cvt_pk_fp8_f32(v1[2], v1[3], hi, true);
                            *(u32x2*)(rowp + bj * 128) = (u32x2){(unsigned)lo, (unsigned)hi}; } } }
        }
    }
};

struct Params {
    const float* in[26];
    float* out; unsigned char* ws;
    int ph_lo, ph_hi, li, pad;
};
enum { I_X = 0, I_C, I_CTX, I_CCTX, I_WADA, I_BADA, I_NMG, I_NFG, I_WIN, I_CMLNG, I_CMLNB, I_CMWS, I_CMBS, I_RPB, I_DECAY, I_WBR, I_WOUT, I_RW, I_RB,
       I_EG, I_EU, I_ED, I_SG, I_SU, I_SD, I_FG };

__device__ __forceinline__ const float* kin(int i) {
    unsigned off = (unsigned)i * 8u; asm volatile("" : "+s"(off));
    const __attribute__((address_space(4))) char* ka = (const __attribute__((address_space(4))) char*)__builtin_amdgcn_kernarg_segment_ptr();
    return (const float*)*(GAS const float* const __attribute__((address_space(4)))*)(ka + off);
}
__device__ __forceinline__ float* kout_ptr() { unsigned off = 208u; asm volatile("" : "+s"(off));
    const __attribute__((address_space(4))) char* ka = (const __attribute__((address_space(4))) char*)__builtin_amdgcn_kernarg_segment_ptr();
    return (float*)*(GAS float* const __attribute__((address_space(4)))*)(ka + off); }
__device__ __forceinline__ unsigned char* kws_ptr() { unsigned off = 216u; asm volatile("" : "+s"(off));
    const __attribute__((address_space(4))) char* ka = (const __attribute__((address_space(4))) char*)__builtin_amdgcn_kernarg_segment_ptr();
    return (unsigned char*)*(GAS unsigned char* const __attribute__((address_space(4)))*)(ka + off); }
static_assert(__builtin_offsetof(Params, out) == 208 && __builtin_offsetof(Params, ws) == 216, "kernarg offsets");
static_assert(__builtin_offsetof(Params, in) == 0, "kin() reads Params::in at kernarg offset 0");
__device__ __forceinline__ void transpose_item(const float* W, int N, bf16_t* WT, int ldk, int extra, LAS float* scr, int kb, int nb, int lane) {
    const int k0 = 64 * kb, n0 = 32 * nb;
    float wv[32];
#pragma unroll
    for (int i = 0; i < 32; ++i) wv[i] = W[(size_t)(k0 + 2 * i + (lane >> 5)) * N + n0 + (lane & 31)];
#pragma unroll
    for (int i = 0; i < 32; ++i) scr[(2 * i + (lane >> 5)) * 33 + (lane & 31)] = wv[i];
    LDS_WAIT(); asm volatile("" ::: "memory");
    const int c = lane & 7;
#pragma unroll
    for (int j = 0; j < 4; ++j) { const int n = (lane >> 3) + 8 * j; const LAS float* s = scr + (8 * c) * 33 + n;
        u32x4 o; o.x = pk2(s[0 * 33], s[1 * 33]); o.y = pk2(s[2 * 33], s[3 * 33]); o.z = pk2(s[4 * 33], s[5 * 33]); o.w = pk2(s[6 * 33], s[7 * 33]);
        *(u32x4*)(WT + (size_t)(n0 + n + extra) * ldk + k0 + 8 * c) = o; }
    LDS_WAIT(); asm volatile("" ::: "memory");
}
__device__ __forceinline__ void transpose_item_f8(const float* W, int N, unsigned char* WT, int ldk, int extra, float scale, LAS float* scr, int kb, int nb, int lane) {
    const int k0 = 64 * kb, n0 = 32 * nb;
    float wv[32];
#pragma unroll
    for (int i = 0; i < 32; ++i) wv[i] = W[(size_t)(k0 + 2 * i + (lane >> 5)) * N + n0 + (lane & 31)];
#pragma unroll
    for (int i = 0; i < 32; ++i) scr[(2 * i + (lane >> 5)) * 33 + (lane & 31)] = wv[i];
    LDS_WAIT(); asm volatile("" ::: "memory");
    const int c = lane & 7;
#pragma unroll
    for (int j = 0; j < 4; ++j) { const int n = (lane >> 3) + 8 * j; const LAS float* s = scr + (8 * c) * 33 + n;
        int lo = 0, hi = 0;
        lo = __builtin_amdgcn_cvt_pk_fp8_f32(s[0 * 33] * scale, s[1 * 33] * scale, lo, false); lo = __builtin_amdgcn_cvt_pk_fp8_f32(s[2 * 33] * scale, s[3 * 33] * scale, lo, true);
        hi = __builtin_amdgcn_cvt_pk_fp8_f32(s[4 * 33] * scale, s[5 * 33] * scale, hi, false); hi = __builtin_amdgcn_cvt_pk_fp8_f32(s[6 * 33] * scale, s[7 * 33] * scale, hi, true);
        *(u32x2*)(WT + (size_t)(n0 + n + extra) * ldk + k0 + 8 * c) = (u32x2){(unsigned)lo, (unsigned)hi}; }
    LDS_WAIT(); asm volatile("" ::: "memory");
}
constexpr int IT_IN = 16 * 224, IT_BR = 3 * 8 * 32, IT_OUT = 16 * 32, IT_SG = 16 * 8, IT_SD = 4 * 32, IT_RT = 16 * 2, IT_CM = 128;
constexpr int MISC_ITEMS = IT_IN + IT_BR + IT_OUT + 2 * IT_SG + IT_SD + IT_RT + IT_CM;
__device__ __forceinline__ void misc_item(const Params& p, int l, int r, LAS float* scr, int lane) {
    unsigned char* wm = p.ws + WS_WM + (size_t)l * WM_STRIDE;
    if (r < IT_IN) { transpose_item(kin(I_WIN) + (size_t)l * 1024 * 7168, 7168, (bf16_t*)(wm + WM_IN), 1024, 0, scr, r / 224, r % 224, lane); return; } r -= IT_IN;
    if (r < IT_BR) { const int i = r / 256, q = r % 256; transpose_item(kin(I_WBR) + ((size_t)l * 3 + i) * 512 * 1024, 1024, (bf16_t*)(wm + WM_BR) + (size_t)i * 1024 * 512, 512, 0, scr, q / 32, q % 32, lane); return; } r -= IT_BR;
    if (r < IT_OUT) { transpose_item(kin(I_WOUT) + (size_t)l * 1024 * 1024, 1024, (bf16_t*)(wm + WM_OUT), 1024, 0, scr, r / 32, r % 32, lane); return; } r -= IT_OUT;
    if (r < 2 * IT_SG) { const int up = r / IT_SG, q = r % IT_SG, nb = q % 8;
        transpose_item_f8(kin(up ? I_SU : I_SG) + (size_t)l * 1024 * 256, 256, (unsigned char*)(wm + WM_SGU), 1024, ((32 * nb) / 128) * 128 + up * 128, 32.0f, scr, q / 8, nb, lane); return; } r -= 2 * IT_SG;
    if (r < IT_SD) { transpose_item_f8(kin(I_SD) + (size_t)l * 256 * 1024, 1024, (unsigned char*)(wm + WM_SD), 256, 0, 16.0f, scr, r / 32, r % 32, lane); return; } r -= IT_SD;
    if (r < IT_RT) { transpose_item(kin(I_RW) + (size_t)l * 1024 * 64, 64, (bf16_t*)(wm + WM_RT), 1024, 0, scr, r / 2, r % 2, lane); return; } r -= IT_RT;
    { const float* src = kin(I_CMWS) + (size_t)l * 65536 + (size_t)r * 512 + lane * 8; const f32x4 a = *(const f32x4*)src, b = *(const f32x4*)(src + 4);
      u32x4 o; o.x = pk2(a[0], a[1]); o.y = pk2(a[2], a[3]); o.z = pk2(b[0], b[1]); o.w = pk2(b[2], b[3]);
      *(u32x4*)((bf16_t*)(wm + WM_CM) + (size_t)r * 512 + lane * 8) = o; }
}
constexpr int EXP_ITEMS = 3 * 64 * 128;
constexpr int FILL_SPLIT = 34000;
__device__ __forceinline__ void expert_item(const Params& p, int l, int r, LAS float* scr, int lane) {
    unsigned char* we = p.ws + WS_WE + (size_t)l * WE_LAYER;
    const int which = r / 8192, q = r % 8192, e = q / 128, it = q % 128;
    if (which < 2) { const int kb = it / 8, nb = it % 8;
        transpose_item_f8(kin(which ? I_EU : I_EG) + ((size_t)l * 64 + e) * 1024 * 256, 256, (unsigned char*)(we + WE_GU) + (size_t)e * 512 * 1024, 1024, ((32 * nb) / 128) * 128 + which * 128, 32.0f, scr, kb, nb, lane); }
    else { const int kb = it / 32, nb = it % 32;
        transpose_item_f8(kin(I_ED) + ((size_t)l * 64 + e) * 256 * 1024, 1024, (unsigned char*)(we + WE_D) + (size_t)e * 1024 * 256, 256, 0, 16.0f, scr, kb, nb, lane); }
}
__device__ __forceinline__ void mod_unit(const Params& p, LAS unsigned char* lds, int u, int tid) {
    const int l = u / 96, cb = u % 96, wave = __builtin_amdgcn_readfirstlane(tid >> 6), lane = tid & 63;
    LAS float* sil = (LAS float*)lds;
    LAS float* part = (LAS float*)(lds + 36864);
    for (int idx = tid; idx < 9 * 1024; idx += NTHREADS) { const int r = idx >> 10, k = idx & 1023; const float v = r < 8 ? kin(I_C)[r * 1024 + k] : kin(I_CCTX)[k]; sil[idx] = v / (1.0f + expf(-v)); }
    __syncthreads();
    float acc[9];
#pragma unroll
    for (int r = 0; r < 9; ++r) acc[r] = 0.f;
    const float* wp = kin(I_WADA) + ((size_t)l * 1024 + wave * 128) * 6144 + cb * 64 + lane;
#pragma unroll 4
    for (int k = 0; k < 128; ++k) { const float wv = wp[(size_t)k * 6144];
#pragma unroll
        for (int r = 0; r < 9; ++r) acc[r] += sil[r * 1024 + wave * 128 + k] * wv; }
#pragma unroll
    for (int r = 0; r < 9; ++r) part[(wave * 9 + r) * 64 + lane] = acc[r];
    __syncthreads();
    for (int idx = tid; idx < 576; idx += NTHREADS) { const int r = idx >> 6, ln = idx & 63; float s = kin(I_BADA)[l * 6144 + cb * 64 + ln];
#pragma unroll
        for (int w = 0; w < 8; ++w) s += part[(w * 9 + r) * 64 + ln];
        ((float*)(p.ws + WS_MOD))[((size_t)l * 9 + r) * 6144 + cb * 64 + ln] = s; }
    __syncthreads();
}

__device__ __forceinline__ void norm_mod_vals(const f32x4 (&v)[4], const float* g, const float* sh, const float* sc, bf16_t* orow, bool to_lds, LAS unsigned char* ldst, int lane) {
    float ss = 0.f;
#pragma unroll
    for (int j = 0; j < 4; ++j) ss += (v[j][0] * v[j][0] + v[j][1] * v[j][1]) + (v[j][2] * v[j][2] + v[j][3] * v[j][3]);
    const float rstd = rsqrtf(wave_sum(ss, lane) * (1.0f / 1024.0f) + EPS);
#pragma unroll
    for (int j = 0; j < 4; ++j) { const f32x4 gg = ((const f32x4*)g)[64 * j + lane], s_h = ((const f32x4*)sh)[64 * j + lane], s_c = ((const f32x4*)sc)[64 * j + lane];
        const f32x4 y = v[j] * rstd * gg * (s_c + 1.0f) + s_h;
        u32x2 o; o.x = pk2(y[0], y[1]); o.y = pk2(y[2], y[3]);
        ((u32x2*)orow)[64 * j + lane] = o;
        if (to_lds) *(LAS u32x2*)(ldst + (64 * j + lane) * 8) = o; }
}
__device__ __forceinline__ void norm_mod_row(const float* xrow, const float* g, const float* sh, const float* sc, bf16_t* orow, bool to_lds, LAS unsigned char* ldst, int lane) {
    f32x4 v[4];
#pragma unroll
    for (int j = 0; j < 4; ++j) v[j] = ((const f32x4*)xrow)[64 * j + lane];
    norm_mod_vals(v, g, sh, sc, orow, to_lds, ldst, lane);
}
__device__ __forceinline__ void combine_row(f32x4 (&v)[4], const float* xrow, const float* ga2, const bf16_t* shrow, const unsigned char* o8, int lane) {
    u32x2 sq[4]; unsigned oq[8][4];
#pragma unroll
    for (int j = 0; j < 4; ++j) { v[j] = ((const f32x4*)xrow)[64 * j + lane]; sq[j] = ((const u32x2*)shrow)[64 * j + lane]; }
#pragma unroll
    for (int k = 0; k < 8; ++k)
#pragma unroll
        for (int j = 0; j < 4; ++j) oq[k][j] = ((const unsigned*)(o8 + (size_t)k * 1024))[64 * j + lane];
#pragma unroll
    for (int j = 0; j < 4; ++j) { f32x4 t = (f32x4){lo16(sq[j].x), hi16(sq[j].x), lo16(sq[j].y), hi16(sq[j].y)};
#pragma unroll
        for (int k = 0; k < 8; ++k) { const int w = (int)oq[k][j];
            t[0] += __builtin_amdgcn_cvt_f32_fp8(w, 0); t[1] += __builtin_amdgcn_cvt_f32_fp8(w, 1); t[2] += __builtin_amdgcn_cvt_f32_fp8(w, 2); t[3] += __builtin_amdgcn_cvt_f32_fp8(w, 3); }
        v[j] += ((const f32x4*)ga2)[64 * j + lane] * t; }
}

constexpr int RT_TILE = 0, RT_PITCH = 2064, RT_LG = 64 * RT_PITCH  , RT_BIAS = RT_LG + 64 * 65 * 4  , RT_LCNT = RT_BIAS + 256, RT_LBASE = RT_LCNT + 256,
              RT_SELE = RT_LBASE + 256  , RT_SELW = RT_SELE + 2048, RT_SELR = RT_SELW + 2048, RT_END = RT_SELR + 2048;
static_assert(RT_END <= LDS_BYTES, "router LDS");
#ifdef TIMING
#define RSTAMP(k) do { if (stamp && tid == 0) ((volatile LAS unsigned long long*)(lds + LDS_BYTES - 16 - 512))[24 + (k)] = __builtin_amdgcn_s_memrealtime(); } while (0)
#else
#define RSTAMP(k) do { } while (0)
#endif
__device__ __forceinline__ void router_unit(const Params& p, LAS unsigned char* lds, int l, int u, const float* xl, const float* xc, int tid, bool commit, bool stamp = false) {
    const int wave = __builtin_amdgcn_readfirstlane(tid >> 6), lane = tid & 63, g4 = lane >> 4, row0 = u * 64;
    const bool lat = row0 < NL;
    const float* mr = (const float*)(p.ws + WS_MOD) + (size_t)l * 9 * 6144 + (size_t)(lat ? (row0 >> 11) : 8) * 6144;
    const float* xbase = lat ? xl + (size_t)row0 * D : xc + (size_t)(row0 - NL) * D;
    unsigned char* H2 = (unsigned char*)(p.ws + WS_H) + (size_t)row0 * D;
    LAS float* lg = (LAS float*)(lds + RT_LG); LAS float* bias = (LAS float*)(lds + RT_BIAS);
    LAS int* lcnt = (LAS int*)(lds + RT_LCNT); LAS int* lbase = (LAS int*)(lds + RT_LBASE);
    LAS int* sele = (LAS int*)(lds + RT_SELE); LAS float* selw = (LAS float*)(lds + RT_SELW); LAS int* selr = (LAS int*)(lds + RT_SELR);
    RSTAMP(0);
    if (tid < 64) { lcnt[tid] = 0; bias[tid] = kin(I_RB)[l * 64 + tid]; }
    const int rb = wave >> 1, eb0 = (wave & 1) * 2;
    const bf16_t* w0 = (const bf16_t*)(p.ws + WS_WM + (size_t)l * WM_STRIDE + WM_RT) + launder((eb0 * 16 + (lane & 15)) * 1024 + g4 * 8); const bf16_t* w1 = w0 + launder(16 * 1024);
    bf16x8 qa0[4], qa1[4];
#pragma unroll
    for (int ks = 0; ks < 4; ++ks) { qa0[ks] = *(const bf16x8*)(w0 + ks * 32); qa1[ks] = *(const bf16x8*)(w1 + ks * 32); }
    { f32x4 gg[4], s_h[4], s_c[4];
#pragma unroll
      for (int j = 0; j < 4; ++j) { gg[j] = ((const f32x4*)(kin(I_NFG) + l * 1024))[64 * j + lane]; s_h[j] = ((const f32x4*)(mr + 3072))[64 * j + lane]; s_c[j] = ((const f32x4*)(mr + 4096))[64 * j + lane] + 1.0f; }
#pragma unroll
      for (int hb = 0; hb < 2; ++hb) { f32x4 v[4][4];
#pragma unroll
          for (int i = 0; i < 4; ++i)
#pragma unroll
              for (int j = 0; j < 4; ++j) v[i][j] = ((const f32x4*)(xbase + (size_t)(wave * 8 + hb * 4 + i) * D))[64 * j + lane];
#pragma unroll
          for (int i = 0; i < 4; ++i) { const int rl = wave * 8 + hb * 4 + i; float ss = 0.f;
#pragma unroll
              for (int j = 0; j < 4; ++j) ss += (v[i][j][0] * v[i][j][0] + v[i][j][1] * v[i][j][1]) + (v[i][j][2] * v[i][j][2] + v[i][j][3] * v[i][j][3]);
              const float rstd = rsqrtf(wave_sum(ss, lane) * (1.0f / 1024.0f) + EPS);
#pragma unroll
              for (int j = 0; j < 4; ++j) { const f32x4 y = v[i][j] * rstd * gg[j] * s_c[j] + s_h[j];
                  u32x2 o; o.x = pk2(y[0], y[1]); o.y = pk2(y[2], y[3]);
                  int q8 = 0; q8 = __builtin_amdgcn_cvt_pk_fp8_f32(y[0], y[1], q8, false); q8 = __builtin_amdgcn_cvt_pk_fp8_f32(y[2], y[3], q8, true);
                  ((unsigned*)(H2 + (size_t)rl * D))[64 * j + lane] = (unsigned)q8; *(LAS u32x2*)(lds + RT_TILE + rl * RT_PITCH + (64 * j + lane) * 8) = o; } } } }
    __syncthreads();
    RSTAMP(1);
    { f32x4 a0 = (f32x4){0.f, 0.f, 0.f, 0.f}, a1 = a0;
      const LAS unsigned char* hrow = lds + RT_TILE + (rb * 16 + (lane & 15)) * RT_PITCH + g4 * 16;
      bf16x8 qb0[4], qb1[4];
      sfor<0, 4>([&](auto it_) { constexpr int it = decltype(it_)::value;
#pragma unroll
          for (int ks = 0; ks < 4; ++ks) { qb0[ks] = *(const bf16x8*)(w0 + ((2 * it + 1) * 4 + ks) * 32); qb1[ks] = *(const bf16x8*)(w1 + ((2 * it + 1) * 4 + ks) * 32); }
#pragma unroll
          for (int ks = 0; ks < 4; ++ks) { const bf16x8 bq = *(const LAS bf16x8*)(hrow + ((2 * it) * 4 + ks) * 64); a0 = mfma16(qa0[ks], bq, a0); a1 = mfma16(qa1[ks], bq, a1); }
          if constexpr (it < 3) {
#pragma unroll
              for (int ks = 0; ks < 4; ++ks) { qa0[ks] = *(const bf16x8*)(w0 + ((2 * it + 2) * 4 + ks) * 32); qa1[ks] = *(const bf16x8*)(w1 + ((2 * it + 2) * 4 + ks) * 32); } }
#pragma unroll
          for (int ks = 0; ks < 4; ++ks) { const bf16x8 bq = *(const LAS bf16x8*)(hrow + ((2 * it + 1) * 4 + ks) * 64); a0 = mfma16(qb0[ks], bq, a0); a1 = mfma16(qb1[ks], bq, a1); } });
      const int rr = rb * 16 + (lane & 15);
#pragma unroll
      for (int r = 0; r < 4; ++r) { lg[rr * 65 + eb0 * 16 + 4 * g4 + r] = sigmoidf_(a0[r]); lg[rr * 65 + (eb0 + 1) * 16 + 4 * g4 + r] = sigmoidf_(a1[r]); } }
    __syncthreads();
    RSTAMP(2);
    { const int row = tid >> 3, g = tid & 7;
      float sv[8]; unsigned key[8];
#pragma unroll
      for (int j = 0; j < 8; ++j) { sv[j] = lg[row * 65 + 8 * g + j]; const unsigned ub = __float_as_uint(sv[j] + bias[8 * g + j]);
          key[j] = ((ub ^ ((ub >> 31) ? 0xffffffffu : 0x80000000u)) & ~63u) | (unsigned)(63 - (8 * g + j)); }
      float m1 = -3e38f, m2 = -3e38f;
#pragma unroll
      for (int j = 0; j < 8; ++j) { const float c = sv[j] + bias[8 * g + j]; if (c > m1) { m2 = m1; m1 = c; } else if (c > m2) m2 = c; }
      const unsigned ug = __float_as_uint(m1 + m2); const unsigned gkey = ((ug ^ ((ug >> 31) ? 0xffffffffu : 0x80000000u)) & ~7u) | (unsigned)(7 - g);
      int grank = 0;
      sfor<1, 8>([&](auto d_) { constexpr int d = decltype(d_)::value; grank += (int)((unsigned)shxi((int)gkey, d, lane) > gkey); });
      const bool gsel = grank < 4;
#pragma unroll
      for (int j = 0; j < 8; ++j) if (!gsel) key[j] = (unsigned)(63 - (8 * g + j));
      int rk[8];
#pragma unroll
      for (int j = 0; j < 8; ++j) { int r = 0;
#pragma unroll
          for (int j2 = 0; j2 < 8; ++j2) r += (int)(key[j2] > key[j]);
          rk[j] = r; }
      sfor<1, 8>([&](auto d_) { constexpr int d = decltype(d_)::value;
          sfor<0, 8>([&](auto j2_) { constexpr int j2 = decltype(j2_)::value; const unsigned ok = (unsigned)shxi((int)key[j2], d, lane);
#pragma unroll
              for (int j = 0; j < 8; ++j) rk[j] += (int)(ok > key[j]); });
          __builtin_amdgcn_sched_barrier(0); });
      float wsum = 0.f;
#pragma unroll
      for (int j = 0; j < 8; ++j) if (gsel && rk[j] < 8) wsum += sv[j];
      wsum += shx(wsum, 1, lane); wsum += shx(wsum, 2, lane); wsum += shx(wsum, 4, lane);
      const float sc = 2.5f / wsum;
#pragma unroll
      for (int j = 0; j < 8; ++j) if (gsel && rk[j] < 8) { const int e = 8 * g + j, k = rk[j];
          sele[row * 8 + k] = e; selw[row * 8 + k] = sv[j] * sc; selr[row * 8 + k] = __hip_atomic_fetch_add(&lcnt[e], 1, __ATOMIC_RELAXED, __HIP_MEMORY_SCOPE_WORKGROUP); } }
    __syncthreads();
    RSTAMP(3);
    if (tid < 64) { const int n = lcnt[tid]; int base = 0; if (n > 0 && commit) base = (int)atomicAdd((unsigned*)(p.ws + WS_CTL) + CW_CNT + l * 2048 + tid * 16, (unsigned)n); lbase[tid] = base; }
    __syncthreads();
    RSTAMP(4);
    { const int rl = tid >> 3, k = tid & 7, e = sele[rl * 8 + k], pos = lbase[e] + selr[rl * 8 + k];
      if (commit) { ((unsigned*)(p.ws + WS_LIST))[(size_t)e * NT + pos] = (unsigned)((row0 + rl) * 8 + k); ((float*)(p.ws + WS_WL))[(size_t)e * NT + pos] = selw[rl * 8 + k]; } }
    __syncthreads();
    RSTAMP(5);
}

__device__ __forceinline__ void mixA_unit(const Params& p, LAS unsigned char* lds, int l, int ch, int g, int tid) {
    const int wave = __builtin_amdgcn_readfirstlane(tid >> 6), lane = tid & 63, g4 = lane >> 4, rows0 = ch * 128;
    const bf16_t* Z = (const bf16_t*)(p.ws + WS_R + R_Z); bf16_t* BR = (bf16_t*)(p.ws + WS_R + R_BR);
    const bf16_t* WCM = (const bf16_t*)(p.ws + WS_WM + (size_t)l * WM_STRIDE + WM_CM);
    LAS unsigned char* vn = lds + 1024;
    { const int q = tid >> 2, cs = (tid & 3) * 32; const f32x2 st2 = *(const f32x2*)((const float*)(p.ws + WS_R + R_STAT) + (size_t)(rows0 + q) * 2); const float mean = st2[0], rstd = st2[1];
      const float* lg = kin(I_CMLNG) + l * 512 + g * 128 + cs; const float* lb = kin(I_CMLNB) + l * 512 + g * 128 + cs;
#pragma unroll
      for (int j = 0; j < 4; ++j) { const u32x4 v = *(const u32x4*)(Z + (size_t)(rows0 + q) * ZW + ZC_AV + g * 128 + cs + 8 * j);
          const f32x4 ga = *(const f32x4*)(lg + 8 * j), gb = *(const f32x4*)(lg + 8 * j + 4), ba = *(const f32x4*)(lb + 8 * j), bb = *(const f32x4*)(lb + 8 * j + 4);
          u32x4 o;
          o.x = pk2((geluf_(lo16(v.x)) - mean) * rstd * ga[0] + ba[0], (geluf_(hi16(v.x)) - mean) * rstd * ga[1] + ba[1]);
          o.y = pk2((geluf_(lo16(v.y)) - mean) * rstd * ga[2] + ba[2], (geluf_(hi16(v.y)) - mean) * rstd * ga[3] + ba[3]);
          o.z = pk2((geluf_(lo16(v.z)) - mean) * rstd * gb[0] + bb[0], (geluf_(hi16(v.z)) - mean) * rstd * gb[1] + bb[1]);
          o.w = pk2((geluf_(lo16(v.w)) - mean) * rstd * gb[2] + bb[2], (geluf_(hi16(v.w)) - mean) * rstd * gb[3] + bb[3]);
          *(LAS u32x4*)(vn + q * 272 + (cs + 8 * j) * 2) = o; } }
    __syncthreads();
    { const int pb = wave, pp = pb * 16 + (lane & 15);
      bf16x8 bfr[4];
#pragma unroll
      for (int ks = 0; ks < 4; ++ks) bfr[ks] = *(const bf16x8*)(WCM + (size_t)(g * 128 + pp) * 128 + 32 * ks + 8 * g4);
      const unsigned vna = tr_lane(lds_addr(vn), 272, 8, lane);
      const float bs = kin(I_CMBS)[l * 512 + g * 128 + pp];
      const size_t row = (size_t)(rows0 + pp);
      sfor<0, 2>([&](auto cg_) { constexpr int cg = decltype(cg_)::value; f32x4 acc[4];
#pragma unroll
          for (int i = 0; i < 4; ++i) acc[i] = (f32x4){0.f, 0.f, 0.f, 0.f};
          sfor<0, 4>([&](auto ks_) { constexpr int ks = decltype(ks_)::value; bf16x8 af[4]; tr_frag4_i<32 * ks * 272 + 128 * cg, 4 * 272>(vna, af);
#pragma unroll
              for (int i = 0; i < 4; ++i) acc[i] = mfma16(af[i], bfr[ks], acc[i]); });
#pragma unroll
          for (int i = 0; i < 4; ++i) { const int c = 16 * (4 * cg + i) + 4 * g4;
          const u32x2 uu = *(const u32x2*)(Z + row * ZW + ZC_AU + g * 128 + c);
          u32x2 o; o.x = pk2(geluf_(lo16(uu.x)) * (acc[i][0] + bs), geluf_(hi16(uu.x)) * (acc[i][1] + bs)); o.y = pk2(geluf_(lo16(uu.y)) * (acc[i][2] + bs), geluf_(hi16(uu.y)) * (acc[i][3] + bs));
          *(u32x2*)(BR + row * BRW + g * 128 + c) = o; } }); }
    __syncthreads();
}

__device__ __forceinline__ void ret_stage_qk(const bf16_t* src  , const float* rope, bool do_rope, int tpos0, int mask  , LAS unsigned char* t0, LAS unsigned char* t1, LAS unsigned char* t2,
                                             float sc0, float l2a, float offa, float siga, float l2b, float offb, float sigb, int tid) {
    const int pp = tid >> 2, half = (tid >> 1) & 1, sub = tid & 1;
    const bf16_t* s = src + (size_t)pp * ZW + 32 * half + 8 * sub;
    const u32x4 a = *(const u32x4*)s, b = *(const u32x4*)(s + 16);
    float x1[8] = {lo16(a.x), hi16(a.x), lo16(a.y), hi16(a.y), lo16(a.z), hi16(a.z), lo16(a.w), hi16(a.w)};
    float x2[8] = {lo16(b.x), hi16(b.x), lo16(b.y), hi16(b.y), lo16(b.z), hi16(b.z), lo16(b.w), hi16(b.w)};
    float o1[8], o2[8];
    if (do_rope) { const int t = tpos0 + pp, pos = half ? (t & 63) : (t >> 6); const f32x4* tb = (const f32x4*)(rope + (size_t)(pos * 16 + 8 * sub) * 2);
#pragma unroll
        for (int j = 0; j < 4; ++j) { const f32x4 cs = tb[j];
            o1[2 * j] = x1[2 * j] * cs[0] - x2[2 * j] * cs[1]; o2[2 * j] = x1[2 * j] * cs[1] + x2[2 * j] * cs[0];
            o1[2 * j + 1] = x1[2 * j + 1] * cs[2] - x2[2 * j + 1] * cs[3]; o2[2 * j + 1] = x1[2 * j + 1] * cs[3] + x2[2 * j + 1] * cs[2]; } }
    else {
#pragma unroll
        for (int j = 0; j < 8; ++j) { o1[j] = x1[j]; o2[j] = x2[j]; } }
    const int off = pp * 144 + (32 * half + 8 * sub) * 2;
    const float fp = (float)pp;
    const float sA = sc0 * __builtin_amdgcn_exp2f((offa + siga * fp) * l2a), sB = sc0 * __builtin_amdgcn_exp2f((offb + sigb * fp) * l2b);
    if (mask & 1) { u32x4 w; w.x = pk2(o1[0] * sc0, o1[1] * sc0); w.y = pk2(o1[2] * sc0, o1[3] * sc0); w.z = pk2(o1[4] * sc0, o1[5] * sc0); w.w = pk2(o1[6] * sc0, o1[7] * sc0); *(LAS u32x4*)(t0 + off) = w;
              w.x = pk2(o2[0] * sc0, o2[1] * sc0); w.y = pk2(o2[2] * sc0, o2[3] * sc0); w.z = pk2(o2[4] * sc0, o2[5] * sc0); w.w = pk2(o2[6] * sc0, o2[7] * sc0); *(LAS u32x4*)(t0 + off + 32) = w; }
    if (mask & 2) { u32x4 w; w.x = pk2(o1[0] * sA, o1[1] * sA); w.y = pk2(o1[2] * sA, o1[3] * sA); w.z = pk2(o1[4] * sA, o1[5] * sA); w.w = pk2(o1[6] * sA, o1[7] * sA); *(LAS u32x4*)(t1 + off) = w;
              w.x = pk2(o2[0] * sA, o2[1] * sA); w.y = pk2(o2[2] * sA, o2[3] * sA); w.z = pk2(o2[4] * sA, o2[5] * sA); w.w = pk2(o2[6] * sA, o2[7] * sA); *(LAS u32x4*)(t1 + off + 32) = w; }
    if (mask & 4) { u32x4 w; w.x = pk2(o1[0] * sB, o1[1] * sB); w.y = pk2(o1[2] * sB, o1[3] * sB); w.z = pk2(o1[4] * sB, o1[5] * sB); w.w = pk2(o1[6] * sB, o1[7] * sB); *(LAS u32x4*)(t2 + off) = w;
              w.x = pk2(o2[0] * sB, o2[1] * sB); w.y = pk2(o2[2] * sB, o2[3] * sB); w.z = pk2(o2[4] * sB, o2[5] * sB); w.w = pk2(o2[6] * sB, o2[7] * sB); *(LAS u32x4*)(t2 + off + 32) = w; }
}
__device__ __forceinline__ void ret_stage_v(const bf16_t* src  , LAS unsigned char* tv, int tid) {
    const int pp = tid >> 2, seg = (tid & 3) * 32;
#pragma unroll
    for (int j = 0; j < 4; ++j) *(LAS u32x4*)(tv + pp * 272 + (seg + 8 * j) * 2) = *(const u32x4*)(src + (size_t)pp * ZW + seg + 8 * j);
}
__device__ __forceinline__ float log2_gamma(const Params& p, int l, int dir, int h) { const float x = kin(I_DECAY)[(l * 2 + dir) * 4 + h]; return -log2f(1.0f + expf(-x)); }
__device__ __forceinline__ int ret_row0(int b, int cc) { return cc < 2 ? NL + b * 256 + cc * 128 : b * 2048 + (cc - 2) * 128; }

__device__ __forceinline__ void retkv_unit(const Params& p, LAS unsigned char* lds, int l, int b, int h, int cc, int tid) {
    const int wave = __builtin_amdgcn_readfirstlane(tid >> 6), lane = tid & 63, g4 = lane >> 4, row0 = ret_row0(b, cc);
    const bf16_t* Z = (const bf16_t*)(p.ws + WS_R + R_Z); float* KV = (float*)(p.ws + WS_R + R_KV);
    const float l2f = log2_gamma(p, l, 0, h), l2b = log2_gamma(p, l, 1, h);
    LAS unsigned char* kf = lds; LAS unsigned char* kb = lds + 18432; LAS unsigned char* vv = lds + 36864;
    ret_stage_qk(Z + (size_t)row0 * ZW + ZC_RK + h * 64, (const float*)(p.ws + WS_ROPE), cc >= 2, (cc - 2) * 128, 6, kf, kf, kb, 0.125f, l2f, 127.f, -1.f, l2b, 0.f, 1.f, tid);
    ret_stage_v(Z + (size_t)row0 * ZW + ZC_RV + h * 128, vv, tid);
    __syncthreads();
    { const int dir = wave >> 2, db = wave & 3; const unsigned ka = tr_lane(lds_addr(dir ? kb : kf), 144, 8, lane) + 32 * db, va = tr_lane(lds_addr(vv), 272, 8, lane);
      bf16x8 afr[4];
      sfor<0, 4>([&](auto ks_) { constexpr int ks = decltype(ks_)::value; afr[ks] = tr_frag_i<32 * ks * 144, 32 * ks * 144 + 4 * 144>(ka); });
      float* dst = KV + ((((size_t)b * 4 + h) * NCHUNK + cc) * 2 + dir) * 8192;
      sfor<0, 2>([&](auto eg_) { constexpr int eg = decltype(eg_)::value; f32x4 acc[4];
#pragma unroll
          for (int i = 0; i < 4; ++i) acc[i] = (f32x4){0.f, 0.f, 0.f, 0.f};
          sfor<0, 4>([&](auto ks_) { constexpr int ks = decltype(ks_)::value; bf16x8 bf[4]; tr_frag4_i<32 * ks * 272 + 128 * eg, 4 * 272>(va, bf);
#pragma unroll
              for (int i = 0; i < 4; ++i) acc[i] = mfma16(afr[ks], bf[i], acc[i]); });
#pragma unroll
          for (int i = 0; i < 4; ++i)
#pragma unroll
              for (int r = 0; r < 4; ++r) dst[(16 * db + 4 * g4 + r) * 128 + 16 * (4 * eg + i) + (lane & 15)] = acc[i][r]; }); }
    __syncthreads();
}

__device__ __forceinline__ void retout_unit(const Params& p, LAS unsigned char* lds, int l, int b, int h, int cc, int tid) {
    const int wave = __builtin_amdgcn_readfirstlane(tid >> 6), lane = tid & 63, g4 = lane >> 4, row0 = ret_row0(b, cc);
    const bf16_t* Z = (const bf16_t*)(p.ws + WS_R + R_Z); bf16_t* BR = (bf16_t*)(p.ws + WS_R + R_BR);
    const float l2f = log2_gamma(p, l, 0, h), l2b = log2_gamma(p, l, 1, h);
    LAS unsigned char* tq = lds; LAS unsigned char* tqf = lds + 18432; LAS unsigned char* tqb = lds + 36864; LAS unsigned char* tk = lds + 55296;
    LAS unsigned char* tv = lds + 73728; LAS unsigned char* st = lds + 108544;
    { const u32x4* src = (const u32x4*)((const bf16_t*)(p.ws + WS_R + R_ST) + (((size_t)b * 4 + h) * NCHUNK + cc) * 2 * 8192);
#pragma unroll
      for (int j = 0; j < 4; ++j) { const int c = tid + 512 * j; *(LAS u32x4*)(st + (c >> 4) * 272 + (c & 15) * 16) = src[c]; } }
    const float* rope = (const float*)(p.ws + WS_ROPE);
    ret_stage_qk(Z + (size_t)row0 * ZW + ZC_RQ + h * 64, rope, cc >= 2, (cc - 2) * 128, 7, tq, tqf, tqb, 1.0f, l2f, 1.f, 1.f, l2b, 128.f, -1.f, tid);
    ret_stage_qk(Z + (size_t)row0 * ZW + ZC_RK + h * 64, rope, cc >= 2, (cc - 2) * 128, 1, tk, tk, tk, 0.125f, 0.f, 0.f, 0.f, 0.f, 0.f, 0.f, tid);
    ret_stage_v(Z + (size_t)row0 * ZW + ZC_RV + h * 128, tv, tid);
    __syncthreads();
    const int ib = wave, ti = ib * 16 + (lane & 15);
    f32x4 oacc[8];
#pragma unroll
    for (int eb = 0; eb < 8; ++eb) oacc[eb] = (f32x4){0.f, 0.f, 0.f, 0.f};
    { bf16x8 bq[4];
#pragma unroll
      for (int ks = 0; ks < 4; ++ks) bq[ks] = *(const LAS bf16x8*)((ks < 2 ? tqf : tqb) + ti * 144 + (32 * (ks & 1) + 8 * g4) * 2);
      const unsigned sa = tr_lane(lds_addr(st), 272, 8, lane);
      sfor<0, 4>([&](auto ks_) { constexpr int ks = decltype(ks_)::value;
          sfor<0, 2>([&](auto eg_) { constexpr int eg = decltype(eg_)::value; bf16x8 af[4]; tr_frag4_i<32 * ks * 272 + 128 * eg, 4 * 272>(sa, af);
#pragma unroll
              for (int i = 0; i < 4; ++i) oacc[4 * eg + i] = mfma16(af[i], bq[ks], oacc[4 * eg + i]); }); }); }
    { bf16x8 bq[2];
#pragma unroll
      for (int ks = 0; ks < 2; ++ks) bq[ks] = *(const LAS bf16x8*)(tq + ti * 144 + (32 * ks + 8 * g4) * 2);
      f32x4 sacc[8];
#pragma unroll
      for (int jb = 0; jb < 8; ++jb) { sacc[jb] = (f32x4){0.f, 0.f, 0.f, 0.f};
#pragma unroll
          for (int ks = 0; ks < 2; ++ks) { const bf16x8 a = *(const LAS bf16x8*)(tk + (16 * jb + (lane & 15)) * 144 + (32 * ks + 8 * g4) * 2); sacc[jb] = mfma16(a, bq[ks], sacc[jb]); }
#pragma unroll
          for (int r = 0; r < 4; ++r) { const int dist = ti - (16 * jb + 4 * g4 + r);
              sacc[jb][r] *= dist >= 0 ? __builtin_amdgcn_exp2f((float)dist * l2f) : __builtin_amdgcn_exp2f((float)(-dist) * l2b); } }
      const unsigned va = tr_lane(lds_addr(tv), 272, 4, lane);
      sfor<0, 4>([&](auto kk_) { constexpr int kk = decltype(kk_)::value;
          u32x4 pw; pw.x = pk2(sacc[2 * kk][0], sacc[2 * kk][1]); pw.y = pk2(sacc[2 * kk][2], sacc[2 * kk][3]); pw.z = pk2(sacc[2 * kk + 1][0], sacc[2 * kk + 1][1]); pw.w = pk2(sacc[2 * kk + 1][2], sacc[2 * kk + 1][3]);
          const bf16x8 bp = as_frag(pw);
          sfor<0, 2>([&](auto eg_) { constexpr int eg = decltype(eg_)::value; bf16x8 af[4]; tr_frag4_i<32 * kk * 272 + 128 * eg, 16 * 272>(va, af);
#pragma unroll
              for (int i = 0; i < 4; ++i) oacc[4 * eg + i] = mfma16(af[i], bp, oacc[4 * eg + i]); }); }); }
    { float ss = 0.f;
#pragma unroll
      for (int eb = 0; eb < 8; ++eb) ss += (oacc[eb][0] * oacc[eb][0] + oacc[eb][1] * oacc[eb][1]) + (oacc[eb][2] * oacc[eb][2] + oacc[eb][3] * oacc[eb][3]);
      ss += shx(ss, 16, lane); ss += shx(ss, 32, lane);
      const float rstd = rsqrtf(ss * (1.0f / 128.0f) + EPS);
      const size_t row = (size_t)(row0 + ti);
#pragma unroll
      for (int eb = 0; eb < 8; ++eb) { const int e = 16 * eb + 4 * g4; const u32x2 gg = *(const u32x2*)(Z + row * ZW + ZC_RG + h * 128 + e);
          u32x2 o; o.x = pk2(oacc[eb][0] * rstd * siluf_(lo16(gg.x)), oacc[eb][1] * rstd * siluf_(hi16(gg.x))); o.y = pk2(oacc[eb][2] * rstd * siluf_(lo16(gg.y)), oacc[eb][3] * rstd * siluf_(hi16(gg.y)));
          *(u32x2*)(BR + row * BRW + 1024 + h * 128 + e) = o; } }
    __syncthreads();
}

constexpr int NA_V = 0, NA_PITCH = 144, NA_CTXROW = 576, NA_TAB = (576 + 256) * NA_PITCH  , NA_MB = NA_TAB + 2048  , NA_MB_SZ = 18432;
static_assert(NA_MB + NA_MB_SZ <= LDS_BYTES - 1024, "NA LDS");
__device__ __forceinline__ void na_unit(const Params& p, LAS unsigned char* lds, int l, int b, int h, int rp, bool local, int tid) {
    const int wave = __builtin_amdgcn_readfirstlane(tid >> 6), lane = tid & 63, g4 = lane >> 4, qb = wave >> 1, half = wave & 1;
    const bf16_t* Z = (const bf16_t*)(p.ws + WS_R + R_Z); bf16_t* BR = (bf16_t*)(p.ws + WS_R + R_BR);
    LAS unsigned char* vl = lds + NA_V; LAS float* tab = (LAS float*)(lds + NA_TAB);
    const int qc = 16 * qb + (lane & 15);
    const int r0 = 2 * rp, rsA = min(max(r0 - 4, 0), 24), nwr = min(9, 32 - rsA);
    const int kbs = min(max(16 * qb - 8, 0), 32), cst = min(max(qc - 8, 0), 48);
    if (local) {
        for (int key = tid; key < nwr * 64; key += NTHREADS) { const size_t krow = (size_t)b * 2048 + (rsA + (key >> 6)) * 64 + (key & 63);
            const u32x4* vs_ = (const u32x4*)(Z + krow * ZW + ZC_NV + h * 64);
#pragma unroll
            for (int j = 0; j < 8; ++j) *(LAS u32x4*)(vl + key * NA_PITCH + 16 * j) = vs_[j]; }
        if (tid < 465) tab[tid] = kin(I_RPB)[(size_t)(l * 8 + h) * 465 + tid]; }
    { const int key = tid >> 1, hb = (tid & 1) * 4; const u32x4* vs_ = (const u32x4*)(Z + ((size_t)NL + b * 256 + key) * ZW + ZC_NV + h * 64) + hb;
#pragma unroll
      for (int j = 0; j < 4; ++j) *(LAS u32x4*)(vl + (NA_CTXROW + key) * NA_PITCH + 16 * (hb + j)) = vs_[j]; }
    __syncthreads();
    const float L2E = 1.44269504089f;
    const unsigned vla = lds_addr(vl);
    const unsigned lane_off = (unsigned)((4 * g4 + ((lane & 15) >> 2)) * NA_PITCH + (lane & 3) * 8);
#pragma unroll 1
    for (int jr = 0; jr < 2; ++jr) {
        const int r = r0 + jr, rs = min(max(r - 4, 0), 24), wofs = rs - rsA;
        const size_t qrow = local ? (size_t)b * 2048 + r * 64 + qc : (size_t)NL + b * 256 + r * 64 + qc;
        bf16x8 bq[2];
#pragma unroll
        for (int ks = 0; ks < 2; ++ks) bq[ks] = *(const bf16x8*)(Z + qrow * ZW + ZC_NQ + h * 64 + 32 * ks + 8 * g4);
        bf16x8 kf[16];
        if (local) {
#pragma unroll
            for (int blk = 0; blk < 8; ++blk) { const size_t krow = (size_t)b * 2048 + (rs + 4 * half + (blk >> 1)) * 64 + kbs + 16 * (blk & 1) + (lane & 15);
#pragma unroll
                for (int ks = 0; ks < 2; ++ks) kf[blk * 2 + ks] = *(const bf16x8*)(Z + krow * ZW + ZC_NK + h * 64 + 32 * ks + 8 * g4); } }
        f32x4 s[16]; float mx = -1e30f;
        if (local) {
#pragma unroll
            for (int blk = 0; blk < 8; ++blk) { const int i = 4 * half + (blk >> 1), cb = blk & 1;
                f32x4 a = (f32x4){0.f, 0.f, 0.f, 0.f};
#pragma unroll
                for (int ks = 0; ks < 2; ++ks) a = mfma16(kf[blk * 2 + ks], bq[ks], a);
                const int ro = rs + i - r + 7;
#pragma unroll
                for (int rg = 0; rg < 4; ++rg) { const int kc = kbs + 16 * cb + 4 * g4 + rg; const bool valid = kc >= cst && kc < cst + 16;
                    const int co = min(max(kc - qc, -15), 15) + 15;
                    const float bv = tab[ro * 31 + co];
                const float v = valid ? a[rg] * 0.125f + bv : -1e30f; s[blk][rg] = v; mx = fmaxf(mx, v); } }
        } else {
#pragma unroll
            for (int blk = 0; blk < 8; ++blk) s[blk] = (f32x4){-1e30f, -1e30f, -1e30f, -1e30f};
        }
#pragma unroll
        for (int blk = 0; blk < 8; ++blk) { const size_t krow = (size_t)NL + b * 256 + half * 128 + 16 * blk + (lane & 15);
#pragma unroll
            for (int ks = 0; ks < 2; ++ks) kf[blk * 2 + ks] = *(const bf16x8*)(Z + krow * ZW + ZC_NK + h * 64 + 32 * ks + 8 * g4); }
#pragma unroll
        for (int blk = 0; blk < 8; ++blk) { f32x4 a = (f32x4){0.f, 0.f, 0.f, 0.f};
#pragma unroll
            for (int ks = 0; ks < 2; ++ks) a = mfma16(kf[blk * 2 + ks], bq[ks], a);
#pragma unroll
            for (int rg = 0; rg < 4; ++rg) { const float v = a[rg] * 0.125f; s[8 + blk][rg] = v; mx = fmaxf(mx, v); } }
        mx = fmaxf(mx, shx(mx, 16, lane)); mx = fmaxf(mx, shx(mx, 32, lane));
        float ls = 0.f;
#pragma unroll
        for (int blk = 0; blk < 16; ++blk)
#pragma unroll
            for (int rg = 0; rg < 4; ++rg) { const float e = __builtin_amdgcn_exp2f((s[blk][rg] - mx) * L2E); s[blk][rg] = e; ls += e; }
        ls += shx(ls, 16, lane); ls += shx(ls, 32, lane);
        f32x4 oacc[4];
#pragma unroll
        for (int db = 0; db < 4; ++db) oacc[db] = (f32x4){0.f, 0.f, 0.f, 0.f};
        if (local) { const unsigned va = vla + (unsigned)(((wofs + 4 * half) * 64 + kbs) * NA_PITCH) + lane_off;
            sfor<0, 4>([&](auto kk_) { constexpr int kk = decltype(kk_)::value;
                u32x4 pw; pw.x = pk2(s[2 * kk][0], s[2 * kk][1]); pw.y = pk2(s[2 * kk][2], s[2 * kk][3]); pw.z = pk2(s[2 * kk + 1][0], s[2 * kk + 1][1]); pw.w = pk2(s[2 * kk + 1][2], s[2 * kk + 1][3]);
                const bf16x8 bp = as_frag(pw); bf16x8 vf[4]; tr_frag4_i<kk * 64 * NA_PITCH, 16 * NA_PITCH>(va, vf);
#pragma unroll
                for (int db = 0; db < 4; ++db) oacc[db] = mfma16(vf[db], bp, oacc[db]); }); }
        { const unsigned va = vla + (unsigned)((NA_CTXROW + half * 128) * NA_PITCH) + lane_off;
          sfor<0, 4>([&](auto kk_) { constexpr int kk = decltype(kk_)::value;
              u32x4 pw; pw.x = pk2(s[8 + 2 * kk][0], s[8 + 2 * kk][1]); pw.y = pk2(s[8 + 2 * kk][2], s[8 + 2 * kk][3]); pw.z = pk2(s[9 + 2 * kk][0], s[9 + 2 * kk][1]); pw.w = pk2(s[9 + 2 * kk][2], s[9 + 2 * kk][3]);
              const bf16x8 bp = as_frag(pw); bf16x8 vf[4]; tr_frag4_i<kk * 32 * NA_PITCH, 16 * NA_PITCH>(va, vf);
#pragma unroll
              for (int db = 0; db < 4; ++db) oacc[db] = mfma16(vf[db], bp, oacc[db]); }); }
        LAS float* mb = (LAS float*)(lds + NA_MB) + (qb * 64 + lane) * 18;
        if (half == 1) { mb[0] = mx; mb[1] = ls;
#pragma unroll
            for (int db = 0; db < 4; ++db)
#pragma unroll
                for (int rg = 0; rg < 4; ++rg) mb[2 + db * 4 + rg] = oacc[db][rg]; }
        __syncthreads();
        if (half == 0) { const float m1 = mb[0], l1 = mb[1], M = fmaxf(mx, m1), a0 = __builtin_amdgcn_exp2f((mx - M) * L2E), a1 = __builtin_amdgcn_exp2f((m1 - M) * L2E);
            const float inv = 1.0f / (ls * a0 + l1 * a1);
#pragma unroll
            for (int db = 0; db < 4; ++db) { float o[4];
#pragma unroll
                for (int rg = 0; rg < 4; ++rg) o[rg] = (oacc[db][rg] * a0 + mb[2 + db * 4 + rg] * a1) * inv;
                u32x2 w; w.x = pk2(o[0], o[1]); w.y = pk2(o[2], o[3]);
                *(u32x2*)(BR + qrow * BRW + 512 + h * 64 + 16 * db + 4 * g4) = w; } }
        __syncthreads();
    }
}

#ifndef STAMP_PHASE
#define STAMP_PHASE -1
#endif
constexpr int PH_PER_LAYER = 10, PH_FINAL = 1 + 2 * PH_PER_LAYER, NPHASES = PH_FINAL + 1;
__device__ __forceinline__ void moe_tables(const Params& p, LAS unsigned char* lds, int l, int tid, int nsplit, int nMs, int G, int c) {
    LAS int* tb = (LAS int*)(lds + MOE_TAB_OFF); LAS int* cn = tb + 128;
    if (tid < 64) { const unsigned c = ((const unsigned*)(p.ws + WS_CTL))[CW_CNT + l * 2048 + tid * 16]; cn[tid] = (int)(c < (unsigned)NT ? c : (unsigned)NT); }
    __syncthreads();
    if (tid == 0) { int s = 0; for (int e = 0; e < 64; ++e) { tb[e] = s; s += (cn[e] + 255) >> 8; } tb[64] = s; }
    __syncthreads();
    if (tid < MOE_UL_MAX) { LAS int* ul = (LAS int*)(lds + MOE_UL_OFF) + tid * 8; const int ntr = tb[64];
        const int idx = tid * G + ((G & 7) == 0 ? (c & 7) * (G >> 3) + (c >> 3) : c);
        if (idx >= nsplit * (ntr + nMs)) ul[0] = -1;
        else if (idx < nsplit * ntr) { const int mt = idx / nsplit, pn = idx % nsplit; int lo = 0, hi = 63;
            for (int it = 0; it < 6; ++it) { const int mid = (lo + hi + 1) >> 1; if (tb[mid] <= mt) lo = mid; else hi = mid - 1; }
            ul[0] = lo; ul[1] = pn; ul[2] = (mt - tb[lo]) * 256; ul[3] = mt; ul[4] = cn[lo]; }
        else { const int s_ = idx - nsplit * ntr; ul[0] = 64; ul[1] = s_ % nsplit; ul[2] = 0; ul[3] = s_ / nsplit; ul[4] = 0; } }
    __syncthreads();
}

__global__ void __launch_bounds__(NTHREADS, 2) fwd_kernel(Params p0) {
    extern __shared__ __attribute__((aligned(16))) unsigned char lds_raw[];
    LAS unsigned char* const lds0 = (LAS unsigned char*)lds_raw;
    const int tid0 = threadIdx.x, G = gridDim.x, bid = blockIdx.x, NGW = G * NWAVES;
    const int wave0 = __builtin_amdgcn_readfirstlane(tid0 >> 6);
#define PHASE_IDS const int tid = launder(wave0 * 64 + lane_id_here()), wave = __builtin_amdgcn_readfirstlane(tid >> 6), lane = tid & 63, gw = bid * NWAVES + wave; (void)lane; (void)gw; \
    Params p = p0; p.ws = kws_ptr(); p.out = kout_ptr(); \
    LAS unsigned char* lds; { unsigned la_ = (unsigned)(size_t)lds0; asm volatile("" : "+s"(la_)); lds = (LAS unsigned char*)(size_t)la_; }
    volatile LAS unsigned* xbw = (volatile LAS unsigned*)(lds0 + LDS_BYTES - 16);
    if (tid0 == 0) { xbw[0] = 0u; xbw[1] = 0u; xbw[2] = 0u; xbw[3] = 0u; }
    __syncthreads();
    XcdBarrier bar = xcd_barrier_post((unsigned*)(p0.ws + WS_CTL) + CW_BAR + p0.li * XCD_BAR_WORDS, xbw);
#ifdef TEST_PHASE
#define IN(k) ((((k) - 1) % PH_PER_LAYER == TEST_PHASE - 1 && (k) >= 1 && (k) < PH_FINAL && TEST_PHASE >= 1) || ((k) == 0 && TEST_PHASE == 0) || ((k) == PH_FINAL && TEST_PHASE == 99)) && (launder_s(p0.ph_lo) <= (k) && (k) < launder_s(p0.ph_hi))
#else
#define IN(k) (launder_s(p0.ph_lo) <= (k) && (k) < launder_s(p0.ph_hi))
#endif
#ifndef DUP_PHASE
#define DUP_PHASE -1
#endif
#define DUP(k) for (int rep_ = 0; rep_ < ((DUP_PHASE) == (k) ? 2 : 1); ++rep_)
#ifdef TIMING
    volatile LAS unsigned long long* tst = (volatile LAS unsigned long long*)(lds0 + LDS_BYTES - 16 - 512);
    if (wave0 == 0 && lane_id_here() == 0) tst[0] = __builtin_amdgcn_s_memrealtime();
#define SEAM(k) do { if (IN(k) && IN((k) + 1)) { xcd_barrier(bar, wave0 == 0 && lane_id_here() == 0); if (wave0 == 0 && lane_id_here() == 0) tst[(k) + 1] = __builtin_amdgcn_s_memrealtime(); } } while (0)
#else
#define SEAM(k) do { if (IN(k) && IN((k) + 1)) xcd_barrier(bar, wave0 == 0 && lane_id_here() == 0); } while (0)
#endif
#define Hb ((bf16_t*)(p.ws + WS_H))
#define Zb ((bf16_t*)(p.ws + WS_R + R_Z))
#define BRb ((bf16_t*)(p.ws + WS_R + R_BR))
#define XC ((float*)(p.ws + WS_XC))
#define xl (l == 0 ? kin(I_X) : (const float*)p.out)
#define xc (l == 0 ? kin(I_CTX) : (const float*)XC)
#define mod ((const float*)(p.ws + WS_MOD) + (size_t)l * 9 * 6144)
#define wm (p.ws + WS_WM + (size_t)l * WM_STRIDE)

    if (IN(0)) { DUP(100) {
        PHASE_IDS;
        for (int u = bid; u < 192; u += G) mod_unit(p, lds, u, tid);
        if (bid == G - 1) { float* rope = (float*)(p.ws + WS_ROPE);
            for (int idx = tid; idx < 1024; idx += NTHREADS) { const int pos = idx >> 4, f = idx & 15; const float inv = exp2f(-(float)f * (13.287712379549449f / 16.0f));
                float x = (float)pos * inv * 0.15915494309189535f; x -= floorf(x);
                rope[idx * 2] = __builtin_amdgcn_cosf(x); rope[idx * 2 + 1] = __builtin_amdgcn_sinf(x); } }
        __syncthreads();
        LAS float* scr = (LAS float*)(lds + wave * 8448);
        for (int it = gw; it < 2 * MISC_ITEMS; it += NGW) {
            if (it < MISC_ITEMS) misc_item(p, 0, it, scr, lane);
            else misc_item(p, 1, it - MISC_ITEMS, scr, lane); }
        __syncthreads();
    } }
    SEAM(0);

    for (int l = 0; l < DEPTH; ++l) {
        const int base = 1 + PH_PER_LAYER * l;
        const bool need_ctx = l < DEPTH - 1;
        const int Mrows = need_ctx ? NT : NL;

        if (IN(base + 0)) { DUP(0) {
            PHASE_IDS;
            for (int row = gw; row < NT; row += NGW) { const bool lat = row < NL;
                const float* mr = mod + (size_t)(lat ? (row >> 11) : 8) * 6144;
                f32x4 v[4];
                if (l == 0) { const float* xr = lat ? kin(I_X) + (size_t)row * D : kin(I_CTX) + (size_t)(row - NL) * D;
#pragma unroll
                    for (int j = 0; j < 4; ++j) v[j] = ((const f32x4*)xr)[64 * j + lane]; }
                else { float* xr = lat ? p.out + (size_t)row * D : XC + (size_t)(row - NL) * D;
                    combine_row(v, xr, mr - 9 * 6144 + 5120, Hb + (size_t)row * D, (const unsigned char*)(p.ws + WS_R + R_O) + (size_t)row * 8 * 1024, lane);
#pragma unroll
                    for (int j = 0; j < 4; ++j) ((f32x4*)xr)[64 * j + lane] = v[j]; }
                norm_mod_vals(v, kin(I_NMG) + l * 1024, mr, mr + 1024, Hb + (size_t)row * D, false, lds, lane); }
        } }
        SEAM(base + 0);
        if (IN(base + 1)) { DUP(1) {
            PHASE_IDS;
            DenseSched S{(const char*)Hb, (const char*)(wm + WM_IN), 1024, 1024, NT / 256, INW / 256, G, bid, 1, 0, 0};
            EpiStoreBf16 E{Zb, ZW, 16, (unsigned char*)(p.ws + WS_R + R_G8)};
            pg8::gemm_phase(lds, tid, 1024, 1024, S, E, (STAMP_PHASE == 2 && l == 0 && bid == 0) ? 25 : -1);
        } }
        SEAM(base + 1);
        if (IN(base + 2)) { DUP(2) {
            PHASE_IDS;
#ifndef DUP_SUB
#define DUP_SUB -1
#endif
            for (int rs_ = 0; rs_ < (DUP_SUB == 0 ? 2 : 1); ++rs_) for (int u = bid; u < 1024; u += G) na_unit(p, lds, l, u >> 7, (u >> 4) & 7, u & 15, true, tid);
            if (need_ctx) for (int u = bid; u < 128; u += G) na_unit(p, lds, l, u >> 4, (u >> 1) & 7, u & 1, false, tid);
            for (int rs_ = 0; rs_ < (DUP_SUB == 1 ? 2 : 1); ++rs_) for (int u = (bid + 64) % G; u < 576; u += G) retkv_unit(p, lds, l, u / 72, (u / 18) % 4, u % 18, tid);
        } }
        SEAM(base + 2);
        if (IN(base + 3)) { DUP(3) {
            PHASE_IDS;
            const float* KV = (const float*)(p.ws + WS_R + R_KV); bf16_t* ST = (bf16_t*)(p.ws + WS_R + R_ST);
            for (int gi = bid * NTHREADS + tid; gi < 64 * 2048; gi += G * NTHREADS) {
                const int combo = gi >> 11, e4 = (gi & 2047) * 4, bh = combo >> 1, dir = combo & 1, h = bh & 3;
                const float dec = __builtin_amdgcn_exp2f(128.f * log2_gamma(p, l, dir, h));
                const float* kv = KV + (size_t)bh * NCHUNK * 2 * 8192 + (size_t)dir * 8192 + e4; bf16_t* st = ST + (size_t)bh * NCHUNK * 2 * 8192 + (size_t)dir * 8192 + e4;
                f32x4 q[NCHUNK];
#pragma unroll
                for (int y = 0; y < NCHUNK; ++y) q[y] = *(const f32x4*)(kv + (size_t)y * 2 * 8192);
                f32x4 sacc = (f32x4){0.f, 0.f, 0.f, 0.f};
#pragma unroll
                for (int i = 0; i < NCHUNK; ++i) { const int y = dir == 0 ? i : (i == 0 ? 1 : (i == 1 ? 0 : 19 - i));
                    u32x2 o; o.x = pk2(sacc[0], sacc[1]); o.y = pk2(sacc[2], sacc[3]); *(u32x2*)(st + (size_t)y * 2 * 8192) = o;
                    f32x4 kvy = q[0];
#pragma unroll
                    for (int j = 1; j < NCHUNK; ++j) kvy = (j == y) ? q[j] : kvy;
                    sacc = sacc * dec + kvy; } }
            { const bf16_t* Z = (const bf16_t*)(p.ws + WS_R + R_Z); float* STAT = (float*)(p.ws + WS_R + R_STAT);
              for (int row = gw; row < Mrows; row += NGW) { const u32x4 v = *(const u32x4*)(Z + (size_t)row * ZW + ZC_AV + lane * 8);
                  const float x0 = geluf_(lo16(v.x)), x1 = geluf_(hi16(v.x)), x2 = geluf_(lo16(v.y)), x3 = geluf_(hi16(v.y)), x4 = geluf_(lo16(v.z)), x5 = geluf_(hi16(v.z)), x6 = geluf_(lo16(v.w)), x7 = geluf_(hi16(v.w));
                  const float mean = wave_sum(((x0 + x1) + (x2 + x3)) + ((x4 + x5) + (x6 + x7)), lane) * (1.0f / 512.0f);
                  const float d0 = x0 - mean, d1 = x1 - mean, d2 = x2 - mean, d3 = x3 - mean, d4 = x4 - mean, d5 = x5 - mean, d6 = x6 - mean, d7 = x7 - mean;
                  const float s2 = wave_sum(((d0 * d0 + d1 * d1) + (d2 * d2 + d3 * d3)) + ((d4 * d4 + d5 * d5) + (d6 * d6 + d7 * d7)), lane);
                  if (lane == 0) *(f32x2*)(STAT + (size_t)row * 2) = (f32x2){mean, rsqrtf(s2 * (1.0f / 512.0f) + EPS)}; } }
        } }
        SEAM(base + 3);
        if (IN(base + 4)) { DUP(4) {
            PHASE_IDS;
            const int cc_lo = need_ctx ? 0 : 2, ncc = NCHUNK - cc_lo, total = 32 * ncc;
            for (int u = bid; u < total; u += G) retout_unit(p, lds, l, u / (4 * ncc), (u / ncc) % 4, cc_lo + u % ncc, tid);
            const int nA = (Mrows / 128) * 4;
            for (int rs_ = 0; rs_ < (DUP_SUB == 2 ? 2 : 1); ++rs_) for (int u = (bid + 64) % G; u < nA; u += G) mixA_unit(p, lds, l, u >> 2, u & 3, tid);
        } }
        SEAM(base + 4);
        if (IN(base + 5)) { DUP(5) {
            PHASE_IDS;
            DenseSched S{(const char*)BRb, (const char*)(wm + WM_BR), BRW, 512, Mrows / 256, 4, G, bid, 3, 512 * 2, (size_t)1024 * 512 * 2};
#ifdef MERGE_PLAIN_DUP
            if (rep_ == 1) { EpiStoreBf16 E2{(bf16_t*)(p.ws + WS_R + R_KV), 1024, 1000, (unsigned char*)0}; pg8::gemm_phase(lds, tid, 512, 512, S, E2); } else
#endif
            { EpiMerge E{Hb, (const unsigned char*)(p.ws + WS_R + R_G8)};
            pg8::gemm_phase(lds, tid, 512, 512, S, E, (STAMP_PHASE == 6 && l == 0 && bid == 0) ? 25 : -1); }
            if (l == 0 && rep_ == 0 && G == 256 && bid >= 32) { LAS float* scr = (LAS float*)(lds + wave * 8448); const int fw = (bid - 32) * NWAVES + wave;
                for (int it = fw; it < FILL_SPLIT; it += 224 * NWAVES) expert_item(p, it / EXP_ITEMS, it % EXP_ITEMS, scr, lane); }
            if (l == 0 && rep_ == 0 && G != 256) { LAS float* scr = (LAS float*)(lds + wave * 8448);
                for (int it = gw; it < 2 * EXP_ITEMS; it += NGW) expert_item(p, it / EXP_ITEMS, it % EXP_ITEMS, scr, lane); }
        } }
        SEAM(base + 5);
        if (IN(base + 6)) { DUP(6) {
            PHASE_IDS;
            DenseSched S{(const char*)Hb, (const char*)(wm + WM_OUT), 1024, 1024, Mrows / 256, 4, G, bid, 1, 0, 0};
            float* const dummy = (float*)(p.ws + WS_R + R_ACT);
            EpiResid E{xl, xc, rep_ == 0 ? p.out : dummy, rep_ == 0 ? XC : dummy + (size_t)NL * D, mod + 2048};
            pg8::gemm_phase(lds, tid, 1024, 1024, S, E, (STAMP_PHASE == 7 && l == 0 && bid == 0) ? 25 : -1);
            if (l == 0 && rep_ == 0 && G == 256 && bid >= 32) { LAS float* scr = (LAS float*)(lds + wave * 8448); const int fw = (bid - 32) * NWAVES + wave;
                for (int it = FILL_SPLIT + fw; it < 2 * EXP_ITEMS; it += 224 * NWAVES) expert_item(p, it / EXP_ITEMS, it % EXP_ITEMS, scr, lane); }
        } }
        SEAM(base + 6);
        if (IN(base + 7)) { DUP(7) {
            PHASE_IDS;
            for (int u = bid; u < Mrows / 64; u += G) router_unit(p, lds, l, u, p.out, XC, tid, rep_ == 0, l == 0 && u == 0);
        } }
        SEAM(base + 7);
        if (IN(base + 8)) { DUP(8) {
            PHASE_IDS;
            moe_tables(p, lds, l, tid, 2, Mrows / 256, G, bid);
            MoeGuSched S{(const char*)Hb, (const char*)(p.ws + WS_WE + (size_t)l * WE_LAYER + WE_GU), (const char*)(wm + WM_SGU), (const unsigned*)(p.ws + WS_LIST),
                         (const LAS int*)(lds + MOE_TAB_OFF), (const LAS int*)(lds + MOE_TAB_OFF) + 128, Mrows / 256, G, bid};
            EpiGateUp E{(bf16_t*)(p.ws + WS_R + R_ACT), (bf16_t*)(p.ws + WS_R + R_ACTS), (const float*)(p.ws + WS_WL)};
            pg8::gemm_phase<true>(lds, tid, 1024, 1024, S, E, (STAMP_PHASE == 9 && l == 0 && bid == 0) ? 25 : -1);
        } }
        SEAM(base + 8);
        if (IN(base + 9)) { DUP(9) {
            PHASE_IDS;
            moe_tables(p, lds, l, tid, 4, Mrows / 256, G, bid);
            MoeDownSched S{(const char*)(p.ws + WS_R + R_ACT), (const char*)(p.ws + WS_WE + (size_t)l * WE_LAYER + WE_D), (const char*)(p.ws + WS_R + R_ACTS), (const char*)(wm + WM_SD),
                           (const LAS int*)(lds + MOE_TAB_OFF), (const LAS int*)(lds + MOE_TAB_OFF) + 128, Mrows / 256, G, bid};
            EpiDown E{(bf16_t*)(p.ws + WS_R + R_O), (const unsigned*)(p.ws + WS_LIST), Hb};
            pg8::gemm_phase<true>(lds, tid, launder_s(256), 256, S, E, (STAMP_PHASE == 10 && l == 0 && bid == 0) ? 25 : -1);
        } }
        SEAM(base + 9);
    }
#ifdef EXTRA_BARRIERS
    if (IN(PH_FINAL) && IN(PH_FINAL - 1)) for (int xb_ = 0; xb_ < EXTRA_BARRIERS; ++xb_) xcd_barrier(bar, wave0 == 0 && lane_id_here() == 0);
#endif
#ifdef TIMING
    float t_scale = 1.0f, t_add = 0.0f;
    { float* tw = (float*)(p0.ws + WS_CTL) + 1024;
      if (bid == 0 && wave0 == 0 && lane_id_here() == 0) { tw[0] = (float)(tst[TA_HI] - tst[TA_LO]) * 0.01f; }
      xcd_barrier(bar, wave0 == 0 && lane_id_here() == 0);
      t_scale = 1.0f + tw[0] / (float)(TA_DIV); t_add = 0.0f; }
#endif
    if (IN(PH_FINAL)) {
        PHASE_IDS;
        const int l = DEPTH - 1;
        for (int row = gw; row < NL; row += NGW) { float* xr = p.out + (size_t)row * D;
            f32x4 v[4]; float ss = 0.f;
            combine_row(v, xr, mod + (size_t)(row >> 11) * 6144 + 5120, Hb + (size_t)row * D, (const unsigned char*)(p.ws + WS_R + R_O) + (size_t)row * 8 * 1024, lane);
#pragma unroll
            for (int j = 0; j < 4; ++j) ss += (v[j][0] * v[j][0] + v[j][1] * v[j][1]) + (v[j][2] * v[j][2] + v[j][3] * v[j][3]);
            const float rstd = rsqrtf(wave_sum(ss, lane) * (1.0f / 1024.0f) + EPS);
#pragma unroll
            for (int j = 0; j < 4; ++j) { f32x4 ov = v[j] * rstd * ((const f32x4*)kin(I_FG))[64 * j + lane];
#ifdef TIMING
                ov = ov * t_scale; if (row == 0 && j == 0 && lane == 0) ov[0] += t_add;
#endif
                ((f32x4*)xr)[64 * j + lane] = ov; } }
    }
#undef IN
#undef SEAM
#undef Hb
#undef Zb
#undef BRb
#undef XC
#undef xl
#undef xc
#undef mod
#undef wm
}

#ifndef STAMP_PHASE_DEFINED
#endif
#ifndef MK_PER_PHASE
#define MK_PER_PHASE 0
#endif
extern "C" void kernel_launch(void* const* d_in, const int* in_sizes, int n_in, void* d_out, int out_size, void* d_ws, size_t ws_size, hipStream_t stream) {
    static int grid = 0;
    if (grid == 0) {
        if (n_in != 26 || out_size != NL * D || ws_size < WS_END) { fprintf(stderr, "kernel_launch: unexpected shapes (n_in %d out %d ws %zu, need %zu)\n", n_in, out_size, ws_size, (size_t)WS_END); grid = -1; return; }
        int dev = 0, cus = 0;
        if (hipGetDevice(&dev) != hipSuccess || hipDeviceGetAttribute(&cus, hipDeviceAttributeMultiprocessorCount, dev) != hipSuccess) { grid = -1; return; }
        if (hipFuncSetAttribute((const void*)fwd_kernel, hipFuncAttributeMaxDynamicSharedMemorySize, LDS_BYTES) != hipSuccess) { fprintf(stderr, "kernel_launch: hipFuncSetAttribute failed\n"); grid = -1; return; }
        int per_cu = 0;
        if (hipOccupancyMaxActiveBlocksPerMultiprocessor(&per_cu, (const void*)fwd_kernel, NTHREADS, LDS_BYTES) != hipSuccess || per_cu < 1) { fprintf(stderr, "kernel_launch: occupancy query says %d\n", per_cu); }
        (void)hipGetLastError();
        grid = cus;
    }
    if (grid < 0) return;
    (void)hipMemsetAsync((char*)d_ws + WS_CTL, 0, CTL_BYTES, stream);
    Params p{};
    for (int i = 0; i < 26; ++i) p.in[i] = (const float*)d_in[i];
    p.out = (float*)d_out; p.ws = (unsigned char*)d_ws;
#if MK_PER_PHASE
    for (int k = 0; k < NPHASES; ++k) { p.ph_lo = k; p.ph_hi = k + 1; p.li = k;
        hipLaunchKernelGGL(fwd_kernel, dim3(grid), dim3(NTHREADS), LDS_BYTES, stream, p); }
#else
    p.ph_lo = 0; p.ph_hi = NPHASES; p.li = 0;
    hipLaunchKernelGGL(fwd_kernel, dim3(grid), dim3(NTHREADS), LDS_BYTES, stream, p);
#endif
}
```

```cpp
#include <hip/hip_runtime.h>
#include <stdint.h>
#include <stdio.h>

#define LAS __attribute__((address_space(3)))
#define GAS __attribute__((address_space(1)))
template <class T> __device__ __forceinline__ T* as_global(T* q) { return (T*)(GAS T*)q; }
typedef unsigned short bf16_t;
typedef short bf16x8 __attribute__((ext_vector_type(8)));
typedef short bf16x4 __attribute__((ext_vector_type(4)));
typedef float f32x4 __attribute__((ext_vector_type(4)));
typedef float f32x2 __attribute__((ext_vector_type(2)));
typedef unsigned u32x4 __attribute__((ext_vector_type(4)));
typedef unsigned u32x2 __attribute__((ext_vector_type(2)));
typedef long i64x2 __attribute__((ext_vector_type(2)));

constexpr int D = 1024, NB = 8, SEQ = 2048, CTXL = 256, DEPTH = 2;
constexpr int NL = NB * SEQ;
constexpr int NC = NB * CTXL;
constexpr int NT = NL + NC;
constexpr int INW = 7168;
constexpr int ZW = 4096;
constexpr int ZC_AU = 0, ZC_AV = 512, ZC_NQ = 1024, ZC_NK = 1536, ZC_NV = 2048, ZC_RQ = 2560, ZC_RK = 2816, ZC_RV = 3072, ZC_RG = 3584,
              ZC_GA = 4096;
constexpr int BRW = 1536;
constexpr int NEXP = 64, TOPK = 8, EXPW = 256;
constexpr int NCHUNK = 18;
constexpr float EPS = 1e-6f;
constexpr int NTHREADS = 512, NWAVES = 8;
constexpr int LDS_BYTES = 159744;

constexpr size_t MiB = 1u << 20;
constexpr size_t WS_CTL = 0, CTL_BYTES = 1 * MiB;
constexpr size_t WS_MOD = 1 * MiB;
constexpr size_t WS_ROPE = 1 * MiB + 512 * 1024;
constexpr size_t WS_WM = 2 * MiB, WM_STRIDE = 21 * MiB;
constexpr size_t WM_IN = 0, WM_BR = 14680064, WM_OUT = WM_BR + 3145728, WM_SGU = WM_OUT + 2097152, WM_SD = WM_SGU + 1048576,
                 WM_RT = WM_SD + 524288, WM_CM = WM_RT + 131072, WM_END = WM_CM + 131072;
static_assert(WM_END <= WM_STRIDE, "misc weights");
constexpr size_t WS_WE = 44 * MiB;
constexpr size_t WE_GU = 0, WE_D = 33554432, WE_LAYER = 50331648;
constexpr size_t WS_XC = 140 * MiB;
constexpr size_t WS_H = 148 * MiB;
constexpr size_t WS_LIST = 184 * MiB, WS_WL = 189 * MiB;
constexpr size_t WS_R = 194 * MiB;
constexpr size_t R_Z = 0, R_G8 = 144 * MiB, R_BR = 252 * MiB, R_KV = 306 * MiB, R_ST = 342 * MiB, R_STAT = 360 * MiB;
constexpr size_t R_O = 0, R_ACT = 288 * MiB, R_ACTS = 368 * MiB;
constexpr size_t WS_END = WS_R + 377 * MiB;
static_assert(R_KV + 37748736 <= 377 * MiB && R_ACTS + 9437184 <= 377 * MiB && R_Z + 150994944 <= R_G8 && R_G8 + 56623104 <= R_BR && R_BR + 56623104 <= R_KV, "region map");
static_assert(R_O + 301989888 <= R_ACT && R_ACT + 83886080 <= R_ACTS, "region map 2");
constexpr int CW_BAR = 4096;
constexpr int CW_CNT = 200000;

__device__ __forceinline__ float bf2f(unsigned short b) { return __uint_as_float(((unsigned)b) << 16); }
__device__ __forceinline__ unsigned f2bf(float f) { unsigned u = __float_as_uint(f); return (u + 0x7fffu + ((u >> 16) & 1u)) >> 16; }
__device__ __forceinline__ unsigned pk2(float lo, float hi) { unsigned r; asm("v_cvt_pk_bf16_f32 %0, %1, %2" : "=v"(r) : "v"(lo), "v"(hi)); return r; }
__device__ __forceinline__ float lo16(unsigned w) { return __uint_as_float(w << 16); }
__device__ __forceinline__ float hi16(unsigned w) { return __uint_as_float(w & 0xffff0000u); }
__device__ __forceinline__ float shx(float v, int o, int lane) { return __int_as_float(__builtin_amdgcn_ds_bpermute((lane ^ o) << 2, __float_as_int(v))); }
__device__ __forceinline__ int shxi(int v, int o, int lane) { return __builtin_amdgcn_ds_bpermute((lane ^ o) << 2, v); }
__device__ __forceinline__ float dpp_f(float v, const int ctrl_tag) {
    const int x = __float_as_int(v);
    switch (ctrl_tag) {
        case 0: return __int_as_float(__builtin_amdgcn_update_dpp(x, x, 0xB1, 0xF, 0xF, false));
        case 1: return __int_as_float(__builtin_amdgcn_update_dpp(x, x, 0x4E, 0xF, 0xF, false));
        case 2: return __int_as_float(__builtin_amdgcn_update_dpp(x, x, 0x141, 0xF, 0xF, false));
        default: return __int_as_float(__builtin_amdgcn_update_dpp(x, x, 0x140, 0xF, 0xF, false));
    }
}
__device__ __forceinline__ float wave_sum(float v, int  ) {
    v += dpp_f(v, 0); v += dpp_f(v, 1); v += dpp_f(v, 2); v += dpp_f(v, 3);
    const int x = __float_as_int(v);
    return (__int_as_float(__builtin_amdgcn_readlane(x, 0)) + __int_as_float(__builtin_amdgcn_readlane(x, 16))) + (__int_as_float(__builtin_amdgcn_readlane(x, 32)) + __int_as_float(__builtin_amdgcn_readlane(x, 48)));
}
__device__ __forceinline__ float fast_exp(float x) { return __builtin_amdgcn_exp2f(x * 1.44269504089f); }
__device__ __forceinline__ float sigmoidf_(float x) { return __builtin_amdgcn_rcpf(1.0f + fast_exp(-x)); }
__device__ __forceinline__ float siluf_(float x) { return x * sigmoidf_(x); }
__device__ __forceinline__ float geluf_(float x) { const float u = 0.7978845608f * (x + 0.044715f * x * x * x); return x * sigmoidf_(2.0f * u); }
__device__ __forceinline__ f32x4 mfma16(bf16x8 a, bf16x8 b, f32x4 c) { return __builtin_amdgcn_mfma_f32_16x16x32_bf16(a, b, c, 0, 0, 0); }
__device__ __forceinline__ bf16x8 as_frag(u32x4 v) { return __builtin_bit_cast(bf16x8, v); }
__device__ __forceinline__ int launder(int v) { asm volatile("" : "+v"(v)); return v; }
__device__ __forceinline__ int lane_id_here() { unsigned m = ~0u; asm volatile("" : "+s"(m)); return (int)__builtin_amdgcn_mbcnt_hi(m, __builtin_amdgcn_mbcnt_lo(m, 0u)); }
__device__ __forceinline__ int launder_s(int v) { asm volatile("" : "+s"(v)); return v; }
template <class T> __device__ __forceinline__ T* launder_p(T* q) { asm volatile("" : "+s"(q)); return q; }
template <class T> __device__ __forceinline__ T* launder_vp(T* q) { asm volatile("" : "+v"(q)); return q; }
#define LDS_WAIT() asm volatile("s_waitcnt lgkmcnt(0)" ::: "memory")
#define VM_WAIT() asm volatile("s_waitcnt vmcnt(0)" ::: "memory")

__device__ __forceinline__ bf16x8 tr_frag(unsigned base, int stride, int r0, int r1, int c0, int lane) {
    const int q = (lane & 15) >> 2, p = lane & 3;
    const unsigned a0 = base + (unsigned)((r0 + q) * stride + (c0 + 4 * p) * 2), a1 = base + (unsigned)((r1 + q) * stride + (c0 + 4 * p) * 2);
    bf16x4 lo, hi;
    asm volatile("ds_read_b64_tr_b16 %0, %2\n\tds_read_b64_tr_b16 %1, %3\n\ts_waitcnt lgkmcnt(0)" : "=&v"(lo), "=&v"(hi) : "v"(a0), "v"(a1) : "memory");
    bf16x8 r; r[0] = lo[0]; r[1] = lo[1]; r[2] = lo[2]; r[3] = lo[3]; r[4] = hi[0]; r[5] = hi[1]; r[6] = hi[2]; r[7] = hi[3];
    return r;
}
__device__ __forceinline__ unsigned lds_addr(LAS unsigned char* p) { return (unsigned)(size_t)p; }
template <int O0, int O1> __device__ __forceinline__ bf16x8 tr_frag_i(unsigned a) {
    static_assert(O0 >= 0 && O0 < 65536 && O1 >= 0 && O1 < 65536, "ds offset field");
    bf16x4 lo, hi;
    asm volatile("ds_read_b64_tr_b16 %0, %2 offset:%3\n\tds_read_b64_tr_b16 %1, %2 offset:%4\n\ts_waitcnt lgkmcnt(0)" : "=&v"(lo), "=&v"(hi) : "v"(a), "n"(O0), "n"(O1) : "memory");
    bf16x8 r; r[0] = lo[0]; r[1] = lo[1]; r[2] = lo[2]; r[3] = lo[3]; r[4] = hi[0]; r[5] = hi[1]; r[6] = hi[2]; r[7] = hi[3];
    return r;
}
template <int OB, int R1> __device__ __forceinline__ void tr_frag4_i(unsigned a, bf16x8 (&f)[4]) {
    static_assert(OB >= 0 && OB + R1 + 96 < 65536, "ds offset field");
    bf16x4 l0, h0, l1, h1, l2, h2, l3, h3;
    asm volatile("ds_read_b64_tr_b16 %0, %8 offset:%9\n\tds_read_b64_tr_b16 %1, %8 offset:%10\n\tds_read_b64_tr_b16 %2, %8 offset:%11\n\tds_read_b64_tr_b16 %3, %8 offset:%12\n\t"
                 "ds_read_b64_tr_b16 %4, %8 offset:%13\n\tds_read_b64_tr_b16 %5, %8 offset:%14\n\tds_read_b64_tr_b16 %6, %8 offset:%15\n\tds_read_b64_tr_b16 %7, %8 offset:%16\n\ts_waitcnt lgkmcnt(0)"
                 : "=&v"(l0), "=&v"(h0), "=&v"(l1), "=&v"(h1), "=&v"(l2), "=&v"(h2), "=&v"(l3), "=&v"(h3)
                 : "v"(a), "n"(OB), "n"(OB + R1), "n"(OB + 32), "n"(OB + 32 + R1), "n"(OB + 64), "n"(OB + 64 + R1), "n"(OB + 96), "n"(OB + 96 + R1) : "memory");
    f[0][0] = l0[0]; f[0][1] = l0[1]; f[0][2] = l0[2]; f[0][3] = l0[3]; f[0][4] = h0[0]; f[0][5] = h0[1]; f[0][6] = h0[2]; f[0][7] = h0[3];
    f[1][0] = l1[0]; f[1][1] = l1[1]; f[1][2] = l1[2]; f[1][3] = l1[3]; f[1][4] = h1[0]; f[1][5] = h1[1]; f[1][6] = h1[2]; f[1][7] = h1[3];
    f[2][0] = l2[0]; f[2][1] = l2[1]; f[2][2] = l2[2]; f[2][3] = l2[3]; f[2][4] = h2[0]; f[2][5] = h2[1]; f[2][6] = h2[2]; f[2][7] = h2[3];
    f[3][0] = l3[0]; f[3][1] = l3[1]; f[3][2] = l3[2]; f[3][3] = l3[3]; f[3][4] = h3[0]; f[3][5] = h3[1]; f[3][6] = h3[2]; f[3][7] = h3[3];
}
__device__ __forceinline__ unsigned tr_lane(unsigned base, int stride, int rmul, int lane) { return base + (unsigned)((rmul * (lane >> 4) + ((lane & 15) >> 2)) * stride + (lane & 3) * 8); }
template <int V> struct IC { static constexpr int value = V; };
template <int I, int N, class F> __device__ __forceinline__ void sfor(F&& f) { if constexpr (I < N) { f(IC<I>{}); sfor<I + 1, N>(f); } }


#define XB_TMO      128
#define XB_XCNT(j)  (256  + 64 * (j))
#define XB_XSUB(j)  (1280 + 64 * (j))
#define XB_XGEN(j)  (2304 + 64 * (j))
#define XB_TOP      3328
#define XB_TOPGEN   3392
#define XCD_BAR_WORDS 3456
#define XB_SPIN_CAP (1u << 21)
__device__ __forceinline__ unsigned xb_ld(unsigned* p)              { return __hip_atomic_load(p, __ATOMIC_RELAXED, __HIP_MEMORY_SCOPE_AGENT); }
__device__ __forceinline__ unsigned xb_add(unsigned* p, unsigned v) { return __hip_atomic_fetch_add(p, v, __ATOMIC_RELAXED, __HIP_MEMORY_SCOPE_AGENT); }
__device__ __forceinline__ unsigned xb_xcc_id() { return (unsigned)__builtin_amdgcn_s_getreg((3 << 11) | 20) & 0xFu; }
#define XB_SPIN(cond, bar) do { unsigned _sp = 0; while (cond) { __builtin_amdgcn_s_sleep(1); \
    if ((++_sp & 255u) == 0u) { if (xb_ld(&(bar)[XB_TMO])) break; if (_sp > XB_SPIN_CAP) { atomicAdd(&(bar)[XB_TMO], 1u); break; } } } } while (0)
struct XcdBarrier { unsigned* bar; unsigned x; volatile LAS unsigned* st; };
__device__ __forceinline__ XcdBarrier xcd_barrier_post(unsigned* bar, volatile LAS unsigned* st) {
    XcdBarrier b; b.bar = bar; b.x = xb_xcc_id(); b.st = st;
    if (threadIdx.x == 0) (void)xb_add(&bar[XB_XCNT(b.x)], 1u);
    return b;
}
__device__ __forceinline__ void xcd_barrier_complete(unsigned* bar, unsigned x, unsigned& nloc, unsigned& nx) {
    const unsigned G = gridDim.x * gridDim.y * gridDim.z;
    unsigned sum, cnt, mine, sp = 0u;
    for (;;) {
        sum = 0u; cnt = 0u; mine = 0u;
#pragma unroll
        for (unsigned j = 0; j < 16; ++j) { const unsigned c = xb_ld(&bar[XB_XCNT(j)]); sum += c; cnt += (c > 0u) ? 1u : 0u; mine = (j == x) ? c : mine; }
        if (sum == G) break;
        __builtin_amdgcn_s_sleep(1);
        if ((++sp & 255u) == 0u) { if (xb_ld(&bar[XB_TMO])) break; if (sp > XB_SPIN_CAP) { atomicAdd(&bar[XB_TMO], 1u); break; } }
    }
    nloc = mine > 0u ? mine : 1u; nx = cnt > 0u ? cnt : 1u;
}
__device__ __forceinline__ void xcd_barrier(const XcdBarrier& b, const bool leader) {
    asm volatile("s_waitcnt vmcnt(0)" ::: "memory");
    __syncthreads();
    if (leader) {
        unsigned* bar = b.bar;
        __builtin_amdgcn_s_waitcnt(0);
        unsigned nloc = b.st[0], nx = b.st[1];
        if (nloc == 0u) { xcd_barrier_complete(bar, b.x, nloc, nx); b.st[0] = nloc; b.st[1] = nx; }
        const unsigned old = xb_add(&bar[XB_XSUB(b.x)], 1u);
        const unsigned gen = old / nloc;
        if (old + 1u == (gen + 1u) * nloc) {
            __builtin_amdgcn_fence(__ATOMIC_RELEASE, "agent");
            asm volatile("s_waitcnt vmcnt(0)" ::: "memory");
            const unsigned og = xb_add(&bar[XB_TOP], 1u);
            const unsigned tg = og / nx;
            if (og + 1u == (tg + 1u) * nx) xb_add(&bar[XB_TOPGEN], 1u);
            else XB_SPIN(xb_ld(&bar[XB_TOPGEN]) == tg, bar);
            __builtin_amdgcn_fence(__ATOMIC_ACQUIRE, "agent");
            xb_add(&bar[XB_XGEN(b.x)], 1u);
            asm volatile("s_waitcnt vmcnt(0)" ::: "memory");
        } else {
            XB_SPIN(xb_ld(&bar[XB_XGEN(b.x)]) == gen, bar);
            __builtin_amdgcn_fence(__ATOMIC_ACQUIRE, "agent");
            asm volatile("s_waitcnt vmcnt(0)" ::: "memory");
        }
    }
    __syncthreads();
}

namespace pg8 {
constexpr int BM = 256, BK = 64, HALF = 128, HTB = HALF * BK * 2, STAGE_BYTES = 8 * HTB, NXCD = 8, WGM = 8;
constexpr int ROWTAB_OFF = 149504;
constexpr int GATHER_SLOT_OFF = 133120;
__device__ __forceinline__ int lds_byte(int r, int c) { const int st = (r >> 4) * 2 + (c >> 5), rr = r & 15, cc = c & 31, ob = rr * 64 + cc * 2; return st * 1024 + (ob ^ (((ob >> 9) & 1) << 5)); }
__device__ __forceinline__ void stage_rc(int b, int& R, int& C) { const int st = b / 1024, sb = b % 1024, swz = sb ^ (((sb >> 9) & 1) << 5); R = (st >> 1) * 16 + swz / 64; C = (st & 1) * 32 + (swz % 64) / 2; }
__device__ __forceinline__ int perm32(int rho) { const int n = rho >> 4, i = rho & 15; return 8 * (i >> 2) + 4 * n + (i & 3); }

struct Unit { const char* A; const char* B; int e0, e1, e2, e3, e4; };

__device__ __forceinline__ bool static_tile(int i, int G, int c, int nM, int nN, int& pm, int& pn) {
    const int nwg = nM * nN; const long L = (long)i * G + c; if (L >= nwg) return false;
    int wgid = (int)L; { const int q = nwg / NXCD, r = nwg % NXCD, xcd = wgid % NXCD, off = wgid / NXCD; wgid = (xcd < r ? xcd * (q + 1) : r * (q + 1) + (xcd - r) * q) + off; }
    const int nig = WGM * nN, gid = wgid / nig, fm = gid * WGM, gsz = (nM - fm) < WGM ? (nM - fm) : WGM;
    pm = fm + ((wgid % nig) % gsz); pn = (wgid % nig) / gsz; return true;
}

template <bool F8 = false, class Epi, class Sched>
__device__ __forceinline__ void gemm_phase(LAS unsigned char* lds, const int tid, const int K, const int ldb  , const Sched& S, const Epi& E, const int stamp_base = -1) {
#ifdef TIMING
#define GSTAMP(k) do { if (stamp_base >= 0 && tid == 0 && (k) < 31) ((volatile LAS unsigned long long*)(lds + LDS_BYTES - 16 - 512))[stamp_base + (k)] = __builtin_amdgcn_s_memrealtime(); } while (0)
#else
#define GSTAMP(k) do { } while (0)
#endif
    GSTAMP(-1);
    const int wid = __builtin_amdgcn_readfirstlane(tid >> 6), lane = tid & 63, wr = wid >> 2, wc = wid & 3, fr = lane & 15, fq = lane >> 4;
    const int nt = K / (F8 ? 2 * BK : BK);
    unsigned voffB[2];
#pragma unroll
    for (int i = 0; i < 2; ++i) { int R, C; stage_rc(tid * 16 + i * 8192, R, C); const int Rb = Epi::PERM ? ((R & ~31) + perm32(R & 31)) : R; voffB[i] = F8 ? (unsigned)(Rb * ldb + C * 2) : (unsigned)(Rb * ldb + C) * 2u; }
    const size_t kstep = (size_t)(BK * 2);
    const size_t hstepB = (size_t)HALF * ldb * (F8 ? 1 : 2);
    const unsigned ldsw = (unsigned)wid * 1024u;
    const int aoff = lds_byte(wr * 64 + fr, fq * 8), boff = lds_byte(wc * 32 + fr, fq * 8);
#define PG8_SA(b, h) (((b) * 2 + (h)) * HTB)
#define PG8_SB(b, h) ((4 + (b) * 2 + (h)) * HTB)
#define PG8_STAGE(bufoff, gbase, voff) do { _Pragma("unroll") for (int _i = 0; _i < 2; ++_i) \
        __builtin_amdgcn_global_load_lds((const unsigned*)((const char*)(gbase) + (voff)[_i]), (LAS unsigned*)(lds + (bufoff) + ldsw + _i * 8192), 16, 0, 0); } while (0)
#define PG8_LDA(dst, b, h) do { _Pragma("unroll") for (int m = 0; m < 4; ++m) _Pragma("unroll") for (int k = 0; k < 2; ++k) dst[m][k] = *(const LAS bf16x8*)(lds + PG8_SA(b, h) + aoff + m * 2048 + k * 1024); } while (0)
#define PG8_LDB(dst, b, h) do { _Pragma("unroll") for (int n = 0; n < 2; ++n) _Pragma("unroll") for (int k = 0; k < 2; ++k) dst[n][k] = *(const LAS bf16x8*)(lds + PG8_SB(b, h) + boff + n * 2048 + k * 1024); } while (0)
#define PG8_MMA(ai, bj, At, Bt) do { __builtin_amdgcn_s_setprio(1); _Pragma("unroll") for (int m = 0; m < 4; ++m) _Pragma("unroll") for (int n = 0; n < 2; ++n) _Pragma("unroll") for (int k = 0; k < 2; ++k) { \
        if constexpr (F8) { const i64x2 b2_ = __builtin_bit_cast(i64x2, Bt[n][k]), a2_ = __builtin_bit_cast(i64x2, At[m][k]); \
            acc[ai][bj][m][n] = __builtin_amdgcn_mfma_f32_16x16x32_fp8_fp8(b2_[0], a2_[0], acc[ai][bj][m][n], 0, 0, 0); \
            acc[ai][bj][m][n] = __builtin_amdgcn_mfma_f32_16x16x32_fp8_fp8(b2_[1], a2_[1], acc[ai][bj][m][n], 0, 0, 0); } \
        else acc[ai][bj][m][n] = __builtin_amdgcn_mfma_f32_16x16x32_bf16(Bt[n][k], At[m][k], acc[ai][bj][m][n], 0, 0, 0); } __builtin_amdgcn_s_setprio(0); } while (0)
#define PG8_WAIT_V(n) asm volatile("s_waitcnt vmcnt(" #n ")" ::: "memory")
#define PG8_WAIT_L(n) asm volatile("s_waitcnt lgkmcnt(" #n ")" ::: "memory")
#define PG8_BAR __builtin_amdgcn_s_barrier()
#define PG8_SCHED __builtin_amdgcn_sched_barrier(0)
    Unit cur, nxt; int ui = 0;
    if (!S.next(0, cur)) return;
    unsigned cvA[2][2], nvA[2][2];
    S.a_offs(cur, tid, cvA);
    LAS unsigned* const gslot = (LAS unsigned*)(lds + GATHER_SLOT_OFF) + tid * 4;
    if constexpr (Sched::GATHER) { *(LAS u32x4*)gslot = (u32x4){cvA[0][0], cvA[0][1], cvA[1][0], cvA[1][1]}; }
    f32x4 acc[2][2][4][2];
#pragma unroll
    for (int a = 0; a < 2; ++a)
#pragma unroll
        for (int b = 0; b < 2; ++b)
#pragma unroll
            for (int m = 0; m < 4; ++m)
#pragma unroll
                for (int n = 0; n < 2; ++n) acc[a][b][m][n] = (f32x4){0.f, 0.f, 0.f, 0.f};
    bf16x8 At[4][2], B0[2][2], B1[2][2];
    const char* cA = cur.A; const char* cB = cur.B;
    PG8_STAGE(PG8_SB(0, 0), cB, voffB); PG8_STAGE(PG8_SA(0, 0), cA, cvA[0]); PG8_STAGE(PG8_SB(0, 1), cB + hstepB, voffB); PG8_STAGE(PG8_SA(0, 1), cA, cvA[1]);
    if (wr == 1) PG8_BAR;
    PG8_WAIT_V(4); PG8_BAR;
    PG8_STAGE(PG8_SB(1, 0), cB + kstep, voffB); PG8_STAGE(PG8_SA(1, 0), cA + kstep, cvA[0]); PG8_STAGE(PG8_SB(1, 1), cB + hstepB + kstep, voffB);
    PG8_WAIT_V(6); PG8_BAR;
    for (;;) {
        if constexpr (Epi::STAGES) { if (wid < 4) E.stage(cur, (LAS unsigned*)(lds + ROWTAB_OFF) + (ui & 1) * 256 + wid * 64, wid * 64 + lane); }
        const bool has_next = S.next(ui + 1, nxt);
        if (has_next) S.a_offs(nxt, tid, nvA);
        else {
#pragma unroll
            for (int h = 0; h < 2; ++h)
#pragma unroll
                for (int i = 0; i < 2; ++i) nvA[h][i] = cvA[h][i];
        }
        if constexpr (Sched::GATHER) { *(LAS u32x4*)(gslot + ((ui + 1) & 1) * 2048) = (u32x4){nvA[0][0], nvA[0][1], nvA[1][0], nvA[1][1]}; }
        const char* nA = has_next ? nxt.A : cA; const char* nB = has_next ? nxt.B : cB;
#pragma unroll 1
        for (int t = 0; t < nt; t += 2) {
            const bool last = (t == nt - 2);
            const char* a1 = cA + (size_t)(t + 1) * kstep;
            const char* a2 = last ? nA : cA + (size_t)(t + 2) * kstep; const char* b2 = last ? nB : cB + (size_t)(t + 2) * kstep;
            const char* a3 = a2 + kstep; const char* b3 = b2 + kstep;
            unsigned sA[2][2];
            if constexpr (Sched::GATHER) {
                const u32x4 cv = *(const LAS u32x4*)(gslot + (ui & 1) * 2048), sv = *(const LAS u32x4*)(gslot + ((ui + (last ? 1 : 0)) & 1) * 2048);
                cvA[0][0] = cv.x; cvA[0][1] = cv.y; cvA[1][0] = cv.z; cvA[1][1] = cv.w; sA[0][0] = sv.x; sA[0][1] = sv.y; sA[1][0] = sv.z; sA[1][1] = sv.w;
            } else {
#pragma unroll
                for (int h = 0; h < 2; ++h)
#pragma unroll
                    for (int i = 0; i < 2; ++i) sA[h][i] = last ? nvA[h][i] : cvA[h][i];
            }
            PG8_LDB(B0, 0, 0); PG8_SCHED; PG8_LDA(At, 0, 0); PG8_STAGE(PG8_SA(1, 1), a1, cvA[1]);
            PG8_WAIT_L(8); PG8_BAR; PG8_WAIT_L(0); PG8_MMA(0, 0, At, B0); PG8_BAR; PG8_SCHED;
            PG8_LDB(B1, 0, 1); PG8_STAGE(PG8_SB(0, 0), b2, voffB);
            PG8_BAR; PG8_WAIT_L(0); PG8_MMA(0, 1, At, B1); PG8_BAR;
            PG8_LDA(At, 0, 1); PG8_STAGE(PG8_SA(0, 0), a2, sA[0]);
            PG8_BAR; PG8_WAIT_L(0); PG8_MMA(1, 0, At, B0); PG8_BAR; PG8_SCHED;
            PG8_STAGE(PG8_SB(0, 1), b2 + hstepB, voffB);
            PG8_WAIT_V(6); PG8_BAR; PG8_MMA(1, 1, At, B1); PG8_BAR;
            PG8_LDB(B0, 1, 0); PG8_SCHED; PG8_LDA(At, 1, 0); PG8_STAGE(PG8_SA(0, 1), a2, sA[1]);
            PG8_WAIT_L(8); PG8_BAR; PG8_WAIT_L(0); PG8_MMA(0, 0, At, B0); PG8_BAR; PG8_SCHED;
            PG8_LDB(B1, 1, 1); PG8_STAGE(PG8_SB(1, 0), b3, voffB);
            PG8_BAR; PG8_WAIT_L(0); PG8_MMA(0, 1, At, B1); PG8_BAR;
            PG8_LDA(At, 1, 1); PG8_STAGE(PG8_SA(1, 0), a3, sA[0]);
            PG8_BAR; PG8_WAIT_L(0); PG8_MMA(1, 0, At, B0); PG8_BAR; PG8_SCHED;
            PG8_STAGE(PG8_SB(1, 1), b3 + hstepB, voffB);
            PG8_WAIT_V(6); PG8_BAR; PG8_MMA(1, 1, At, B1); PG8_BAR;
        }
        GSTAMP(2 * ui);
        if constexpr (Epi::STAGES) E(acc, cur, wr, wc, fr, fq, (const LAS unsigned*)(lds + ROWTAB_OFF) + (ui & 1) * 256); else E(acc, cur, wr, wc, fr, fq);
        GSTAMP(2 * ui + 1);
        if (!has_next) break;
        if (!(Epi::KEEPS && E.keep(cur))) {
#pragma unroll
        for (int a = 0; a < 2; ++a)
#pragma unroll
            for (int b = 0; b < 2; ++b)
#pragma unroll
                for (int m = 0; m < 4; ++m)
#pragma unroll
                    for (int n = 0; n < 2; ++n) acc[a][b][m][n] = (f32x4){0.f, 0.f, 0.f, 0.f};
        }
        cur = nxt; cA = nA; cB = nB; ++ui;
        if constexpr (!Sched::GATHER) {
#pragma unroll
            for (int h = 0; h < 2; ++h)
#pragma unroll
                for (int i = 0; i < 2; ++i) cvA[h][i] = nvA[h][i];
        }
    }
    PG8_WAIT_V(0);
    if (wr == 0) PG8_BAR;
    PG8_BAR;
#undef PG8_SA
#undef PG8_SB
#undef PG8_STAGE
#undef PG8_LDA
#undef PG8_LDB
#undef PG8_MMA
#undef PG8_WAIT_V
#undef PG8_WAIT_L
#undef PG8_BAR
#undef PG8_SCHED
}
}

using pg8::Unit;
struct DenseSched {
    static constexpr bool GATHER = false;
    const char* A; const char* B; int lda, ldb, nM, nN, G, c, nsub; size_t asub, bsub;
    __device__ __forceinline__ bool next(int i, Unit& u) const {
        const int sub = i % nsub, ti = i / nsub; int pm, pn;
        if (!pg8::static_tile(ti, G, c, nM, nN, pm, pn)) return false;
        u.A = A + (size_t)pm * 256 * lda * 2 + (size_t)sub * asub; u.B = B + (size_t)pn * 256 * ldb * 2 + (size_t)sub * bsub;
        u.e0 = pm; u.e1 = pn; u.e2 = sub; u.e3 = 0; u.e4 = 0; return true;
    }
    __device__ __forceinline__ void a_offs(const Unit&, int tid, unsigned (&vo)[2][2]) const {
#pragma unroll
        for (int i = 0; i < 2; ++i) { int R, C; pg8::stage_rc(tid * 16 + i * 8192, R, C);
#pragma unroll
            for (int h = 0; h < 2; ++h) vo[h][i] = (unsigned)((h * 128 + R) * lda + C) * 2u; }
    }
};
constexpr int MOE_TAB_OFF = 131072;
constexpr int MOE_UL_OFF = MOE_TAB_OFF + 1024, MOE_UL_MAX = 24;
#define RFL(x) __builtin_amdgcn_readfirstlane(x)
__device__ __forceinline__ int moe_find_expert(const LAS int* tbase, int mt) {
    int lo = 0, hi = 63;
#pragma unroll
    for (int it = 0; it < 6; ++it) { const int mid = (lo + hi + 1) >> 1; if (RFL(tbase[mid]) <= mt) lo = mid; else hi = mid - 1; }
    return lo;
}
struct MoeGuSched {
    static constexpr bool GATHER = true;
    const char* H2; const char* WGU; const char* WSGU; const unsigned* list; const LAS int* tbase; const LAS int* cnt; int nMs, G, c;
    __device__ __forceinline__ bool next(int i, Unit& u) const {
        if (i >= MOE_UL_MAX) return false;
        const LAS int* ul = tbase + (MOE_UL_OFF - MOE_TAB_OFF) / 4 + i * 8;
        const int e = RFL(ul[0]), nt = RFL(ul[1]), p0 = RFL(ul[2]), t3 = RFL(ul[3]), cn_ = RFL(ul[4]);
        if (e < 0) return false;
        u.e0 = e; u.e1 = nt; u.e2 = p0; u.e3 = t3; u.e4 = cn_;
        if (e != 64) { u.A = H2; u.B = WGU + (size_t)e * (512 * 1024) + (size_t)nt * (256 * 1024); }
        else { u.A = H2 + (size_t)t3 * 256 * 1024; u.B = WSGU + (size_t)nt * (256 * 1024); }
        return true;
    }
    __device__ __forceinline__ void a_offs(const Unit& u, int tid, unsigned (&vo)[2][2]) const {
#pragma unroll
        for (int i = 0; i < 2; ++i) { int R, C; pg8::stage_rc(tid * 16 + i * 8192, R, C); R = launder(R);
#pragma unroll
            for (int h = 0; h < 2; ++h) {
                if (u.e0 == 64) vo[h][i] = (unsigned)((h * 128 + R) * 1024 + C * 2);
                else { const int pos = u.e2 + h * 128 + R; const unsigned tv = list[(size_t)u.e0 * NT + pos] >> 3;
                    vo[h][i] = (pos < u.e4 ? tv : 0u) * 1024u + (unsigned)C * 2u; } } }
    }
};
struct MoeDownSched {
    static constexpr bool GATHER = false;
    const char* ACT; const char* WD; const char* ACTS; const char* WSD; const LAS int* tbase; const LAS int* cnt; int nMs, G, c;
    __device__ __forceinline__ bool next(int i, Unit& u) const {
        if (i >= MOE_UL_MAX) return false;
        const LAS int* ul = tbase + (MOE_UL_OFF - MOE_TAB_OFF) / 4 + i * 8;
        const int e = RFL(ul[0]), pn = RFL(ul[1]), p0 = RFL(ul[2]), t3 = RFL(ul[3]), cn_ = RFL(ul[4]);
        if (e < 0) return false;
        u.e0 = e; u.e1 = pn; u.e2 = p0; u.e3 = t3; u.e4 = cn_;
        if (e != 64) { u.A = ACT + (size_t)t3 * (256 * 256); u.B = WD + (size_t)e * (1024 * 256) + (size_t)pn * (256 * 256); }
        else { u.A = ACTS + (size_t)t3 * (256 * 256); u.B = WSD + (size_t)pn * (256 * 256); }
        return true;
    }
    __device__ __forceinline__ void a_offs(const Unit&, int tid, unsigned (&vo)[2][2]) const {
#pragma unroll
        for (int i = 0; i < 2; ++i) { int R, C; pg8::stage_rc(tid * 16 + i * 8192, R, C);
#pragma unroll
            for (int h = 0; h < 2; ++h) vo[h][i] = (unsigned)((h * 128 + R) * 256 + C * 2); }
    }
};

struct EpiStoreBf16 {
    static constexpr bool STAGES = false;
    static constexpr bool KEEPS = false; __device__ __forceinline__ bool keep(const Unit&) const { return false; }
    static constexpr bool PERM = true;
    bf16_t* O; int ldc; int gate_tile0; unsigned char* G8;
    __device__ __forceinline__ void operator()(const f32x4 (&acc)[2][2][4][2], const Unit& u, int wr, int wc, int fr, int fq) const {
        const int row0 = u.e0 * 256 + launder(wr * 64 + fr), col0 = u.e1 * 256 + wc * 32 + 8 * fq;
        if (u.e1 >= gate_tile0) {
            const int gi = (u.e1 - gate_tile0) >> 2, pn = (u.e1 - gate_tile0) & 3, tidx = launder(((wr * 4 + wc) * 64) + fq * 16 + fr);
            unsigned char* gp = G8 + ((size_t)((u.e0 * 4 + pn) * 3 + gi) * 65536) + (size_t)tidx * 128;
#pragma unroll
            for (int ai = 0; ai < 2; ++ai)
#pragma unroll
                for (int m = 0; m < 4; ++m) { u32x4 w;
#pragma unroll
                    for (int bj = 0; bj < 2; ++bj) { const f32x4 v0 = acc[ai][bj][m][0], v1 = acc[ai][bj][m][1];
                        float q[8] = {v0[0], v0[1], v0[2], v0[3], v1[0], v1[1], v1[2], v1[3]}; unsigned qb[8];
#pragma unroll
                        for (int j = 0; j < 8; ++j) { const float t = fminf(fmaxf(sigmoidf_(q[j]) * 255.0f + 0.5f, 1.0f), 255.0f); qb[j] = (unsigned)t; }
                        const unsigned lo = qb[0] | (qb[1] << 8) | (qb[2] << 16) | (qb[3] << 24), hi = qb[4] | (qb[5] << 8) | (qb[6] << 16) | (qb[7] << 24);
                        if (bj == 0) { w.x = lo; w.y = hi; } else { w.z = lo; w.w = hi; } }
                    *(u32x4*)(gp + (ai * 4 + m) * 16) = w; }
            return;
        }
#pragma unroll
        for (int ai = 0; ai < 2; ++ai)
#pragma unroll
            for (int m = 0; m < 4; ++m) { bf16_t* rowp = O + (size_t)(row0 + ai * 128 + m * 16) * ldc + col0;
#pragma unroll
                for (int bj = 0; bj < 2; ++bj) { const f32x4 v0 = acc[ai][bj][m][0], v1 = acc[ai][bj][m][1];
                    u32x4 w; w.x = pk2(v0[0], v0[1]); w.y = pk2(v0[2], v0[3]); w.z = pk2(v1[0], v1[1]); w.w = pk2(v1[2], v1[3]);
                    *(u32x4*)(rowp + bj * 128) = w; } }
    }
};
struct EpiMerge {
    static constexpr bool PERM = true, KEEPS = true, STAGES = false;
    bf16_t* Mo; const unsigned char* G8;
    __device__ __forceinline__ bool keep(const Unit& u) const { return u.e2 < 2; }
    __device__ __forceinline__ void operator()(f32x4 (&acc)[2][2][4][2], const Unit& u, int wr, int wc, int fr, int fq) const {
        const int row0 = u.e0 * 256 + launder(wr * 64 + fr), col0 = u.e1 * 256 + wc * 32 + 8 * fq, sub = u.e2, tidx = launder(((wr * 4 + wc) * 64) + fq * 16 + fr);
        const unsigned char* gp = G8 + ((size_t)((u.e0 * 4 + u.e1) * 3 + sub) * 65536) + (size_t)tidx * 128;
        u32x4 gq[8], hq[8];
        const unsigned char* hp = gp + (sub < 2 ? 65536 : 0);
#pragma unroll
        for (int k = 0; k < 8; ++k) { gq[k] = *(const u32x4*)(gp + k * 16); hq[k] = *(const u32x4*)(hp + k * 16); }
        if (sub < 2) {
#pragma unroll
            for (int ai = 0; ai < 2; ++ai)
#pragma unroll
                for (int m = 0; m < 4; ++m)
#pragma unroll
                    for (int bj = 0; bj < 2; ++bj) { const u32x4 g4v = gq[ai * 4 + m], h4v = hq[ai * 4 + m];
                        const unsigned g0 = bj ? g4v.z : g4v.x, g1 = bj ? g4v.w : g4v.y, h0 = bj ? h4v.z : h4v.x, h1 = bj ? h4v.w : h4v.y;
                        float f[8];
#pragma unroll
                        for (int j = 0; j < 8; ++j) { const float qg = (float)(((j < 4 ? g0 : g1) >> (8 * (j & 3))) & 255u), qh = (float)(((j < 4 ? h0 : h1) >> (8 * (j & 3))) & 255u);
                            f[j] = qg * __builtin_amdgcn_rcpf(qh); }
                        acc[ai][bj][m][0] = acc[ai][bj][m][0] * (f32x4){f[0], f[1], f[2], f[3]}; acc[ai][bj][m][1] = acc[ai][bj][m][1] * (f32x4){f[4], f[5], f[6], f[7]}; }
        } else {
#pragma unroll
            for (int ai = 0; ai < 2; ++ai)
#pragma unroll
                for (int m = 0; m < 4; ++m)
#pragma unroll
                    for (int bj = 0; bj < 2; ++bj) { const u32x4 g4v = gq[ai * 4 + m];
                        const unsigned g0 = bj ? g4v.z : g4v.x, g1 = bj ? g4v.w : g4v.y;
                        float f[8];
#pragma unroll
                        for (int j = 0; j < 8; ++j) f[j] = (float)(((j < 4 ? g0 : g1) >> (8 * (j & 3))) & 255u) * (1.0f / 255.0f);
                        const f32x4 v0 = acc[ai][bj][m][0] * (f32x4){f[0], f[1], f[2], f[3]}, v1 = acc[ai][bj][m][1] * (f32x4){f[4], f[5], f[6], f[7]};
                        const size_t row = (size_t)(row0 + ai * 128 + m * 16);
                        u32x4 w; w.x = pk2(v0[0], v0[1]); w.y = pk2(v0[2], v0[3]); w.z = pk2(v1[0], v1[1]); w.w = pk2(v1[2], v1[3]);
                        *(u32x4*)(Mo + row * 1024 + col0 + bj * 128) = w; }
        }
    }
};
struct EpiResid {
    static constexpr bool STAGES = false;
    static constexpr bool KEEPS = false; __device__ __forceinline__ bool keep(const Unit&) const { return false; }
    static constexpr bool PERM = false;
    const float* src_l; const float* src_c; float* dst_l; float* dst_c; const float* gate;
    __device__ __forceinline__ void operator()(const f32x4 (&acc)[2][2][4][2], const Unit& u, int wr, int wc, int fr, int fq) const {
        const int g0 = u.e0 * 256; const bool lat = g0 < NL;
        const float* src = lat ? src_l + (size_t)g0 * D : src_c + (size_t)(g0 - NL) * D;
        float* dst = lat ? dst_l + (size_t)g0 * D : dst_c + (size_t)(g0 - NL) * D;
        const float* gp = gate + (size_t)(lat ? (g0 >> 11) : 8) * 6144;
        const int row0 = launder(wr * 64 + fr), col0 = u.e1 * 256 + wc * 32 + 4 * fq;
        f32x4 gv[2][2];
#pragma unroll
        for (int bj = 0; bj < 2; ++bj)
#pragma unroll
            for (int n = 0; n < 2; ++n) gv[bj][n] = *(const f32x4*)(gp + col0 + bj * 128 + n * 16);
#pragma unroll
        for (int am = 0; am < 4; ++am) { const int ai = am >> 1, mh = (am & 1) * 2;
            f32x4 sq[2][2][2];
#pragma unroll
            for (int mm = 0; mm < 2; ++mm)
#pragma unroll
                for (int bj = 0; bj < 2; ++bj)
#pragma unroll
                    for (int n = 0; n < 2; ++n) sq[mm][bj][n] = *(const f32x4*)(src + (size_t)(row0 + ai * 128 + (mh + mm) * 16) * D + col0 + bj * 128 + n * 16);
#pragma unroll
            for (int mm = 0; mm < 2; ++mm)
#pragma unroll
                for (int bj = 0; bj < 2; ++bj)
#pragma unroll
                    for (int n = 0; n < 2; ++n) *(f32x4*)(dst + (size_t)(row0 + ai * 128 + (mh + mm) * 16) * D + col0 + bj * 128 + n * 16) = sq[mm][bj][n] + gv[bj][n] * acc[ai][bj][mh + mm][n];
            if (am == 1) asm volatile("" ::: "memory");
        }
    }
};
struct EpiGateUp {
    static constexpr bool KEEPS = false; __device__ __forceinline__ bool keep(const Unit&) const { return false; }
    static constexpr bool PERM = true, STAGES = true;
    bf16_t* ACT; bf16_t* ACTS; const float* wl;
    __device__ __forceinline__ void stage(const Unit& u, LAS unsigned* dst_wave, int entry) const {
        if (u.e0 != 64) __builtin_amdgcn_global_load_lds((const unsigned*)(wl + (size_t)u.e0 * NT + u.e2 + entry), dst_wave, 4, 0, 0);
    }
    __device__ __forceinline__ void operator()(const f32x4 (&acc)[2][2][4][2], const Unit& u, int wr, int wc, int fr, int fq, const LAS unsigned* tab) const {
        const int row0 = launder(wr * 64 + fr), col0 = u.e1 * 128 + wc * 32 + 8 * fq;
        unsigned char* base = (unsigned char*)(u.e0 == 64 ? ACTS : ACT) + (size_t)u.e3 * 256 * 256;
#pragma unroll
        for (int ai = 0; ai < 2; ++ai)
#pragma unroll
            for (int m = 0; m < 4; ++m) { const int row = row0 + ai * 128 + m * 16; const float tw = __uint_as_float(tab[row]);
                const float w = u.e0 == 64 ? 1.0f : (u.e2 + row < u.e4 ? tw : 0.0f);
                const f32x4 g0 = acc[ai][0][m][0] * 0.03125f, g1 = acc[ai][0][m][1] * 0.03125f, u0 = acc[ai][1][m][0] * (0.03125f * 8.0f * w), u1 = acc[ai][1][m][1] * (0.03125f * 8.0f * w);
                int lo = 0, hi = 0;
                lo = __builtin_amdgcn_cvt_pk_fp8_f32(siluf_(g0[0]) * u0[0], siluf_(g0[1]) * u0[1], lo, false); lo = __builtin_amdgcn_cvt_pk_fp8_f32(siluf_(g0[2]) * u0[2], siluf_(g0[3]) * u0[3], lo, true);
                hi = __builtin_amdgcn_cvt_pk_fp8_f32(siluf_(g1[0]) * u1[0], siluf_(g1[1]) * u1[1], hi, false); hi = __builtin_amdgcn_cvt_pk_fp8_f32(siluf_(g1[2]) * u1[2], siluf_(g1[3]) * u1[3], hi, true);
                *(u32x2*)(base + (size_t)row * 256 + col0) = (u32x2){(unsigned)lo, (unsigned)hi}; }
    }
};
struct EpiDown {
    static constexpr bool KEEPS = false; __device__ __forceinline__ bool keep(const Unit&) const { return false; }
    static constexpr bool PERM = true, STAGES = true;
    bf16_t* O; const unsigned* list; bf16_t* Hs;
    __device__ __forceinline__ void stage(const Unit& u, LAS unsigned* dst_wave, int entry) const {
        if (u.e0 != 64) __builtin_amdgcn_global_load_lds(list + (size_t)u.e0 * NT + u.e2 + entry, dst_wave, 4, 0, 0);
    }
    __device__ __forceinline__ void operator()(const f32x4 (&acc)[2][2][4][2], const Unit& u, int wr, int wc, int fr, int fq, const LAS unsigned* tab) const {
        const int row0 = launder(wr * 64 + fr), col0 = u.e1 * 256 + wc * 32 + 8 * fq;
        if (u.e0 == 64) {
#pragma unroll
            for (int ai = 0; ai < 2; ++ai)
#pragma unroll
                for (int m = 0; m < 4; ++m) { bf16_t* rowp = Hs + (size_t)(u.e3 * 256 + row0 + ai * 128 + m * 16) * 1024 + col0;
#pragma unroll
                    for (int bj = 0; bj < 2; ++bj) { const f32x4 v0 = acc[ai][bj][m][0] * 0.0078125f, v1 = acc[ai][bj][m][1] * 0.0078125f;
                        u32x4 w; w.x = pk2(v0[0], v0[1]); w.y = pk2(v0[2], v0[3]); w.z = pk2(v1[0], v1[1]); w.w = pk2(v1[2], v1[3]);
                        *(u32x4*)(rowp + bj * 128) = w; } }
        } else {
            unsigned dq[2][4];
#pragma unroll
            for (int ai = 0; ai < 2; ++ai)
#pragma unroll
                for (int m = 0; m < 4; ++m) dq[ai][m] = tab[row0 + ai * 128 + m * 16];
#pragma unroll
            for (int ai = 0; ai < 2; ++ai)
#pragma unroll
                for (int m = 0; m < 4; ++m) {
                    if (u.e2 + row0 + ai * 128 + m * 16 < u.e4) { unsigned char* rowp = (unsigned char*)O + (size_t)dq[ai][m] * 1024 + col0;
#pragma unroll
                        for (int bj = 0; bj < 2; ++bj) { const f32x4 v0 = acc[ai][bj][m][0] * 0.0078125f, v1 = acc[ai][bj][m][1] * 0.0078125f;
                            int lo = 0, hi = 0;
                            lo = __builtin_amdgcn_cvt_pk_fp8_f32(v0[0], v0[1], lo, false); lo = __builtin_amdgcn_cvt_pk_fp8_f32(v0[2], v0[3], lo, true);
                            hi = __builtin_amdgcn_cvt_pk_fp8_f32(v1[0], v1[1], hi, false); hi = __builtin_amdgcn_cvt_pk_fp8_f32(v1[2], v1[3], hi, true);
                            *(u32x2*)(rowp + bj * 128) = (u32x2){(unsigned)lo, (unsigned)hi}; } } }
        }
    }
};

struct Params {
    const float* in[26];
    float* out; unsigned char* ws;
    int ph_lo, ph_hi, li, pad;
};
enum { I_X = 0, I_C, I_CTX, I_CCTX, I_WADA, I_BADA, I_NMG, I_NFG, I_WIN, I_CMLNG, I_CMLNB, I_CMWS, I_CMBS, I_RPB, I_DECAY, I_WBR, I_WOUT, I_RW, I_RB,
       I_EG, I_EU, I_ED, I_SG, I_SU, I_SD, I_FG };

__device__ __forceinline__ const float* kin(int i) {
    unsigned off = (unsigned)i * 8u; asm volatile("" : "+s"(off));
    const __attribute__((address_space(4))) char* ka = (const __attribute__((address_space(4))) char*)__builtin_amdgcn_kernarg_segment_ptr();
    return (const float*)*(GAS const float* const __attribute__((address_space(4)))*)(ka + off);
}
__device__ __forceinline__ float* kout_ptr() { unsigned off = 208u; asm volatile("" : "+s"(off));
    const __attribute__((address_space(4))) char* ka = (const __attribute__((address_space(4))) char*)__builtin_amdgcn_kernarg_segment_ptr();
    return (float*)*(GAS float* const __attribute__((address_space(4)))*)(ka + off); }
__device__ __forceinline__ unsigned char* kws_ptr() { unsigned off = 216u; asm volatile("" : "+s"(off));
    const __attribute__((address_space(4))) char* ka = (const __attribute__((address_space(4))) char*)__builtin_amdgcn_kernarg_segment_ptr();
    return (unsigned char*)*(GAS unsigned char* const __attribute__((address_space(4)))*)(ka + off); }
static_assert(__builtin_offsetof(Params, out) == 208 && __builtin_offsetof(Params, ws) == 216, "kernarg offsets");
static_assert(__builtin_offsetof(Params, in) == 0, "kin() reads Params::in at kernarg offset 0");
__device__ __forceinline__ void transpose_item(const float* W, int N, bf16_t* WT, int ldk, int extra, LAS float* scr, int kb, int nb, int lane) {
    const int k0 = 64 * kb, n0 = 32 * nb;
    float wv[32];
#pragma unroll
    for (int i = 0; i < 32; ++i) wv[i] = W[(size_t)(k0 + 2 * i + (lane >> 5)) * N + n0 + (lane & 31)];
#pragma unroll
    for (int i = 0; i < 32; ++i) scr[(2 * i + (lane >> 5)) * 33 + (lane & 31)] = wv[i];
    LDS_WAIT(); asm volatile("" ::: "memory");
    const int c = lane & 7;
#pragma unroll
    for (int j = 0; j < 4; ++j) { const int n = (lane >> 3) + 8 * j; const LAS float* s = scr + (8 * c) * 33 + n;
        u32x4 o; o.x = pk2(s[0 * 33], s[1 * 33]); o.y = pk2(s[2 * 33], s[3 * 33]); o.z = pk2(s[4 * 33], s[5 * 33]); o.w = pk2(s[6 * 33], s[7 * 33]);
        *(u32x4*)(WT + (size_t)(n0 + n + extra) * ldk + k0 + 8 * c) = o; }
    LDS_WAIT(); asm volatile("" ::: "memory");
}
__device__ __forceinline__ void transpose_item_f8(const float* W, int N, unsigned char* WT, int ldk, int extra, float scale, LAS float* scr, int kb, int nb, int lane) {
    const int k0 = 64 * kb, n0 = 32 * nb;
    float wv[32];
#pragma unroll
    for (int i = 0; i < 32; ++i) wv[i] = W[(size_t)(k0 + 2 * i + (lane >> 5)) * N + n0 + (lane & 31)];
#pragma unroll
    for (int i = 0; i < 32; ++i) scr[(2 * i + (lane >> 5)) * 33 + (lane & 31)] = wv[i];
    LDS_WAIT(); asm volatile("" ::: "memory");
    const int c = lane & 7;
#pragma unroll
    for (int j = 0; j < 4; ++j) { const int n = (lane >> 3) + 8 * j; const LAS float* s = scr + (8 * c) * 33 + n;
        int lo = 0, hi = 0;
        lo = __builtin_amdgcn_cvt_pk_fp8_f32(s[0 * 33] * scale, s[1 * 33] * scale, lo, false); lo = __builtin_amdgcn_cvt_pk_fp8_f32(s[2 * 33] * scale, s[3 * 33] * scale, lo, true);
        hi = __builtin_amdgcn_cvt_pk_fp8_f32(s[4 * 33] * scale, s[5 * 33] * scale, hi, false); hi = __builtin_amdgcn_cvt_pk_fp8_f32(s[6 * 33] * scale, s[7 * 33] * scale, hi, true);
        *(u32x2*)(WT + (size_t)(n0 + n + extra) * ldk + k0 + 8 * c) = (u32x2){(unsigned)lo, (unsigned)hi}; }
    LDS_WAIT(); asm volatile("" ::: "memory");
}
constexpr int IT_IN = 16 * 224, IT_BR = 3 * 8 * 32, IT_OUT = 16 * 32, IT_SG = 16 * 8, IT_SD = 4 * 32, IT_RT = 16 * 2, IT_CM = 128;
constexpr int MISC_ITEMS = IT_IN + IT_BR + IT_OUT + 2 * IT_SG + IT_SD + IT_RT + IT_CM;
__device__ __forceinline__ void misc_item(const Params& p, int l, int r, LAS float* scr, int lane) {
    unsigned char* wm = p.ws + WS_WM + (size_t)l * WM_STRIDE;
    if (r < IT_IN) { transpose_item(kin(I_WIN) + (size_t)l * 1024 * 7168, 7168, (bf16_t*)(wm + WM_IN), 1024, 0, scr, r / 224, r % 224, lane); return; } r -= IT_IN;
    if (r < IT_BR) { const int i = r / 256, q = r % 256; transpose_item(kin(I_WBR) + ((size_t)l * 3 + i) * 512 * 1024, 1024, (bf16_t*)(wm + WM_BR) + (size_t)i * 1024 * 512, 512, 0, scr, q / 32, q % 32, lane); return; } r -= IT_BR;
    if (r < IT_OUT) { transpose_item(kin(I_WOUT) + (size_t)l * 1024 * 1024, 1024, (bf16_t*)(wm + WM_OUT), 1024, 0, scr, r / 32, r % 32, lane); return; } r -= IT_OUT;
    if (r < 2 * IT_SG) { const int up = r / IT_SG, q = r % IT_SG, nb = q % 8;
        transpose_item_f8(kin(up ? I_SU : I_SG) + (size_t)l * 1024 * 256, 256, (unsigned char*)(wm + WM_SGU), 1024, ((32 * nb) / 128) * 128 + up * 128, 32.0f, scr, q / 8, nb, lane); return; } r -= 2 * IT_SG;
    if (r < IT_SD) { transpose_item_f8(kin(I_SD) + (size_t)l * 256 * 1024, 1024, (unsigned char*)(wm + WM_SD), 256, 0, 16.0f, scr, r / 32, r % 32, lane); return; } r -= IT_SD;
    if (r < IT_RT) { transpose_item(kin(I_RW) + (size_t)l * 1024 * 64, 64, (bf16_t*)(wm + WM_RT), 1024, 0, scr, r / 2, r % 2, lane); return; } r -= IT_RT;
    { const float* src = kin(I_CMWS) + (size_t)l * 65536 + (size_t)r * 512 + lane * 8; const f32x4 a = *(const f32x4*)src, b = *(const f32x4*)(src + 4);
      u32x4 o; o.x = pk2(a[0], a[1]); o.y = pk2(a[2], a[3]); o.z = pk2(b[0], b[1]); o.w = pk2(b[2], b[3]);
      *(u32x4*)((bf16_t*)(wm + WM_CM) + (size_t)r * 512 + lane * 8) = o; }
}
constexpr int EXP_ITEMS = 3 * 64 * 128;
constexpr int FILL_SPLIT = 34000;
__device__ __forceinline__ void expert_item(const Params& p, int l, int r, LAS float* scr, int lane) {
    unsigned char* we = p.ws + WS_WE + (size_t)l * WE_LAYER;
    const int which = r / 8192, q = r % 8192, e = q / 128, it = q % 128;
    if (which < 2) { const int kb = it / 8, nb = it % 8;
        transpose_item_f8(kin(which ? I_EU : I_EG) + ((size_t)l * 64 + e) * 1024 * 256, 256, (unsigned char*)(we + WE_GU) + (size_t)e * 512 * 1024, 1024, ((32 * nb) / 128) * 128 + which * 128, 32.0f, scr, kb, nb, lane); }
    else { const int kb = it / 32, nb = it % 32;
        transpose_item_f8(kin(I_ED) + ((size_t)l * 64 + e) * 256 * 1024, 1024, (unsigned char*)(we + WE_D) + (size_t)e * 1024 * 256, 256, 0, 16.0f, scr, kb, nb, lane); }
}
__device__ __forceinline__ void mod_unit(const Params& p, LAS unsigned char* lds, int u, int tid) {
    const int l = u / 96, cb = u % 96, wave = __builtin_amdgcn_readfirstlane(tid >> 6), lane = tid & 63;
    LAS float* sil = (LAS float*)lds;
    LAS float* part = (LAS float*)(lds + 36864);
    for (int idx = tid; idx < 9 * 1024; idx += NTHREADS) { const int r = idx >> 10, k = idx & 1023; const float v = r < 8 ? kin(I_C)[r * 1024 + k] : kin(I_CCTX)[k]; sil[idx] = v / (1.0f + expf(-v)); }
    __syncthreads();
    float acc[9];
#pragma unroll
    for (int r = 0; r < 9; ++r) acc[r] = 0.f;
    const float* wp = kin(I_WADA) + ((size_t)l * 1024 + wave * 128) * 6144 + cb * 64 + lane;
#pragma unroll 4
    for (int k = 0; k < 128; ++k) { const float wv = wp[(size_t)k * 6144];
#pragma unroll
        for (int r = 0; r < 9; ++r) acc[r] += sil[r * 1024 + wave * 128 + k] * wv; }
#pragma unroll
    for (int r = 0; r < 9; ++r) part[(wave * 9 + r) * 64 + lane] = acc[r];
    __syncthreads();
    for (int idx = tid; idx < 576; idx += NTHREADS) { const int r = idx >> 6, ln = idx & 63; float s = kin(I_BADA)[l * 6144 + cb * 64 + ln];
#pragma unroll
        for (int w = 0; w < 8; ++w) s += part[(w * 9 + r) * 64 + ln];
        ((float*)(p.ws + WS_MOD))[((size_t)l * 9 + r) * 6144 + cb * 64 + ln] = s; }
    __syncthreads();
}

__device__ __forceinline__ void norm_mod_vals(const f32x4 (&v)[4], const float* g, const float* sh, const float* sc, bf16_t* orow, bool to_lds, LAS unsigned char* ldst, int lane) {
    f32x4 gq[4], hq[4], cq[4];
#pragma unroll
    for (int j = 0; j < 4; ++j) { gq[j] = ((const f32x4*)g)[64 * j + lane]; hq[j] = ((const f32x4*)sh)[64 * j + lane]; cq[j] = ((const f32x4*)sc)[64 * j + lane]; }
    float ss = 0.f;
#pragma unroll
    for (int j = 0; j < 4; ++j) ss += (v[j][0] * v[j][0] + v[j][1] * v[j][1]) + (v[j][2] * v[j][2] + v[j][3] * v[j][3]);
    const float rstd = rsqrtf(wave_sum(ss, lane) * (1.0f / 1024.0f) + EPS);
#pragma unroll
    for (int j = 0; j < 4; ++j) { const f32x4 gg = gq[j], s_h = hq[j], s_c = cq[j];
        const f32x4 y = v[j] * rstd * gg * (s_c + 1.0f) + s_h;
        u32x2 o; o.x = pk2(y[0], y[1]); o.y = pk2(y[2], y[3]);
        ((u32x2*)orow)[64 * j + lane] = o;
        if (to_lds) *(LAS u32x2*)(ldst + (64 * j + lane) * 8) = o; }
}
__device__ __forceinline__ void norm_mod_row(const float* xrow, const float* g, const float* sh, const float* sc, bf16_t* orow, bool to_lds, LAS unsigned char* ldst, int lane) {
    f32x4 v[4];
#pragma unroll
    for (int j = 0; j < 4; ++j) v[j] = ((const f32x4*)xrow)[64 * j + lane];
    norm_mod_vals(v, g, sh, sc, orow, to_lds, ldst, lane);
}
__device__ __forceinline__ void combine_row(f32x4 (&v)[4], const float* xrow, const float* ga2, const bf16_t* shrow, const unsigned char* o8, int lane) {
    u32x2 sq[4]; unsigned oq[8][4]; f32x4 gq[4];
#pragma unroll
    for (int j = 0; j < 4; ++j) { v[j] = ((const f32x4*)xrow)[64 * j + lane]; gq[j] = ((const f32x4*)ga2)[64 * j + lane]; sq[j] = ((const u32x2*)shrow)[64 * j + lane]; }
#pragma unroll
    for (int k = 0; k < 8; ++k)
#pragma unroll
        for (int j = 0; j < 4; ++j) oq[k][j] = ((const unsigned*)(o8 + (size_t)k * 1024))[64 * j + lane];
    asm volatile("" :: "v"(v[0]), "v"(v[1]), "v"(v[2]), "v"(v[3]), "v"(gq[0]), "v"(gq[1]), "v"(gq[2]), "v"(gq[3]) : "memory");
#pragma unroll
    for (int j = 0; j < 4; ++j) { f32x4 t = (f32x4){lo16(sq[j].x), hi16(sq[j].x), lo16(sq[j].y), hi16(sq[j].y)};
#pragma unroll
        for (int k = 0; k < 8; ++k) { const int w = (int)oq[k][j];
            t[0] += __builtin_amdgcn_cvt_f32_fp8(w, 0); t[1] += __builtin_amdgcn_cvt_f32_fp8(w, 1); t[2] += __builtin_amdgcn_cvt_f32_fp8(w, 2); t[3] += __builtin_amdgcn_cvt_f32_fp8(w, 3); }
        v[j] += gq[j] * t; }
}

constexpr int RT_TILE = 0, RT_PITCH = 2064, RT_LG = 64 * RT_PITCH  , RT_BIAS = RT_LG + 64 * 65 * 4  , RT_LCNT = RT_BIAS + 256, RT_LBASE = RT_LCNT + 256,
              RT_SELE = RT_LBASE + 256  , RT_SELW = RT_SELE + 2048, RT_SELR = RT_SELW + 2048, RT_END = RT_SELR + 2048;
static_assert(RT_END <= LDS_BYTES, "router LDS");
#ifdef TIMING
#define RSTAMP(k) do { if (stamp && tid == 0) ((volatile LAS unsigned long long*)(lds + LDS_BYTES - 16 - 512))[24 + (k)] = __builtin_amdgcn_s_memrealtime(); } while (0)
#else
#define RSTAMP(k) do { } while (0)
#endif
__device__ __forceinline__ void router_unit(const Params& p, LAS unsigned char* lds, int l, int u, const float* xl, const float* xc, int tid, bool commit, bool stamp = false) {
    const int wave = __builtin_amdgcn_readfirstlane(tid >> 6), lane = tid & 63, g4 = lane >> 4, row0 = u * 64;
    const bool lat = row0 < NL;
    const float* mr = (const float*)(p.ws + WS_MOD) + (size_t)l * 9 * 6144 + (size_t)(lat ? (row0 >> 11) : 8) * 6144;
    const float* xbase = lat ? xl + (size_t)row0 * D : xc + (size_t)(row0 - NL) * D;
    unsigned char* H2 = (unsigned char*)(p.ws + WS_H) + (size_t)row0 * D;
    LAS float* lg = (LAS float*)(lds + RT_LG); LAS float* bias = (LAS float*)(lds + RT_BIAS);
    LAS int* lcnt = (LAS int*)(lds + RT_LCNT); LAS int* lbase = (LAS int*)(lds + RT_LBASE);
    LAS int* sele = (LAS int*)(lds + RT_SELE); LAS float* selw = (LAS float*)(lds + RT_SELW); LAS int* selr = (LAS int*)(lds + RT_SELR);
    RSTAMP(0);
    if (tid < 64) { lcnt[tid] = 0; bias[tid] = kin(I_RB)[l * 64 + tid]; }
    const int rb = wave >> 1, eb0 = (wave & 1) * 2;
    const bf16_t* w0 = (const bf16_t*)(p.ws + WS_WM + (size_t)l * WM_STRIDE + WM_RT) + launder((eb0 * 16 + (lane & 15)) * 1024 + g4 * 8); const bf16_t* w1 = w0 + launder(16 * 1024);
    bf16x8 qa0[4], qa1[4];
#pragma unroll
    for (int ks = 0; ks < 4; ++ks) { qa0[ks] = *(const bf16x8*)(w0 + ks * 32); qa1[ks] = *(const bf16x8*)(w1 + ks * 32); }
    { f32x4 gg[4], s_h[4], s_c[4];
#pragma unroll
      for (int j = 0; j < 4; ++j) { gg[j] = ((const f32x4*)(kin(I_NFG) + l * 1024))[64 * j + lane]; s_h[j] = ((const f32x4*)(mr + 3072))[64 * j + lane]; s_c[j] = ((const f32x4*)(mr + 4096))[64 * j + lane] + 1.0f; }
#pragma unroll
      for (int hb = 0; hb < 2; ++hb) { f32x4 v[4][4];
#pragma unroll
          for (int i = 0; i < 4; ++i)
#pragma unroll
              for (int j = 0; j < 4; ++j) v[i][j] = ((const f32x4*)(xbase + (size_t)(wave * 8 + hb * 4 + i) * D))[64 * j + lane];
#pragma unroll
          for (int i = 0; i < 4; ++i) { const int rl = wave * 8 + hb * 4 + i; float ss = 0.f;
#pragma unroll
              for (int j = 0; j < 4; ++j) ss += (v[i][j][0] * v[i][j][0] + v[i][j][1] * v[i][j][1]) + (v[i][j][2] * v[i][j][2] + v[i][j][3] * v[i][j][3]);
              const float rstd = rsqrtf(wave_sum(ss, lane) * (1.0f / 1024.0f) + EPS);
#pragma unroll
              for (int j = 0; j < 4; ++j) { const f32x4 y = v[i][j] * rstd * gg[j] * s_c[j] + s_h[j];
                  u32x2 o; o.x = pk2(y[0], y[1]); o.y = pk2(y[2], y[3]);
                  int q8 = 0; q8 = __builtin_amdgcn_cvt_pk_fp8_f32(y[0], y[1], q8, false); q8 = __builtin_amdgcn_cvt_pk_fp8_f32(y[2], y[3], q8, true);
                  ((unsigned*)(H2 + (size_t)rl * D))[64 * j + lane] = (unsigned)q8; *(LAS u32x2*)(lds + RT_TILE + rl * RT_PITCH + (64 * j + lane) * 8) = o; } } } }
    __syncthreads();
    RSTAMP(1);
    { f32x4 a0 = (f32x4){0.f, 0.f, 0.f, 0.f}, a1 = a0;
      const LAS unsigned char* hrow = lds + RT_TILE + (rb * 16 + (lane & 15)) * RT_PITCH + g4 * 16;
      bf16x8 qb0[4], qb1[4];
      sfor<0, 4>([&](auto it_) { constexpr int it = decltype(it_)::value;
#pragma unroll
          for (int ks = 0; ks < 4; ++ks) { qb0[ks] = *(const bf16x8*)(w0 + ((2 * it + 1) * 4 + ks) * 32); qb1[ks] = *(const bf16x8*)(w1 + ((2 * it + 1) * 4 + ks) * 32); }
#pragma unroll
          for (int ks = 0; ks < 4; ++ks) { const bf16x8 bq = *(const LAS bf16x8*)(hrow + ((2 * it) * 4 + ks) * 64); a0 = mfma16(qa0[ks], bq, a0); a1 = mfma16(qa1[ks], bq, a1); }
          if constexpr (it < 3) {
#pragma unroll
              for (int ks = 0; ks < 4; ++ks) { qa0[ks] = *(const bf16x8*)(w0 + ((2 * it + 2) * 4 + ks) * 32); qa1[ks] = *(const bf16x8*)(w1 + ((2 * it + 2) * 4 + ks) * 32); } }
#pragma unroll
          for (int ks = 0; ks < 4; ++ks) { const bf16x8 bq = *(const LAS bf16x8*)(hrow + ((2 * it + 1) * 4 + ks) * 64); a0 = mfma16(qb0[ks], bq, a0); a1 = mfma16(qb1[ks], bq, a1); } });
      const int rr = rb * 16 + (lane & 15);
#pragma unroll
      for (int r = 0; r < 4; ++r) { lg[rr * 65 + eb0 * 16 + 4 * g4 + r] = sigmoidf_(a0[r]); lg[rr * 65 + (eb0 + 1) * 16 + 4 * g4 + r] = sigmoidf_(a1[r]); } }
    __syncthreads();
    RSTAMP(2);
    { const int row = tid >> 3, g = tid & 7;
      float sv[8]; unsigned key[8];
#pragma unroll
      for (int j = 0; j < 8; ++j) { sv[j] = lg[row * 65 + 8 * g + j]; const unsigned ub = __float_as_uint(sv[j] + bias[8 * g + j]);
          key[j] = ((ub ^ ((ub >> 31) ? 0xffffffffu : 0x80000000u)) & ~63u) | (unsigned)(63 - (8 * g + j)); }
      float m1 = -3e38f, m2 = -3e38f;
#pragma unroll
      for (int j = 0; j < 8; ++j) { const float c = sv[j] + bias[8 * g + j]; if (c > m1) { m2 = m1; m1 = c; } else if (c > m2) m2 = c; }
      const unsigned ug = __float_as_uint(m1 + m2); const unsigned gkey = ((ug ^ ((ug >> 31) ? 0xffffffffu : 0x80000000u)) & ~7u) | (unsigned)(7 - g);
      int grank = 0;
      sfor<1, 8>([&](auto d_) { constexpr int d = decltype(d_)::value; grank += (int)((unsigned)shxi((int)gkey, d, lane) > gkey); });
      const bool gsel = grank < 4;
#pragma unroll
      for (int j = 0; j < 8; ++j) if (!gsel) key[j] = (unsigned)(63 - (8 * g + j));
      int rk[8];
#pragma unroll
      for (int j = 0; j < 8; ++j) { int r = 0;
#pragma unroll
          for (int j2 = 0; j2 < 8; ++j2) r += (int)(key[j2] > key[j]);
          rk[j] = r; }
      sfor<1, 8>([&](auto d_) { constexpr int d = decltype(d_)::value;
          sfor<0, 8>([&](auto j2_) { constexpr int j2 = decltype(j2_)::value; const unsigned ok = (unsigned)shxi((int)key[j2], d, lane);
#pragma unroll
              for (int j = 0; j < 8; ++j) rk[j] += (int)(ok > key[j]); });
          __builtin_amdgcn_sched_barrier(0); });
      float wsum = 0.f;
#pragma unroll
      for (int j = 0; j < 8; ++j) if (gsel && rk[j] < 8) wsum += sv[j];
      wsum += shx(wsum, 1, lane); wsum += shx(wsum, 2, lane); wsum += shx(wsum, 4, lane);
      const float sc = 2.5f / wsum;
#pragma unroll
      for (int j = 0; j < 8; ++j) if (gsel && rk[j] < 8) { const int e = 8 * g + j, k = rk[j];
          sele[row * 8 + k] = e; selw[row * 8 + k] = sv[j] * sc; selr[row * 8 + k] = __hip_atomic_fetch_add(&lcnt[e], 1, __ATOMIC_RELAXED, __HIP_MEMORY_SCOPE_WORKGROUP); } }
    __syncthreads();
    RSTAMP(3);
    if (tid < 64) { const int n = lcnt[tid]; int base = 0; if (n > 0 && commit) base = (int)atomicAdd((unsigned*)(p.ws + WS_CTL) + CW_CNT + l * 2048 + tid * 16, (unsigned)n); lbase[tid] = base; }
    __syncthreads();
    RSTAMP(4);
    { const int rl = tid >> 3, k = tid & 7, e = sele[rl * 8 + k], pos = lbase[e] + selr[rl * 8 + k];
      if (commit) { ((unsigned*)(p.ws + WS_LIST))[(size_t)e * NT + pos] = (unsigned)((row0 + rl) * 8 + k); ((float*)(p.ws + WS_WL))[(size_t)e * NT + pos] = selw[rl * 8 + k]; } }
    __syncthreads();
    RSTAMP(5);
}

__device__ __forceinline__ void mixA_unit(const Params& p, LAS unsigned char* lds, int l, int ch, int g, int tid) {
    const int wave = __builtin_amdgcn_readfirstlane(tid >> 6), lane = tid & 63, g4 = lane >> 4, rows0 = ch * 128;
    const bf16_t* Z = (const bf16_t*)(p.ws + WS_R + R_Z); bf16_t* BR = (bf16_t*)(p.ws + WS_R + R_BR);
    const bf16_t* WCM = (const bf16_t*)(p.ws + WS_WM + (size_t)l * WM_STRIDE + WM_CM);
    LAS unsigned char* vn = lds + 1024;
    { const int q = tid >> 2, cs = (tid & 3) * 32; const f32x2 st2 = *(const f32x2*)((const float*)(p.ws + WS_R + R_STAT) + (size_t)(rows0 + q) * 2); const float mean = st2[0], rstd = st2[1];
      const float* lg = kin(I_CMLNG) + l * 512 + g * 128 + cs; const float* lb = kin(I_CMLNB) + l * 512 + g * 128 + cs;
#pragma unroll
      for (int j = 0; j < 4; ++j) { const u32x4 v = *(const u32x4*)(Z + (size_t)(rows0 + q) * ZW + ZC_AV + g * 128 + cs + 8 * j);
          const f32x4 ga = *(const f32x4*)(lg + 8 * j), gb = *(const f32x4*)(lg + 8 * j + 4), ba = *(const f32x4*)(lb + 8 * j), bb = *(const f32x4*)(lb + 8 * j + 4);
          u32x4 o;
          o.x = pk2((geluf_(lo16(v.x)) - mean) * rstd * ga[0] + ba[0], (geluf_(hi16(v.x)) - mean) * rstd * ga[1] + ba[1]);
          o.y = pk2((geluf_(lo16(v.y)) - mean) * rstd * ga[2] + ba[2], (geluf_(hi16(v.y)) - mean) * rstd * ga[3] + ba[3]);
          o.z = pk2((geluf_(lo16(v.z)) - mean) * rstd * gb[0] + bb[0], (geluf_(hi16(v.z)) - mean) * rstd * gb[1] + bb[1]);
          o.w = pk2((geluf_(lo16(v.w)) - mean) * rstd * gb[2] + bb[2], (geluf_(hi16(v.w)) - mean) * rstd * gb[3] + bb[3]);
          *(LAS u32x4*)(vn + q * 272 + (cs + 8 * j) * 2) = o; } }
    __syncthreads();
    { const int pb = wave, pp = pb * 16 + (lane & 15);
      bf16x8 bfr[4];
#pragma unroll
      for (int ks = 0; ks < 4; ++ks) bfr[ks] = *(const bf16x8*)(WCM + (size_t)(g * 128 + pp) * 128 + 32 * ks + 8 * g4);
      const unsigned vna = tr_lane(lds_addr(vn), 272, 8, lane);
      const float bs = kin(I_CMBS)[l * 512 + g * 128 + pp];
      const size_t row = (size_t)(rows0 + pp);
      sfor<0, 2>([&](auto cg_) { constexpr int cg = decltype(cg_)::value; f32x4 acc[4];
#pragma unroll
          for (int i = 0; i < 4; ++i) acc[i] = (f32x4){0.f, 0.f, 0.f, 0.f};
          sfor<0, 4>([&](auto ks_) { constexpr int ks = decltype(ks_)::value; bf16x8 af[4]; tr_frag4_i<32 * ks * 272 + 128 * cg, 4 * 272>(vna, af);
#pragma unroll
              for (int i = 0; i < 4; ++i) acc[i] = mfma16(af[i], bfr[ks], acc[i]); });
#pragma unroll
          for (int i = 0; i < 4; ++i) { const int c = 16 * (4 * cg + i) + 4 * g4;
          const u32x2 uu = *(const u32x2*)(Z + row * ZW + ZC_AU + g * 128 + c);
          u32x2 o; o.x = pk2(geluf_(lo16(uu.x)) * (acc[i][0] + bs), geluf_(hi16(uu.x)) * (acc[i][1] + bs)); o.y = pk2(geluf_(lo16(uu.y)) * (acc[i][2] + bs), geluf_(hi16(uu.y)) * (acc[i][3] + bs));
          *(u32x2*)(BR + row * BRW + g * 128 + c) = o; } }); }
    __syncthreads();
}

__device__ __forceinline__ void ret_stage_qk(const bf16_t* src  , const float* rope, bool do_rope, int tpos0, int mask  , LAS unsigned char* t0, LAS unsigned char* t1, LAS unsigned char* t2,
                                             float sc0, float l2a, float offa, float siga, float l2b, float offb, float sigb, int tid) {
    const int pp = tid >> 2, half = (tid >> 1) & 1, sub = tid & 1;
    const bf16_t* s = src + (size_t)pp * ZW + 32 * half + 8 * sub;
    const u32x4 a = *(const u32x4*)s, b = *(const u32x4*)(s + 16);
    float x1[8] = {lo16(a.x), hi16(a.x), lo16(a.y), hi16(a.y), lo16(a.z), hi16(a.z), lo16(a.w), hi16(a.w)};
    float x2[8] = {lo16(b.x), hi16(b.x), lo16(b.y), hi16(b.y), lo16(b.z), hi16(b.z), lo16(b.w), hi16(b.w)};
    float o1[8], o2[8];
    if (do_rope) { const int t = tpos0 + pp, pos = half ? (t & 63) : (t >> 6); const f32x4* tb = (const f32x4*)(rope + (size_t)(pos * 16 + 8 * sub) * 2);
#pragma unroll
        for (int j = 0; j < 4; ++j) { const f32x4 cs = tb[j];
            o1[2 * j] = x1[2 * j] * cs[0] - x2[2 * j] * cs[1]; o2[2 * j] = x1[2 * j] * cs[1] + x2[2 * j] * cs[0];
            o1[2 * j + 1] = x1[2 * j + 1] * cs[2] - x2[2 * j + 1] * cs[3]; o2[2 * j + 1] = x1[2 * j + 1] * cs[3] + x2[2 * j + 1] * cs[2]; } }
    else {
#pragma unroll
        for (int j = 0; j < 8; ++j) { o1[j] = x1[j]; o2[j] = x2[j]; } }
    const int off = pp * 144 + (32 * half + 8 * sub) * 2;
    const float fp = (float)pp;
    const float sA = sc0 * __builtin_amdgcn_exp2f((offa + siga * fp) * l2a), sB = sc0 * __builtin_amdgcn_exp2f((offb + sigb * fp) * l2b);
    if (mask & 1) { u32x4 w; w.x = pk2(o1[0] * sc0, o1[1] * sc0); w.y = pk2(o1[2] * sc0, o1[3] * sc0); w.z = pk2(o1[4] * sc0, o1[5] * sc0); w.w = pk2(o1[6] * sc0, o1[7] * sc0); *(LAS u32x4*)(t0 + off) = w;
              w.x = pk2(o2[0] * sc0, o2[1] * sc0); w.y = pk2(o2[2] * sc0, o2[3] * sc0); w.z = pk2(o2[4] * sc0, o2[5] * sc0); w.w = pk2(o2[6] * sc0, o2[7] * sc0); *(LAS u32x4*)(t0 + off + 32) = w; }
    if (mask & 2) { u32x4 w; w.x = pk2(o1[0] * sA, o1[1] * sA); w.y = pk2(o1[2] * sA, o1[3] * sA); w.z = pk2(o1[4] * sA, o1[5] * sA); w.w = pk2(o1[6] * sA, o1[7] * sA); *(LAS u32x4*)(t1 + off) = w;
              w.x = pk2(o2[0] * sA, o2[1] * sA); w.y = pk2(o2[2] * sA, o2[3] * sA); w.z = pk2(o2[4] * sA, o2[5] * sA); w.w = pk2(o2[6] * sA, o2[7] * sA); *(LAS u32x4*)(t1 + off + 32) = w; }
    if (mask & 4) { u32x4 w; w.x = pk2(o1[0] * sB, o1[1] * sB); w.y = pk2(o1[2] * sB, o1[3] * sB); w.z = pk2(o1[4] * sB, o1[5] * sB); w.w = pk2(o1[6] * sB, o1[7] * sB); *(LAS u32x4*)(t2 + off) = w;
              w.x = pk2(o2[0] * sB, o2[1] * sB); w.y = pk2(o2[2] * sB, o2[3] * sB); w.z = pk2(o2[4] * sB, o2[5] * sB); w.w = pk2(o2[6] * sB, o2[7] * sB); *(LAS u32x4*)(t2 + off + 32) = w; }
}
__device__ __forceinline__ void ret_stage_v(const bf16_t* src  , LAS unsigned char* tv, int tid) {
    const int pp = tid >> 2, seg = (tid & 3) * 32;
#pragma unroll
    for (int j = 0; j < 4; ++j) *(LAS u32x4*)(tv + pp * 272 + (seg + 8 * j) * 2) = *(const u32x4*)(src + (size_t)pp * ZW + seg + 8 * j);
}
__device__ __forceinline__ float log2_gamma(const Params& p, int l, int dir, int h) { const float x = kin(I_DECAY)[(l * 2 + dir) * 4 + h]; return -log2f(1.0f + expf(-x)); }
__device__ __forceinline__ int ret_row0(int b, int cc) { return cc < 2 ? NL + b * 256 + cc * 128 : b * 2048 + (cc - 2) * 128; }

__device__ __forceinline__ void retkv_unit(const Params& p, LAS unsigned char* lds, int l, int b, int h, int cc, int tid) {
    const int wave = __builtin_amdgcn_readfirstlane(tid >> 6), lane = tid & 63, g4 = lane >> 4, row0 = ret_row0(b, cc);
    const bf16_t* Z = (const bf16_t*)(p.ws + WS_R + R_Z); float* KV = (float*)(p.ws + WS_R + R_KV);
    const float l2f = log2_gamma(p, l, 0, h), l2b = log2_gamma(p, l, 1, h);
    LAS unsigned char* kf = lds; LAS unsigned char* kb = lds + 18432; LAS unsigned char* vv = lds + 36864;
    ret_stage_qk(Z + (size_t)row0 * ZW + ZC_RK + h * 64, (const float*)(p.ws + WS_ROPE), cc >= 2, (cc - 2) * 128, 6, kf, kf, kb, 0.125f, l2f, 127.f, -1.f, l2b, 0.f, 1.f, tid);
    ret_stage_v(Z + (size_t)row0 * ZW + ZC_RV + h * 128, vv, tid);
    __syncthreads();
    { const int dir = wave >> 2, db = wave & 3; const unsigned ka = tr_lane(lds_addr(dir ? kb : kf), 144, 8, lane) + 32 * db, va = tr_lane(lds_addr(vv), 272, 8, lane);
      bf16x8 afr[4];
      sfor<0, 4>([&](auto ks_) { constexpr int ks = decltype(ks_)::value; afr[ks] = tr_frag_i<32 * ks * 144, 32 * ks * 144 + 4 * 144>(ka); });
      float* dst = KV + ((((size_t)b * 4 + h) * NCHUNK + cc) * 2 + dir) * 8192;
      sfor<0, 2>([&](auto eg_) { constexpr int eg = decltype(eg_)::value; f32x4 acc[4];
#pragma unroll
          for (int i = 0; i < 4; ++i) acc[i] = (f32x4){0.f, 0.f, 0.f, 0.f};
          sfor<0, 4>([&](auto ks_) { constexpr int ks = decltype(ks_)::value; bf16x8 bf[4]; tr_frag4_i<32 * ks * 272 + 128 * eg, 4 * 272>(va, bf);
#pragma unroll
              for (int i = 0; i < 4; ++i) acc[i] = mfma16(afr[ks], bf[i], acc[i]); });
#pragma unroll
          for (int i = 0; i < 4; ++i)
#pragma unroll
              for (int r = 0; r < 4; ++r) dst[(16 * db + 4 * g4 + r) * 128 + 16 * (4 * eg + i) + (lane & 15)] = acc[i][r]; }); }
    __syncthreads();
}

__device__ __forceinline__ void retout_unit(const Params& p, LAS unsigned char* lds, int l, int b, int h, int cc, int tid) {
    const int wave = __builtin_amdgcn_readfirstlane(tid >> 6), lane = tid & 63, g4 = lane >> 4, row0 = ret_row0(b, cc);
    const bf16_t* Z = (const bf16_t*)(p.ws + WS_R + R_Z); bf16_t* BR = (bf16_t*)(p.ws + WS_R + R_BR);
    const float l2f = log2_gamma(p, l, 0, h), l2b = log2_gamma(p, l, 1, h);
    LAS unsigned char* tq = lds; LAS unsigned char* tqf = lds + 18432; LAS unsigned char* tqb = lds + 36864; LAS unsigned char* tk = lds + 55296;
    LAS unsigned char* tv = lds + 73728; LAS unsigned char* st = lds + 108544;
    { const u32x4* src = (const u32x4*)((const bf16_t*)(p.ws + WS_R + R_ST) + (((size_t)b * 4 + h) * NCHUNK + cc) * 2 * 8192);
#pragma unroll
      for (int j = 0; j < 4; ++j) { const int c = tid + 512 * j; *(LAS u32x4*)(st + (c >> 4) * 272 + (c & 15) * 16) = src[c]; } }
    const float* rope = (const float*)(p.ws + WS_ROPE);
    ret_stage_qk(Z + (size_t)row0 * ZW + ZC_RQ + h * 64, rope, cc >= 2, (cc - 2) * 128, 7, tq, tqf, tqb, 1.0f, l2f, 1.f, 1.f, l2b, 128.f, -1.f, tid);
    ret_stage_qk(Z + (size_t)row0 * ZW + ZC_RK + h * 64, rope, cc >= 2, (cc - 2) * 128, 1, tk, tk, tk, 0.125f, 0.f, 0.f, 0.f, 0.f, 0.f, 0.f, tid);
    ret_stage_v(Z + (size_t)row0 * ZW + ZC_RV + h * 128, tv, tid);
    __syncthreads();
    const int ib = wave, ti = ib * 16 + (lane & 15);
    f32x4 oacc[8];
#pragma unroll
    for (int eb = 0; eb < 8; ++eb) oacc[eb] = (f32x4){0.f, 0.f, 0.f, 0.f};
    { bf16x8 bq[4];
#pragma unroll
      for (int ks = 0; ks < 4; ++ks) bq[ks] = *(const LAS bf16x8*)((ks < 2 ? tqf : tqb) + ti * 144 + (32 * (ks & 1) + 8 * g4) * 2);
      const unsigned sa = tr_lane(lds_addr(st), 272, 8, lane);
      sfor<0, 4>([&](auto ks_) { constexpr int ks = decltype(ks_)::value;
          sfor<0, 2>([&](auto eg_) { constexpr int eg = decltype(eg_)::value; bf16x8 af[4]; tr_frag4_i<32 * ks * 272 + 128 * eg, 4 * 272>(sa, af);
#pragma unroll
              for (int i = 0; i < 4; ++i) oacc[4 * eg + i] = mfma16(af[i], bq[ks], oacc[4 * eg + i]); }); }); }
    { bf16x8 bq[2];
#pragma unroll
      for (int ks = 0; ks < 2; ++ks) bq[ks] = *(const LAS bf16x8*)(tq + ti * 144 + (32 * ks + 8 * g4) * 2);
      f32x4 sacc[8];
#pragma unroll
      for (int jb = 0; jb < 8; ++jb) { sacc[jb] = (f32x4){0.f, 0.f, 0.f, 0.f};
#pragma unroll
          for (int ks = 0; ks < 2; ++ks) { const bf16x8 a = *(const LAS bf16x8*)(tk + (16 * jb + (lane & 15)) * 144 + (32 * ks + 8 * g4) * 2); sacc[jb] = mfma16(a, bq[ks], sacc[jb]); }
#pragma unroll
          for (int r = 0; r < 4; ++r) { const int dist = ti - (16 * jb + 4 * g4 + r);
              sacc[jb][r] *= dist >= 0 ? __builtin_amdgcn_exp2f((float)dist * l2f) : __builtin_amdgcn_exp2f((float)(-dist) * l2b); } }
      const unsigned va = tr_lane(lds_addr(tv), 272, 4, lane);
      sfor<0, 4>([&](auto kk_) { constexpr int kk = decltype(kk_)::value;
          u32x4 pw; pw.x = pk2(sacc[2 * kk][0], sacc[2 * kk][1]); pw.y = pk2(sacc[2 * kk][2], sacc[2 * kk][3]); pw.z = pk2(sacc[2 * kk + 1][0], sacc[2 * kk + 1][1]); pw.w = pk2(sacc[2 * kk + 1][2], sacc[2 * kk + 1][3]);
          const bf16x8 bp = as_frag(pw);
          sfor<0, 2>([&](auto eg_) { constexpr int eg = decltype(eg_)::value; bf16x8 af[4]; tr_frag4_i<32 * kk * 272 + 128 * eg, 16 * 272>(va, af);
#pragma unroll
              for (int i = 0; i < 4; ++i) oacc[4 * eg + i] = mfma16(af[i], bp, oacc[4 * eg + i]); }); }); }
    { float ss = 0.f;
#pragma unroll
      for (int eb = 0; eb < 8; ++eb) ss += (oacc[eb][0] * oacc[eb][0] + oacc[eb][1] * oacc[eb][1]) + (oacc[eb][2] * oacc[eb][2] + oacc[eb][3] * oacc[eb][3]);
      ss += shx(ss, 16, lane); ss += shx(ss, 32, lane);
      const float rstd = rsqrtf(ss * (1.0f / 128.0f) + EPS);
      const size_t row = (size_t)(row0 + ti);
#pragma unroll
      for (int eb = 0; eb < 8; ++eb) { const int e = 16 * eb + 4 * g4; const u32x2 gg = *(const u32x2*)(Z + row * ZW + ZC_RG + h * 128 + e);
          u32x2 o; o.x = pk2(oacc[eb][0] * rstd * siluf_(lo16(gg.x)), oacc[eb][1] * rstd * siluf_(hi16(gg.x))); o.y = pk2(oacc[eb][2] * rstd * siluf_(lo16(gg.y)), oacc[eb][3] * rstd * siluf_(hi16(gg.y)));
          *(u32x2*)(BR + row * BRW + 1024 + h * 128 + e) = o; } }
    __syncthreads();
}

constexpr int NA_V = 0, NA_PITCH = 144, NA_CTXROW = 576, NA_TAB = (576 + 256) * NA_PITCH  , NA_MB = NA_TAB + 2048  , NA_MB_SZ = 18432;
static_assert(NA_MB + NA_MB_SZ <= LDS_BYTES - 1024, "NA LDS");
__device__ __forceinline__ void na_unit(const Params& p, LAS unsigned char* lds, int l, int b, int h, int rp, bool local, int tid) {
    const int wave = __builtin_amdgcn_readfirstlane(tid >> 6), lane = tid & 63, g4 = lane >> 4, qb = wave >> 1, half = wave & 1;
    const bf16_t* Z = (const bf16_t*)(p.ws + WS_R + R_Z); bf16_t* BR = (bf16_t*)(p.ws + WS_R + R_BR);
    LAS unsigned char* vl = lds + NA_V; LAS float* tab = (LAS float*)(lds + NA_TAB);
    const int qc = 16 * qb + (lane & 15);
    const int r0 = 2 * rp, rsA = min(max(r0 - 4, 0), 24), nwr = min(9, 32 - rsA);
    const int kbs = min(max(16 * qb - 8, 0), 32), cst = min(max(qc - 8, 0), 48);
    if (local) {
        for (int key = tid; key < nwr * 64; key += NTHREADS) { const size_t krow = (size_t)b * 2048 + (rsA + (key >> 6)) * 64 + (key & 63);
            const u32x4* vs_ = (const u32x4*)(Z + krow * ZW + ZC_NV + h * 64);
#pragma unroll
            for (int j = 0; j < 8; ++j) *(LAS u32x4*)(vl + key * NA_PITCH + 16 * j) = vs_[j]; }
        if (tid < 465) tab[tid] = kin(I_RPB)[(size_t)(l * 8 + h) * 465 + tid]; }
    { const int key = tid >> 1, hb = (tid & 1) * 4; const u32x4* vs_ = (const u32x4*)(Z + ((size_t)NL + b * 256 + key) * ZW + ZC_NV + h * 64) + hb;
#pragma unroll
      for (int j = 0; j < 4; ++j) *(LAS u32x4*)(vl + (NA_CTXROW + key) * NA_PITCH + 16 * (hb + j)) = vs_[j]; }
    __syncthreads();
    const float L2E = 1.44269504089f;
    const unsigned vla = lds_addr(vl);
    const unsigned lane_off = (unsigned)((4 * g4 + ((lane & 15) >> 2)) * NA_PITCH + (lane & 3) * 8);
#pragma unroll 1
    for (int jr = 0; jr < 2; ++jr) {
        const int r = r0 + jr, rs = min(max(r - 4, 0), 24), wofs = rs - rsA;
        const size_t qrow = local ? (size_t)b * 2048 + r * 64 + qc : (size_t)NL + b * 256 + r * 64 + qc;
        bf16x8 bq[2];
#pragma unroll
        for (int ks = 0; ks < 2; ++ks) bq[ks] = *(const bf16x8*)(Z + qrow * ZW + ZC_NQ + h * 64 + 32 * ks + 8 * g4);
        bf16x8 kf[16];
        if (local) {
#pragma unroll
            for (int blk = 0; blk < 8; ++blk) { const size_t krow = (size_t)b * 2048 + (rs + 4 * half + (blk >> 1)) * 64 + kbs + 16 * (blk & 1) + (lane & 15);
#pragma unroll
                for (int ks = 0; ks < 2; ++ks) kf[blk * 2 + ks] = *(const bf16x8*)(Z + krow * ZW + ZC_NK + h * 64 + 32 * ks + 8 * g4); } }
        f32x4 s[16]; float mx = -1e30f;
        if (local) {
#pragma unroll
            for (int blk = 0; blk < 8; ++blk) { const int i = 4 * half + (blk >> 1), cb = blk & 1;
                f32x4 a = (f32x4){0.f, 0.f, 0.f, 0.f};
#pragma unroll
                for (int ks = 0; ks < 2; ++ks) a = mfma16(kf[blk * 2 + ks], bq[ks], a);
                const int ro = rs + i - r + 7;
#pragma unroll
                for (int rg = 0; rg < 4; ++rg) { const int kc = kbs + 16 * cb + 4 * g4 + rg; const bool valid = kc >= cst && kc < cst + 16;
                    const int co = min(max(kc - qc, -15), 15) + 15;
                    const float bv = tab[ro * 31 + co];
                const float v = valid ? a[rg] * 0.125f + bv : -1e30f; s[blk][rg] = v; mx = fmaxf(mx, v); } }
        } else {
#pragma unroll
            for (int blk = 0; blk < 8; ++blk) s[blk] = (f32x4){-1e30f, -1e30f, -1e30f, -1e30f};
        }
#pragma unroll
        for (int blk = 0; blk < 8; ++blk) { const size_t krow = (size_t)NL + b * 256 + half * 128 + 16 * blk + (lane & 15);
#pragma unroll
            for (int ks = 0; ks < 2; ++ks) kf[blk * 2 + ks] = *(const bf16x8*)(Z + krow * ZW + ZC_NK + h * 64 + 32 * ks + 8 * g4); }
#pragma unroll
        for (int blk = 0; blk < 8; ++blk) { f32x4 a = (f32x4){0.f, 0.f, 0.f, 0.f};
#pragma unroll
            for (int ks = 0; ks < 2; ++ks) a = mfma16(kf[blk * 2 + ks], bq[ks], a);
#pragma unroll
            for (int rg = 0; rg < 4; ++rg) { const float v = a[rg] * 0.125f; s[8 + blk][rg] = v; mx = fmaxf(mx, v); } }
        mx = fmaxf(mx, shx(mx, 16, lane)); mx = fmaxf(mx, shx(mx, 32, lane));
        float ls = 0.f;
#pragma unroll
        for (int blk = 0; blk < 16; ++blk)
#pragma unroll
            for (int rg = 0; rg < 4; ++rg) { const float e = __builtin_amdgcn_exp2f((s[blk][rg] - mx) * L2E); s[blk][rg] = e; ls += e; }
        ls += shx(ls, 16, lane); ls += shx(ls, 32, lane);
        f32x4 oacc[4];
#pragma unroll
        for (int db = 0; db < 4; ++db) oacc[db] = (f32x4){0.f, 0.f, 0.f, 0.f};
        if (local) { const unsigned va = vla + (unsigned)(((wofs + 4 * half) * 64 + kbs) * NA_PITCH) + lane_off;
            sfor<0, 4>([&](auto kk_) { constexpr int kk = decltype(kk_)::value;
                u32x4 pw; pw.x = pk2(s[2 * kk][0], s[2 * kk][1]); pw.y = pk2(s[2 * kk][2], s[2 * kk][3]); pw.z = pk2(s[2 * kk + 1][0], s[2 * kk + 1][1]); pw.w = pk2(s[2 * kk + 1][2], s[2 * kk + 1][3]);
                const bf16x8 bp = as_frag(pw); bf16x8 vf[4]; tr_frag4_i<kk * 64 * NA_PITCH, 16 * NA_PITCH>(va, vf);
#pragma unroll
                for (int db = 0; db < 4; ++db) oacc[db] = mfma16(vf[db], bp, oacc[db]); }); }
        { const unsigned va = vla + (unsigned)((NA_CTXROW + half * 128) * NA_PITCH) + lane_off;
          sfor<0, 4>([&](auto kk_) { constexpr int kk = decltype(kk_)::value;
              u32x4 pw; pw.x = pk2(s[8 + 2 * kk][0], s[8 + 2 * kk][1]); pw.y = pk2(s[8 + 2 * kk][2], s[8 + 2 * kk][3]); pw.z = pk2(s[9 + 2 * kk][0], s[9 + 2 * kk][1]); pw.w = pk2(s[9 + 2 * kk][2], s[9 + 2 * kk][3]);
              const bf16x8 bp = as_frag(pw); bf16x8 vf[4]; tr_frag4_i<kk * 32 * NA_PITCH, 16 * NA_PITCH>(va, vf);
#pragma unroll
              for (int db = 0; db < 4; ++db) oacc[db] = mfma16(vf[db], bp, oacc[db]); }); }
        LAS float* mb = (LAS float*)(lds + NA_MB) + (qb * 64 + lane) * 18;
        if (half == 1) { mb[0] = mx; mb[1] = ls;
#pragma unroll
            for (int db = 0; db < 4; ++db)
#pragma unroll
                for (int rg = 0; rg < 4; ++rg) mb[2 + db * 4 + rg] = oacc[db][rg]; }
        __syncthreads();
        if (half == 0) { const float m1 = mb[0], l1 = mb[1], M = fmaxf(mx, m1), a0 = __builtin_amdgcn_exp2f((mx - M) * L2E), a1 = __builtin_amdgcn_exp2f((m1 - M) * L2E);
            const float inv = 1.0f / (ls * a0 + l1 * a1);
#pragma unroll
            for (int db = 0; db < 4; ++db) { float o[4];
#pragma unroll
                for (int rg = 0; rg < 4; ++rg) o[rg] = (oacc[db][rg] * a0 + mb[2 + db * 4 + rg] * a1) * inv;
                u32x2 w; w.x = pk2(o[0], o[1]); w.y = pk2(o[2], o[3]);
                *(u32x2*)(BR + qrow * BRW + 512 + h * 64 + 16 * db + 4 * g4) = w; } }
        __syncthreads();
    }
}

#ifndef STAMP_PHASE
#define STAMP_PHASE -1
#endif
constexpr int PH_PER_LAYER = 10, PH_FINAL = 1 + 2 * PH_PER_LAYER, NPHASES = PH_FINAL + 1;
__device__ __forceinline__ void moe_tables(const Params& p, LAS unsigned char* lds, int l, int tid, int nsplit, int nMs, int G, int c) {
    LAS int* tb = (LAS int*)(lds + MOE_TAB_OFF); LAS int* cn = tb + 128;
    if (tid < 64) { const unsigned c = ((const unsigned*)(p.ws + WS_CTL))[CW_CNT + l * 2048 + tid * 16]; cn[tid] = (int)(c < (unsigned)NT ? c : (unsigned)NT); }
    __syncthreads();
    if (tid == 0) { int s = 0; for (int e = 0; e < 64; ++e) { tb[e] = s; s += (cn[e] + 255) >> 8; } tb[64] = s; }
    __syncthreads();
    if (tid < MOE_UL_MAX) { LAS int* ul = (LAS int*)(lds + MOE_UL_OFF) + tid * 8; const int ntr = tb[64];
        const int idx = tid * G + ((G & 7) == 0 ? (c & 7) * (G >> 3) + (c >> 3) : c);
        if (idx >= nsplit * (ntr + nMs)) ul[0] = -1;
        else if (idx < nsplit * ntr) { const int mt = idx / nsplit, pn = idx % nsplit; int lo = 0, hi = 63;
            for (int it = 0; it < 6; ++it) { const int mid = (lo + hi + 1) >> 1; if (tb[mid] <= mt) lo = mid; else hi = mid - 1; }
            ul[0] = lo; ul[1] = pn; ul[2] = (mt - tb[lo]) * 256; ul[3] = mt; ul[4] = cn[lo]; }
        else { const int s_ = idx - nsplit * ntr; ul[0] = 64; ul[1] = s_ % nsplit; ul[2] = 0; ul[3] = s_ / nsplit; ul[4] = 0; } }
    __syncthreads();
}

__global__ void __launch_bounds__(NTHREADS, 2) fwd_kernel(Params p0) {
    extern __shared__ __attribute__((aligned(16))) unsigned char lds_raw[];
    LAS unsigned char* const lds0 = (LAS unsigned char*)lds_raw;
    const int tid0 = threadIdx.x, G = gridDim.x, bid = blockIdx.x, NGW = G * NWAVES;
    const int wave0 = __builtin_amdgcn_readfirstlane(tid0 >> 6);
#define PHASE_IDS const int tid = launder(wave0 * 64 + lane_id_here()), wave = __builtin_amdgcn_readfirstlane(tid >> 6), lane = tid & 63, gw = bid * NWAVES + wave; (void)lane; (void)gw; \
    Params p = p0; p.ws = kws_ptr(); p.out = kout_ptr(); \
    LAS unsigned char* lds; { unsigned la_ = (unsigned)(size_t)lds0; asm volatile("" : "+s"(la_)); lds = (LAS unsigned char*)(size_t)la_; }
    volatile LAS unsigned* xbw = (volatile LAS unsigned*)(lds0 + LDS_BYTES - 16);
    if (tid0 == 0) { xbw[0] = 0u; xbw[1] = 0u; xbw[2] = 0u; xbw[3] = 0u; }
    __syncthreads();
    XcdBarrier bar = xcd_barrier_post((unsigned*)(p0.ws + WS_CTL) + CW_BAR + p0.li * XCD_BAR_WORDS, xbw);
#ifdef TEST_PHASE
#define IN(k) ((((k) - 1) % PH_PER_LAYER == TEST_PHASE - 1 && (k) >= 1 && (k) < PH_FINAL && TEST_PHASE >= 1) || ((k) == 0 && TEST_PHASE == 0) || ((k) == PH_FINAL && TEST_PHASE == 99)) && (launder_s(p0.ph_lo) <= (k) && (k) < launder_s(p0.ph_hi))
#else
#define IN(k) (launder_s(p0.ph_lo) <= (k) && (k) < launder_s(p0.ph_hi))
#endif
#ifndef DUP_PHASE
#define DUP_PHASE -1
#endif
#define DUP(k) for (int rep_ = 0; rep_ < ((DUP_PHASE) == (k) ? 2 : 1); ++rep_)
#ifdef TIMING
    volatile LAS unsigned long long* tst = (volatile LAS unsigned long long*)(lds0 + LDS_BYTES - 16 - 512);
    if (wave0 == 0 && lane_id_here() == 0) tst[0] = __builtin_amdgcn_s_memrealtime();
#define SEAM(k) do { if (IN(k) && IN((k) + 1)) { xcd_barrier(bar, wave0 == 0 && lane_id_here() == 0); if (wave0 == 0 && lane_id_here() == 0) tst[(k) + 1] = __builtin_amdgcn_s_memrealtime(); } } while (0)
#else
#define SEAM(k) do { if (IN(k) && IN((k) + 1)) xcd_barrier(bar, wave0 == 0 && lane_id_here() == 0); } while (0)
#endif
#define Hb ((bf16_t*)(p.ws + WS_H))
#define Zb ((bf16_t*)(p.ws + WS_R + R_Z))
#define BRb ((bf16_t*)(p.ws + WS_R + R_BR))
#define XC ((float*)(p.ws + WS_XC))
#define xl (l == 0 ? kin(I_X) : (const float*)p.out)
#define xc (l == 0 ? kin(I_CTX) : (const float*)XC)
#define mod ((const float*)(p.ws + WS_MOD) + (size_t)l * 9 * 6144)
#define wm (p.ws + WS_WM + (size_t)l * WM_STRIDE)

    if (IN(0)) { DUP(100) {
        PHASE_IDS;
        for (int u = bid; u < 192; u += G) mod_unit(p, lds, u, tid);
        if (bid == G - 1) { float* rope = (float*)(p.ws + WS_ROPE);
            for (int idx = tid; idx < 1024; idx += NTHREADS) { const int pos = idx >> 4, f = idx & 15; const float inv = exp2f(-(float)f * (13.287712379549449f / 16.0f));
                float x = (float)pos * inv * 0.15915494309189535f; x -= floorf(x);
                rope[idx * 2] = __builtin_amdgcn_cosf(x); rope[idx * 2 + 1] = __builtin_amdgcn_sinf(x); } }
        __syncthreads();
        LAS float* scr = (LAS float*)(lds + wave * 8448);
        for (int it = gw; it < 2 * MISC_ITEMS; it += NGW) {
            if (it < MISC_ITEMS) misc_item(p, 0, it, scr, lane);
            else misc_item(p, 1, it - MISC_ITEMS, scr, lane); }
        __syncthreads();
    } }
    SEAM(0);

    for (int l = 0; l < DEPTH; ++l) {
        const int base = 1 + PH_PER_LAYER * l;
        const bool need_ctx = l < DEPTH - 1;
        const int Mrows = need_ctx ? NT : NL;

        if (IN(base + 0)) { DUP(0) {
            PHASE_IDS;
            const float* const nmg = kin(I_NMG) + l * 1024; const float* const xin = kin(I_X); const float* const cin = kin(I_CTX);
            for (int row = gw; row < NT; row += NGW) { const bool lat = row < NL;
                const float* mr = mod + (size_t)(lat ? (row >> 11) : 8) * 6144;
                f32x4 v[4];
                if (l == 0) { const float* xr = lat ? xin + (size_t)row * D : cin + (size_t)(row - NL) * D;
#pragma unroll
                    for (int j = 0; j < 4; ++j) v[j] = ((const f32x4*)xr)[64 * j + lane]; }
                else { float* xr = lat ? p.out + (size_t)row * D : XC + (size_t)(row - NL) * D;
                    combine_row(v, xr, mr - 9 * 6144 + 5120, Hb + (size_t)row * D, (const unsigned char*)(p.ws + WS_R + R_O) + (size_t)row * 8 * 1024, lane);
#pragma unroll
                    for (int j = 0; j < 4; ++j) ((f32x4*)xr)[64 * j + lane] = v[j]; }
                norm_mod_vals(v, nmg, mr, mr + 1024, Hb + (size_t)row * D, false, lds, lane); }
        } }
        SEAM(base + 0);
        if (IN(base + 1)) { DUP(1) {
            PHASE_IDS;
            DenseSched S{(const char*)Hb, (const char*)(wm + WM_IN), 1024, 1024, NT / 256, INW / 256, G, bid, 1, 0, 0};
            EpiStoreBf16 E{Zb, ZW, 16, (unsigned char*)(p.ws + WS_R + R_G8)};
            pg8::gemm_phase(lds, tid, 1024, 1024, S, E, (STAMP_PHASE == 2 && l == 0 && bid == 0) ? 25 : -1);
        } }
        SEAM(base + 1);
        if (IN(base + 2)) { DUP(2) {
            PHASE_IDS;
#ifndef DUP_SUB
#define DUP_SUB -1
#endif
            for (int rs_ = 0; rs_ < (DUP_SUB == 0 ? 2 : 1); ++rs_) for (int u = bid; u < 1024; u += G) na_unit(p, lds, l, u >> 7, (u >> 4) & 7, u & 15, true, tid);
            if (need_ctx) for (int u = bid; u < 128; u += G) na_unit(p, lds, l, u >> 4, (u >> 1) & 7, u & 1, false, tid);
            for (int rs_ = 0; rs_ < (DUP_SUB == 1 ? 2 : 1); ++rs_) for (int u = (bid + 64) % G; u < 576; u += G) retkv_unit(p, lds, l, u / 72, (u / 18) % 4, u % 18, tid);
        } }
        SEAM(base + 2);
        if (IN(base + 3)) { DUP(3) {
            PHASE_IDS;
            const float* KV = (const float*)(p.ws + WS_R + R_KV); bf16_t* ST = (bf16_t*)(p.ws + WS_R + R_ST);
            for (int gi = bid * NTHREADS + tid; gi < 64 * 2048; gi += G * NTHREADS) {
                const int combo = gi >> 11, e4 = (gi & 2047) * 4, bh = combo >> 1, dir = combo & 1, h = bh & 3;
                const float dec = __builtin_amdgcn_exp2f(128.f * log2_gamma(p, l, dir, h));
                const float* kv = KV + (size_t)bh * NCHUNK * 2 * 8192 + (size_t)dir * 8192 + e4; bf16_t* st = ST + (size_t)bh * NCHUNK * 2 * 8192 + (size_t)dir * 8192 + e4;
                f32x4 q[NCHUNK];
#pragma unroll
                for (int y = 0; y < NCHUNK; ++y) q[y] = *(const f32x4*)(kv + (size_t)y * 2 * 8192);
                f32x4 sacc = (f32x4){0.f, 0.f, 0.f, 0.f};
#pragma unroll
                for (int i = 0; i < NCHUNK; ++i) { const int y = dir == 0 ? i : (i == 0 ? 1 : (i == 1 ? 0 : 19 - i));
                    u32x2 o; o.x = pk2(sacc[0], sacc[1]); o.y = pk2(sacc[2], sacc[3]); *(u32x2*)(st + (size_t)y * 2 * 8192) = o;
                    f32x4 kvy = q[0];
#pragma unroll
                    for (int j = 1; j < NCHUNK; ++j) kvy = (j == y) ? q[j] : kvy;
                    sacc = sacc * dec + kvy; } }
            { const bf16_t* Z = (const bf16_t*)(p.ws + WS_R + R_Z); float* STAT = (float*)(p.ws + WS_R + R_STAT);
              for (int row = gw; row < Mrows; row += NGW) { const u32x4 v = *(const u32x4*)(Z + (size_t)row * ZW + ZC_AV + lane * 8);
                  const float x0 = geluf_(lo16(v.x)), x1 = geluf_(hi16(v.x)), x2 = geluf_(lo16(v.y)), x3 = geluf_(hi16(v.y)), x4 = geluf_(lo16(v.z)), x5 = geluf_(hi16(v.z)), x6 = geluf_(lo16(v.w)), x7 = geluf_(hi16(v.w));
                  const float mean = wave_sum(((x0 + x1) + (x2 + x3)) + ((x4 + x5) + (x6 + x7)), lane) * (1.0f / 512.0f);
                  const float d0 = x0 - mean, d1 = x1 - mean, d2 = x2 - mean, d3 = x3 - mean, d4 = x4 - mean, d5 = x5 - mean, d6 = x6 - mean, d7 = x7 - mean;
                  const float s2 = wave_sum(((d0 * d0 + d1 * d1) + (d2 * d2 + d3 * d3)) + ((d4 * d4 + d5 * d5) + (d6 * d6 + d7 * d7)), lane);
                  if (lane == 0) *(f32x2*)(STAT + (size_t)row * 2) = (f32x2){mean, rsqrtf(s2 * (1.0f / 512.0f) + EPS)}; } }
        } }
        SEAM(base + 3);
        if (IN(base + 4)) { DUP(4) {
            PHASE_IDS;
            const int cc_lo = need_ctx ? 0 : 2, ncc = NCHUNK - cc_lo, total = 32 * ncc;
            for (int u = bid; u < total; u += G) retout_unit(p, lds, l, u / (4 * ncc), (u / ncc) % 4, cc_lo + u % ncc, tid);
            const int nA = (Mrows / 128) * 4;
            for (int rs_ = 0; rs_ < (DUP_SUB == 2 ? 2 : 1); ++rs_) for (int u = (bid + 64) % G; u < nA; u += G) mixA_unit(p, lds, l, u >> 2, u & 3, tid);
        } }
        SEAM(base + 4);
        if (IN(base + 5)) { DUP(5) {
            PHASE_IDS;
            DenseSched S{(const char*)BRb, (const char*)(wm + WM_BR), BRW, 512, Mrows / 256, 4, G, bid, 3, 512 * 2, (size_t)1024 * 512 * 2};
#ifdef MERGE_PLAIN_DUP
            if (rep_ == 1) { EpiStoreBf16 E2{(bf16_t*)(p.ws + WS_R + R_KV), 1024, 1000, (unsigned char*)0}; pg8::gemm_phase(lds, tid, 512, 512, S, E2); } else
#endif
            { EpiMerge E{Hb, (const unsigned char*)(p.ws + WS_R + R_G8)};
            pg8::gemm_phase(lds, tid, 512, 512, S, E, (STAMP_PHASE == 6 && l == 0 && bid == 0) ? 25 : -1); }
            if (l == 0 && rep_ == 0 && G == 256 && bid >= 32) { LAS float* scr = (LAS float*)(lds + wave * 8448); const int fw = (bid - 32) * NWAVES + wave;
                for (int it = fw; it < FILL_SPLIT; it += 224 * NWAVES) expert_item(p, it / EXP_ITEMS, it % EXP_ITEMS, scr, lane); }
            if (l == 0 && rep_ == 0 && G != 256) { LAS float* scr = (LAS float*)(lds + wave * 8448);
                for (int it = gw; it < 2 * EXP_ITEMS; it += NGW) expert_item(p, it / EXP_ITEMS, it % EXP_ITEMS, scr, lane); }
        } }
        SEAM(base + 5);
        if (IN(base + 6)) { DUP(6) {
            PHASE_IDS;
            DenseSched S{(const char*)Hb, (const char*)(wm + WM_OUT), 1024, 1024, Mrows / 256, 4, G, bid, 1, 0, 0};
            float* const dummy = (float*)(p.ws + WS_R + R_ACT);
            EpiResid E{xl, xc, rep_ == 0 ? p.out : dummy, rep_ == 0 ? XC : dummy + (size_t)NL * D, mod + 2048};
            pg8::gemm_phase(lds, tid, 1024, 1024, S, E, (STAMP_PHASE == 7 && l == 0 && bid == 0) ? 25 : -1);
            if (l == 0 && rep_ == 0 && G == 256 && bid >= 32) { LAS float* scr = (LAS float*)(lds + wave * 8448); const int fw = (bid - 32) * NWAVES + wave;
                for (int it = FILL_SPLIT + fw; it < 2 * EXP_ITEMS; it += 224 * NWAVES) expert_item(p, it / EXP_ITEMS, it % EXP_ITEMS, scr, lane); }
        } }
        SEAM(base + 6);
        if (IN(base + 7)) { DUP(7) {
            PHASE_IDS;
            for (int u = bid; u < Mrows / 64; u += G) router_unit(p, lds, l, u, p.out, XC, tid, rep_ == 0, l == 0 && u == 0);
        } }
        SEAM(base + 7);
        if (IN(base + 8)) { DUP(8) {
            PHASE_IDS;
            moe_tables(p, lds, l, tid, 2, Mrows / 256, G, bid);
            MoeGuSched S{(const char*)Hb, (const char*)(p.ws + WS_WE + (size_t)l * WE_LAYER + WE_GU), (const char*)(wm + WM_SGU), (const unsigned*)(p.ws + WS_LIST),
                         (const LAS int*)(lds + MOE_TAB_OFF), (const LAS int*)(lds + MOE_TAB_OFF) + 128, Mrows / 256, G, bid};
            EpiGateUp E{(bf16_t*)(p.ws + WS_R + R_ACT), (bf16_t*)(p.ws + WS_R + R_ACTS), (const float*)(p.ws + WS_WL)};
            pg8::gemm_phase<true>(lds, tid, 1024, 1024, S, E, (STAMP_PHASE == 9 && l == 0 && bid == 0) ? 25 : -1);
        } }
        SEAM(base + 8);
        if (IN(base + 9)) { DUP(9) {
            PHASE_IDS;
            moe_tables(p, lds, l, tid, 4, Mrows / 256, G, bid);
            MoeDownSched S{(const char*)(p.ws + WS_R + R_ACT), (const char*)(p.ws + WS_WE + (size_t)l * WE_LAYER + WE_D), (const char*)(p.ws + WS_R + R_ACTS), (const char*)(wm + WM_SD),
                           (const LAS int*)(lds + MOE_TAB_OFF), (const LAS int*)(lds + MOE_TAB_OFF) + 128, Mrows / 256, G, bid};
            EpiDown E{(bf16_t*)(p.ws + WS_R + R_O), (const unsigned*)(p.ws + WS_LIST), Hb};
            pg8::gemm_phase<true>(lds, tid, launder_s(256), 256, S, E, (STAMP_PHASE == 10 && l == 0 && bid == 0) ? 25 : -1);
        } }
        SEAM(base + 9);
    }
#ifdef EXTRA_BARRIERS
    if (IN(PH_FINAL) && IN(PH_FINAL - 1)) for (int xb_ = 0; xb_ < EXTRA_BARRIERS; ++xb_) xcd_barrier(bar, wave0 == 0 && lane_id_here() == 0);
#endif
#ifdef TIMING
    float t_scale = 1.0f, t_add = 0.0f;
    { float* tw = (float*)(p0.ws + WS_CTL) + 1024;
      if (bid == 0 && wave0 == 0 && lane_id_here() == 0) { tw[0] = (float)(tst[TA_HI] - tst[TA_LO]) * 0.01f; }
      xcd_barrier(bar, wave0 == 0 && lane_id_here() == 0);
      t_scale = 1.0f + tw[0] / (float)(TA_DIV); t_add = 0.0f; }
#endif
    if (IN(PH_FINAL)) {
        PHASE_IDS;
        const int l = DEPTH - 1;
        f32x4 fg[4];
#pragma unroll
        for (int j = 0; j < 4; ++j) fg[j] = ((const f32x4*)kin(I_FG))[64 * j + lane];
        for (int row = gw; row < NL; row += NGW) { float* xr = p.out + (size_t)row * D;
            f32x4 v[4]; float ss = 0.f;
            combine_row(v, xr, mod + (size_t)(row >> 11) * 6144 + 5120, Hb + (size_t)row * D, (const unsigned char*)(p.ws + WS_R + R_O) + (size_t)row * 8 * 1024, lane);
#pragma unroll
            for (int j = 0; j < 4; ++j) ss += (v[j][0] * v[j][0] + v[j][1] * v[j][1]) + (v[j][2] * v[j][2] + v[j][3] * v[j][3]);
            const float rstd = rsqrtf(wave_sum(ss, lane) * (1.0f / 1024.0f) + EPS);
#pragma unroll
            for (int j = 0; j < 4; ++j) { f32x4 ov = v[j] * rstd * fg[j];
#ifdef TIMING
                ov = ov * t_scale; if (row == 0 && j == 0 && lane == 0) ov[0] += t_add;
#endif
                ((f32x4*)xr)[64 * j + lane] = ov; } }
    }
#undef IN
#undef SEAM
#undef Hb
#undef Zb
#undef BRb
#undef XC
#undef xl
#undef xc
#undef mod
#undef wm
}

#ifndef STAMP_PHASE_DEFINED
#endif
#ifndef MK_PER_PHASE
#define MK_PER_PHASE 0
#endif
extern "C" void kernel_launch(void* const* d_in, const int* in_sizes, int n_in, void* d_out, int out_size, void* d_ws, size_t ws_size, hipStream_t stream) {
    static int grid = 0;
    if (grid == 0) {
        if (n_in != 26 || out_size != NL * D || ws_size < WS_END) { fprintf(stderr, "kernel_launch: unexpected shapes (n_in %d out %d ws %zu, need %zu)\n", n_in, out_size, ws_size, (size_t)WS_END); grid = -1; return; }
        int dev = 0, cus = 0;
        if (hipGetDevice(&dev) != hipSuccess || hipDeviceGetAttribute(&cus, hipDeviceAttributeMultiprocessorCount, dev) != hipSuccess) { grid = -1; return; }
        if (hipFuncSetAttribute((const void*)fwd_kernel, hipFuncAttributeMaxDynamicSharedMemorySize, LDS_BYTES) != hipSuccess) { fprintf(stderr, "kernel_launch: hipFuncSetAttribute failed\n"); grid = -1; return; }
        int per_cu = 0;
        if (hipOccupancyMaxActiveBlocksPerMultiprocessor(&per_cu, (const void*)fwd_kernel, NTHREADS, LDS_BYTES) != hipSuccess || per_cu < 1) { fprintf(stderr, "kernel_launch: occupancy query says %d\n", per_cu); }
        (void)hipGetLastError();
        grid = cus;
    }
    if (grid < 0) return;
    (void)hipMemsetAsync((char*)d_ws + WS_CTL, 0, CTL_BYTES, stream);
    Params p{};
    for (int i = 0; i < 26; ++i) p.in[i] = (const float*)d_in[i];
    p.out = (float*)d_out; p.ws = (unsigned char*)d_ws;
#if MK_PER_PHASE
    for (int k = 0; k < NPHASES; ++k) { p.ph_lo = k; p.ph_hi = k + 1; p.li = k;
        hipLaunchKernelGGL(fwd_kernel, dim3(grid), dim3(NTHREADS), LDS_BYTES, stream, p); }
#else
    p.ph_lo = 0; p.ph_hi = NPHASES; p.li = 0;
    hipLaunchKernelGGL(fwd_kernel, dim3(grid), dim3(NTHREADS), LDS_BYTES, stream, p);
#endif
}
```

```cpp
#include <hip/hip_runtime.h>
#include <stdint.h>
#include <stdio.h>

#define LAS __attribute__((address_space(3)))
#define GAS __attribute__((address_space(1)))
template <class T> __device__ __forceinline__ T* as_global(T* q) { return (T*)(GAS T*)q; }
typedef unsigned short bf16_t;
typedef short bf16x8 __attribute__((ext_vector_type(8)));
typedef short bf16x4 __attribute__((ext_vector_type(4)));
typedef float f32x4 __attribute__((ext_vector_type(4)));
typedef float f32x2 __attribute__((ext_vector_type(2)));
typedef unsigned u32x4 __attribute__((ext_vector_type(4)));
typedef unsigned u32x2 __attribute__((ext_vector_type(2)));
typedef long i64x2 __attribute__((ext_vector_type(2)));

constexpr int D = 1024, NB = 8, SEQ = 2048, CTXL = 256, DEPTH = 2;
constexpr int NL = NB * SEQ;
constexpr int NC = NB * CTXL;
constexpr int NT = NL + NC;
constexpr int INW = 7168;
constexpr int ZW = 4096;
constexpr int ZC_AU = 0, ZC_AV = 512, ZC_NQ = 1024, ZC_NK = 1536, ZC_NV = 2048, ZC_RQ = 2560, ZC_RK = 2816, ZC_RV = 3072, ZC_RG = 3584,
              ZC_GA = 4096;
constexpr int BRW = 1536;
constexpr int NEXP = 64, TOPK = 8, EXPW = 256;
constexpr int NCHUNK = 18;
constexpr float EPS = 1e-6f;
constexpr int NTHREADS = 512, NWAVES = 8;
constexpr int LDS_BYTES = 159744;

constexpr size_t MiB = 1u << 20;
constexpr size_t WS_CTL = 0, CTL_BYTES = 1 * MiB;
constexpr size_t WS_MOD = 1 * MiB;
constexpr size_t WS_ROPE = 1 * MiB + 512 * 1024;
constexpr size_t WS_WM = 2 * MiB, WM_STRIDE = 21 * MiB;
constexpr size_t WM_IN = 0, WM_BR = 14680064, WM_OUT = WM_BR + 3145728, WM_SGU = WM_OUT + 2097152, WM_SD = WM_SGU + 1048576,
                 WM_RT = WM_SD + 524288, WM_CM = WM_RT + 131072, WM_END = WM_CM + 131072;
static_assert(WM_END <= WM_STRIDE, "misc weights");
constexpr size_t WS_WE = 44 * MiB;
constexpr size_t WE_GU = 0, WE_D = 33554432, WE_LAYER = 50331648;
constexpr size_t WS_XC = 140 * MiB;
constexpr size_t WS_H = 148 * MiB;
constexpr size_t WS_LIST = 184 * MiB, WS_WL = 189 * MiB;
constexpr size_t WS_R = 194 * MiB;
constexpr size_t R_Z = 0, R_G8 = 144 * MiB, R_BR = 252 * MiB, R_KV = 306 * MiB, R_ST = 342 * MiB, R_STAT = 360 * MiB;
constexpr size_t R_O = 0, R_ACT = 288 * MiB, R_ACTS = 368 * MiB;
constexpr size_t WS_END = WS_R + 377 * MiB;
static_assert(R_KV + 37748736 <= 377 * MiB && R_ACTS + 9437184 <= 377 * MiB && R_Z + 150994944 <= R_G8 && R_G8 + 56623104 <= R_BR && R_BR + 56623104 <= R_KV, "region map");
static_assert(R_O + 301989888 <= R_ACT && R_ACT + 83886080 <= R_ACTS, "region map 2");
constexpr int CW_BAR = 4096;
constexpr int CW_CNT = 200000;

__device__ __forceinline__ float bf2f(unsigned short b) { return __uint_as_float(((unsigned)b) << 16); }
__device__ __forceinline__ unsigned f2bf(float f) { unsigned u = __float_as_uint(f); return (u + 0x7fffu + ((u >> 16) & 1u)) >> 16; }
__device__ __forceinline__ unsigned pk2(float lo, float hi) { unsigned r; asm("v_cvt_pk_bf16_f32 %0, %1, %2" : "=v"(r) : "v"(lo), "v"(hi)); return r; }
__device__ __forceinline__ float lo16(unsigned w) { return __uint_as_float(w << 16); }
__device__ __forceinline__ float hi16(unsigned w) { return __uint_as_float(w & 0xffff0000u); }
__device__ __forceinline__ float shx(float v, int o, int lane) { return __int_as_float(__builtin_amdgcn_ds_bpermute((lane ^ o) << 2, __float_as_int(v))); }
__device__ __forceinline__ int shxi(int v, int o, int lane) { return __builtin_amdgcn_ds_bpermute((lane ^ o) << 2, v); }
__device__ __forceinline__ float dpp_f(float v, const int ctrl_tag) {
    const int x = __float_as_int(v);
    switch (ctrl_tag) {
        case 0: return __int_as_float(__builtin_amdgcn_update_dpp(x, x, 0xB1, 0xF, 0xF, false));
        case 1: return __int_as_float(__builtin_amdgcn_update_dpp(x, x, 0x4E, 0xF, 0xF, false));
        case 2: return __int_as_float(__builtin_amdgcn_update_dpp(x, x, 0x141, 0xF, 0xF, false));
        default: return __int_as_float(__builtin_amdgcn_update_dpp(x, x, 0x140, 0xF, 0xF, false));
    }
}
__device__ __forceinline__ float wave_sum(float v, int  ) {
    v += dpp_f(v, 0); v += dpp_f(v, 1); v += dpp_f(v, 2); v += dpp_f(v, 3);
    const int x = __float_as_int(v);
    return (__int_as_float(__builtin_amdgcn_readlane(x, 0)) + __int_as_float(__builtin_amdgcn_readlane(x, 16))) + (__int_as_float(__builtin_amdgcn_readlane(x, 32)) + __int_as_float(__builtin_amdgcn_readlane(x, 48)));
}
__device__ __forceinline__ float fast_exp(float x) { return __builtin_amdgcn_exp2f(x * 1.44269504089f); }
__device__ __forceinline__ float sigmoidf_(float x) { return __builtin_amdgcn_rcpf(1.0f + fast_exp(-x)); }
__device__ __forceinline__ float siluf_(float x) { return x * sigmoidf_(x); }
__device__ __forceinline__ float geluf_(float x) { const float u = 0.7978845608f * (x + 0.044715f * x * x * x); return x * sigmoidf_(2.0f * u); }
__device__ __forceinline__ f32x4 mfma16(bf16x8 a, bf16x8 b, f32x4 c) { return __builtin_amdgcn_mfma_f32_16x16x32_bf16(a, b, c, 0, 0, 0); }
__device__ __forceinline__ bf16x8 as_frag(u32x4 v) { return __builtin_bit_cast(bf16x8, v); }
__device__ __forceinline__ int launder(int v) { asm volatile("" : "+v"(v)); return v; }
__device__ __forceinline__ int lane_id_here() { unsigned m = ~0u; asm volatile("" : "+s"(m)); return (int)__builtin_amdgcn_mbcnt_hi(m, __builtin_amdgcn_mbcnt_lo(m, 0u)); }
__device__ __forceinline__ int launder_s(int v) { asm volatile("" : "+s"(v)); return v; }
template <class T> __device__ __forceinline__ T* launder_p(T* q) { asm volatile("" : "+s"(q)); return q; }
template <class T> __device__ __forceinline__ T* launder_vp(T* q) { asm volatile("" : "+v"(q)); return q; }
#define LDS_WAIT() asm volatile("s_waitcnt lgkmcnt(0)" ::: "memory")
#define VM_WAIT() asm volatile("s_waitcnt vmcnt(0)" ::: "memory")

__device__ __forceinline__ bf16x8 tr_frag(unsigned base, int stride, int r0, int r1, int c0, int lane) {
    const int q = (lane & 15) >> 2, p = lane & 3;
    const unsigned a0 = base + (unsigned)((r0 + q) * stride + (c0 + 4 * p) * 2), a1 = base + (unsigned)((r1 + q) * stride + (c0 + 4 * p) * 2);
    bf16x4 lo, hi;
    asm volatile("ds_read_b64_tr_b16 %0, %2\n\tds_read_b64_tr_b16 %1, %3\n\ts_waitcnt lgkmcnt(0)" : "=&v"(lo), "=&v"(hi) : "v"(a0), "v"(a1) : "memory");
    bf16x8 r; r[0] = lo[0]; r[1] = lo[1]; r[2] = lo[2]; r[3] = lo[3]; r[4] = hi[0]; r[5] = hi[1]; r[6] = hi[2]; r[7] = hi[3];
    return r;
}
__device__ __forceinline__ unsigned lds_addr(LAS unsigned char* p) { return (unsigned)(size_t)p; }
template <int O0, int O1> __device__ __forceinline__ bf16x8 tr_frag_i(unsigned a) {
    static_assert(O0 >= 0 && O0 < 65536 && O1 >= 0 && O1 < 65536, "ds offset field");
    bf16x4 lo, hi;
    asm volatile("ds_read_b64_tr_b16 %0, %2 offset:%3\n\tds_read_b64_tr_b16 %1, %2 offset:%4\n\ts_waitcnt lgkmcnt(0)" : "=&v"(lo), "=&v"(hi) : "v"(a), "n"(O0), "n"(O1) : "memory");
    bf16x8 r; r[0] = lo[0]; r[1] = lo[1]; r[2] = lo[2]; r[3] = lo[3]; r[4] = hi[0]; r[5] = hi[1]; r[6] = hi[2]; r[7] = hi[3];
    return r;
}
template <int OB, int R1> __device__ __forceinline__ void tr_frag4_i(unsigned a, bf16x8 (&f)[4]) {
    static_assert(OB >= 0 && OB + R1 + 96 < 65536, "ds offset field");
    bf16x4 l0, h0, l1, h1, l2, h2, l3, h3;
    asm volatile("ds_read_b64_tr_b16 %0, %8 offset:%9\n\tds_read_b64_tr_b16 %1, %8 offset:%10\n\tds_read_b64_tr_b16 %2, %8 offset:%11\n\tds_read_b64_tr_b16 %3, %8 offset:%12\n\t"
                 "ds_read_b64_tr_b16 %4, %8 offset:%13\n\tds_read_b64_tr_b16 %5, %8 offset:%14\n\tds_read_b64_tr_b16 %6, %8 offset:%15\n\tds_read_b64_tr_b16 %7, %8 offset:%16\n\ts_waitcnt lgkmcnt(0)"
                 : "=&v"(l0), "=&v"(h0), "=&v"(l1), "=&v"(h1), "=&v"(l2), "=&v"(h2), "=&v"(l3), "=&v"(h3)
                 : "v"(a), "n"(OB), "n"(OB + R1), "n"(OB + 32), "n"(OB + 32 + R1), "n"(OB + 64), "n"(OB + 64 + R1), "n"(OB + 96), "n"(OB + 96 + R1) : "memory");
    f[0][0] = l0[0]; f[0][1] = l0[1]; f[0][2] = l0[2]; f[0][3] = l0[3]; f[0][4] = h0[0]; f[0][5] = h0[1]; f[0][6] = h0[2]; f[0][7] = h0[3];
    f[1][0] = l1[0]; f[1][1] = l1[1]; f[1][2] = l1[2]; f[1][3] = l1[3]; f[1][4] = h1[0]; f[1][5] = h1[1]; f[1][6] = h1[2]; f[1][7] = h1[3];
    f[2][0] = l2[0]; f[2][1] = l2[1]; f[2][2] = l2[2]; f[2][3] = l2[3]; f[2][4] = h2[0]; f[2][5] = h2[1]; f[2][6] = h2[2]; f[2][7] = h2[3];
    f[3][0] = l3[0]; f[3][1] = l3[1]; f[3][2] = l3[2]; f[3][3] = l3[3]; f[3][4] = h3[0]; f[3][5] = h3[1]; f[3][6] = h3[2]; f[3][7] = h3[3];
}
__device__ __forceinline__ unsigned tr_lane(unsigned base, int stride, int rmul, int lane) { return base + (unsigned)((rmul * (lane >> 4) + ((lane & 15) >> 2)) * stride + (lane & 3) * 8); }
template <int V> struct IC { static constexpr int value = V; };
template <int I, int N, class F> __device__ __forceinline__ void sfor(F&& f) { if constexpr (I < N) { f(IC<I>{}); sfor<I + 1, N>(f); } }


#define XB_TMO      128
#define XB_XCNT(j)  (256  + 64 * (j))
#define XB_XSUB(j)  (1280 + 64 * (j))
#define XB_XGEN(j)  (2304 + 64 * (j))
#define XB_TOP      3328
#define XB_TOPGEN   3392
#define XCD_BAR_WORDS 3456
#define XB_SPIN_CAP (1u << 21)
__device__ __forceinline__ unsigned xb_ld(unsigned* p)              { return __hip_atomic_load(p, __ATOMIC_RELAXED, __HIP_MEMORY_SCOPE_AGENT); }
__device__ __forceinline__ unsigned xb_add(unsigned* p, unsigned v) { return __hip_atomic_fetch_add(p, v, __ATOMIC_RELAXED, __HIP_MEMORY_SCOPE_AGENT); }
__device__ __forceinline__ unsigned xb_xcc_id() { return (unsigned)__builtin_amdgcn_s_getreg((3 << 11) | 20) & 0xFu; }
#define XB_SPIN(cond, bar) do { unsigned _sp = 0; while (cond) { __builtin_amdgcn_s_sleep(1); \
    if ((++_sp & 255u) == 0u) { if (xb_ld(&(bar)[XB_TMO])) break; if (_sp > XB_SPIN_CAP) { atomicAdd(&(bar)[XB_TMO], 1u); break; } } } } while (0)
struct XcdBarrier { unsigned* bar; unsigned x; volatile LAS unsigned* st; };
__device__ __forceinline__ XcdBarrier xcd_barrier_post(unsigned* bar, volatile LAS unsigned* st) {
    XcdBarrier b; b.bar = bar; b.x = xb_xcc_id(); b.st = st;
    if (threadIdx.x == 0) (void)xb_add(&bar[XB_XCNT(b.x)], 1u);
    return b;
}
__device__ __forceinline__ void xcd_barrier_complete(unsigned* bar, unsigned x, unsigned& nloc, unsigned& nx) {
    const unsigned G = gridDim.x * gridDim.y * gridDim.z;
    unsigned sum, cnt, mine, sp = 0u;
    for (;;) {
        sum = 0u; cnt = 0u; mine = 0u;
#pragma unroll
        for (unsigned j = 0; j < 16; ++j) { const unsigned c = xb_ld(&bar[XB_XCNT(j)]); sum += c; cnt += (c > 0u) ? 1u : 0u; mine = (j == x) ? c : mine; }
        if (sum == G) break;
        __builtin_amdgcn_s_sleep(1);
        if ((++sp & 255u) == 0u) { if (xb_ld(&bar[XB_TMO])) break; if (sp > XB_SPIN_CAP) { atomicAdd(&bar[XB_TMO], 1u); break; } }
    }
    nloc = mine > 0u ? mine : 1u; nx = cnt > 0u ? cnt : 1u;
}
__device__ __forceinline__ void xcd_barrier(const XcdBarrier& b, const bool leader) {
    asm volatile("s_waitcnt vmcnt(0)" ::: "memory");
    __syncthreads();
    if (leader) {
        unsigned* bar = b.bar;
        __builtin_amdgcn_s_waitcnt(0);
        unsigned nloc = b.st[0], nx = b.st[1];
        if (nloc == 0u) { xcd_barrier_complete(bar, b.x, nloc, nx); b.st[0] = nloc; b.st[1] = nx; }
        const unsigned old = xb_add(&bar[XB_XSUB(b.x)], 1u);
        const unsigned gen = old / nloc;
        if (old + 1u == (gen + 1u) * nloc) {
            __builtin_amdgcn_fence(__ATOMIC_RELEASE, "agent");
            asm volatile("s_waitcnt vmcnt(0)" ::: "memory");
            const unsigned og = xb_add(&bar[XB_TOP], 1u);
            const unsigned tg = og / nx;
            if (og + 1u == (tg + 1u) * nx) xb_add(&bar[XB_TOPGEN], 1u);
            else XB_SPIN(xb_ld(&bar[XB_TOPGEN]) == tg, bar);
            __builtin_amdgcn_fence(__ATOMIC_ACQUIRE, "agent");
            xb_add(&bar[XB_XGEN(b.x)], 1u);
            asm volatile("s_waitcnt vmcnt(0)" ::: "memory");
        } else {
            XB_SPIN(xb_ld(&bar[XB_XGEN(b.x)]) == gen, bar);
            __builtin_amdgcn_fence(__ATOMIC_ACQUIRE, "agent");
            asm volatile("s_waitcnt vmcnt(0)" ::: "memory");
        }
    }
    __syncthreads();
}

namespace pg8 {
constexpr int BM = 256, BK = 64, HALF = 128, HTB = HALF * BK * 2, STAGE_BYTES = 8 * HTB, NXCD = 8, WGM = 8;
constexpr int ROWTAB_OFF = 149504;
constexpr int GATHER_SLOT_OFF = 133120;
__device__ __forceinline__ int lds_byte(int r, int c) { const int st = (r >> 4) * 2 + (c >> 5), rr = r & 15, cc = c & 31, ob = rr * 64 + cc * 2; return st * 1024 + (ob ^ (((ob >> 9) & 1) << 5)); }
__device__ __forceinline__ void stage_rc(int b, int& R, int& C) { const int st = b / 1024, sb = b % 1024, swz = sb ^ (((sb >> 9) & 1) << 5); R = (st >> 1) * 16 + swz / 64; C = (st & 1) * 32 + (swz % 64) / 2; }
__device__ __forceinline__ int perm32(int rho) { const int n = rho >> 4, i = rho & 15; return 8 * (i >> 2) + 4 * n + (i & 3); }

struct Unit { const char* A; const char* B; int e0, e1, e2, e3, e4; };

__device__ __forceinline__ bool static_tile(int i, int G, int c, int nM, int nN, int& pm, int& pn) {
    const int nwg = nM * nN; const long L = (long)i * G + c; if (L >= nwg) return false;
    int wgid = (int)L; { const int q = nwg / NXCD, r = nwg % NXCD, xcd = wgid % NXCD, off = wgid / NXCD; wgid = (xcd < r ? xcd * (q + 1) : r * (q + 1) + (xcd - r) * q) + off; }
    const int nig = WGM * nN, gid = wgid / nig, fm = gid * WGM, gsz = (nM - fm) < WGM ? (nM - fm) : WGM;
    pm = fm + ((wgid % nig) % gsz); pn = (wgid % nig) / gsz; return true;
}

template <bool F8 = false, class Epi, class Sched>
__device__ __forceinline__ void gemm_phase(LAS unsigned char* lds, const int tid, const int K, const int ldb  , const Sched& S, const Epi& E, const int stamp_base = -1) {
#ifdef TIMING
#define GSTAMP(k) do { if (stamp_base >= 0 && tid == 0 && (k) < 31) ((volatile LAS unsigned long long*)(lds + LDS_BYTES - 16 - 512))[stamp_base + (k)] = __builtin_amdgcn_s_memrealtime(); } while (0)
#else
#define GSTAMP(k) do { } while (0)
#endif
    GSTAMP(-1);
    const int wid = __builtin_amdgcn_readfirstlane(tid >> 6), lane = tid & 63, wr = wid >> 2, wc = wid & 3, fr = lane & 15, fq = lane >> 4;
    const int nt = K / (F8 ? 2 * BK : BK);
    unsigned voffB[2];
#pragma unroll
    for (int i = 0; i < 2; ++i) { int R, C; stage_rc(tid * 16 + i * 8192, R, C); const int Rb = Epi::PERM ? ((R & ~31) + perm32(R & 31)) : R; voffB[i] = F8 ? (unsigned)(Rb * ldb + C * 2) : (unsigned)(Rb * ldb + C) * 2u; }
    const size_t kstep = (size_t)(BK * 2);
    const size_t hstepB = (size_t)HALF * ldb * (F8 ? 1 : 2);
    const unsigned ldsw = (unsigned)wid * 1024u;
    const int aoff = lds_byte(wr * 64 + fr, fq * 8), boff = lds_byte(wc * 32 + fr, fq * 8);
#define PG8_SA(b, h) (((b) * 2 + (h)) * HTB)
#define PG8_SB(b, h) ((4 + (b) * 2 + (h)) * HTB)
#define PG8_STAGE(bufoff, gbase, voff) do { _Pragma("unroll") for (int _i = 0; _i < 2; ++_i) \
        __builtin_amdgcn_global_load_lds((const unsigned*)((const char*)(gbase) + (voff)[_i]), (LAS unsigned*)(lds + (bufoff) + ldsw + _i * 8192), 16, 0, 0); } while (0)
#define PG8_LDA(dst, b, h) do { _Pragma("unroll") for (int m = 0; m < 4; ++m) _Pragma("unroll") for (int k = 0; k < 2; ++k) dst[m][k] = *(const LAS bf16x8*)(lds + PG8_SA(b, h) + aoff + m * 2048 + k * 1024); } while (0)
#define PG8_LDB(dst, b, h) do { _Pragma("unroll") for (int n = 0; n < 2; ++n) _Pragma("unroll") for (int k = 0; k < 2; ++k) dst[n][k] = *(const LAS bf16x8*)(lds + PG8_SB(b, h) + boff + n * 2048 + k * 1024); } while (0)
#define PG8_MMA(ai, bj, At, Bt) do { __builtin_amdgcn_s_setprio(1); _Pragma("unroll") for (int m = 0; m < 4; ++m) _Pragma("unroll") for (int n = 0; n < 2; ++n) _Pragma("unroll") for (int k = 0; k < 2; ++k) { \
        if constexpr (F8) { const i64x2 b2_ = __builtin_bit_cast(i64x2, Bt[n][k]), a2_ = __builtin_bit_cast(i64x2, At[m][k]); \
            acc[ai][bj][m][n] = __builtin_amdgcn_mfma_f32_16x16x32_fp8_fp8(b2_[0], a2_[0], acc[ai][bj][m][n], 0, 0, 0); \
            acc[ai][bj][m][n] = __builtin_amdgcn_mfma_f32_16x16x32_fp8_fp8(b2_[1], a2_[1], acc[ai][bj][m][n], 0, 0, 0); } \
        else acc[ai][bj][m][n] = __builtin_amdgcn_mfma_f32_16x16x32_bf16(Bt[n][k], At[m][k], acc[ai][bj][m][n], 0, 0, 0); } __builtin_amdgcn_s_setprio(0); } while (0)
#define PG8_WAIT_V(n) asm volatile("s_waitcnt vmcnt(" #n ")" ::: "memory")
#define PG8_WAIT_L(n) asm volatile("s_waitcnt lgkmcnt(" #n ")" ::: "memory")
#define PG8_BAR __builtin_amdgcn_s_barrier()
#define PG8_SCHED __builtin_amdgcn_sched_barrier(0)
    Unit cur, nxt; int ui = 0;
    if (!S.next(0, cur)) return;
    unsigned cvA[2][2], nvA[2][2];
    S.a_offs(cur, tid, cvA);
    LAS unsigned* const gslot = (LAS unsigned*)(lds + GATHER_SLOT_OFF) + tid * 4;
    if constexpr (Sched::GATHER) { *(LAS u32x4*)gslot = (u32x4){cvA[0][0], cvA[0][1], cvA[1][0], cvA[1][1]}; }
    f32x4 acc[2][2][4][2];
#pragma unroll
    for (int a = 0; a < 2; ++a)
#pragma unroll
        for (int b = 0; b < 2; ++b)
#pragma unroll
            for (int m = 0; m < 4; ++m)
#pragma unroll
                for (int n = 0; n < 2; ++n) acc[a][b][m][n] = (f32x4){0.f, 0.f, 0.f, 0.f};
    bf16x8 At[4][2], B0[2][2], B1[2][2];
    const char* cA = cur.A; const char* cB = cur.B;
    PG8_STAGE(PG8_SB(0, 0), cB, voffB); PG8_STAGE(PG8_SA(0, 0), cA, cvA[0]); PG8_STAGE(PG8_SB(0, 1), cB + hstepB, voffB); PG8_STAGE(PG8_SA(0, 1), cA, cvA[1]);
    if (wr == 1) PG8_BAR;
    PG8_WAIT_V(4); PG8_BAR;
    PG8_STAGE(PG8_SB(1, 0), cB + kstep, voffB); PG8_STAGE(PG8_SA(1, 0), cA + kstep, cvA[0]); PG8_STAGE(PG8_SB(1, 1), cB + hstepB + kstep, voffB);
    PG8_WAIT_V(6); PG8_BAR;
    for (;;) {
        if constexpr (Epi::STAGES) { if (wid < 4) E.stage(cur, (LAS unsigned*)(lds + ROWTAB_OFF) + (ui & 1) * 256 + wid * 64, wid * 64 + lane); }
        const bool has_next = S.next(ui + 1, nxt);
        if (has_next) S.a_offs(nxt, tid, nvA);
        else {
#pragma unroll
            for (int h = 0; h < 2; ++h)
#pragma unroll
                for (int i = 0; i < 2; ++i) nvA[h][i] = cvA[h][i];
        }
        if constexpr (Sched::GATHER) { *(LAS u32x4*)(gslot + ((ui + 1) & 1) * 2048) = (u32x4){nvA[0][0], nvA[0][1], nvA[1][0], nvA[1][1]}; }
        const char* nA = has_next ? nxt.A : cA; const char* nB = has_next ? nxt.B : cB;
#pragma unroll 1
        for (int t = 0; t < nt; t += 2) {
            const bool last = (t == nt - 2);
            const char* a1 = cA + (size_t)(t + 1) * kstep;
            const char* a2 = last ? nA : cA + (size_t)(t + 2) * kstep; const char* b2 = last ? nB : cB + (size_t)(t + 2) * kstep;
            const char* a3 = a2 + kstep; const char* b3 = b2 + kstep;
            unsigned sA[2][2];
            if constexpr (Sched::GATHER) {
                const u32x4 cv = *(const LAS u32x4*)(gslot + (ui & 1) * 2048), sv = *(const LAS u32x4*)(gslot + ((ui + (last ? 1 : 0)) & 1) * 2048);
                cvA[0][0] = cv.x; cvA[0][1] = cv.y; cvA[1][0] = cv.z; cvA[1][1] = cv.w; sA[0][0] = sv.x; sA[0][1] = sv.y; sA[1][0] = sv.z; sA[1][1] = sv.w;
            } else {
#pragma unroll
                for (int h = 0; h < 2; ++h)
#pragma unroll
                    for (int i = 0; i < 2; ++i) sA[h][i] = last ? nvA[h][i] : cvA[h][i];
            }
            PG8_LDB(B0, 0, 0); PG8_SCHED; PG8_LDA(At, 0, 0); PG8_STAGE(PG8_SA(1, 1), a1, cvA[1]);
            PG8_WAIT_L(8); PG8_BAR; PG8_WAIT_L(0); PG8_MMA(0, 0, At, B0); PG8_BAR; PG8_SCHED;
            PG8_LDB(B1, 0, 1); PG8_STAGE(PG8_SB(0, 0), b2, voffB);
            PG8_BAR; PG8_WAIT_L(0); PG8_MMA(0, 1, At, B1); PG8_BAR;
            PG8_LDA(At, 0, 1); PG8_STAGE(PG8_SA(0, 0), a2, sA[0]);
            PG8_BAR; PG8_WAIT_L(0); PG8_MMA(1, 0, At, B0); PG8_BAR; PG8_SCHED;
            PG8_STAGE(PG8_SB(0, 1), b2 + hstepB, voffB);
            PG8_WAIT_V(6); PG8_BAR; PG8_MMA(1, 1, At, B1); PG8_BAR;
            PG8_LDB(B0, 1, 0); PG8_SCHED; PG8_LDA(At, 1, 0); PG8_STAGE(PG8_SA(0, 1), a2, sA[1]);
            PG8_WAIT_L(8); PG8_BAR; PG8_WAIT_L(0); PG8_MMA(0, 0, At, B0); PG8_BAR; PG8_SCHED;
            PG8_LDB(B1, 1, 1); PG8_STAGE(PG8_SB(1, 0), b3, voffB);
            PG8_BAR; PG8_WAIT_L(0); PG8_MMA(0, 1, At, B1); PG8_BAR;
            PG8_LDA(At, 1, 1); PG8_STAGE(PG8_SA(1, 0), a3, sA[0]);
            PG8_BAR; PG8_WAIT_L(0); PG8_MMA(1, 0, At, B0); PG8_BAR; PG8_SCHED;
            PG8_STAGE(PG8_SB(1, 1), b3 + hstepB, voffB);
            PG8_WAIT_V(6); PG8_BAR; PG8_MMA(1, 1, At, B1); PG8_BAR;
        }
        GSTAMP(2 * ui);
        if constexpr (Epi::STAGES) E(acc, cur, wr, wc, fr, fq, (const LAS unsigned*)(lds + ROWTAB_OFF) + (ui & 1) * 256); else E(acc, cur, wr, wc, fr, fq);
        GSTAMP(2 * ui + 1);
        if (!has_next) break;
        if (!(Epi::KEEPS && E.keep(cur))) {
#pragma unroll
        for (int a = 0; a < 2; ++a)
#pragma unroll
            for (int b = 0; b < 2; ++b)
#pragma unroll
                for (int m = 0; m < 4; ++m)
#pragma unroll
                    for (int n = 0; n < 2; ++n) acc[a][b][m][n] = (f32x4){0.f, 0.f, 0.f, 0.f};
        }
        cur = nxt; cA = nA; cB = nB; ++ui;
        if constexpr (!Sched::GATHER) {
#pragma unroll
            for (int h = 0; h < 2; ++h)
#pragma unroll
                for (int i = 0; i < 2; ++i) cvA[h][i] = nvA[h][i];
        }
    }
    PG8_WAIT_V(0);
    if (wr == 0) PG8_BAR;
    PG8_BAR;
#undef PG8_SA
#undef PG8_SB
#undef PG8_STAGE
#undef PG8_LDA
#undef PG8_LDB
#undef PG8_MMA
#undef PG8_WAIT_V
#undef PG8_WAIT_L
#undef PG8_BAR
#undef PG8_SCHED
}
}

using pg8::Unit;
struct DenseSched {
    static constexpr bool GATHER = false;
    const char* A; const char* B; int lda, ldb, nM, nN, G, c, nsub; size_t asub, bsub;
    __device__ __forceinline__ bool next(int i, Unit& u) const {
        const int sub = i % nsub, ti = i / nsub; int pm, pn;
        if (!pg8::static_tile(ti, G, c, nM, nN, pm, pn)) return false;
        u.A = A + (size_t)pm * 256 * lda * 2 + (size_t)sub * asub; u.B = B + (size_t)pn * 256 * ldb * 2 + (size_t)sub * bsub;
        u.e0 = pm; u.e1 = pn; u.e2 = sub; u.e3 = 0; u.e4 = 0; return true;
    }
    __device__ __forceinline__ void a_offs(const Unit&, int tid, unsigned (&vo)[2][2]) const {
#pragma unroll
        for (int i = 0; i < 2; ++i) { int R, C; pg8::stage_rc(tid * 16 + i * 8192, R, C);
#pragma unroll
            for (int h = 0; h < 2; ++h) vo[h][i] = (unsigned)((h * 128 + R) * lda + C) * 2u; }
    }
};
constexpr int MOE_TAB_OFF = 131072;
constexpr int MOE_UL_OFF = MOE_TAB_OFF + 1024, MOE_UL_MAX = 24;
#define RFL(x) __builtin_amdgcn_readfirstlane(x)
__device__ __forceinline__ int moe_find_expert(const LAS int* tbase, int mt) {
    int lo = 0, hi = 63;
#pragma unroll
    for (int it = 0; it < 6; ++it) { const int mid = (lo + hi + 1) >> 1; if (RFL(tbase[mid]) <= mt) lo = mid; else hi = mid - 1; }
    return lo;
}
struct MoeGuSched {
    static constexpr bool GATHER = true;
    const char* H2; const char* WGU; const char* WSGU; const unsigned* list; const LAS int* tbase; const LAS int* cnt; int nMs, G, c;
    __device__ __forceinline__ bool next(int i, Unit& u) const {
        if (i >= MOE_UL_MAX) return false;
        const LAS int* ul = tbase + (MOE_UL_OFF - MOE_TAB_OFF) / 4 + i * 8;
        const int e = RFL(ul[0]), nt = RFL(ul[1]), p0 = RFL(ul[2]), t3 = RFL(ul[3]), cn_ = RFL(ul[4]);
        if (e < 0) return false;
        u.e0 = e; u.e1 = nt; u.e2 = p0; u.e3 = t3; u.e4 = cn_;
        if (e != 64) { u.A = H2; u.B = WGU + (size_t)e * (512 * 1024) + (size_t)nt * (256 * 1024); }
        else { u.A = H2 + (size_t)t3 * 256 * 1024; u.B = WSGU + (size_t)nt * (256 * 1024); }
        return true;
    }
    __device__ __forceinline__ void a_offs(const Unit& u, int tid, unsigned (&vo)[2][2]) const {
#pragma unroll
        for (int i = 0; i < 2; ++i) { int R, C; pg8::stage_rc(tid * 16 + i * 8192, R, C); R = launder(R);
#pragma unroll
            for (int h = 0; h < 2; ++h) {
                if (u.e0 == 64) vo[h][i] = (unsigned)((h * 128 + R) * 1024 + C * 2);
                else { const int pos = u.e2 + h * 128 + R; const unsigned tv = list[(size_t)u.e0 * NT + pos] >> 3;
                    vo[h][i] = (pos < u.e4 ? tv : 0u) * 1024u + (unsigned)C * 2u; } } }
    }
};
struct MoeDownSched {
    static constexpr bool GATHER = false;
    const char* ACT; const char* WD; const char* ACTS; const char* WSD; const LAS int* tbase; const LAS int* cnt; int nMs, G, c;
    __device__ __forceinline__ bool next(int i, Unit& u) const {
        if (i >= MOE_UL_MAX) return false;
        const LAS int* ul = tbase + (MOE_UL_OFF - MOE_TAB_OFF) / 4 + i * 8;
        const int e = RFL(ul[0]), pn = RFL(ul[1]), p0 = RFL(ul[2]), t3 = RFL(ul[3]), cn_ = RFL(ul[4]);
        if (e < 0) return false;
        u.e0 = e; u.e1 = pn; u.e2 = p0; u.e3 = t3; u.e4 = cn_;
        if (e != 64) { u.A = ACT + (size_t)t3 * (256 * 256); u.B = WD + (size_t)e * (1024 * 256) + (size_t)pn * (256 * 256); }
        else { u.A = ACTS + (size_t)t3 * (256 * 256); u.B = WSD + (size_t)pn * (256 * 256); }
        return true;
    }
    __device__ __forceinline__ void a_offs(const Unit&, int tid, unsigned (&vo)[2][2]) const {
#pragma unroll
        for (int i = 0; i < 2; ++i) { int R, C; pg8::stage_rc(tid * 16 + i * 8192, R, C);
#pragma unroll
            for (int h = 0; h < 2; ++h) vo[h][i] = (unsigned)((h * 128 + R) * 256 + C * 2); }
    }
};

struct EpiStoreBf16 {
    static constexpr bool STAGES = false;
    static constexpr bool KEEPS = false; __device__ __forceinline__ bool keep(const Unit&) const { return false; }
    static constexpr bool PERM = true;
    bf16_t* O; int ldc; int gate_tile0; unsigned char* G8;
    __device__ __forceinline__ void operator()(const f32x4 (&acc)[2][2][4][2], const Unit& u, int wr, int wc, int fr, int fq) const {
        const int row0 = u.e0 * 256 + launder(wr * 64 + fr), col0 = u.e1 * 256 + wc * 32 + 8 * fq;
        if (u.e1 >= gate_tile0) {
            const int gi = (u.e1 - gate_tile0) >> 2, pn = (u.e1 - gate_tile0) & 3, tidx = launder(((wr * 4 + wc) * 64) + fq * 16 + fr);
            unsigned char* gp = G8 + ((size_t)((u.e0 * 4 + pn) * 3 + gi) * 65536) + (size_t)tidx * 128;
#pragma unroll
            for (int ai = 0; ai < 2; ++ai)
#pragma unroll
                for (int m = 0; m < 4; ++m) { u32x4 w;
#pragma unroll
                    for (int bj = 0; bj < 2; ++bj) { const f32x4 v0 = acc[ai][bj][m][0], v1 = acc[ai][bj][m][1];
                        float q[8] = {v0[0], v0[1], v0[2], v0[3], v1[0], v1[1], v1[2], v1[3]}; unsigned qb[8];
#pragma unroll
                        for (int j = 0; j < 8; ++j) { const float t = fminf(fmaxf(sigmoidf_(q[j]) * 255.0f + 0.5f, 1.0f), 255.0f); qb[j] = (unsigned)t; }
                        const unsigned lo = qb[0] | (qb[1] << 8) | (qb[2] << 16) | (qb[3] << 24), hi = qb[4] | (qb[5] << 8) | (qb[6] << 16) | (qb[7] << 24);
                        if (bj == 0) { w.x = lo; w.y = hi; } else { w.z = lo; w.w = hi; } }
                    *(u32x4*)(gp + (ai * 4 + m) * 16) = w; }
            return;
        }
#pragma unroll
        for (int ai = 0; ai < 2; ++ai)
#pragma unroll
            for (int m = 0; m < 4; ++m) { bf16_t* rowp = O + (size_t)(row0 + ai * 128 + m * 16) * ldc + col0;
#pragma unroll
                for (int bj = 0; bj < 2; ++bj) { const f32x4 v0 = acc[ai][bj][m][0], v1 = acc[ai][bj][m][1];
                    u32x4 w; w.x = pk2(v0[0], v0[1]); w.y = pk2(v0[2], v0[3]); w.z = pk2(v1[0], v1[1]); w.w = pk2(v1[2], v1[3]);
                    *(u32x4*)(rowp + bj * 128) = w; } }
    }
};
struct EpiMerge {
    static constexpr bool PERM = true, KEEPS = true, STAGES = false;
    bf16_t* Mo; const unsigned char* G8;
    __device__ __forceinline__ bool keep(const Unit& u) const { return u.e2 < 2; }
    __device__ __forceinline__ void operator()(f32x4 (&acc)[2][2][4][2], const Unit& u, int wr, int wc, int fr, int fq) const {
        const int row0 = u.e0 * 256 + launder(wr * 64 + fr), col0 = u.e1 * 256 + wc * 32 + 8 * fq, sub = u.e2, tidx = launder(((wr * 4 + wc) * 64) + fq * 16 + fr);
        const unsigned char* gp = G8 + ((size_t)((u.e0 * 4 + u.e1) * 3 + sub) * 65536) + (size_t)tidx * 128;
        u32x4 gq[8], hq[8];
        const unsigned char* hp = gp + (sub < 2 ? 65536 : 0);
#pragma unroll
        for (int k = 0; k < 8; ++k) { gq[k] = *(const u32x4*)(gp + k * 16); hq[k] = *(const u32x4*)(hp + k * 16); }
        if (sub < 2) {
#pragma unroll
            for (int ai = 0; ai < 2; ++ai)
#pragma unroll
                for (int m = 0; m < 4; ++m)
#pragma unroll
                    for (int bj = 0; bj < 2; ++bj) { const u32x4 g4v = gq[ai * 4 + m], h4v = hq[ai * 4 + m];
                        const unsigned g0 = bj ? g4v.z : g4v.x, g1 = bj ? g4v.w : g4v.y, h0 = bj ? h4v.z : h4v.x, h1 = bj ? h4v.w : h4v.y;
                        float f[8];
#pragma unroll
                        for (int j = 0; j < 8; ++j) { const float qg = (float)(((j < 4 ? g0 : g1) >> (8 * (j & 3))) & 255u), qh = (float)(((j < 4 ? h0 : h1) >> (8 * (j & 3))) & 255u);
                            f[j] = qg * __builtin_amdgcn_rcpf(qh); }
                        acc[ai][bj][m][0] = acc[ai][bj][m][0] * (f32x4){f[0], f[1], f[2], f[3]}; acc[ai][bj][m][1] = acc[ai][bj][m][1] * (f32x4){f[4], f[5], f[6], f[7]}; }
        } else {
#pragma unroll
            for (int ai = 0; ai < 2; ++ai)
#pragma unroll
                for (int m = 0; m < 4; ++m)
#pragma unroll
                    for (int bj = 0; bj < 2; ++bj) { const u32x4 g4v = gq[ai * 4 + m];
                        const unsigned g0 = bj ? g4v.z : g4v.x, g1 = bj ? g4v.w : g4v.y;
                        float f[8];
#pragma unroll
                        for (int j = 0; j < 8; ++j) f[j] = (float)(((j < 4 ? g0 : g1) >> (8 * (j & 3))) & 255u) * (1.0f / 255.0f);
                        const f32x4 v0 = acc[ai][bj][m][0] * (f32x4){f[0], f[1], f[2], f[3]}, v1 = acc[ai][bj][m][1] * (f32x4){f[4], f[5], f[6], f[7]};
                        const size_t row = (size_t)(row0 + ai * 128 + m * 16);
                        u32x4 w; w.x = pk2(v0[0], v0[1]); w.y = pk2(v0[2], v0[3]); w.z = pk2(v1[0], v1[1]); w.w = pk2(v1[2], v1[3]);
                        *(u32x4*)(Mo + row * 1024 + col0 + bj * 128) = w; }
        }
    }
};
struct EpiResid {
    static constexpr bool STAGES = false;
    static constexpr bool KEEPS = false; __device__ __forceinline__ bool keep(const Unit&) const { return false; }
    static constexpr bool PERM = false;
    const float* src_l; const float* src_c; float* dst_l; float* dst_c; const float* gate;
    __device__ __forceinline__ void operator()(const f32x4 (&acc)[2][2][4][2], const Unit& u, int wr, int wc, int fr, int fq) const {
        const int g0 = u.e0 * 256; const bool lat = g0 < NL;
        const float* src = lat ? src_l + (size_t)g0 * D : src_c + (size_t)(g0 - NL) * D;
        float* dst = lat ? dst_l + (size_t)g0 * D : dst_c + (size_t)(g0 - NL) * D;
        const float* gp = gate + (size_t)(lat ? (g0 >> 11) : 8) * 6144;
        const int row0 = launder(wr * 64 + fr), col0 = u.e1 * 256 + wc * 32 + 4 * fq;
        f32x4 gv[2][2];
#pragma unroll
        for (int bj = 0; bj < 2; ++bj)
#pragma unroll
            for (int n = 0; n < 2; ++n) gv[bj][n] = *(const f32x4*)(gp + col0 + bj * 128 + n * 16);
#pragma unroll
        for (int am = 0; am < 4; ++am) { const int ai = am >> 1, mh = (am & 1) * 2;
            f32x4 sq[2][2][2];
#pragma unroll
            for (int mm = 0; mm < 2; ++mm)
#pragma unroll
                for (int bj = 0; bj < 2; ++bj)
#pragma unroll
                    for (int n = 0; n < 2; ++n) sq[mm][bj][n] = *(const f32x4*)(src + (size_t)(row0 + ai * 128 + (mh + mm) * 16) * D + col0 + bj * 128 + n * 16);
#pragma unroll
            for (int mm = 0; mm < 2; ++mm)
#pragma unroll
                for (int bj = 0; bj < 2; ++bj)
#pragma unroll
                    for (int n = 0; n < 2; ++n) *(f32x4*)(dst + (size_t)(row0 + ai * 128 + (mh + mm) * 16) * D + col0 + bj * 128 + n * 16) = sq[mm][bj][n] + gv[bj][n] * acc[ai][bj][mh + mm][n];
            if (am == 1) asm volatile("" ::: "memory");
        }
    }
};
struct EpiGateUp {
    static constexpr bool KEEPS = false; __device__ __forceinline__ bool keep(const Unit&) const { return false; }
    static constexpr bool PERM = true, STAGES = true;
    bf16_t* ACT; bf16_t* ACTS; const float* wl;
    __device__ __forceinline__ void stage(const Unit& u, LAS unsigned* dst_wave, int entry) const {
        if (u.e0 != 64) __builtin_amdgcn_global_load_lds((const unsigned*)(wl + (size_t)u.e0 * NT + u.e2 + entry), dst_wave, 4, 0, 0);
    }
    __device__ __forceinline__ void operator()(const f32x4 (&acc)[2][2][4][2], const Unit& u, int wr, int wc, int fr, int fq, const LAS unsigned* tab) const {
        const int row0 = launder(wr * 64 + fr), col0 = u.e1 * 128 + wc * 32 + 8 * fq;
        unsigned char* base = (unsigned char*)(u.e0 == 64 ? ACTS : ACT) + (size_t)u.e3 * 256 * 256;
#pragma unroll
        for (int ai = 0; ai < 2; ++ai)
#pragma unroll
            for (int m = 0; m < 4; ++m) { const int row = row0 + ai * 128 + m * 16; const float tw = __uint_as_float(tab[row]);
                const float w = u.e0 == 64 ? 1.0f : (u.e2 + row < u.e4 ? tw : 0.0f);
                const f32x4 g0 = acc[ai][0][m][0] * 0.03125f, g1 = acc[ai][0][m][1] * 0.03125f, u0 = acc[ai][1][m][0] * (0.03125f * 8.0f * w), u1 = acc[ai][1][m][1] * (0.03125f * 8.0f * w);
                int lo = 0, hi = 0;
                lo = __builtin_amdgcn_cvt_pk_fp8_f32(siluf_(g0[0]) * u0[0], siluf_(g0[1]) * u0[1], lo, false); lo = __builtin_amdgcn_cvt_pk_fp8_f32(siluf_(g0[2]) * u0[2], siluf_(g0[3]) * u0[3], lo, true);
                hi = __builtin_amdgcn_cvt_pk_fp8_f32(siluf_(g1[0]) * u1[0], siluf_(g1[1]) * u1[1], hi, false); hi = __builtin_amdgcn_cvt_pk_fp8_f32(siluf_(g1[2]) * u1[2], siluf_(g1[3]) * u1[3], hi, true);
                *(u32x2*)(base + (size_t)row * 256 + col0) = (u32x2){(unsigned)lo, (unsigned)hi}; }
    }
};
struct EpiDown {
    static constexpr bool KEEPS = false; __device__ __forceinline__ bool keep(const Unit&) const { return false; }
    static constexpr bool PERM = true, STAGES = true;
    bf16_t* O; const unsigned* list; bf16_t* Hs;
    __device__ __forceinline__ void stage(const Unit& u, LAS unsigned* dst_wave, int entry) const {
        if (u.e0 != 64) __builtin_amdgcn_global_load_lds(list + (size_t)u.e0 * NT + u.e2 + entry, dst_wave, 4, 0, 0);
    }
    __device__ __forceinline__ void operator()(const f32x4 (&acc)[2][2][4][2], const Unit& u, int wr, int wc, int fr, int fq, const LAS unsigned* tab) const {
        const int row0 = launder(wr * 64 + fr), col0 = u.e1 * 256 + wc * 32 + 8 * fq;
        if (u.e0 == 64) {
#pragma unroll
            for (int ai = 0; ai < 2; ++ai)
#pragma unroll
                for (int m = 0; m < 4; ++m) { bf16_t* rowp = Hs + (size_t)(u.e3 * 256 + row0 + ai * 128 + m * 16) * 1024 + col0;
#pragma unroll
                    for (int bj = 0; bj < 2; ++bj) { const f32x4 v0 = acc[ai][bj][m][0] * 0.0078125f, v1 = acc[ai][bj][m][1] * 0.0078125f;
                        u32x4 w; w.x = pk2(v0[0], v0[1]); w.y = pk2(v0[2], v0[3]); w.z = pk2(v1[0], v1[1]); w.w = pk2(v1[2], v1[3]);
                        *(u32x4*)(rowp + bj * 128) = w; } }
        } else {
            unsigned dq[2][4];
#pragma unroll
            for (int ai = 0; ai < 2; ++ai)
#pragma unroll
                for (int m = 0; m < 4; ++m) dq[ai][m] = tab[row0 + ai * 128 + m * 16];
#pragma unroll
            for (int ai = 0; ai < 2; ++ai)
#pragma unroll
                for (int m = 0; m < 4; ++m) {
                    if (u.e2 + row0 + ai * 128 + m * 16 < u.e4) { unsigned char* rowp = (unsigned char*)O + (size_t)dq[ai][m] * 1024 + col0;
#pragma unroll
                        for (int bj = 0; bj < 2; ++bj) { const f32x4 v0 = acc[ai][bj][m][0] * 0.0078125f, v1 = acc[ai][bj][m][1] * 0.0078125f;
                            int lo = 0, hi = 0;
                            lo = __builtin_amdgcn_cvt_pk_fp8_f32(v0[0], v0[1], lo, false); lo = __builtin_amdgcn_cvt_pk_fp8_f32(v0[2], v0[3], lo, true);
                            hi = __builtin_amdgcn_cvt_pk_fp8_f32(v1[0], v1[1], hi, false); hi = __builtin_amdgcn_cvt_pk_fp8_f32(v1[2], v1[3], hi, true);
                            *(u32x2*)(rowp + bj * 128) = (u32x2){(unsigned)lo, (unsigned)hi}; } } }
        }
    }
};

struct Params {
    const float* in[26];
    float* out; unsigned char* ws;
    int ph_lo, ph_hi, li, pad;
};
enum { I_X = 0, I_C, I_CTX, I_CCTX, I_WADA, I_BADA, I_NMG, I_NFG, I_WIN, I_CMLNG, I_CMLNB, I_CMWS, I_CMBS, I_RPB, I_DECAY, I_WBR, I_WOUT, I_RW, I_RB,
       I_EG, I_EU, I_ED, I_SG, I_SU, I_SD, I_FG };

__device__ __forceinline__ const float* kin(int i) {
    unsigned off = (unsigned)i * 8u; asm volatile("" : "+s"(off));
    const __attribute__((address_space(4))) char* ka = (const __attribute__((address_space(4))) char*)__builtin_amdgcn_kernarg_segment_ptr();
    return (const float*)*(GAS const float* const __attribute__((address_space(4)))*)(ka + off);
}
__device__ __forceinline__ float* kout_ptr() { unsigned off = 208u; asm volatile("" : "+s"(off));
    const __attribute__((address_space(4))) char* ka = (const __attribute__((address_space(4))) char*)__builtin_amdgcn_kernarg_segment_ptr();
    return (float*)*(GAS float* const __attribute__((address_space(4)))*)(ka + off); }
__device__ __forceinline__ unsigned char* kws_ptr() { unsigned off = 216u; asm volatile("" : "+s"(off));
    const __attribute__((address_space(4))) char* ka = (const __attribute__((address_space(4))) char*)__builtin_amdgcn_kernarg_segment_ptr();
    return (unsigned char*)*(GAS unsigned char* const __attribute__((address_space(4)))*)(ka + off); }
static_assert(__builtin_offsetof(Params, out) == 208 && __builtin_offsetof(Params, ws) == 216, "kernarg offsets");
static_assert(__builtin_offsetof(Params, in) == 0, "kin() reads Params::in at kernarg offset 0");
__device__ __forceinline__ void transpose_item(const float* W, int N, bf16_t* WT, int ldk, int extra, LAS float* scr, int kb, int nb, int lane) {
    const int k0 = 64 * kb, n0 = 32 * nb;
    float wv[32];
#pragma unroll
    for (int i = 0; i < 32; ++i) wv[i] = W[(size_t)(k0 + 2 * i + (lane >> 5)) * N + n0 + (lane & 31)];
#pragma unroll
    for (int i = 0; i < 32; ++i) scr[(2 * i + (lane >> 5)) * 33 + (lane & 31)] = wv[i];
    LDS_WAIT(); asm volatile("" ::: "memory");
    const int c = lane & 7;
#pragma unroll
    for (int j = 0; j < 4; ++j) { const int n = (lane >> 3) + 8 * j; const LAS float* s = scr + (8 * c) * 33 + n;
        u32x4 o; o.x = pk2(s[0 * 33], s[1 * 33]); o.y = pk2(s[2 * 33], s[3 * 33]); o.z = pk2(s[4 * 33], s[5 * 33]); o.w = pk2(s[6 * 33], s[7 * 33]);
        *(u32x4*)(WT + (size_t)(n0 + n + extra) * ldk + k0 + 8 * c) = o; }
    LDS_WAIT(); asm volatile("" ::: "memory");
}
__device__ __forceinline__ void transpose_item_f8(const float* W, int N, unsigned char* WT, int ldk, int extra, float scale, LAS float* scr, int kb, int nb, int lane) {
    const int k0 = 64 * kb, n0 = 32 * nb;
    float wv[32];
#pragma unroll
    for (int i = 0; i < 32; ++i) wv[i] = W[(size_t)(k0 + 2 * i + (lane >> 5)) * N + n0 + (lane & 31)];
#pragma unroll
    for (int i = 0; i < 32; ++i) scr[(2 * i + (lane >> 5)) * 33 + (lane & 31)] = wv[i];
    LDS_WAIT(); asm volatile("" ::: "memory");
    const int c = lane & 7;
#pragma unroll
    for (int j = 0; j < 4; ++j) { const int n = (lane >> 3) + 8 * j; const LAS float* s = scr + (8 * c) * 33 + n;
        int lo = 0, hi = 0;
        lo = __builtin_amdgcn_cvt_pk_fp8_f32(s[0 * 33] * scale, s[1 * 33] * scale, lo, false); lo = __builtin_amdgcn_cvt_pk_fp8_f32(s[2 * 33] * scale, s[3 * 33] * scale, lo, true);
        hi = __builtin_amdgcn_cvt_pk_fp8_f32(s[4 * 33] * scale, s[5 * 33] * scale, hi, false); hi = __builtin_amdgcn_cvt_pk_fp8_f32(s[6 * 33] * scale, s[7 * 33] * scale, hi, true);
        *(u32x2*)(WT + (size_t)(n0 + n + extra) * ldk + k0 + 8 * c) = (u32x2){(unsigned)lo, (unsigned)hi}; }
    LDS_WAIT(); asm volatile("" ::: "memory");
}
constexpr int IT_IN = 16 * 224, IT_BR = 3 * 8 * 32, IT_OUT = 16 * 32, IT_SG = 16 * 8, IT_SD = 4 * 32, IT_RT = 16 * 2, IT_CM = 128;
constexpr int MISC_ITEMS = IT_IN + IT_BR + IT_OUT + 2 * IT_SG + IT_SD + IT_RT + IT_CM;
__device__ __forceinline__ void misc_item(const Params& p, int l, int r, LAS float* scr, int lane) {
    unsigned char* wm = p.ws + WS_WM + (size_t)l * WM_STRIDE;
    if (r < IT_IN) { transpose_item(kin(I_WIN) + (size_t)l * 1024 * 7168, 7168, (bf16_t*)(wm + WM_IN), 1024, 0, scr, r / 224, r % 224, lane); return; } r -= IT_IN;
    if (r < IT_BR) { const int i = r / 256, q = r % 256; transpose_item(kin(I_WBR) + ((size_t)l * 3 + i) * 512 * 1024, 1024, (bf16_t*)(wm + WM_BR) + (size_t)i * 1024 * 512, 512, 0, scr, q / 32, q % 32, lane); return; } r -= IT_BR;
    if (r < IT_OUT) { transpose_item(kin(I_WOUT) + (size_t)l * 1024 * 1024, 1024, (bf16_t*)(wm + WM_OUT), 1024, 0, scr, r / 32, r % 32, lane); return; } r -= IT_OUT;
    if (r < 2 * IT_SG) { const int up = r / IT_SG, q = r % IT_SG, nb = q % 8;
        transpose_item_f8(kin(up ? I_SU : I_SG) + (size_t)l * 1024 * 256, 256, (unsigned char*)(wm + WM_SGU), 1024, ((32 * nb) / 128) * 128 + up * 128, 32.0f, scr, q / 8, nb, lane); return; } r -= 2 * IT_SG;
    if (r < IT_SD) { transpose_item_f8(kin(I_SD) + (size_t)l * 256 * 1024, 1024, (unsigned char*)(wm + WM_SD), 256, 0, 16.0f, scr, r / 32, r % 32, lane); return; } r -= IT_SD;
    if (r < IT_RT) { transpose_item(kin(I_RW) + (size_t)l * 1024 * 64, 64, (bf16_t*)(wm + WM_RT), 1024, 0, scr, r / 2, r % 2, lane); return; } r -= IT_RT;
    { const float* src = kin(I_CMWS) + (size_t)l * 65536 + (size_t)r * 512 + lane * 8; const f32x4 a = *(const f32x4*)src, b = *(const f32x4*)(src + 4);
      u32x4 o; o.x = pk2(a[0], a[1]); o.y = pk2(a[2], a[3]); o.z = pk2(b[0], b[1]); o.w = pk2(b[2], b[3]);
      *(u32x4*)((bf16_t*)(wm + WM_CM) + (size_t)r * 512 + lane * 8) = o; }
}
constexpr int EXP_ITEMS = 3 * 64 * 128;
constexpr int FILL_SPLIT = 34000;
__device__ __forceinline__ void expert_item(const Params& p, int l, int r, LAS float* scr, int lane) {
    unsigned char* we = p.ws + WS_WE + (size_t)l * WE_LAYER;
    const int which = r / 8192, q = r % 8192, e = q / 128, it = q % 128;
    if (which < 2) { const int kb = it / 8, nb = it % 8;
        transpose_item_f8(kin(which ? I_EU : I_EG) + ((size_t)l * 64 + e) * 1024 * 256, 256, (unsigned char*)(we + WE_GU) + (size_t)e * 512 * 1024, 1024, ((32 * nb) / 128) * 128 + which * 128, 32.0f, scr, kb, nb, lane); }
    else { const int kb = it / 32, nb = it % 32;
        transpose_item_f8(kin(I_ED) + ((size_t)l * 64 + e) * 256 * 1024, 1024, (unsigned char*)(we + WE_D) + (size_t)e * 1024 * 256, 256, 0, 16.0f, scr, kb, nb, lane); }
}
__device__ __forceinline__ void mod_unit(const Params& p, LAS unsigned char* lds, int u, int tid) {
    const int l = u / 96, cb = u % 96, wave = __builtin_amdgcn_readfirstlane(tid >> 6), lane = tid & 63;
    LAS float* sil = (LAS float*)lds;
    LAS float* part = (LAS float*)(lds + 36864);
    for (int idx = tid; idx < 9 * 1024; idx += NTHREADS) { const int r = idx >> 10, k = idx & 1023; const float v = r < 8 ? kin(I_C)[r * 1024 + k] : kin(I_CCTX)[k]; sil[idx] = v / (1.0f + expf(-v)); }
    __syncthreads();
    float acc[9];
#pragma unroll
    for (int r = 0; r < 9; ++r) acc[r] = 0.f;
    const float* wp = kin(I_WADA) + ((size_t)l * 1024 + wave * 128) * 6144 + cb * 64 + lane;
#pragma unroll 4
    for (int k = 0; k < 128; ++k) { const float wv = wp[(size_t)k * 6144];
#pragma unroll
        for (int r = 0; r < 9; ++r) acc[r] += sil[r * 1024 + wave * 128 + k] * wv; }
#pragma unroll
    for (int r = 0; r < 9; ++r) part[(wave * 9 + r) * 64 + lane] = acc[r];
    __syncthreads();
    for (int idx = tid; idx < 576; idx += NTHREADS) { const int r = idx >> 6, ln = idx & 63; float s = kin(I_BADA)[l * 6144 + cb * 64 + ln];
#pragma unroll
        for (int w = 0; w < 8; ++w) s += part[(w * 9 + r) * 64 + ln];
        ((float*)(p.ws + WS_MOD))[((size_t)l * 9 + r) * 6144 + cb * 64 + ln] = s; }
    __syncthreads();
}

__device__ __forceinline__ void norm_mod_vals(const f32x4 (&v)[4], const float* g, const float* sh, const float* sc, bf16_t* orow, bool to_lds, LAS unsigned char* ldst, int lane) {
    f32x4 gq[4], hq[4], cq[4];
#pragma unroll
    for (int j = 0; j < 4; ++j) { gq[j] = ((const f32x4*)g)[64 * j + lane]; hq[j] = ((const f32x4*)sh)[64 * j + lane]; cq[j] = ((const f32x4*)sc)[64 * j + lane]; }
    float ss = 0.f;
#pragma unroll
    for (int j = 0; j < 4; ++j) ss += (v[j][0] * v[j][0] + v[j][1] * v[j][1]) + (v[j][2] * v[j][2] + v[j][3] * v[j][3]);
    const float rstd = rsqrtf(wave_sum(ss, lane) * (1.0f / 1024.0f) + EPS);
#pragma unroll
    for (int j = 0; j < 4; ++j) { const f32x4 gg = gq[j], s_h = hq[j], s_c = cq[j];
        const f32x4 y = v[j] * rstd * gg * (s_c + 1.0f) + s_h;
        u32x2 o; o.x = pk2(y[0], y[1]); o.y = pk2(y[2], y[3]);
        ((u32x2*)orow)[64 * j + lane] = o;
        if (to_lds) *(LAS u32x2*)(ldst + (64 * j + lane) * 8) = o; }
}
__device__ __forceinline__ void norm_mod_row(const float* xrow, const float* g, const float* sh, const float* sc, bf16_t* orow, bool to_lds, LAS unsigned char* ldst, int lane) {
    f32x4 v[4];
#pragma unroll
    for (int j = 0; j < 4; ++j) v[j] = ((const f32x4*)xrow)[64 * j + lane];
    norm_mod_vals(v, g, sh, sc, orow, to_lds, ldst, lane);
}
__device__ __forceinline__ void combine_row(f32x4 (&v)[4], const float* xrow, const float* ga2, const bf16_t* shrow, const unsigned char* o8, int lane) {
    u32x2 sq[4]; unsigned oq[8][4]; f32x4 gq[4];
#pragma unroll
    for (int j = 0; j < 4; ++j) { v[j] = ((const f32x4*)xrow)[64 * j + lane]; gq[j] = ((const f32x4*)ga2)[64 * j + lane]; sq[j] = ((const u32x2*)shrow)[64 * j + lane]; }
#pragma unroll
    for (int k = 0; k < 8; ++k)
#pragma unroll
        for (int j = 0; j < 4; ++j) oq[k][j] = ((const unsigned*)(o8 + (size_t)k * 1024))[64 * j + lane];
    asm volatile("" :: "v"(v[0]), "v"(v[1]), "v"(v[2]), "v"(v[3]), "v"(gq[0]), "v"(gq[1]), "v"(gq[2]), "v"(gq[3]) : "memory");
#pragma unroll
    for (int j = 0; j < 4; ++j) { f32x4 t = (f32x4){lo16(sq[j].x), hi16(sq[j].x), lo16(sq[j].y), hi16(sq[j].y)};
#pragma unroll
        for (int k = 0; k < 8; ++k) { const int w = (int)oq[k][j];
            t[0] += __builtin_amdgcn_cvt_f32_fp8(w, 0); t[1] += __builtin_amdgcn_cvt_f32_fp8(w, 1); t[2] += __builtin_amdgcn_cvt_f32_fp8(w, 2); t[3] += __builtin_amdgcn_cvt_f32_fp8(w, 3); }
        v[j] += gq[j] * t; }
}

constexpr int RT_TILE = 0, RT_PITCH = 2064, RT_LG = 64 * RT_PITCH  , RT_BIAS = RT_LG + 64 * 65 * 4  , RT_LCNT = RT_BIAS + 256, RT_LBASE = RT_LCNT + 256,
              RT_SELE = RT_LBASE + 256  , RT_SELW = RT_SELE + 2048, RT_SELR = RT_SELW + 2048, RT_END = RT_SELR + 2048;
static_assert(RT_END <= LDS_BYTES, "router LDS");
#ifdef TIMING
#define RSTAMP(k) do { if (stamp && tid == 0) ((volatile LAS unsigned long long*)(lds + LDS_BYTES - 16 - 512))[24 + (k)] = __builtin_amdgcn_s_memrealtime(); } while (0)
#else
#define RSTAMP(k) do { } while (0)
#endif
__device__ __forceinline__ void router_unit(const Params& p, LAS unsigned char* lds, int l, int u, const float* xl, const float* xc, int tid, bool commit, bool stamp = false) {
    const int wave = __builtin_amdgcn_readfirstlane(tid >> 6), lane = tid & 63, g4 = lane >> 4, row0 = u * 64;
    const bool lat = row0 < NL;
    const float* mr = (const float*)(p.ws + WS_MOD) + (size_t)l * 9 * 6144 + (size_t)(lat ? (row0 >> 11) : 8) * 6144;
    const float* xbase = lat ? xl + (size_t)row0 * D : xc + (size_t)(row0 - NL) * D;
    unsigned char* H2 = (unsigned char*)(p.ws + WS_H) + (size_t)row0 * D;
    LAS float* lg = (LAS float*)(lds + RT_LG); LAS float* bias = (LAS float*)(lds + RT_BIAS);
    LAS int* lcnt = (LAS int*)(lds + RT_LCNT); LAS int* lbase = (LAS int*)(lds + RT_LBASE);
    LAS int* sele = (LAS int*)(lds + RT_SELE); LAS float* selw = (LAS float*)(lds + RT_SELW); LAS int* selr = (LAS int*)(lds + RT_SELR);
    RSTAMP(0);
    if (tid < 64) { lcnt[tid] = 0; bias[tid] = kin(I_RB)[l * 64 + tid]; }
    const int rb = wave >> 1, eb0 = (wave & 1) * 2;
    const bf16_t* w0 = (const bf16_t*)(p.ws + WS_WM + (size_t)l * WM_STRIDE + WM_RT) + launder((eb0 * 16 + (lane & 15)) * 1024 + g4 * 8); const bf16_t* w1 = w0 + launder(16 * 1024);
    bf16x8 qa0[4], qa1[4];
#pragma unroll
    for (int ks = 0; ks < 4; ++ks) { qa0[ks] = *(const bf16x8*)(w0 + ks * 32); qa1[ks] = *(const bf16x8*)(w1 + ks * 32); }
    { f32x4 gg[4], s_h[4], s_c[4];
#pragma unroll
      for (int j = 0; j < 4; ++j) { gg[j] = ((const f32x4*)(kin(I_NFG) + l * 1024))[64 * j + lane]; s_h[j] = ((const f32x4*)(mr + 3072))[64 * j + lane]; s_c[j] = ((const f32x4*)(mr + 4096))[64 * j + lane] + 1.0f; }
#pragma unroll
      for (int hb = 0; hb < 2; ++hb) { f32x4 v[4][4];
#pragma unroll
          for (int i = 0; i < 4; ++i)
#pragma unroll
              for (int j = 0; j < 4; ++j) v[i][j] = ((const f32x4*)(xbase + (size_t)(wave * 8 + hb * 4 + i) * D))[64 * j + lane];
#pragma unroll
          for (int i = 0; i < 4; ++i) { const int rl = wave * 8 + hb * 4 + i; float ss = 0.f;
#pragma unroll
              for (int j = 0; j < 4; ++j) ss += (v[i][j][0] * v[i][j][0] + v[i][j][1] * v[i][j][1]) + (v[i][j][2] * v[i][j][2] + v[i][j][3] * v[i][j][3]);
              const float rstd = rsqrtf(wave_sum(ss, lane) * (1.0f / 1024.0f) + EPS);
#pragma unroll
              for (int j = 0; j < 4; ++j) { const f32x4 y = v[i][j] * rstd * gg[j] * s_c[j] + s_h[j];
                  u32x2 o; o.x = pk2(y[0], y[1]); o.y = pk2(y[2], y[3]);
                  int q8 = 0; q8 = __builtin_amdgcn_cvt_pk_fp8_f32(y[0], y[1], q8, false); q8 = __builtin_amdgcn_cvt_pk_fp8_f32(y[2], y[3], q8, true);
                  ((unsigned*)(H2 + (size_t)rl * D))[64 * j + lane] = (unsigned)q8; *(LAS u32x2*)(lds + RT_TILE + rl * RT_PITCH + (64 * j + lane) * 8) = o; } } } }
    __syncthreads();
    RSTAMP(1);
    { f32x4 a0 = (f32x4){0.f, 0.f, 0.f, 0.f}, a1 = a0;
      const LAS unsigned char* hrow = lds + RT_TILE + (rb * 16 + (lane & 15)) * RT_PITCH + g4 * 16;
      bf16x8 qb0[4], qb1[4];
      sfor<0, 4>([&](auto it_) { constexpr int it = decltype(it_)::value;
#pragma unroll
          for (int ks = 0; ks < 4; ++ks) { qb0[ks] = *(const bf16x8*)(w0 + ((2 * it + 1) * 4 + ks) * 32); qb1[ks] = *(const bf16x8*)(w1 + ((2 * it + 1) * 4 + ks) * 32); }
#pragma unroll
          for (int ks = 0; ks < 4; ++ks) { const bf16x8 bq = *(const LAS bf16x8*)(hrow + ((2 * it) * 4 + ks) * 64); a0 = mfma16(qa0[ks], bq, a0); a1 = mfma16(qa1[ks], bq, a1); }
          if constexpr (it < 3) {
#pragma unroll
              for (int ks = 0; ks < 4; ++ks) { qa0[ks] = *(const bf16x8*)(w0 + ((2 * it + 2) * 4 + ks) * 32); qa1[ks] = *(const bf16x8*)(w1 + ((2 * it + 2) * 4 + ks) * 32); } }
#pragma unroll
          for (int ks = 0; ks < 4; ++ks) { const bf16x8 bq = *(const LAS bf16x8*)(hrow + ((2 * it + 1) * 4 + ks) * 64); a0 = mfma16(qb0[ks], bq, a0); a1 = mfma16(qb1[ks], bq, a1); } });
      const int rr = rb * 16 + (lane & 15);
#pragma unroll
      for (int r = 0; r < 4; ++r) { lg[rr * 65 + eb0 * 16 + 4 * g4 + r] = sigmoidf_(a0[r]); lg[rr * 65 + (eb0 + 1) * 16 + 4 * g4 + r] = sigmoidf_(a1[r]); } }
    __syncthreads();
    RSTAMP(2);
    { const int row = tid >> 3, g = tid & 7;
      float sv[8]; unsigned key[8];
#pragma unroll
      for (int j = 0; j < 8; ++j) { sv[j] = lg[row * 65 + 8 * g + j]; const unsigned ub = __float_as_uint(sv[j] + bias[8 * g + j]);
          key[j] = ((ub ^ ((ub >> 31) ? 0xffffffffu : 0x80000000u)) & ~63u) | (unsigned)(63 - (8 * g + j)); }
      float m1 = -3e38f, m2 = -3e38f;
#pragma unroll
      for (int j = 0; j < 8; ++j) { const float c = sv[j] + bias[8 * g + j]; if (c > m1) { m2 = m1; m1 = c; } else if (c > m2) m2 = c; }
      const unsigned ug = __float_as_uint(m1 + m2); const unsigned gkey = ((ug ^ ((ug >> 31) ? 0xffffffffu : 0x80000000u)) & ~7u) | (unsigned)(7 - g);
      int grank = 0;
      sfor<1, 8>([&](auto d_) { constexpr int d = decltype(d_)::value; grank += (int)((unsigned)shxi((int)gkey, d, lane) > gkey); });
      const bool gsel = grank < 4;
#pragma unroll
      for (int j = 0; j < 8; ++j) if (!gsel) key[j] = (unsigned)(63 - (8 * g + j));
      int rk[8];
#pragma unroll
      for (int j = 0; j < 8; ++j) { int r = 0;
#pragma unroll
          for (int j2 = 0; j2 < 8; ++j2) r += (int)(key[j2] > key[j]);
          rk[j] = r; }
      sfor<1, 8>([&](auto d_) { constexpr int d = decltype(d_)::value;
          sfor<0, 8>([&](auto j2_) { constexpr int j2 = decltype(j2_)::value; const unsigned ok = (unsigned)shxi((int)key[j2], d, lane);
#pragma unroll
              for (int j = 0; j < 8; ++j) rk[j] += (int)(ok > key[j]); });
          __builtin_amdgcn_sched_barrier(0); });
      float wsum = 0.f;
#pragma unroll
      for (int j = 0; j < 8; ++j) if (gsel && rk[j] < 8) wsum += sv[j];
      wsum += shx(wsum, 1, lane); wsum += shx(wsum, 2, lane); wsum += shx(wsum, 4, lane);
      const float sc = 2.5f / wsum;
#pragma unroll
      for (int j = 0; j < 8; ++j) if (gsel && rk[j] < 8) { const int e = 8 * g + j, k = rk[j];
          sele[row * 8 + k] = e; selw[row * 8 + k] = sv[j] * sc; selr[row * 8 + k] = __hip_atomic_fetch_add(&lcnt[e], 1, __ATOMIC_RELAXED, __HIP_MEMORY_SCOPE_WORKGROUP); } }
    __syncthreads();
    RSTAMP(3);
    if (tid < 64) { const int n = lcnt[tid]; int base = 0; if (n > 0 && commit) base = (int)atomicAdd((unsigned*)(p.ws + WS_CTL) + CW_CNT + l * 2048 + tid * 16, (unsigned)n); lbase[tid] = base; }
    __syncthreads();
    RSTAMP(4);
    { const int rl = tid >> 3, k = tid & 7, e = sele[rl * 8 + k], pos = lbase[e] + selr[rl * 8 + k];
      if (commit) { ((unsigned*)(p.ws + WS_LIST))[(size_t)e * NT + pos] = (unsigned)((row0 + rl) * 8 + k); ((float*)(p.ws + WS_WL))[(size_t)e * NT + pos] = selw[rl * 8 + k]; } }
    __syncthreads();
    RSTAMP(5);
}

__device__ __forceinline__ void mixA_unit(const Params& p, LAS unsigned char* lds, int l, int ch, int g, int tid) {
    const int wave = __builtin_amdgcn_readfirstlane(tid >> 6), lane = tid & 63, g4 = lane >> 4, rows0 = ch * 128;
    const bf16_t* Z = (const bf16_t*)(p.ws + WS_R + R_Z); bf16_t* BR = (bf16_t*)(p.ws + WS_R + R_BR);
    const bf16_t* WCM = (const bf16_t*)(p.ws + WS_WM + (size_t)l * WM_STRIDE + WM_CM);
    LAS unsigned char* vn = lds + 1024;
    { const int q = tid >> 2, cs = (tid & 3) * 32; const f32x2 st2 = *(const f32x2*)((const float*)(p.ws + WS_R + R_STAT) + (size_t)(rows0 + q) * 2); const float mean = st2[0], rstd = st2[1];
      const float* lg = kin(I_CMLNG) + l * 512 + g * 128 + cs; const float* lb = kin(I_CMLNB) + l * 512 + g * 128 + cs;
#pragma unroll
      for (int j = 0; j < 4; ++j) { const u32x4 v = *(const u32x4*)(Z + (size_t)(rows0 + q) * ZW + ZC_AV + g * 128 + cs + 8 * j);
          const f32x4 ga = *(const f32x4*)(lg + 8 * j), gb = *(const f32x4*)(lg + 8 * j + 4), ba = *(const f32x4*)(lb + 8 * j), bb = *(const f32x4*)(lb + 8 * j + 4);
          u32x4 o;
          o.x = pk2((geluf_(lo16(v.x)) - mean) * rstd * ga[0] + ba[0], (geluf_(hi16(v.x)) - mean) * rstd * ga[1] + ba[1]);
          o.y = pk2((geluf_(lo16(v.y)) - mean) * rstd * ga[2] + ba[2], (geluf_(hi16(v.y)) - mean) * rstd * ga[3] + ba[3]);
          o.z = pk2((geluf_(lo16(v.z)) - mean) * rstd * gb[0] + bb[0], (geluf_(hi16(v.z)) - mean) * rstd * gb[1] + bb[1]);
          o.w = pk2((geluf_(lo16(v.w)) - mean) * rstd * gb[2] + bb[2], (geluf_(hi16(v.w)) - mean) * rstd * gb[3] + bb[3]);
          *(LAS u32x4*)(vn + q * 272 + (cs + 8 * j) * 2) = o; } }
    __syncthreads();
    { const int pb = wave, pp = pb * 16 + (lane & 15);
      bf16x8 bfr[4];
#pragma unroll
      for (int ks = 0; ks < 4; ++ks) bfr[ks] = *(const bf16x8*)(WCM + (size_t)(g * 128 + pp) * 128 + 32 * ks + 8 * g4);
      const unsigned vna = tr_lane(lds_addr(vn), 272, 8, lane);
      const float bs = kin(I_CMBS)[l * 512 + g * 128 + pp];
      const size_t row = (size_t)(rows0 + pp);
      u32x2 uq[8];
#pragma unroll
      for (int i = 0; i < 8; ++i) uq[i] = *(const u32x2*)(Z + row * ZW + ZC_AU + g * 128 + 16 * i + 4 * g4);
      sfor<0, 2>([&](auto cg_) { constexpr int cg = decltype(cg_)::value; f32x4 acc[4];
#pragma unroll
          for (int i = 0; i < 4; ++i) acc[i] = (f32x4){0.f, 0.f, 0.f, 0.f};
          sfor<0, 4>([&](auto ks_) { constexpr int ks = decltype(ks_)::value; bf16x8 af[4]; tr_frag4_i<32 * ks * 272 + 128 * cg, 4 * 272>(vna, af);
#pragma unroll
              for (int i = 0; i < 4; ++i) acc[i] = mfma16(af[i], bfr[ks], acc[i]); });
#pragma unroll
          for (int i = 0; i < 4; ++i) { const int c = 16 * (4 * cg + i) + 4 * g4;
          const u32x2 uu = uq[4 * cg + i];
          u32x2 o; o.x = pk2(geluf_(lo16(uu.x)) * (acc[i][0] + bs), geluf_(hi16(uu.x)) * (acc[i][1] + bs)); o.y = pk2(geluf_(lo16(uu.y)) * (acc[i][2] + bs), geluf_(hi16(uu.y)) * (acc[i][3] + bs));
          *(u32x2*)(BR + row * BRW + g * 128 + c) = o; } }); }
    __syncthreads();
}

__device__ __forceinline__ void ret_stage_qk(const bf16_t* src  , const float* rope, bool do_rope, int tpos0, int mask  , LAS unsigned char* t0, LAS unsigned char* t1, LAS unsigned char* t2,
                                             float sc0, float l2a, float offa, float siga, float l2b, float offb, float sigb, int tid) {
    const int pp = tid >> 2, half = (tid >> 1) & 1, sub = tid & 1;
    const bf16_t* s = src + (size_t)pp * ZW + 32 * half + 8 * sub;
    const u32x4 a = *(const u32x4*)s, b = *(const u32x4*)(s + 16);
    float x1[8] = {lo16(a.x), hi16(a.x), lo16(a.y), hi16(a.y), lo16(a.z), hi16(a.z), lo16(a.w), hi16(a.w)};
    float x2[8] = {lo16(b.x), hi16(b.x), lo16(b.y), hi16(b.y), lo16(b.z), hi16(b.z), lo16(b.w), hi16(b.w)};
    float o1[8], o2[8];
    if (do_rope) { const int t = tpos0 + pp, pos = half ? (t & 63) : (t >> 6); const f32x4* tb = (const f32x4*)(rope + (size_t)(pos * 16 + 8 * sub) * 2);
#pragma unroll
        for (int j = 0; j < 4; ++j) { const f32x4 cs = tb[j];
            o1[2 * j] = x1[2 * j] * cs[0] - x2[2 * j] * cs[1]; o2[2 * j] = x1[2 * j] * cs[1] + x2[2 * j] * cs[0];
            o1[2 * j + 1] = x1[2 * j + 1] * cs[2] - x2[2 * j + 1] * cs[3]; o2[2 * j + 1] = x1[2 * j + 1] * cs[3] + x2[2 * j + 1] * cs[2]; } }
    else {
#pragma unroll
        for (int j = 0; j < 8; ++j) { o1[j] = x1[j]; o2[j] = x2[j]; } }
    const int off = pp * 144 + (32 * half + 8 * sub) * 2;
    const float fp = (float)pp;
    const float sA = sc0 * __builtin_amdgcn_exp2f((offa + siga * fp) * l2a), sB = sc0 * __builtin_amdgcn_exp2f((offb + sigb * fp) * l2b);
    if (mask & 1) { u32x4 w; w.x = pk2(o1[0] * sc0, o1[1] * sc0); w.y = pk2(o1[2] * sc0, o1[3] * sc0); w.z = pk2(o1[4] * sc0, o1[5] * sc0); w.w = pk2(o1[6] * sc0, o1[7] * sc0); *(LAS u32x4*)(t0 + off) = w;
              w.x = pk2(o2[0] * sc0, o2[1] * sc0); w.y = pk2(o2[2] * sc0, o2[3] * sc0); w.z = pk2(o2[4] * sc0, o2[5] * sc0); w.w = pk2(o2[6] * sc0, o2[7] * sc0); *(LAS u32x4*)(t0 + off + 32) = w; }
    if (mask & 2) { u32x4 w; w.x = pk2(o1[0] * sA, o1[1] * sA); w.y = pk2(o1[2] * sA, o1[3] * sA); w.z = pk2(o1[4] * sA, o1[5] * sA); w.w = pk2(o1[6] * sA, o1[7] * sA); *(LAS u32x4*)(t1 + off) = w;
              w.x = pk2(o2[0] * sA, o2[1] * sA); w.y = pk2(o2[2] * sA, o2[3] * sA); w.z = pk2(o2[4] * sA, o2[5] * sA); w.w = pk2(o2[6] * sA, o2[7] * sA); *(LAS u32x4*)(t1 + off + 32) = w; }
    if (mask & 4) { u32x4 w; w.x = pk2(o1[0] * sB, o1[1] * sB); w.y = pk2(o1[2] * sB, o1[3] * sB); w.z = pk2(o1[4] * sB, o1[5] * sB); w.w = pk2(o1[6] * sB, o1[7] * sB); *(LAS u32x4*)(t2 + off) = w;
              w.x = pk2(o2[0] * sB, o2[1] * sB); w.y = pk2(o2[2] * sB, o2[3] * sB); w.z = pk2(o2[4] * sB, o2[5] * sB); w.w = pk2(o2[6] * sB, o2[7] * sB); *(LAS u32x4*)(t2 + off + 32) = w; }
}
__device__ __forceinline__ void ret_stage_v(const bf16_t* src  , LAS unsigned char* tv, int tid) {
    const int pp = tid >> 2, seg = (tid & 3) * 32;
#pragma unroll
    for (int j = 0; j < 4; ++j) *(LAS u32x4*)(tv + pp * 272 + (seg + 8 * j) * 2) = *(const u32x4*)(src + (size_t)pp * ZW + seg + 8 * j);
}
__device__ __forceinline__ float log2_gamma(const Params& p, int l, int dir, int h) { const float x = kin(I_DECAY)[(l * 2 + dir) * 4 + h]; return -log2f(1.0f + expf(-x)); }
__device__ __forceinline__ int ret_row0(int b, int cc) { return cc < 2 ? NL + b * 256 + cc * 128 : b * 2048 + (cc - 2) * 128; }

__device__ __forceinline__ void retkv_unit(const Params& p, LAS unsigned char* lds, int l, int b, int h, int cc, int tid) {
    const int wave = __builtin_amdgcn_readfirstlane(tid >> 6), lane = tid & 63, g4 = lane >> 4, row0 = ret_row0(b, cc);
    const bf16_t* Z = (const bf16_t*)(p.ws + WS_R + R_Z); float* KV = (float*)(p.ws + WS_R + R_KV);
    const float l2f = log2_gamma(p, l, 0, h), l2b = log2_gamma(p, l, 1, h);
    LAS unsigned char* kf = lds; LAS unsigned char* kb = lds + 18432; LAS unsigned char* vv = lds + 36864;
    ret_stage_qk(Z + (size_t)row0 * ZW + ZC_RK + h * 64, (const float*)(p.ws + WS_ROPE), cc >= 2, (cc - 2) * 128, 6, kf, kf, kb, 0.125f, l2f, 127.f, -1.f, l2b, 0.f, 1.f, tid);
    ret_stage_v(Z + (size_t)row0 * ZW + ZC_RV + h * 128, vv, tid);
    __syncthreads();
    { const int dir = wave >> 2, db = wave & 3; const unsigned ka = tr_lane(lds_addr(dir ? kb : kf), 144, 8, lane) + 32 * db, va = tr_lane(lds_addr(vv), 272, 8, lane);
      bf16x8 afr[4];
      sfor<0, 4>([&](auto ks_) { constexpr int ks = decltype(ks_)::value; afr[ks] = tr_frag_i<32 * ks * 144, 32 * ks * 144 + 4 * 144>(ka); });
      float* dst = KV + ((((size_t)b * 4 + h) * NCHUNK + cc) * 2 + dir) * 8192;
      sfor<0, 2>([&](auto eg_) { constexpr int eg = decltype(eg_)::value; f32x4 acc[4];
#pragma unroll
          for (int i = 0; i < 4; ++i) acc[i] = (f32x4){0.f, 0.f, 0.f, 0.f};
          sfor<0, 4>([&](auto ks_) { constexpr int ks = decltype(ks_)::value; bf16x8 bf[4]; tr_frag4_i<32 * ks * 272 + 128 * eg, 4 * 272>(va, bf);
#pragma unroll
              for (int i = 0; i < 4; ++i) acc[i] = mfma16(afr[ks], bf[i], acc[i]); });
#pragma unroll
          for (int i = 0; i < 4; ++i)
#pragma unroll
              for (int r = 0; r < 4; ++r) dst[(16 * db + 4 * g4 + r) * 128 + 16 * (4 * eg + i) + (lane & 15)] = acc[i][r]; }); }
    __syncthreads();
}

__device__ __forceinline__ void retout_unit(const Params& p, LAS unsigned char* lds, int l, int b, int h, int cc, int tid) {
    const int wave = __builtin_amdgcn_readfirstlane(tid >> 6), lane = tid & 63, g4 = lane >> 4, row0 = ret_row0(b, cc);
    const bf16_t* Z = (const bf16_t*)(p.ws + WS_R + R_Z); bf16_t* BR = (bf16_t*)(p.ws + WS_R + R_BR);
    const float l2f = log2_gamma(p, l, 0, h), l2b = log2_gamma(p, l, 1, h);
    LAS unsigned char* tq = lds; LAS unsigned char* tqf = lds + 18432; LAS unsigned char* tqb = lds + 36864; LAS unsigned char* tk = lds + 55296;
    LAS unsigned char* tv = lds + 73728; LAS unsigned char* st = lds + 108544;
    { const u32x4* src = (const u32x4*)((const bf16_t*)(p.ws + WS_R + R_ST) + (((size_t)b * 4 + h) * NCHUNK + cc) * 2 * 8192);
#pragma unroll
      for (int j = 0; j < 4; ++j) { const int c = tid + 512 * j; *(LAS u32x4*)(st + (c >> 4) * 272 + (c & 15) * 16) = src[c]; } }
    const float* rope = (const float*)(p.ws + WS_ROPE);
    ret_stage_qk(Z + (size_t)row0 * ZW + ZC_RQ + h * 64, rope, cc >= 2, (cc - 2) * 128, 7, tq, tqf, tqb, 1.0f, l2f, 1.f, 1.f, l2b, 128.f, -1.f, tid);
    ret_stage_qk(Z + (size_t)row0 * ZW + ZC_RK + h * 64, rope, cc >= 2, (cc - 2) * 128, 1, tk, tk, tk, 0.125f, 0.f, 0.f, 0.f, 0.f, 0.f, 0.f, tid);
    ret_stage_v(Z + (size_t)row0 * ZW + ZC_RV + h * 128, tv, tid);
    __syncthreads();
    const int ib = wave, ti = ib * 16 + (lane & 15);
    f32x4 oacc[8];
#pragma unroll
    for (int eb = 0; eb < 8; ++eb) oacc[eb] = (f32x4){0.f, 0.f, 0.f, 0.f};
    { bf16x8 bq[4];
#pragma unroll
      for (int ks = 0; ks < 4; ++ks) bq[ks] = *(const LAS bf16x8*)((ks < 2 ? tqf : tqb) + ti * 144 + (32 * (ks & 1) + 8 * g4) * 2);
      const unsigned sa = tr_lane(lds_addr(st), 272, 8, lane);
      sfor<0, 4>([&](auto ks_) { constexpr int ks = decltype(ks_)::value;
          sfor<0, 2>([&](auto eg_) { constexpr int eg = decltype(eg_)::value; bf16x8 af[4]; tr_frag4_i<32 * ks * 272 + 128 * eg, 4 * 272>(sa, af);
#pragma unroll
              for (int i = 0; i < 4; ++i) oacc[4 * eg + i] = mfma16(af[i], bq[ks], oacc[4 * eg + i]); }); }); }
    { bf16x8 bq[2];
#pragma unroll
      for (int ks = 0; ks < 2; ++ks) bq[ks] = *(const LAS bf16x8*)(tq + ti * 144 + (32 * ks + 8 * g4) * 2);
      f32x4 sacc[8];
#pragma unroll
      for (int jb = 0; jb < 8; ++jb) { sacc[jb] = (f32x4){0.f, 0.f, 0.f, 0.f};
#pragma unroll
          for (int ks = 0; ks < 2; ++ks) { const bf16x8 a = *(const LAS bf16x8*)(tk + (16 * jb + (lane & 15)) * 144 + (32 * ks + 8 * g4) * 2); sacc[jb] = mfma16(a, bq[ks], sacc[jb]); }
#pragma unroll
          for (int r = 0; r < 4; ++r) { const int dist = ti - (16 * jb + 4 * g4 + r);
              sacc[jb][r] *= dist >= 0 ? __builtin_amdgcn_exp2f((float)dist * l2f) : __builtin_amdgcn_exp2f((float)(-dist) * l2b); } }
      const unsigned va = tr_lane(lds_addr(tv), 272, 4, lane);
      sfor<0, 4>([&](auto kk_) { constexpr int kk = decltype(kk_)::value;
          u32x4 pw; pw.x = pk2(sacc[2 * kk][0], sacc[2 * kk][1]); pw.y = pk2(sacc[2 * kk][2], sacc[2 * kk][3]); pw.z = pk2(sacc[2 * kk + 1][0], sacc[2 * kk + 1][1]); pw.w = pk2(sacc[2 * kk + 1][2], sacc[2 * kk + 1][3]);
          const bf16x8 bp = as_frag(pw);
          sfor<0, 2>([&](auto eg_) { constexpr int eg = decltype(eg_)::value; bf16x8 af[4]; tr_frag4_i<32 * kk * 272 + 128 * eg, 16 * 272>(va, af);
#pragma unroll
              for (int i = 0; i < 4; ++i) oacc[4 * eg + i] = mfma16(af[i], bp, oacc[4 * eg + i]); }); }); }
    { float ss = 0.f;
#pragma unroll
      for (int eb = 0; eb < 8; ++eb) ss += (oacc[eb][0] * oacc[eb][0] + oacc[eb][1] * oacc[eb][1]) + (oacc[eb][2] * oacc[eb][2] + oacc[eb][3] * oacc[eb][3]);
      ss += shx(ss, 16, lane); ss += shx(ss, 32, lane);
      const float rstd = rsqrtf(ss * (1.0f / 128.0f) + EPS);
      const size_t row = (size_t)(row0 + ti);
      u32x2 gq[8];
#pragma unroll
      for (int eb = 0; eb < 8; ++eb) gq[eb] = *(const u32x2*)(Z + row * ZW + ZC_RG + h * 128 + 16 * eb + 4 * g4);
#pragma unroll
      for (int eb = 0; eb < 8; ++eb) { const int e = 16 * eb + 4 * g4; const u32x2 gg = gq[eb];
          u32x2 o; o.x = pk2(oacc[eb][0] * rstd * siluf_(lo16(gg.x)), oacc[eb][1] * rstd * siluf_(hi16(gg.x))); o.y = pk2(oacc[eb][2] * rstd * siluf_(lo16(gg.y)), oacc[eb][3] * rstd * siluf_(hi16(gg.y)));
          *(u32x2*)(BR + row * BRW + 1024 + h * 128 + e) = o; } }
    __syncthreads();
}

constexpr int NA_V = 0, NA_PITCH = 144, NA_CTXROW = 576, NA_TAB = (576 + 256) * NA_PITCH  , NA_MB = NA_TAB + 2048  , NA_MB_SZ = 18432;
static_assert(NA_MB + NA_MB_SZ <= LDS_BYTES - 1024, "NA LDS");
__device__ __forceinline__ void na_unit(const Params& p, LAS unsigned char* lds, int l, int b, int h, int rp, bool local, int tid) {
    const int wave = __builtin_amdgcn_readfirstlane(tid >> 6), lane = tid & 63, g4 = lane >> 4, qb = wave >> 1, half = wave & 1;
    const bf16_t* Z = (const bf16_t*)(p.ws + WS_R + R_Z); bf16_t* BR = (bf16_t*)(p.ws + WS_R + R_BR);
    LAS unsigned char* vl = lds + NA_V; LAS float* tab = (LAS float*)(lds + NA_TAB);
    const int qc = 16 * qb + (lane & 15);
    const int r0 = 2 * rp, rsA = min(max(r0 - 4, 0), 24), nwr = min(9, 32 - rsA);
    const int kbs = min(max(16 * qb - 8, 0), 32), cst = min(max(qc - 8, 0), 48);
    if (local) {
        for (int key = tid; key < nwr * 64; key += NTHREADS) { const size_t krow = (size_t)b * 2048 + (rsA + (key >> 6)) * 64 + (key & 63);
            const u32x4* vs_ = (const u32x4*)(Z + krow * ZW + ZC_NV + h * 64);
#pragma unroll
            for (int j = 0; j < 8; ++j) *(LAS u32x4*)(vl + key * NA_PITCH + 16 * j) = vs_[j]; }
        if (tid < 465) tab[tid] = kin(I_RPB)[(size_t)(l * 8 + h) * 465 + tid]; }
    { const int key = tid >> 1, hb = (tid & 1) * 4; const u32x4* vs_ = (const u32x4*)(Z + ((size_t)NL + b * 256 + key) * ZW + ZC_NV + h * 64) + hb;
#pragma unroll
      for (int j = 0; j < 4; ++j) *(LAS u32x4*)(vl + (NA_CTXROW + key) * NA_PITCH + 16 * (hb + j)) = vs_[j]; }
    __syncthreads();
    const float L2E = 1.44269504089f;
    const unsigned vla = lds_addr(vl);
    const unsigned lane_off = (unsigned)((4 * g4 + ((lane & 15) >> 2)) * NA_PITCH + (lane & 3) * 8);
#pragma unroll 1
    for (int jr = 0; jr < 2; ++jr) {
        const int r = r0 + jr, rs = min(max(r - 4, 0), 24), wofs = rs - rsA;
        const size_t qrow = local ? (size_t)b * 2048 + r * 64 + qc : (size_t)NL + b * 256 + r * 64 + qc;
        bf16x8 bq[2];
#pragma unroll
        for (int ks = 0; ks < 2; ++ks) bq[ks] = *(const bf16x8*)(Z + qrow * ZW + ZC_NQ + h * 64 + 32 * ks + 8 * g4);
        bf16x8 kf[16];
        if (local) {
#pragma unroll
            for (int blk = 0; blk < 8; ++blk) { const size_t krow = (size_t)b * 2048 + (rs + 4 * half + (blk >> 1)) * 64 + kbs + 16 * (blk & 1) + (lane & 15);
#pragma unroll
                for (int ks = 0; ks < 2; ++ks) kf[blk * 2 + ks] = *(const bf16x8*)(Z + krow * ZW + ZC_NK + h * 64 + 32 * ks + 8 * g4); } }
        f32x4 s[16]; float mx = -1e30f;
        if (local) {
#pragma unroll
            for (int blk = 0; blk < 8; ++blk) { const int i = 4 * half + (blk >> 1), cb = blk & 1;
                f32x4 a = (f32x4){0.f, 0.f, 0.f, 0.f};
#pragma unroll
                for (int ks = 0; ks < 2; ++ks) a = mfma16(kf[blk * 2 + ks], bq[ks], a);
                const int ro = rs + i - r + 7;
#pragma unroll
                for (int rg = 0; rg < 4; ++rg) { const int kc = kbs + 16 * cb + 4 * g4 + rg; const bool valid = kc >= cst && kc < cst + 16;
                    const int co = min(max(kc - qc, -15), 15) + 15;
                    const float bv = tab[ro * 31 + co];
                const float v = valid ? a[rg] * 0.125f + bv : -1e30f; s[blk][rg] = v; mx = fmaxf(mx, v); } }
        } else {
#pragma unroll
            for (int blk = 0; blk < 8; ++blk) s[blk] = (f32x4){-1e30f, -1e30f, -1e30f, -1e30f};
        }
#pragma unroll
        for (int blk = 0; blk < 8; ++blk) { const size_t krow = (size_t)NL + b * 256 + half * 128 + 16 * blk + (lane & 15);
#pragma unroll
            for (int ks = 0; ks < 2; ++ks) kf[blk * 2 + ks] = *(const bf16x8*)(Z + krow * ZW + ZC_NK + h * 64 + 32 * ks + 8 * g4); }
#pragma unroll
        for (int blk = 0; blk < 8; ++blk) { f32x4 a = (f32x4){0.f, 0.f, 0.f, 0.f};
#pragma unroll
            for (int ks = 0; ks < 2; ++ks) a = mfma16(kf[blk * 2 + ks], bq[ks], a);
#pragma unroll
            for (int rg = 0; rg < 4; ++rg) { const float v = a[rg] * 0.125f; s[8 + blk][rg] = v; mx = fmaxf(mx, v); } }
        mx = fmaxf(mx, shx(mx, 16, lane)); mx = fmaxf(mx, shx(mx, 32, lane));
        float ls = 0.f;
#pragma unroll
        for (int blk = 0; blk < 16; ++blk)
#pragma unroll
            for (int rg = 0; rg < 4; ++rg) { const float e = __builtin_amdgcn_exp2f((s[blk][rg] - mx) * L2E); s[blk][rg] = e; ls += e; }
        ls += shx(ls, 16, lane); ls += shx(ls, 32, lane);
        f32x4 oacc[4];
#pragma unroll
        for (int db = 0; db < 4; ++db) oacc[db] = (f32x4){0.f, 0.f, 0.f, 0.f};
        if (local) { const unsigned va = vla + (unsigned)(((wofs + 4 * half) * 64 + kbs) * NA_PITCH) + lane_off;
            sfor<0, 4>([&](auto kk_) { constexpr int kk = decltype(kk_)::value;
                u32x4 pw; pw.x = pk2(s[2 * kk][0], s[2 * kk][1]); pw.y = pk2(s[2 * kk][2], s[2 * kk][3]); pw.z = pk2(s[2 * kk + 1][0], s[2 * kk + 1][1]); pw.w = pk2(s[2 * kk + 1][2], s[2 * kk + 1][3]);
                const bf16x8 bp = as_frag(pw); bf16x8 vf[4]; tr_frag4_i<kk * 64 * NA_PITCH, 16 * NA_PITCH>(va, vf);
#pragma unroll
                for (int db = 0; db < 4; ++db) oacc[db] = mfma16(vf[db], bp, oacc[db]); }); }
        { const unsigned va = vla + (unsigned)((NA_CTXROW + half * 128) * NA_PITCH) + lane_off;
          sfor<0, 4>([&](auto kk_) { constexpr int kk = decltype(kk_)::value;
              u32x4 pw; pw.x = pk2(s[8 + 2 * kk][0], s[8 + 2 * kk][1]); pw.y = pk2(s[8 + 2 * kk][2], s[8 + 2 * kk][3]); pw.z = pk2(s[9 + 2 * kk][0], s[9 + 2 * kk][1]); pw.w = pk2(s[9 + 2 * kk][2], s[9 + 2 * kk][3]);
              const bf16x8 bp = as_frag(pw); bf16x8 vf[4]; tr_frag4_i<kk * 32 * NA_PITCH, 16 * NA_PITCH>(va, vf);
#pragma unroll
              for (int db = 0; db < 4; ++db) oacc[db] = mfma16(vf[db], bp, oacc[db]); }); }
        LAS float* mb = (LAS float*)(lds + NA_MB) + (qb * 64 + lane) * 18;
        if (half == 1) { mb[0] = mx; mb[1] = ls;
#pragma unroll
            for (int db = 0; db < 4; ++db)
#pragma unroll
                for (int rg = 0; rg < 4; ++rg) mb[2 + db * 4 + rg] = oacc[db][rg]; }
        __syncthreads();
        if (half == 0) { const float m1 = mb[0], l1 = mb[1], M = fmaxf(mx, m1), a0 = __builtin_amdgcn_exp2f((mx - M) * L2E), a1 = __builtin_amdgcn_exp2f((m1 - M) * L2E);
            const float inv = 1.0f / (ls * a0 + l1 * a1);
#pragma unroll
            for (int db = 0; db < 4; ++db) { float o[4];
#pragma unroll
                for (int rg = 0; rg < 4; ++rg) o[rg] = (oacc[db][rg] * a0 + mb[2 + db * 4 + rg] * a1) * inv;
                u32x2 w; w.x = pk2(o[0], o[1]); w.y = pk2(o[2], o[3]);
                *(u32x2*)(BR + qrow * BRW + 512 + h * 64 + 16 * db + 4 * g4) = w; } }
        __syncthreads();
    }
}

#ifndef STAMP_PHASE
#define STAMP_PHASE -1
#endif
constexpr int PH_PER_LAYER = 10, PH_FINAL = 1 + 2 * PH_PER_LAYER, NPHASES = PH_FINAL + 1;
__device__ __forceinline__ void moe_tables(const Params& p, LAS unsigned char* lds, int l, int tid, int nsplit, int nMs, int G, int c) {
    LAS int* tb = (LAS int*)(lds + MOE_TAB_OFF); LAS int* cn = tb + 128;
    if (tid < 64) { const unsigned c = ((const unsigned*)(p.ws + WS_CTL))[CW_CNT + l * 2048 + tid * 16]; cn[tid] = (int)(c < (unsigned)NT ? c : (unsigned)NT); }
    __syncthreads();
    if (tid == 0) { int s = 0; for (int e = 0; e < 64; ++e) { tb[e] = s; s += (cn[e] + 255) >> 8; } tb[64] = s; }
    __syncthreads();
    if (tid < MOE_UL_MAX) { LAS int* ul = (LAS int*)(lds + MOE_UL_OFF) + tid * 8; const int ntr = tb[64];
        const int idx = tid * G + ((G & 7) == 0 ? (c & 7) * (G >> 3) + (c >> 3) : c);
        if (idx >= nsplit * (ntr + nMs)) ul[0] = -1;
        else if (idx < nsplit * ntr) { const int mt = idx / nsplit, pn = idx % nsplit; int lo = 0, hi = 63;
            for (int it = 0; it < 6; ++it) { const int mid = (lo + hi + 1) >> 1; if (tb[mid] <= mt) lo = mid; else hi = mid - 1; }
            ul[0] = lo; ul[1] = pn; ul[2] = (mt - tb[lo]) * 256; ul[3] = mt; ul[4] = cn[lo]; }
        else { const int s_ = idx - nsplit * ntr; ul[0] = 64; ul[1] = s_ % nsplit; ul[2] = 0; ul[3] = s_ / nsplit; ul[4] = 0; } }
    __syncthreads();
}

__global__ void __launch_bounds__(NTHREADS, 2) fwd_kernel(Params p0) {
    extern __shared__ __attribute__((aligned(16))) unsigned char lds_raw[];
    LAS unsigned char* const lds0 = (LAS unsigned char*)lds_raw;
    const int tid0 = threadIdx.x, G = gridDim.x, bid = blockIdx.x, NGW = G * NWAVES;
    const int wave0 = __builtin_amdgcn_readfirstlane(tid0 >> 6);
#define PHASE_IDS const int tid = launder(wave0 * 64 + lane_id_here()), wave = __builtin_amdgcn_readfirstlane(tid >> 6), lane = tid & 63, gw = bid * NWAVES + wave; (void)lane; (void)gw; \
    Params p = p0; p.ws = kws_ptr(); p.out = kout_ptr(); \
    LAS unsigned char* lds; { unsigned la_ = (unsigned)(size_t)lds0; asm volatile("" : "+s"(la_)); lds = (LAS unsigned char*)(size_t)la_; }
    volatile LAS unsigned* xbw = (volatile LAS unsigned*)(lds0 + LDS_BYTES - 16);
    if (tid0 == 0) { xbw[0] = 0u; xbw[1] = 0u; xbw[2] = 0u; xbw[3] = 0u; }
    __syncthreads();
    XcdBarrier bar = xcd_barrier_post((unsigned*)(p0.ws + WS_CTL) + CW_BAR + p0.li * XCD_BAR_WORDS, xbw);
#ifdef TEST_PHASE
#define IN(k) ((((k) - 1) % PH_PER_LAYER == TEST_PHASE - 1 && (k) >= 1 && (k) < PH_FINAL && TEST_PHASE >= 1) || ((k) == 0 && TEST_PHASE == 0) || ((k) == PH_FINAL && TEST_PHASE == 99)) && (launder_s(p0.ph_lo) <= (k) && (k) < launder_s(p0.ph_hi))
#else
#define IN(k) (launder_s(p0.ph_lo) <= (k) && (k) < launder_s(p0.ph_hi))
#endif
#ifndef DUP_PHASE
#define DUP_PHASE -1
#endif
#define DUP(k) for (int rep_ = 0; rep_ < ((DUP_PHASE) == (k) ? 2 : 1); ++rep_)
#ifdef TIMING
    volatile LAS unsigned long long* tst = (volatile LAS unsigned long long*)(lds0 + LDS_BYTES - 16 - 512);
    if (wave0 == 0 && lane_id_here() == 0) tst[0] = __builtin_amdgcn_s_memrealtime();
#define SEAM(k) do { if (IN(k) && IN((k) + 1)) { xcd_barrier(bar, wave0 == 0 && lane_id_here() == 0); if (wave0 == 0 && lane_id_here() == 0) tst[(k) + 1] = __builtin_amdgcn_s_memrealtime(); } } while (0)
#else
#define SEAM(k) do { if (IN(k) && IN((k) + 1)) xcd_barrier(bar, wave0 == 0 && lane_id_here() == 0); } while (0)
#endif
#define Hb ((bf16_t*)(p.ws + WS_H))
#define Zb ((bf16_t*)(p.ws + WS_R + R_Z))
#define BRb ((bf16_t*)(p.ws + WS_R + R_BR))
#define XC ((float*)(p.ws + WS_XC))
#define xl (l == 0 ? kin(I_X) : (const float*)p.out)
#define xc (l == 0 ? kin(I_CTX) : (const float*)XC)
#define mod ((const float*)(p.ws + WS_MOD) + (size_t)l * 9 * 6144)
#define wm (p.ws + WS_WM + (size_t)l * WM_STRIDE)

    if (IN(0)) { DUP(100) {
        PHASE_IDS;
        for (int u = bid; u < 192; u += G) mod_unit(p, lds, u, tid);
        if (bid == G - 1) { float* rope = (float*)(p.ws + WS_ROPE);
            for (int idx = tid; idx < 1024; idx += NTHREADS) { const int pos = idx >> 4, f = idx & 15; const float inv = exp2f(-(float)f * (13.287712379549449f / 16.0f));
                float x = (float)pos * inv * 0.15915494309189535f; x -= floorf(x);
                rope[idx * 2] = __builtin_amdgcn_cosf(x); rope[idx * 2 + 1] = __builtin_amdgcn_sinf(x); } }
        __syncthreads();
        LAS float* scr = (LAS float*)(lds + wave * 8448);
        for (int it = gw; it < 2 * MISC_ITEMS; it += NGW) {
            if (it < MISC_ITEMS) misc_item(p, 0, it, scr, lane);
            else misc_item(p, 1, it - MISC_ITEMS, scr, lane); }
        __syncthreads();
    } }
    SEAM(0);

    for (int l = 0; l < DEPTH; ++l) {
        const int base = 1 + PH_PER_LAYER * l;
        const bool need_ctx = l < DEPTH - 1;
        const int Mrows = need_ctx ? NT : NL;

        if (IN(base + 0)) { DUP(0) {
            PHASE_IDS;
            const float* const nmg = kin(I_NMG) + l * 1024; const float* const xin = kin(I_X); const float* const cin = kin(I_CTX);
            for (int row = gw; row < NT; row += NGW) { const bool lat = row < NL;
                const float* mr = mod + (size_t)(lat ? (row >> 11) : 8) * 6144;
                f32x4 v[4];
                if (l == 0) { const float* xr = lat ? xin + (size_t)row * D : cin + (size_t)(row - NL) * D;
#pragma unroll
                    for (int j = 0; j < 4; ++j) v[j] = ((const f32x4*)xr)[64 * j + lane]; }
                else { float* xr = lat ? p.out + (size_t)row * D : XC + (size_t)(row - NL) * D;
                    combine_row(v, xr, mr - 9 * 6144 + 5120, Hb + (size_t)row * D, (const unsigned char*)(p.ws + WS_R + R_O) + (size_t)row * 8 * 1024, lane);
#pragma unroll
                    for (int j = 0; j < 4; ++j) ((f32x4*)xr)[64 * j + lane] = v[j]; }
                norm_mod_vals(v, nmg, mr, mr + 1024, Hb + (size_t)row * D, false, lds, lane); }
        } }
        SEAM(base + 0);
        if (IN(base + 1)) { DUP(1) {
            PHASE_IDS;
            DenseSched S{(const char*)Hb, (const char*)(wm + WM_IN), 1024, 1024, NT / 256, INW / 256, G, bid, 1, 0, 0};
            EpiStoreBf16 E{Zb, ZW, 16, (unsigned char*)(p.ws + WS_R + R_G8)};
            pg8::gemm_phase(lds, tid, 1024, 1024, S, E, (STAMP_PHASE == 2 && l == 0 && bid == 0) ? 25 : -1);
        } }
        SEAM(base + 1);
        if (IN(base + 2)) { DUP(2) {
            PHASE_IDS;
#ifndef DUP_SUB
#define DUP_SUB -1
#endif
            for (int rs_ = 0; rs_ < (DUP_SUB == 0 ? 2 : 1); ++rs_) for (int u = bid; u < 1024; u += G) na_unit(p, lds, l, u >> 7, (u >> 4) & 7, u & 15, true, tid);
            if (need_ctx) for (int u = bid; u < 128; u += G) na_unit(p, lds, l, u >> 4, (u >> 1) & 7, u & 1, false, tid);
            for (int rs_ = 0; rs_ < (DUP_SUB == 1 ? 2 : 1); ++rs_) for (int u = (bid + 64) % G; u < 576; u += G) retkv_unit(p, lds, l, u / 72, (u / 18) % 4, u % 18, tid);
        } }
        SEAM(base + 2);
        if (IN(base + 3)) { DUP(3) {
            PHASE_IDS;
            const float* KV = (const float*)(p.ws + WS_R + R_KV); bf16_t* ST = (bf16_t*)(p.ws + WS_R + R_ST);
            for (int gi = bid * NTHREADS + tid; gi < 64 * 2048; gi += G * NTHREADS) {
                const int combo = gi >> 11, e4 = (gi & 2047) * 4, bh = combo >> 1, dir = combo & 1, h = bh & 3;
                const float dec = __builtin_amdgcn_exp2f(128.f * log2_gamma(p, l, dir, h));
                const float* kv = KV + (size_t)bh * NCHUNK * 2 * 8192 + (size_t)dir * 8192 + e4; bf16_t* st = ST + (size_t)bh * NCHUNK * 2 * 8192 + (size_t)dir * 8192 + e4;
                f32x4 q[NCHUNK];
#pragma unroll
                for (int y = 0; y < NCHUNK; ++y) q[y] = *(const f32x4*)(kv + (size_t)y * 2 * 8192);
                f32x4 sacc = (f32x4){0.f, 0.f, 0.f, 0.f};
#pragma unroll
                for (int i = 0; i < NCHUNK; ++i) { const int y = dir == 0 ? i : (i == 0 ? 1 : (i == 1 ? 0 : 19 - i));
                    u32x2 o; o.x = pk2(sacc[0], sacc[1]); o.y = pk2(sacc[2], sacc[3]); *(u32x2*)(st + (size_t)y * 2 * 8192) = o;
                    f32x4 kvy = q[0];
#pragma unroll
                    for (int j = 1; j < NCHUNK; ++j) kvy = (j == y) ? q[j] : kvy;
                    sacc = sacc * dec + kvy; } }
            { const bf16_t* Z = (const bf16_t*)(p.ws + WS_R + R_Z); float* STAT = (float*)(p.ws + WS_R + R_STAT);
              for (int row = gw; row < Mrows; row += NGW) { const u32x4 v = *(const u32x4*)(Z + (size_t)row * ZW + ZC_AV + lane * 8);
                  const float x0 = geluf_(lo16(v.x)), x1 = geluf_(hi16(v.x)), x2 = geluf_(lo16(v.y)), x3 = geluf_(hi16(v.y)), x4 = geluf_(lo16(v.z)), x5 = geluf_(hi16(v.z)), x6 = geluf_(lo16(v.w)), x7 = geluf_(hi16(v.w));
                  const float mean = wave_sum(((x0 + x1) + (x2 + x3)) + ((x4 + x5) + (x6 + x7)), lane) * (1.0f / 512.0f);
                  const float d0 = x0 - mean, d1 = x1 - mean, d2 = x2 - mean, d3 = x3 - mean, d4 = x4 - mean, d5 = x5 - mean, d6 = x6 - mean, d7 = x7 - mean;
                  const float s2 = wave_sum(((d0 * d0 + d1 * d1) + (d2 * d2 + d3 * d3)) + ((d4 * d4 + d5 * d5) + (d6 * d6 + d7 * d7)), lane);
                  if (lane == 0) *(f32x2*)(STAT + (size_t)row * 2) = (f32x2){mean, rsqrtf(s2 * (1.0f / 512.0f) + EPS)}; } }
        } }
        SEAM(base + 3);
        if (IN(base + 4)) { DUP(4) {
            PHASE_IDS;
            const int cc_lo = need_ctx ? 0 : 2, ncc = NCHUNK - cc_lo, total = 32 * ncc;
            for (int u = bid; u < total; u += G) retout_unit(p, lds, l, u / (4 * ncc), (u / ncc) % 4, cc_lo + u % ncc, tid);
            const int nA = (Mrows / 128) * 4;
            for (int rs_ = 0; rs_ < (DUP_SUB == 2 ? 2 : 1); ++rs_) for (int u = (bid + 64) % G; u < nA; u += G) mixA_unit(p, lds, l, u >> 2, u & 3, tid);
        } }
        SEAM(base + 4);
        if (IN(base + 5)) { DUP(5) {
            PHASE_IDS;
            DenseSched S{(const char*)BRb, (const char*)(wm + WM_BR), BRW, 512, Mrows / 256, 4, G, bid, 3, 512 * 2, (size_t)1024 * 512 * 2};
#ifdef MERGE_PLAIN_DUP
            if (rep_ == 1) { EpiStoreBf16 E2{(bf16_t*)(p.ws + WS_R + R_KV), 1024, 1000, (unsigned char*)0}; pg8::gemm_phase(lds, tid, 512, 512, S, E2); } else
#endif
            { EpiMerge E{Hb, (const unsigned char*)(p.ws + WS_R + R_G8)};
            pg8::gemm_phase(lds, tid, 512, 512, S, E, (STAMP_PHASE == 6 && l == 0 && bid == 0) ? 25 : -1); }
            if (l == 0 && rep_ == 0 && G == 256 && bid >= 32) { LAS float* scr = (LAS float*)(lds + wave * 8448); const int fw = (bid - 32) * NWAVES + wave;
                for (int it = fw; it < FILL_SPLIT; it += 224 * NWAVES) expert_item(p, it / EXP_ITEMS, it % EXP_ITEMS, scr, lane); }
            if (l == 0 && rep_ == 0 && G != 256) { LAS float* scr = (LAS float*)(lds + wave * 8448);
                for (int it = gw; it < 2 * EXP_ITEMS; it += NGW) expert_item(p, it / EXP_ITEMS, it % EXP_ITEMS, scr, lane); }
        } }
        SEAM(base + 5);
        if (IN(base + 6)) { DUP(6) {
            PHASE_IDS;
            DenseSched S{(const char*)Hb, (const char*)(wm + WM_OUT), 1024, 1024, Mrows / 256, 4, G, bid, 1, 0, 0};
            float* const dummy = (float*)(p.ws + WS_R + R_ACT);
            EpiResid E{xl, xc, rep_ == 0 ? p.out : dummy, rep_ == 0 ? XC : dummy + (size_t)NL * D, mod + 2048};
            pg8::gemm_phase(lds, tid, 1024, 1024, S, E, (STAMP_PHASE == 7 && l == 0 && bid == 0) ? 25 : -1);
            if (l == 0 && rep_ == 0 && G == 256 && bid >= 32) { LAS float* scr = (LAS float*)(lds + wave * 8448); const int fw = (bid - 32) * NWAVES + wave;
                for (int it = FILL_SPLIT + fw; it < 2 * EXP_ITEMS; it += 224 * NWAVES) expert_item(p, it / EXP_ITEMS, it % EXP_ITEMS, scr, lane); }
        } }
        SEAM(base + 6);
        if (IN(base + 7)) { DUP(7) {
            PHASE_IDS;
            for (int u = bid; u < Mrows / 64; u += G) router_unit(p, lds, l, u, p.out, XC, tid, rep_ == 0, l == 0 && u == 0);
        } }
        SEAM(base + 7);
        if (IN(base + 8)) { DUP(8) {
            PHASE_IDS;
            moe_tables(p, lds, l, tid, 2, Mrows / 256, G, bid);
            MoeGuSched S{(const char*)Hb, (const char*)(p.ws + WS_WE + (size_t)l * WE_LAYER + WE_GU), (const char*)(wm + WM_SGU), (const unsigned*)(p.ws + WS_LIST),
                         (const LAS int*)(lds + MOE_TAB_OFF), (const LAS int*)(lds + MOE_TAB_OFF) + 128, Mrows / 256, G, bid};
            EpiGateUp E{(bf16_t*)(p.ws + WS_R + R_ACT), (bf16_t*)(p.ws + WS_R + R_ACTS), (const float*)(p.ws + WS_WL)};
            pg8::gemm_phase<true>(lds, tid, 1024, 1024, S, E, (STAMP_PHASE == 9 && l == 0 && bid == 0) ? 25 : -1);
        } }
        SEAM(base + 8);
        if (IN(base + 9)) { DUP(9) {
            PHASE_IDS;
            moe_tables(p, lds, l, tid, 4, Mrows / 256, G, bid);
            MoeDownSched S{(const char*)(p.ws + WS_R + R_ACT), (const char*)(p.ws + WS_WE + (size_t)l * WE_LAYER + WE_D), (const char*)(p.ws + WS_R + R_ACTS), (const char*)(wm + WM_SD),
                           (const LAS int*)(lds + MOE_TAB_OFF), (const LAS int*)(lds + MOE_TAB_OFF) + 128, Mrows / 256, G, bid};
            EpiDown E{(bf16_t*)(p.ws + WS_R + R_O), (const unsigned*)(p.ws + WS_LIST), Hb};
            pg8::gemm_phase<true>(lds, tid, launder_s(256), 256, S, E, (STAMP_PHASE == 10 && l == 0 && bid == 0) ? 25 : -1);
        } }
        SEAM(base + 9);
    }
#ifdef EXTRA_BARRIERS
    if (IN(PH_FINAL) && IN(PH_FINAL - 1)) for (int xb_ = 0; xb_ < EXTRA_BARRIERS; ++xb_) xcd_barrier(bar, wave0 == 0 && lane_id_here() == 0);
#endif
#ifdef TIMING
    float t_scale = 1.0f, t_add = 0.0f;
    { float* tw = (float*)(p0.ws + WS_CTL) + 1024;
      if (bid == 0 && wave0 == 0 && lane_id_here() == 0) { tw[0] = (float)(tst[TA_HI] - tst[TA_LO]) * 0.01f; }
      xcd_barrier(bar, wave0 == 0 && lane_id_here() == 0);
      t_scale = 1.0f + tw[0] / (float)(TA_DIV); t_add = 0.0f; }
#endif
    if (IN(PH_FINAL)) {
        PHASE_IDS;
        const int l = DEPTH - 1;
        f32x4 fg[4];
#pragma unroll
        for (int j = 0; j < 4; ++j) fg[j] = ((const f32x4*)kin(I_FG))[64 * j + lane];
        for (int row = gw; row < NL; row += NGW) { float* xr = p.out + (size_t)row * D;
            f32x4 v[4]; float ss = 0.f;
            combine_row(v, xr, mod + (size_t)(row >> 11) * 6144 + 5120, Hb + (size_t)row * D, (const unsigned char*)(p.ws + WS_R + R_O) + (size_t)row * 8 * 1024, lane);
#pragma unroll
            for (int j = 0; j < 4; ++j) ss += (v[j][0] * v[j][0] + v[j][1] * v[j][1]) + (v[j][2] * v[j][2] + v[j][3] * v[j][3]);
            const float rstd = rsqrtf(wave_sum(ss, lane) * (1.0f / 1024.0f) + EPS);
#pragma unroll
            for (int j = 0; j < 4; ++j) { f32x4 ov = v[j] * rstd * fg[j];
#ifdef TIMING
                ov = ov * t_scale; if (row == 0 && j == 0 && lane == 0) ov[0] += t_add;
#endif
                ((f32x4*)xr)[64 * j + lane] = ov; } }
    }
#undef IN
#undef SEAM
#undef Hb
#undef Zb
#undef BRb
#undef XC
#undef xl
#undef xc
#undef mod
#undef wm
}

#ifndef STAMP_PHASE_DEFINED
#endif
#ifndef MK_PER_PHASE
#define MK_PER_PHASE 0
#endif
extern "C" void kernel_launch(void* const* d_in, const int* in_sizes, int n_in, void* d_out, int out_size, void* d_ws, size_t ws_size, hipStream_t stream) {
    static int grid = 0;
    if (grid == 0) {
        if (n_in != 26 || out_size != NL * D || ws_size < WS_END) { fprintf(stderr, "kernel_launch: unexpected shapes (n_in %d out %d ws %zu, need %zu)\n", n_in, out_size, ws_size, (size_t)WS_END); grid = -1; return; }
        int dev = 0, cus = 0;
        if (hipGetDevice(&dev) != hipSuccess || hipDeviceGetAttribute(&cus, hipDeviceAttributeMultiprocessorCount, dev) != hipSuccess) { grid = -1; return; }
        if (hipFuncSetAttribute((const void*)fwd_kernel, hipFuncAttributeMaxDynamicSharedMemorySize, LDS_BYTES) != hipSuccess) { fprintf(stderr, "kernel_launch: hipFuncSetAttribute failed\n"); grid = -1; return; }
        int per_cu = 0;
        if (hipOccupancyMaxActiveBlocksPerMultiprocessor(&per_cu, (const void*)fwd_kernel, NTHREADS, LDS_BYTES) != hipSuccess || per_cu < 1) { fprintf(stderr, "kernel_launch: occupancy query says %d\n", per_cu); }
        (void)hipGetLastError();
        grid = cus;
    }
    if (grid < 0) return;
    (void)hipMemsetAsync((char*)d_ws + WS_CTL, 0, CTL_BYTES, stream);
    Params p{};
    for (int i = 0; i < 26; ++i) p.in[i] = (const float*)d_in[i];
    p.out = (float*)d_out; p.ws = (unsigned char*)d_ws;
#if MK_PER_PHASE
    for (int k = 0; k < NPHASES; ++k) { p.ph_lo = k; p.ph_hi = k + 1; p.li = k;
        hipLaunchKernelGGL(fwd_kernel, dim3(grid), dim3(NTHREADS), LDS_BYTES, stream, p); }
#else
    p.ph_lo = 0; p.ph_hi = NPHASES; p.li = 0;
    hipLaunchKernelGGL(fwd_kernel, dim3(grid), dim3(NTHREADS), LDS_BYTES, stream, p);
#endif
}
```

```cpp
#include <hip/hip_runtime.h>
#include <stdint.h>
#include <stdio.h>

#define LAS __attribute__((address_space(3)))
#define GAS __attribute__((address_space(1)))
template <class T> __device__ __forceinline__ T* as_global(T* q) { return (T*)(GAS T*)q; }
typedef unsigned short bf16_t;
typedef short bf16x8 __attribute__((ext_vector_type(8)));
typedef short bf16x4 __attribute__((ext_vector_type(4)));
typedef float f32x4 __attribute__((ext_vector_type(4)));
typedef float f32x2 __attribute__((ext_vector_type(2)));
typedef unsigned u32x4 __attribute__((ext_vector_type(4)));
typedef unsigned u32x2 __attribute__((ext_vector_type(2)));
typedef long i64x2 __attribute__((ext_vector_type(2)));

constexpr int D = 1024, NB = 8, SEQ = 2048, CTXL = 256, DEPTH = 2;
constexpr int NL = NB * SEQ;
constexpr int NC = NB * CTXL;
constexpr int NT = NL + NC;
constexpr int INW = 7168;
constexpr int ZW = 4096;
constexpr int ZC_AU = 0, ZC_AV = 512, ZC_NQ = 1024, ZC_NK = 1536, ZC_NV = 2048, ZC_RQ = 2560, ZC_RK = 2816, ZC_RV = 3072, ZC_RG = 3584,
              ZC_GA = 4096;
constexpr int BRW = 1536;
constexpr int NEXP = 64, TOPK = 8, EXPW = 256;
constexpr int NCHUNK = 18;
constexpr float EPS = 1e-6f;
constexpr int NTHREADS = 512, NWAVES = 8;
constexpr int LDS_BYTES = 159744;

constexpr size_t MiB = 1u << 20;
constexpr size_t WS_CTL = 0, CTL_BYTES = 1 * MiB;
constexpr size_t WS_MOD = 1 * MiB;
constexpr size_t WS_ROPE = 1 * MiB + 512 * 1024;
constexpr size_t WS_WM = 2 * MiB, WM_STRIDE = 21 * MiB;
constexpr size_t WM_IN = 0, WM_BR = 14680064, WM_OUT = WM_BR + 3145728, WM_SGU = WM_OUT + 2097152, WM_SD = WM_SGU + 1048576,
                 WM_RT = WM_SD + 524288, WM_CM = WM_RT + 131072, WM_END = WM_CM + 131072;
static_assert(WM_END <= WM_STRIDE, "misc weights");
constexpr size_t WS_WE = 44 * MiB;
constexpr size_t WE_GU = 0, WE_D = 33554432, WE_LAYER = 50331648;
constexpr size_t WS_XC = 140 * MiB;
constexpr size_t WS_H = 148 * MiB;
constexpr size_t WS_LIST = 184 * MiB, WS_WL = 189 * MiB;
constexpr size_t WS_R = 194 * MiB;
constexpr size_t R_Z = 0, R_G8 = 144 * MiB, R_BR = 252 * MiB, R_KV = 306 * MiB, R_ST = 342 * MiB, R_STAT = 360 * MiB;
constexpr size_t R_O = 0, R_ACT = 288 * MiB, R_ACTS = 368 * MiB;
constexpr size_t WS_END = WS_R + 377 * MiB;
static_assert(R_KV + 37748736 <= 377 * MiB && R_ACTS + 9437184 <= 377 * MiB && R_Z + 150994944 <= R_G8 && R_G8 + 56623104 <= R_BR && R_BR + 56623104 <= R_KV, "region map");
static_assert(R_O + 301989888 <= R_ACT && R_ACT + 83886080 <= R_ACTS, "region map 2");
constexpr int CW_BAR = 4096;
constexpr int CW_CNT = 200000;

__device__ __forceinline__ float bf2f(unsigned short b) { return __uint_as_float(((unsigned)b) << 16); }
__device__ __forceinline__ unsigned f2bf(float f) { unsigned u = __float_as_uint(f); return (u + 0x7fffu + ((u >> 16) & 1u)) >> 16; }
__device__ __forceinline__ unsigned pk2(float lo, float hi) { unsigned r; asm("v_cvt_pk_bf16_f32 %0, %1, %2" : "=v"(r) : "v"(lo), "v"(hi)); return r; }
__device__ __forceinline__ float lo16(unsigned w) { return __uint_as_float(w << 16); }
__device__ __forceinline__ float hi16(unsigned w) { return __uint_as_float(w & 0xffff0000u); }
__device__ __forceinline__ float shx(float v, int o, int lane) { return __int_as_float(__builtin_amdgcn_ds_bpermute((lane ^ o) << 2, __float_as_int(v))); }
__device__ __forceinline__ int shxi(int v, int o, int lane) { return __builtin_amdgcn_ds_bpermute((lane ^ o) << 2, v); }
__device__ __forceinline__ float dpp_f(float v, const int ctrl_tag) {
    const int x = __float_as_int(v);
    switch (ctrl_tag) {
        case 0: return __int_as_float(__builtin_amdgcn_update_dpp(x, x, 0xB1, 0xF, 0xF, false));
        case 1: return __int_as_float(__builtin_amdgcn_update_dpp(x, x, 0x4E, 0xF, 0xF, false));
        case 2: return __int_as_float(__builtin_amdgcn_update_dpp(x, x, 0x141, 0xF, 0xF, false));
        default: return __int_as_float(__builtin_amdgcn_update_dpp(x, x, 0x140, 0xF, 0xF, false));
    }
}
__device__ __forceinline__ float wave_sum(float v, int  ) {
    v += dpp_f(v, 0); v += dpp_f(v, 1); v += dpp_f(v, 2); v += dpp_f(v, 3);
    const int x = __float_as_int(v);
    return (__int_as_float(__builtin_amdgcn_readlane(x, 0)) + __int_as_float(__builtin_amdgcn_readlane(x, 16))) + (__int_as_float(__builtin_amdgcn_readlane(x, 32)) + __int_as_float(__builtin_amdgcn_readlane(x, 48)));
}
__device__ __forceinline__ float fast_exp(float x) { return __builtin_amdgcn_exp2f(x * 1.44269504089f); }
__device__ __forceinline__ float sigmoidf_(float x) { return __builtin_amdgcn_rcpf(1.0f + fast_exp(-x)); }
__device__ __forceinline__ float siluf_(float x) { return x * sigmoidf_(x); }
__device__ __forceinline__ float geluf_(float x) { const float u = 0.7978845608f * (x + 0.044715f * x * x * x); return x * sigmoidf_(2.0f * u); }
__device__ __forceinline__ f32x4 mfma16(bf16x8 a, bf16x8 b, f32x4 c) { return __builtin_amdgcn_mfma_f32_16x16x32_bf16(a, b, c, 0, 0, 0); }
__device__ __forceinline__ bf16x8 as_frag(u32x4 v) { return __builtin_bit_cast(bf16x8, v); }
__device__ __forceinline__ int launder(int v) { asm volatile("" : "+v"(v)); return v; }
__device__ __forceinline__ int lane_id_here() { unsigned m = ~0u; asm volatile("" : "+s"(m)); return (int)__builtin_amdgcn_mbcnt_hi(m, __builtin_amdgcn_mbcnt_lo(m, 0u)); }
__device__ __forceinline__ int launder_s(int v) { asm volatile("" : "+s"(v)); return v; }
template <class T> __device__ __forceinline__ T* launder_p(T* q) { asm volatile("" : "+s"(q)); return q; }
template <class T> __device__ __forceinline__ T* launder_vp(T* q) { asm volatile("" : "+v"(q)); return q; }
#define LDS_WAIT() asm volatile("s_waitcnt lgkmcnt(0)" ::: "memory")
#define VM_WAIT() asm volatile("s_waitcnt vmcnt(0)" ::: "memory")

__device__ __forceinline__ bf16x8 tr_frag(unsigned base, int stride, int r0, int r1, int c0, int lane) {
    const int q = (lane & 15) >> 2, p = lane & 3;
    const unsigned a0 = base + (unsigned)((r0 + q) * stride + (c0 + 4 * p) * 2), a1 = base + (unsigned)((r1 + q) * stride + (c0 + 4 * p) * 2);
    bf16x4 lo, hi;
    asm volatile("ds_read_b64_tr_b16 %0, %2\n\tds_read_b64_tr_b16 %1, %3\n\ts_waitcnt lgkmcnt(0)" : "=&v"(lo), "=&v"(hi) : "v"(a0), "v"(a1) : "memory");
    bf16x8 r; r[0] = lo[0]; r[1] = lo[1]; r[2] = lo[2]; r[3] = lo[3]; r[4] = hi[0]; r[5] = hi[1]; r[6] = hi[2]; r[7] = hi[3];
    return r;
}
__device__ __forceinline__ unsigned lds_addr(LAS unsigned char* p) { return (unsigned)(size_t)p; }
template <int O0, int O1> __device__ __forceinline__ bf16x8 tr_frag_i(unsigned a) {
    static_assert(O0 >= 0 && O0 < 65536 && O1 >= 0 && O1 < 65536, "ds offset field");
    bf16x4 lo, hi;
    asm volatile("ds_read_b64_tr_b16 %0, %2 offset:%3\n\tds_read_b64_tr_b16 %1, %2 offset:%4\n\ts_waitcnt lgkmcnt(0)" : "=&v"(lo), "=&v"(hi) : "v"(a), "n"(O0), "n"(O1) : "memory");
    bf16x8 r; r[0] = lo[0]; r[1] = lo[1]; r[2] = lo[2]; r[3] = lo[3]; r[4] = hi[0]; r[5] = hi[1]; r[6] = hi[2]; r[7] = hi[3];
    return r;
}
template <int OB, int R1> __device__ __forceinline__ void tr_frag4_i(unsigned a, bf16x8 (&f)[4]) {
    static_assert(OB >= 0 && OB + R1 + 96 < 65536, "ds offset field");
    bf16x4 l0, h0, l1, h1, l2, h2, l3, h3;
    asm volatile("ds_read_b64_tr_b16 %0, %8 offset:%9\n\tds_read_b64_tr_b16 %1, %8 offset:%10\n\tds_read_b64_tr_b16 %2, %8 offset:%11\n\tds_read_b64_tr_b16 %3, %8 offset:%12\n\t"
                 "ds_read_b64_tr_b16 %4, %8 offset:%13\n\tds_read_b64_tr_b16 %5, %8 offset:%14\n\tds_read_b64_tr_b16 %6, %8 offset:%15\n\tds_read_b64_tr_b16 %7, %8 offset:%16\n\ts_waitcnt lgkmcnt(0)"
                 : "=&v"(l0), "=&v"(h0), "=&v"(l1), "=&v"(h1), "=&v"(l2), "=&v"(h2), "=&v"(l3), "=&v"(h3)
                 : "v"(a), "n"(OB), "n"(OB + R1), "n"(OB + 32), "n"(OB + 32 + R1), "n"(OB + 64), "n"(OB + 64 + R1), "n"(OB + 96), "n"(OB + 96 + R1) : "memory");
    f[0][0] = l0[0]; f[0][1] = l0[1]; f[0][2] = l0[2]; f[0][3] = l0[3]; f[0][4] = h0[0]; f[0][5] = h0[1]; f[0][6] = h0[2]; f[0][7] = h0[3];
    f[1][0] = l1[0]; f[1][1] = l1[1]; f[1][2] = l1[2]; f[1][3] = l1[3]; f[1][4] = h1[0]; f[1][5] = h1[1]; f[1][6] = h1[2]; f[1][7] = h1[3];
    f[2][0] = l2[0]; f[2][1] = l2[1]; f[2][2] = l2[2]; f[2][3] = l2[3]; f[2][4] = h2[0]; f[2][5] = h2[1]; f[2][6] = h2[2]; f[2][7] = h2[3];
    f[3][0] = l3[0]; f[3][1] = l3[1]; f[3][2] = l3[2]; f[3][3] = l3[3]; f[3][4] = h3[0]; f[3][5] = h3[1]; f[3][6] = h3[2]; f[3][7] = h3[3];
}
__device__ __forceinline__ unsigned tr_lane(unsigned base, int stride, int rmul, int lane) { return base + (unsigned)((rmul * (lane >> 4) + ((lane & 15) >> 2)) * stride + (lane & 3) * 8); }
template <int V> struct IC { static constexpr int value = V; };
template <int I, int N, class F> __device__ __forceinline__ void sfor(F&& f) { if constexpr (I < N) { f(IC<I>{}); sfor<I + 1, N>(f); } }


#define XB_TMO      128
#define XB_XCNT(j)  (256  + 64 * (j))
#define XB_XSUB(j)  (1280 + 64 * (j))
#define XB_XGEN(j)  (2304 + 64 * (j))
#define XB_TOP      3328
#define XB_TOPGEN   3392
#define XCD_BAR_WORDS 3456
#define XB_SPIN_CAP (1u << 21)
__device__ __forceinline__ unsigned xb_ld(unsigned* p)              { return __hip_atomic_load(p, __ATOMIC_RELAXED, __HIP_MEMORY_SCOPE_AGENT); }
__device__ __forceinline__ unsigned xb_add(unsigned* p, unsigned v) { return __hip_atomic_fetch_add(p, v, __ATOMIC_RELAXED, __HIP_MEMORY_SCOPE_AGENT); }
__device__ __forceinline__ unsigned xb_xcc_id() { return (unsigned)__builtin_amdgcn_s_getreg((3 << 11) | 20) & 0xFu; }
#define XB_SPIN(cond, bar) do { unsigned _sp = 0; while (cond) { __builtin_amdgcn_s_sleep(1); \
    if ((++_sp & 255u) == 0u) { if (xb_ld(&(bar)[XB_TMO])) break; if (_sp > XB_SPIN_CAP) { atomicAdd(&(bar)[XB_TMO], 1u); break; } } } } while (0)
struct XcdBarrier { unsigned* bar; unsigned x; volatile LAS unsigned* st; };
__device__ __forceinline__ XcdBarrier xcd_barrier_post(unsigned* bar, volatile LAS unsigned* st) {
    XcdBarrier b; b.bar = bar; b.x = xb_xcc_id(); b.st = st;
    if (threadIdx.x == 0) (void)xb_add(&bar[XB_XCNT(b.x)], 1u);
    return b;
}
__device__ __forceinline__ void xcd_barrier_complete(unsigned* bar, unsigned x, unsigned& nloc, unsigned& nx) {
    const unsigned G = gridDim.x * gridDim.y * gridDim.z;
    unsigned sum, cnt, mine, sp = 0u;
    for (;;) {
        sum = 0u; cnt = 0u; mine = 0u;
#pragma unroll
        for (unsigned j = 0; j < 16; ++j) { const unsigned c = xb_ld(&bar[XB_XCNT(j)]); sum += c; cnt += (c > 0u) ? 1u : 0u; mine = (j == x) ? c : mine; }
        if (sum == G) break;
        __builtin_amdgcn_s_sleep(1);
        if ((++sp & 255u) == 0u) { if (xb_ld(&bar[XB_TMO])) break; if (sp > XB_SPIN_CAP) { atomicAdd(&bar[XB_TMO], 1u); break; } }
    }
    nloc = mine > 0u ? mine : 1u; nx = cnt > 0u ? cnt : 1u;
}
__device__ __forceinline__ void xcd_barrier(const XcdBarrier& b, const bool leader) {
    asm volatile("s_waitcnt vmcnt(0)" ::: "memory");
    __syncthreads();
    if (leader) {
        unsigned* bar = b.bar;
        __builtin_amdgcn_s_waitcnt(0);
        unsigned nloc = b.st[0], nx = b.st[1];
        if (nloc == 0u) { xcd_barrier_complete(bar, b.x, nloc, nx); b.st[0] = nloc; b.st[1] = nx; }
        const unsigned old = xb_add(&bar[XB_XSUB(b.x)], 1u);
        const unsigned gen = old / nloc;
        if (old + 1u == (gen + 1u) * nloc) {
            __builtin_amdgcn_fence(__ATOMIC_RELEASE, "agent");
            asm volatile("s_waitcnt vmcnt(0)" ::: "memory");
            const unsigned og = xb_add(&bar[XB_TOP], 1u);
            const unsigned tg = og / nx;
            if (og + 1u == (tg + 1u) * nx) xb_add(&bar[XB_TOPGEN], 1u);
            else XB_SPIN(xb_ld(&bar[XB_TOPGEN]) == tg, bar);
            __builtin_amdgcn_fence(__ATOMIC_ACQUIRE, "agent");
            xb_add(&bar[XB_XGEN(b.x)], 1u);
            asm volatile("s_waitcnt vmcnt(0)" ::: "memory");
        } else {
            XB_SPIN(xb_ld(&bar[XB_XGEN(b.x)]) == gen, bar);
            __builtin_amdgcn_fence(__ATOMIC_ACQUIRE, "agent");
            asm volatile("s_waitcnt vmcnt(0)" ::: "memory");
        }
    }
    __syncthreads();
}

namespace pg8 {
constexpr int BM = 256, BK = 64, HALF = 128, HTB = HALF * BK * 2, STAGE_BYTES = 8 * HTB, NXCD = 8, WGM = 8;
constexpr int ROWTAB_OFF = 149504;
constexpr int GATHER_SLOT_OFF = 133120;
__device__ __forceinline__ int lds_byte(int r, int c) { const int st = (r >> 4) * 2 + (c >> 5), rr = r & 15, cc = c & 31, ob = rr * 64 + cc * 2; return st * 1024 + (ob ^ (((ob >> 9) & 1) << 5)); }
__device__ __forceinline__ void stage_rc(int b, int& R, int& C) { const int st = b / 1024, sb = b % 1024, swz = sb ^ (((sb >> 9) & 1) << 5); R = (st >> 1) * 16 + swz / 64; C = (st & 1) * 32 + (swz % 64) / 2; }
__device__ __forceinline__ int perm32(int rho) { const int n = rho >> 4, i = rho & 15; return 8 * (i >> 2) + 4 * n + (i & 3); }

struct Unit { const char* A; const char* B; int e0, e1, e2, e3, e4; };

__device__ __forceinline__ bool static_tile(int i, int G, int c, int nM, int nN, int& pm, int& pn) {
    const int nwg = nM * nN; const long L = (long)i * G + c; if (L >= nwg) return false;
    int wgid = (int)L; { const int q = nwg / NXCD, r = nwg % NXCD, xcd = wgid % NXCD, off = wgid / NXCD; wgid = (xcd < r ? xcd * (q + 1) : r * (q + 1) + (xcd - r) * q) + off; }
    const int nig = WGM * nN, gid = wgid / nig, fm = gid * WGM, gsz = (nM - fm) < WGM ? (nM - fm) : WGM;
    pm = fm + ((wgid % nig) % gsz); pn = (wgid % nig) / gsz; return true;
}

template <bool F8 = false, class Epi, class Sched>
__device__ __forceinline__ void gemm_phase(LAS unsigned char* lds, const int tid, const int K, const int ldb  , const Sched& S, const Epi& E, const int stamp_base = -1) {
#ifdef TIMING
#define GSTAMP(k) do { if (stamp_base >= 0 && tid == 0 && (k) < 31) ((volatile LAS unsigned long long*)(lds + LDS_BYTES - 16 - 512))[stamp_base + (k)] = __builtin_amdgcn_s_memrealtime(); } while (0)
#else
#define GSTAMP(k) do { } while (0)
#endif
    GSTAMP(-1);
    const int wid = __builtin_amdgcn_readfirstlane(tid >> 6), lane = tid & 63, wr = wid >> 2, wc = wid & 3, fr = lane & 15, fq = lane >> 4;
    const int nt = K / (F8 ? 2 * BK : BK);
    unsigned voffB[2];
#pragma unroll
    for (int i = 0; i < 2; ++i) { int R, C; stage_rc(tid * 16 + i * 8192, R, C); const int Rb = Epi::PERM ? ((R & ~31) + perm32(R & 31)) : R; voffB[i] = F8 ? (unsigned)(Rb * ldb + C * 2) : (unsigned)(Rb * ldb + C) * 2u; }
    const size_t kstep = (size_t)(BK * 2);
    const size_t hstepB = (size_t)HALF * ldb * (F8 ? 1 : 2);
    const unsigned ldsw = (unsigned)wid * 1024u;
    const int aoff = lds_byte(wr * 64 + fr, fq * 8), boff = lds_byte(wc * 32 + fr, fq * 8);
#define PG8_SA(b, h) (((b) * 2 + (h)) * HTB)
#define PG8_SB(b, h) ((4 + (b) * 2 + (h)) * HTB)
#define PG8_STAGE(bufoff, gbase, voff) do { _Pragma("unroll") for (int _i = 0; _i < 2; ++_i) \
        __builtin_amdgcn_global_load_lds((const unsigned*)((const char*)(gbase) + (voff)[_i]), (LAS unsigned*)(lds + (bufoff) + ldsw + _i * 8192), 16, 0, 0); } while (0)
#define PG8_LDA(dst, b, h) do { _Pragma("unroll") for (int m = 0; m < 4; ++m) _Pragma("unroll") for (int k = 0; k < 2; ++k) dst[m][k] = *(const LAS bf16x8*)(lds + PG8_SA(b, h) + aoff + m * 2048 + k * 1024); } while (0)
#define PG8_LDB(dst, b, h) do { _Pragma("unroll") for (int n = 0; n < 2; ++n) _Pragma("unroll") for (int k = 0; k < 2; ++k) dst[n][k] = *(const LAS bf16x8*)(lds + PG8_SB(b, h) + boff + n * 2048 + k * 1024); } while (0)
#define PG8_MMA(ai, bj, At, Bt) do { __builtin_amdgcn_s_setprio(1); _Pragma("unroll") for (int m = 0; m < 4; ++m) _Pragma("unroll") for (int n = 0; n < 2; ++n) _Pragma("unroll") for (int k = 0; k < 2; ++k) { \
        if constexpr (F8) { const i64x2 b2_ = __builtin_bit_cast(i64x2, Bt[n][k]), a2_ = __builtin_bit_cast(i64x2, At[m][k]); \
            acc[ai][bj][m][n] = __builtin_amdgcn_mfma_f32_16x16x32_fp8_fp8(b2_[0], a2_[0], acc[ai][bj][m][n], 0, 0, 0); \
            acc[ai][bj][m][n] = __builtin_amdgcn_mfma_f32_16x16x32_fp8_fp8(b2_[1], a2_[1], acc[ai][bj][m][n], 0, 0, 0); } \
        else acc[ai][bj][m][n] = __builtin_amdgcn_mfma_f32_16x16x32_bf16(Bt[n][k], At[m][k], acc[ai][bj][m][n], 0, 0, 0); } __builtin_amdgcn_s_setprio(0); } while (0)
#define PG8_WAIT_V(n) asm volatile("s_waitcnt vmcnt(" #n ")" ::: "memory")
#define PG8_WAIT_L(n) asm volatile("s_waitcnt lgkmcnt(" #n ")" ::: "memory")
#define PG8_BAR __builtin_amdgcn_s_barrier()
#define PG8_SCHED __builtin_amdgcn_sched_barrier(0)
    Unit cur, nxt; int ui = 0;
    if (!S.next(0, cur)) return;
    unsigned cvA[2][2], nvA[2][2];
    S.a_offs(cur, tid, cvA);
    LAS unsigned* const gslot = (LAS unsigned*)(lds + GATHER_SLOT_OFF) + tid * 4;
    if constexpr (Sched::GATHER) { *(LAS u32x4*)gslot = (u32x4){cvA[0][0], cvA[0][1], cvA[1][0], cvA[1][1]}; }
    f32x4 acc[2][2][4][2];
#pragma unroll
    for (int a = 0; a < 2; ++a)
#pragma unroll
        for (int b = 0; b < 2; ++b)
#pragma unroll
            for (int m = 0; m < 4; ++m)
#pragma unroll
                for (int n = 0; n < 2; ++n) acc[a][b][m][n] = (f32x4){0.f, 0.f, 0.f, 0.f};
    bf16x8 At[4][2], B0[2][2], B1[2][2];
    const char* cA = cur.A; const char* cB = cur.B;
    PG8_STAGE(PG8_SB(0, 0), cB, voffB); PG8_STAGE(PG8_SA(0, 0), cA, cvA[0]); PG8_STAGE(PG8_SB(0, 1), cB + hstepB, voffB); PG8_STAGE(PG8_SA(0, 1), cA, cvA[1]);
    if (wr == 1) PG8_BAR;
    PG8_WAIT_V(4); PG8_BAR;
    PG8_STAGE(PG8_SB(1, 0), cB + kstep, voffB); PG8_STAGE(PG8_SA(1, 0), cA + kstep, cvA[0]); PG8_STAGE(PG8_SB(1, 1), cB + hstepB + kstep, voffB);
    PG8_WAIT_V(6); PG8_BAR;
    for (;;) {
        if constexpr (Epi::STAGES) { if (wid < 4) E.stage(cur, (LAS unsigned*)(lds + ROWTAB_OFF) + (ui & 1) * 256 + wid * 64, wid * 64 + lane); }
        const bool has_next = S.next(ui + 1, nxt);
        if (has_next) S.a_offs(nxt, tid, nvA);
        else {
#pragma unroll
            for (int h = 0; h < 2; ++h)
#pragma unroll
                for (int i = 0; i < 2; ++i) nvA[h][i] = cvA[h][i];
        }
        if constexpr (Sched::GATHER) { *(LAS u32x4*)(gslot + ((ui + 1) & 1) * 2048) = (u32x4){nvA[0][0], nvA[0][1], nvA[1][0], nvA[1][1]}; }
        const char* nA = has_next ? nxt.A : cA; const char* nB = has_next ? nxt.B : cB;
#pragma unroll 1
        for (int t = 0; t < nt; t += 2) {
            const bool last = (t == nt - 2);
            const char* a1 = cA + (size_t)(t + 1) * kstep;
            const char* a2 = last ? nA : cA + (size_t)(t + 2) * kstep; const char* b2 = last ? nB : cB + (size_t)(t + 2) * kstep;
            const char* a3 = a2 + kstep; const char* b3 = b2 + kstep;
            unsigned sA[2][2];
            if constexpr (Sched::GATHER) {
                const u32x4 cv = *(const LAS u32x4*)(gslot + (ui & 1) * 2048), sv = *(const LAS u32x4*)(gslot + ((ui + (last ? 1 : 0)) & 1) * 2048);
                cvA[0][0] = cv.x; cvA[0][1] = cv.y; cvA[1][0] = cv.z; cvA[1][1] = cv.w; sA[0][0] = sv.x; sA[0][1] = sv.y; sA[1][0] = sv.z; sA[1][1] = sv.w;
            } else {
#pragma unroll
                for (int h = 0; h < 2; ++h)
#pragma unroll
                    for (int i = 0; i < 2; ++i) sA[h][i] = last ? nvA[h][i] : cvA[h][i];
            }
            PG8_LDB(B0, 0, 0); PG8_SCHED; PG8_LDA(At, 0, 0); PG8_STAGE(PG8_SA(1, 1), a1, cvA[1]);
            PG8_WAIT_L(8); PG8_BAR; PG8_WAIT_L(0); PG8_MMA(0, 0, At, B0); PG8_BAR; PG8_SCHED;
            PG8_LDB(B1, 0, 1); PG8_STAGE(PG8_SB(0, 0), b2, voffB);
            PG8_BAR; PG8_WAIT_L(0); PG8_MMA(0, 1, At, B1); PG8_BAR;
            PG8_LDA(At, 0, 1); PG8_STAGE(PG8_SA(0, 0), a2, sA[0]);
            PG8_BAR; PG8_WAIT_L(0); PG8_MMA(1, 0, At, B0); PG8_BAR; PG8_SCHED;
            PG8_STAGE(PG8_SB(0, 1), b2 + hstepB, voffB);
            PG8_WAIT_V(6); PG8_BAR; PG8_MMA(1, 1, At, B1); PG8_BAR;
            PG8_LDB(B0, 1, 0); PG8_SCHED; PG8_LDA(At, 1, 0); PG8_STAGE(PG8_SA(0, 1), a2, sA[1]);
            PG8_WAIT_L(8); PG8_BAR; PG8_WAIT_L(0); PG8_MMA(0, 0, At, B0); PG8_BAR; PG8_SCHED;
            PG8_LDB(B1, 1, 1); PG8_STAGE(PG8_SB(1, 0), b3, voffB);
            PG8_BAR; PG8_WAIT_L(0); PG8_MMA(0, 1, At, B1); PG8_BAR;
            PG8_LDA(At, 1, 1); PG8_STAGE(PG8_SA(1, 0), a3, sA[0]);
            PG8_BAR; PG8_WAIT_L(0); PG8_MMA(1, 0, At, B0); PG8_BAR; PG8_SCHED;
            PG8_STAGE(PG8_SB(1, 1), b3 + hstepB, voffB);
            PG8_WAIT_V(6); PG8_BAR; PG8_MMA(1, 1, At, B1); PG8_BAR;
        }
        GSTAMP(2 * ui);
        if constexpr (Epi::STAGES) E(acc, cur, wr, wc, fr, fq, (const LAS unsigned*)(lds + ROWTAB_OFF) + (ui & 1) * 256); else E(acc, cur, wr, wc, fr, fq);
        GSTAMP(2 * ui + 1);
        if (!has_next) break;
        if (!(Epi::KEEPS && E.keep(cur))) {
#pragma unroll
        for (int a = 0; a < 2; ++a)
#pragma unroll
            for (int b = 0; b < 2; ++b)
#pragma unroll
                for (int m = 0; m < 4; ++m)
#pragma unroll
                    for (int n = 0; n < 2; ++n) acc[a][b][m][n] = (f32x4){0.f, 0.f, 0.f, 0.f};
        }
        cur = nxt; cA = nA; cB = nB; ++ui;
        if constexpr (!Sched::GATHER) {
#pragma unroll
            for (int h = 0; h < 2; ++h)
#pragma unroll
                for (int i = 0; i < 2; ++i) cvA[h][i] = nvA[h][i];
        }
    }
    PG8_WAIT_V(0);
    if (wr == 0) PG8_BAR;
    PG8_BAR;
#undef PG8_SA
#undef PG8_SB
#undef PG8_STAGE
#undef PG8_LDA
#undef PG8_LDB
#undef PG8_MMA
#undef PG8_WAIT_V
#undef PG8_WAIT_L
#undef PG8_BAR
#undef PG8_SCHED
}
}

using pg8::Unit;
template <int ES = 2  > struct DenseSchedT {
    static constexpr bool GATHER = false;
    const char* A; const char* B; int lda, ldb, nM, nN, G, c, nsub; size_t asub, bsub;
    __device__ __forceinline__ bool next(int i, Unit& u) const {
        const int sub = i % nsub, ti = i / nsub; int pm, pn;
        if (!pg8::static_tile(ti, G, c, nM, nN, pm, pn)) return false;
        u.A = A + (size_t)pm * 256 * lda * ES + (size_t)sub * asub; u.B = B + (size_t)pn * 256 * ldb * ES + (size_t)sub * bsub;
        u.e0 = pm; u.e1 = pn; u.e2 = sub; u.e3 = 0; u.e4 = 0; return true;
    }
    __device__ __forceinline__ void a_offs(const Unit&, int tid, unsigned (&vo)[2][2]) const {
#pragma unroll
        for (int i = 0; i < 2; ++i) { int R, C; pg8::stage_rc(tid * 16 + i * 8192, R, C);
#pragma unroll
            for (int h = 0; h < 2; ++h) vo[h][i] = ES == 2 ? (unsigned)((h * 128 + R) * lda + C) * 2u : (unsigned)((h * 128 + R) * lda + C * 2); }
    }
};
using DenseSched = DenseSchedT<2>;
constexpr int MOE_TAB_OFF = 131072;
constexpr int MOE_UL_OFF = MOE_TAB_OFF + 1024, MOE_UL_MAX = 24;
#define RFL(x) __builtin_amdgcn_readfirstlane(x)
__device__ __forceinline__ int moe_find_expert(const LAS int* tbase, int mt) {
    int lo = 0, hi = 63;
#pragma unroll
    for (int it = 0; it < 6; ++it) { const int mid = (lo + hi + 1) >> 1; if (RFL(tbase[mid]) <= mt) lo = mid; else hi = mid - 1; }
    return lo;
}
struct MoeGuSched {
    static constexpr bool GATHER = true;
    const char* H2; const char* WGU; const char* WSGU; const unsigned* list; const LAS int* tbase; const LAS int* cnt; int nMs, G, c;
    __device__ __forceinline__ bool next(int i, Unit& u) const {
        if (i >= MOE_UL_MAX) return false;
        const LAS int* ul = tbase + (MOE_UL_OFF - MOE_TAB_OFF) / 4 + i * 8;
        const int e = RFL(ul[0]), nt = RFL(ul[1]), p0 = RFL(ul[2]), t3 = RFL(ul[3]), cn_ = RFL(ul[4]);
        if (e < 0) return false;
        u.e0 = e; u.e1 = nt; u.e2 = p0; u.e3 = t3; u.e4 = cn_;
        if (e != 64) { u.A = H2; u.B = WGU + (size_t)e * (512 * 1024) + (size_t)nt * (256 * 1024); }
        else { u.A = H2 + (size_t)t3 * 256 * 1024; u.B = WSGU + (size_t)nt * (256 * 1024); }
        return true;
    }
    __device__ __forceinline__ void a_offs(const Unit& u, int tid, unsigned (&vo)[2][2]) const {
#pragma unroll
        for (int i = 0; i < 2; ++i) { int R, C; pg8::stage_rc(tid * 16 + i * 8192, R, C); R = launder(R);
#pragma unroll
            for (int h = 0; h < 2; ++h) {
                if (u.e0 == 64) vo[h][i] = (unsigned)((h * 128 + R) * 1024 + C * 2);
                else { const int pos = u.e2 + h * 128 + R; const unsigned tv = list[(size_t)u.e0 * NT + pos] >> 3;
                    vo[h][i] = (pos < u.e4 ? tv : 0u) * 1024u + (unsigned)C * 2u; } } }
    }
};
struct MoeDownSched {
    static constexpr bool GATHER = false;
    const char* ACT; const char* WD; const char* ACTS; const char* WSD; const LAS int* tbase; const LAS int* cnt; int nMs, G, c;
    __device__ __forceinline__ bool next(int i, Unit& u) const {
        if (i >= MOE_UL_MAX) return false;
        const LAS int* ul = tbase + (MOE_UL_OFF - MOE_TAB_OFF) / 4 + i * 8;
        const int e = RFL(ul[0]), pn = RFL(ul[1]), p0 = RFL(ul[2]), t3 = RFL(ul[3]), cn_ = RFL(ul[4]);
        if (e < 0) return false;
        u.e0 = e; u.e1 = pn; u.e2 = p0; u.e3 = t3; u.e4 = cn_;
        if (e != 64) { u.A = ACT + (size_t)t3 * (256 * 256); u.B = WD + (size_t)e * (1024 * 256) + (size_t)pn * (256 * 256); }
        else { u.A = ACTS + (size_t)t3 * (256 * 256); u.B = WSD + (size_t)pn * (256 * 256); }
        return true;
    }
    __device__ __forceinline__ void a_offs(const Unit&, int tid, unsigned (&vo)[2][2]) const {
#pragma unroll
        for (int i = 0; i < 2; ++i) { int R, C; pg8::stage_rc(tid * 16 + i * 8192, R, C);
#pragma unroll
            for (int h = 0; h < 2; ++h) vo[h][i] = (unsigned)((h * 128 + R) * 256 + C * 2); }
    }
};

struct EpiStoreBf16 {
    static constexpr bool STAGES = false;
    static constexpr bool KEEPS = false; __device__ __forceinline__ bool keep(const Unit&) const { return false; }
    static constexpr bool PERM = true;
    bf16_t* O; int ldc; int gate_tile0; unsigned char* G8; float sc;
    __device__ __forceinline__ void operator()(const f32x4 (&acc)[2][2][4][2], const Unit& u, int wr, int wc, int fr, int fq) const {
        const int row0 = u.e0 * 256 + launder(wr * 64 + fr), col0 = u.e1 * 256 + wc * 32 + 8 * fq;
        if (u.e1 >= gate_tile0) {
            const int gi = (u.e1 - gate_tile0) >> 2, pn = (u.e1 - gate_tile0) & 3, tidx = launder(((wr * 4 + wc) * 64) + fq * 16 + fr);
            unsigned char* gp = G8 + ((size_t)((u.e0 * 4 + pn) * 3 + gi) * 65536) + (size_t)tidx * 128;
#pragma unroll
            for (int ai = 0; ai < 2; ++ai)
#pragma unroll
                for (int m = 0; m < 4; ++m) { u32x4 w;
#pragma unroll
                    for (int bj = 0; bj < 2; ++bj) { const f32x4 v0 = acc[ai][bj][m][0] * sc, v1 = acc[ai][bj][m][1] * sc;
                        float q[8] = {v0[0], v0[1], v0[2], v0[3], v1[0], v1[1], v1[2], v1[3]}; unsigned qb[8];
#pragma unroll
                        for (int j = 0; j < 8; ++j) { const float t = fminf(fmaxf(sigmoidf_(q[j]) * 255.0f + 0.5f, 1.0f), 255.0f); qb[j] = (unsigned)t; }
                        const unsigned lo = qb[0] | (qb[1] << 8) | (qb[2] << 16) | (qb[3] << 24), hi = qb[4] | (qb[5] << 8) | (qb[6] << 16) | (qb[7] << 24);
                        if (bj == 0) { w.x = lo; w.y = hi; } else { w.z = lo; w.w = hi; } }
                    *(u32x4*)(gp + (ai * 4 + m) * 16) = w; }
            return;
        }
#pragma unroll
        for (int ai = 0; ai < 2; ++ai)
#pragma unroll
            for (int m = 0; m < 4; ++m) { bf16_t* rowp = O + (size_t)(row0 + ai * 128 + m * 16) * ldc + col0;
#pragma unroll
                for (int bj = 0; bj < 2; ++bj) { const f32x4 v0 = acc[ai][bj][m][0] * sc, v1 = acc[ai][bj][m][1] * sc;
                    u32x4 w; w.x = pk2(v0[0], v0[1]); w.y = pk2(v0[2], v0[3]); w.z = pk2(v1[0], v1[1]); w.w = pk2(v1[2], v1[3]);
                    *(u32x4*)(rowp + bj * 128) = w; } }
    }
};
struct EpiMerge {
    static constexpr bool PERM = true, KEEPS = true, STAGES = false;
    bf16_t* Mo; const unsigned char* G8;
    __device__ __forceinline__ bool keep(const Unit& u) const { return u.e2 < 2; }
    __device__ __forceinline__ void operator()(f32x4 (&acc)[2][2][4][2], const Unit& u, int wr, int wc, int fr, int fq) const {
        const int row0 = u.e0 * 256 + launder(wr * 64 + fr), col0 = u.e1 * 256 + wc * 32 + 8 * fq, sub = u.e2, tidx = launder(((wr * 4 + wc) * 64) + fq * 16 + fr);
        const unsigned char* gp = G8 + ((size_t)((u.e0 * 4 + u.e1) * 3 + sub) * 65536) + (size_t)tidx * 128;
        u32x4 gq[8], hq[8];
        const unsigned char* hp = gp + (sub < 2 ? 65536 : 0);
#pragma unroll
        for (int k = 0; k < 8; ++k) { gq[k] = *(const u32x4*)(gp + k * 16); hq[k] = *(const u32x4*)(hp + k * 16); }
        if (sub < 2) {
#pragma unroll
            for (int ai = 0; ai < 2; ++ai)
#pragma unroll
                for (int m = 0; m < 4; ++m)
#pragma unroll
                    for (int bj = 0; bj < 2; ++bj) { const u32x4 g4v = gq[ai * 4 + m], h4v = hq[ai * 4 + m];
                        const unsigned g0 = bj ? g4v.z : g4v.x, g1 = bj ? g4v.w : g4v.y, h0 = bj ? h4v.z : h4v.x, h1 = bj ? h4v.w : h4v.y;
                        float f[8];
#pragma unroll
                        for (int j = 0; j < 8; ++j) { const float qg = (float)(((j < 4 ? g0 : g1) >> (8 * (j & 3))) & 255u), qh = (float)(((j < 4 ? h0 : h1) >> (8 * (j & 3))) & 255u);
                            f[j] = qg * __builtin_amdgcn_rcpf(qh); }
                        acc[ai][bj][m][0] = acc[ai][bj][m][0] * (f32x4){f[0], f[1], f[2], f[3]}; acc[ai][bj][m][1] = acc[ai][bj][m][1] * (f32x4){f[4], f[5], f[6], f[7]}; }
        } else {
#pragma unroll
            for (int ai = 0; ai < 2; ++ai)
#pragma unroll
                for (int m = 0; m < 4; ++m)
#pragma unroll
                    for (int bj = 0; bj < 2; ++bj) { const u32x4 g4v = gq[ai * 4 + m];
                        const unsigned g0 = bj ? g4v.z : g4v.x, g1 = bj ? g4v.w : g4v.y;
                        float f[8];
#pragma unroll
                        for (int j = 0; j < 8; ++j) f[j] = (float)(((j < 4 ? g0 : g1) >> (8 * (j & 3))) & 255u) * (1.0f / 255.0f);
                        const f32x4 v0 = acc[ai][bj][m][0] * (f32x4){f[0], f[1], f[2], f[3]}, v1 = acc[ai][bj][m][1] * (f32x4){f[4], f[5], f[6], f[7]};
                        const size_t row = (size_t)(row0 + ai * 128 + m * 16);
                        u32x4 w; w.x = pk2(v0[0], v0[1]); w.y = pk2(v0[2], v0[3]); w.z = pk2(v1[0], v1[1]); w.w = pk2(v1[2], v1[3]);
                        *(u32x4*)(Mo + row * 1024 + col0 + bj * 128) = w; }
        }
    }
};
struct EpiResid {
    static constexpr bool STAGES = false;
    static constexpr bool KEEPS = false; __device__ __forceinline__ bool keep(const Unit&) const { return false; }
    static constexpr bool PERM = false;
    const float* src_l; const float* src_c; float* dst_l; float* dst_c; const float* gate;
    __device__ __forceinline__ void operator()(const f32x4 (&acc)[2][2][4][2], const Unit& u, int wr, int wc, int fr, int fq) const {
        const int g0 = u.e0 * 256; const bool lat = g0 < NL;
        const float* src = lat ? src_l + (size_t)g0 * D : src_c + (size_t)(g0 - NL) * D;
        float* dst = lat ? dst_l + (size_t)g0 * D : dst_c + (size_t)(g0 - NL) * D;
        const float* gp = gate + (size_t)(lat ? (g0 >> 11) : 8) * 6144;
        const int row0 = launder(wr * 64 + fr), col0 = u.e1 * 256 + wc * 32 + 4 * fq;
        f32x4 gv[2][2];
#pragma unroll
        for (int bj = 0; bj < 2; ++bj)
#pragma unroll
            for (int n = 0; n < 2; ++n) gv[bj][n] = *(const f32x4*)(gp + col0 + bj * 128 + n * 16);
#pragma unroll
        for (int am = 0; am < 4; ++am) { const int ai = am >> 1, mh = (am & 1) * 2;
            f32x4 sq[2][2][2];
#pragma unroll
            for (int mm = 0; mm < 2; ++mm)
#pragma unroll
                for (int bj = 0; bj < 2; ++bj)
#pragma unroll
                    for (int n = 0; n < 2; ++n) sq[mm][bj][n] = *(const f32x4*)(src + (size_t)(row0 + ai * 128 + (mh + mm) * 16) * D + col0 + bj * 128 + n * 16);
#pragma unroll
            for (int mm = 0; mm < 2; ++mm)
#pragma unroll
                for (int bj = 0; bj < 2; ++bj)
#pragma unroll
                    for (int n = 0; n < 2; ++n) *(f32x4*)(dst + (size_t)(row0 + ai * 128 + (mh + mm) * 16) * D + col0 + bj * 128 + n * 16) = sq[mm][bj][n] + gv[bj][n] * acc[ai][bj][mh + mm][n];
            if (am == 1) asm volatile("" ::: "memory");
        }
    }
};
struct EpiGateUp {
    static constexpr bool KEEPS = false; __device__ __forceinline__ bool keep(const Unit&) const { return false; }
    static constexpr bool PERM = true, STAGES = true;
    bf16_t* ACT; bf16_t* ACTS; const float* wl;
    __device__ __forceinline__ void stage(const Unit& u, LAS unsigned* dst_wave, int entry) const {
        if (u.e0 != 64) __builtin_amdgcn_global_load_lds((const unsigned*)(wl + (size_t)u.e0 * NT + u.e2 + entry), dst_wave, 4, 0, 0);
    }
    __device__ __forceinline__ void operator()(const f32x4 (&acc)[2][2][4][2], const Unit& u, int wr, int wc, int fr, int fq, const LAS unsigned* tab) const {
        const int row0 = launder(wr * 64 + fr), col0 = u.e1 * 128 + wc * 32 + 8 * fq;
        unsigned char* base = (unsigned char*)(u.e0 == 64 ? ACTS : ACT) + (size_t)u.e3 * 256 * 256;
#pragma unroll
        for (int ai = 0; ai < 2; ++ai)
#pragma unroll
            for (int m = 0; m < 4; ++m) { const int row = row0 + ai * 128 + m * 16; const float tw = __uint_as_float(tab[row]);
                const float w = u.e0 == 64 ? 1.0f : (u.e2 + row < u.e4 ? tw : 0.0f);
                const f32x4 g0 = acc[ai][0][m][0] * 0.03125f, g1 = acc[ai][0][m][1] * 0.03125f, u0 = acc[ai][1][m][0] * (0.03125f * 8.0f * w), u1 = acc[ai][1][m][1] * (0.03125f * 8.0f * w);
                int lo = 0, hi = 0;
                lo = __builtin_amdgcn_cvt_pk_fp8_f32(siluf_(g0[0]) * u0[0], siluf_(g0[1]) * u0[1], lo, false); lo = __builtin_amdgcn_cvt_pk_fp8_f32(siluf_(g0[2]) * u0[2], siluf_(g0[3]) * u0[3], lo, true);
                hi = __builtin_amdgcn_cvt_pk_fp8_f32(siluf_(g1[0]) * u1[0], siluf_(g1[1]) * u1[1], hi, false); hi = __builtin_amdgcn_cvt_pk_fp8_f32(siluf_(g1[2]) * u1[2], siluf_(g1[3]) * u1[3], hi, true);
                *(u32x2*)(base + (size_t)row * 256 + col0) = (u32x2){(unsigned)lo, (unsigned)hi}; }
    }
};
struct EpiDown {
    static constexpr bool KEEPS = false; __device__ __forceinline__ bool keep(const Unit&) const { return false; }
    static constexpr bool PERM = true, STAGES = true;
    bf16_t* O; const unsigned* list; bf16_t* Hs;
    __device__ __forceinline__ void stage(const Unit& u, LAS unsigned* dst_wave, int entry) const {
        if (u.e0 != 64) __builtin_amdgcn_global_load_lds(list + (size_t)u.e0 * NT + u.e2 + entry, dst_wave, 4, 0, 0);
    }
    __device__ __forceinline__ void operator()(const f32x4 (&acc)[2][2][4][2], const Unit& u, int wr, int wc, int fr, int fq, const LAS unsigned* tab) const {
        const int row0 = launder(wr * 64 + fr), col0 = u.e1 * 256 + wc * 32 + 8 * fq;
        if (u.e0 == 64) {
#pragma unroll
            for (int ai = 0; ai < 2; ++ai)
#pragma unroll
                for (int m = 0; m < 4; ++m) { bf16_t* rowp = Hs + (size_t)(u.e3 * 256 + row0 + ai * 128 + m * 16) * 1024 + col0;
#pragma unroll
                    for (int bj = 0; bj < 2; ++bj) { const f32x4 v0 = acc[ai][bj][m][0] * 0.0078125f, v1 = acc[ai][bj][m][1] * 0.0078125f;
                        u32x4 w; w.x = pk2(v0[0], v0[1]); w.y = pk2(v0[2], v0[3]); w.z = pk2(v1[0], v1[1]); w.w = pk2(v1[2], v1[3]);
                        *(u32x4*)(rowp + bj * 128) = w; } }
        } else {
            unsigned dq[2][4];
#pragma unroll
            for (int ai = 0; ai < 2; ++ai)
#pragma unroll
                for (int m = 0; m < 4; ++m) dq[ai][m] = tab[row0 + ai * 128 + m * 16];
#pragma unroll
            for (int ai = 0; ai < 2; ++ai)
#pragma unroll
                for (int m = 0; m < 4; ++m) {
                    if (u.e2 + row0 + ai * 128 + m * 16 < u.e4) { unsigned char* rowp = (unsigned char*)O + (size_t)dq[ai][m] * 1024 + col0;
#pragma unroll
                        for (int bj = 0; bj < 2; ++bj) { const f32x4 v0 = acc[ai][bj][m][0] * 0.0078125f, v1 = acc[ai][bj][m][1] * 0.0078125f;
                            int lo = 0, hi = 0;
                            lo = __builtin_amdgcn_cvt_pk_fp8_f32(v0[0], v0[1], lo, false); lo = __builtin_amdgcn_cvt_pk_fp8_f32(v0[2], v0[3], lo, true);
                            hi = __builtin_amdgcn_cvt_pk_fp8_f32(v1[0], v1[1], hi, false); hi = __builtin_amdgcn_cvt_pk_fp8_f32(v1[2], v1[3], hi, true);
                            *(u32x2*)(rowp + bj * 128) = (u32x2){(unsigned)lo, (unsigned)hi}; } } }
        }
    }
};

struct Params {
    const float* in[26];
    float* out; unsigned char* ws;
    int ph_lo, ph_hi, li, pad;
};
enum { I_X = 0, I_C, I_CTX, I_CCTX, I_WADA, I_BADA, I_NMG, I_NFG, I_WIN, I_CMLNG, I_CMLNB, I_CMWS, I_CMBS, I_RPB, I_DECAY, I_WBR, I_WOUT, I_RW, I_RB,
       I_EG, I_EU, I_ED, I_SG, I_SU, I_SD, I_FG };

__device__ __forceinline__ const float* kin(int i) {
    unsigned off = (unsigned)i * 8u; asm volatile("" : "+s"(off));
    const __attribute__((address_space(4))) char* ka = (const __attribute__((address_space(4))) char*)__builtin_amdgcn_kernarg_segment_ptr();
    return (const float*)*(GAS const float* const __attribute__((address_space(4)))*)(ka + off);
}
__device__ __forceinline__ float* kout_ptr() { unsigned off = 208u; asm volatile("" : "+s"(off));
    const __attribute__((address_space(4))) char* ka = (const __attribute__((address_space(4))) char*)__builtin_amdgcn_kernarg_segment_ptr();
    return (float*)*(GAS float* const __attribute__((address_space(4)))*)(ka + off); }
__device__ __forceinline__ unsigned char* kws_ptr() { unsigned off = 216u; asm volatile("" : "+s"(off));
    const __attribute__((address_space(4))) char* ka = (const __attribute__((address_space(4))) char*)__builtin_amdgcn_kernarg_segment_ptr();
    return (unsigned char*)*(GAS unsigned char* const __attribute__((address_space(4)))*)(ka + off); }
static_assert(__builtin_offsetof(Params, out) == 208 && __builtin_offsetof(Params, ws) == 216, "kernarg offsets");
static_assert(__builtin_offsetof(Params, in) == 0, "kin() reads Params::in at kernarg offset 0");
__device__ __forceinline__ void transpose_item(const float* W, int N, bf16_t* WT, int ldk, int extra, LAS float* scr, int kb, int nb, int lane) {
    const int k0 = 64 * kb, n0 = 32 * nb;
    float wv[32];
#pragma unroll
    for (int i = 0; i < 32; ++i) wv[i] = W[(size_t)(k0 + 2 * i + (lane >> 5)) * N + n0 + (lane & 31)];
#pragma unroll
    for (int i = 0; i < 32; ++i) scr[(2 * i + (lane >> 5)) * 33 + (lane & 31)] = wv[i];
    LDS_WAIT(); asm volatile("" ::: "memory");
    const int c = lane & 7;
#pragma unroll
    for (int j = 0; j < 4; ++j) { const int n = (lane >> 3) + 8 * j; const LAS float* s = scr + (8 * c) * 33 + n;
        u32x4 o; o.x = pk2(s[0 * 33], s[1 * 33]); o.y = pk2(s[2 * 33], s[3 * 33]); o.z = pk2(s[4 * 33], s[5 * 33]); o.w = pk2(s[6 * 33], s[7 * 33]);
        *(u32x4*)(WT + (size_t)(n0 + n + extra) * ldk + k0 + 8 * c) = o; }
    LDS_WAIT(); asm volatile("" ::: "memory");
}
__device__ __forceinline__ void transpose_item_f8(const float* W, int N, unsigned char* WT, int ldk, int extra, float scale, LAS float* scr, int kb, int nb, int lane) {
    const int k0 = 64 * kb, n0 = 32 * nb;
    float wv[32];
#pragma unroll
    for (int i = 0; i < 32; ++i) wv[i] = W[(size_t)(k0 + 2 * i + (lane >> 5)) * N + n0 + (lane & 31)];
#pragma unroll
    for (int i = 0; i < 32; ++i) scr[(2 * i + (lane >> 5)) * 33 + (lane & 31)] = wv[i];
    LDS_WAIT(); asm volatile("" ::: "memory");
    const int c = lane & 7;
#pragma unroll
    for (int j = 0; j < 4; ++j) { const int n = (lane >> 3) + 8 * j; const LAS float* s = scr + (8 * c) * 33 + n;
        int lo = 0, hi = 0;
        lo = __builtin_amdgcn_cvt_pk_fp8_f32(s[0 * 33] * scale, s[1 * 33] * scale, lo, false); lo = __builtin_amdgcn_cvt_pk_fp8_f32(s[2 * 33] * scale, s[3 * 33] * scale, lo, true);
        hi = __builtin_amdgcn_cvt_pk_fp8_f32(s[4 * 33] * scale, s[5 * 33] * scale, hi, false); hi = __builtin_amdgcn_cvt_pk_fp8_f32(s[6 * 33] * scale, s[7 * 33] * scale, hi, true);
        *(u32x2*)(WT + (size_t)(n0 + n + extra) * ldk + k0 + 8 * c) = (u32x2){(unsigned)lo, (unsigned)hi}; }
    LDS_WAIT(); asm volatile("" ::: "memory");
}
constexpr int IT_IN = 16 * 224, IT_BR = 3 * 8 * 32, IT_OUT = 16 * 32, IT_SG = 16 * 8, IT_SD = 4 * 32, IT_RT = 16 * 2, IT_CM = 128;
constexpr int MISC_ITEMS = IT_IN + IT_BR + IT_OUT + 2 * IT_SG + IT_SD + IT_RT + IT_CM;
__device__ __forceinline__ void misc_item(const Params& p, int l, int r, LAS float* scr, int lane) {
    unsigned char* wm = p.ws + WS_WM + (size_t)l * WM_STRIDE;
    if (r < IT_IN) { transpose_item_f8(kin(I_WIN) + (size_t)l * 1024 * 7168, 7168, (unsigned char*)(wm + WM_IN), 1024, 0, 32.0f, scr, r / 224, r % 224, lane); return; } r -= IT_IN;
    if (r < IT_BR) { const int i = r / 256, q = r % 256; transpose_item(kin(I_WBR) + ((size_t)l * 3 + i) * 512 * 1024, 1024, (bf16_t*)(wm + WM_BR) + (size_t)i * 1024 * 512, 512, 0, scr, q / 32, q % 32, lane); return; } r -= IT_BR;
    if (r < IT_OUT) { transpose_item(kin(I_WOUT) + (size_t)l * 1024 * 1024, 1024, (bf16_t*)(wm + WM_OUT), 1024, 0, scr, r / 32, r % 32, lane); return; } r -= IT_OUT;
    if (r < 2 * IT_SG) { const int up = r / IT_SG, q = r % IT_SG, nb = q % 8;
        transpose_item_f8(kin(up ? I_SU : I_SG) + (size_t)l * 1024 * 256, 256, (unsigned char*)(wm + WM_SGU), 1024, ((32 * nb) / 128) * 128 + up * 128, 32.0f, scr, q / 8, nb, lane); return; } r -= 2 * IT_SG;
    if (r < IT_SD) { transpose_item_f8(kin(I_SD) + (size_t)l * 256 * 1024, 1024, (unsigned char*)(wm + WM_SD), 256, 0, 16.0f, scr, r / 32, r % 32, lane); return; } r -= IT_SD;
    if (r < IT_RT) { transpose_item(kin(I_RW) + (size_t)l * 1024 * 64, 64, (bf16_t*)(wm + WM_RT), 1024, 0, scr, r / 2, r % 2, lane); return; } r -= IT_RT;
    { const float* src = kin(I_CMWS) + (size_t)l * 65536 + (size_t)r * 512 + lane * 8; const f32x4 a = *(const f32x4*)src, b = *(const f32x4*)(src + 4);
      u32x4 o; o.x = pk2(a[0], a[1]); o.y = pk2(a[2], a[3]); o.z = pk2(b[0], b[1]); o.w = pk2(b[2], b[3]);
      *(u32x4*)((bf16_t*)(wm + WM_CM) + (size_t)r * 512 + lane * 8) = o; }
}
constexpr int EXP_ITEMS = 3 * 64 * 128;
constexpr int FILL_SPLIT = 34000;
__device__ __forceinline__ void expert_item(const Params& p, int l, int r, LAS float* scr, int lane) {
    unsigned char* we = p.ws + WS_WE + (size_t)l * WE_LAYER;
    const int which = r / 8192, q = r % 8192, e = q / 128, it = q % 128;
    if (which < 2) { const int kb = it / 8, nb = it % 8;
        transpose_item_f8(kin(which ? I_EU : I_EG) + ((size_t)l * 64 + e) * 1024 * 256, 256, (unsigned char*)(we + WE_GU) + (size_t)e * 512 * 1024, 1024, ((32 * nb) / 128) * 128 + which * 128, 32.0f, scr, kb, nb, lane); }
    else { const int kb = it / 32, nb = it % 32;
        transpose_item_f8(kin(I_ED) + ((size_t)l * 64 + e) * 256 * 1024, 1024, (unsigned char*)(we + WE_D) + (size_t)e * 1024 * 256, 256, 0, 16.0f, scr, kb, nb, lane); }
}
__device__ __forceinline__ void mod_unit(const Params& p, LAS unsigned char* lds, int u, int tid) {
    const int l = u / 96, cb = u % 96, wave = __builtin_amdgcn_readfirstlane(tid >> 6), lane = tid & 63;
    LAS float* sil = (LAS float*)lds;
    LAS float* part = (LAS float*)(lds + 36864);
    for (int idx = tid; idx < 9 * 1024; idx += NTHREADS) { const int r = idx >> 10, k = idx & 1023; const float v = r < 8 ? kin(I_C)[r * 1024 + k] : kin(I_CCTX)[k]; sil[idx] = v / (1.0f + expf(-v)); }
    __syncthreads();
    float acc[9];
#pragma unroll
    for (int r = 0; r < 9; ++r) acc[r] = 0.f;
    const float* wp = kin(I_WADA) + ((size_t)l * 1024 + wave * 128) * 6144 + cb * 64 + lane;
#pragma unroll 4
    for (int k = 0; k < 128; ++k) { const float wv = wp[(size_t)k * 6144];
#pragma unroll
        for (int r = 0; r < 9; ++r) acc[r] += sil[r * 1024 + wave * 128 + k] * wv; }
#pragma unroll
    for (int r = 0; r < 9; ++r) part[(wave * 9 + r) * 64 + lane] = acc[r];
    __syncthreads();
    for (int idx = tid; idx < 576; idx += NTHREADS) { const int r = idx >> 6, ln = idx & 63; float s = kin(I_BADA)[l * 6144 + cb * 64 + ln];
#pragma unroll
        for (int w = 0; w < 8; ++w) s += part[(w * 9 + r) * 64 + ln];
        ((float*)(p.ws + WS_MOD))[((size_t)l * 9 + r) * 6144 + cb * 64 + ln] = s; }
    __syncthreads();
}

__device__ __forceinline__ void norm_mod_vals(const f32x4 (&v)[4], const float* g, const float* sh, const float* sc, bf16_t* orow, bool to_lds, LAS unsigned char* ldst, int lane) {
    f32x4 gq[4], hq[4], cq[4];
#pragma unroll
    for (int j = 0; j < 4; ++j) { gq[j] = ((const f32x4*)g)[64 * j + lane]; hq[j] = ((const f32x4*)sh)[64 * j + lane]; cq[j] = ((const f32x4*)sc)[64 * j + lane]; }
    float ss = 0.f;
#pragma unroll
    for (int j = 0; j < 4; ++j) ss += (v[j][0] * v[j][0] + v[j][1] * v[j][1]) + (v[j][2] * v[j][2] + v[j][3] * v[j][3]);
    const float rstd = rsqrtf(wave_sum(ss, lane) * (1.0f / 1024.0f) + EPS);
#pragma unroll
    for (int j = 0; j < 4; ++j) { const f32x4 gg = gq[j], s_h = hq[j], s_c = cq[j];
        const f32x4 y = v[j] * rstd * gg * (s_c + 1.0f) + s_h;
        u32x2 o; o.x = pk2(y[0], y[1]); o.y = pk2(y[2], y[3]);
        ((u32x2*)orow)[64 * j + lane] = o;
        if (to_lds) *(LAS u32x2*)(ldst + (64 * j + lane) * 8) = o; }
}
__device__ __forceinline__ void norm_mod_vals_f8(const f32x4 (&v)[4], const float* g, const float* sh, const float* sc, unsigned char* orow, int lane) {
    f32x4 gq[4], hq[4], cq[4];
#pragma unroll
    for (int j = 0; j < 4; ++j) { gq[j] = ((const f32x4*)g)[64 * j + lane]; hq[j] = ((const f32x4*)sh)[64 * j + lane]; cq[j] = ((const f32x4*)sc)[64 * j + lane]; }
    float ss = 0.f;
#pragma unroll
    for (int j = 0; j < 4; ++j) ss += (v[j][0] * v[j][0] + v[j][1] * v[j][1]) + (v[j][2] * v[j][2] + v[j][3] * v[j][3]);
    const float rstd = rsqrtf(wave_sum(ss, lane) * (1.0f / 1024.0f) + EPS);
#pragma unroll
    for (int j = 0; j < 4; ++j) { const f32x4 y = v[j] * rstd * gq[j] * (cq[j] + 1.0f) + hq[j];
        int w = 0; w = __builtin_amdgcn_cvt_pk_fp8_f32(y[0], y[1], w, false); w = __builtin_amdgcn_cvt_pk_fp8_f32(y[2], y[3], w, true);
        ((unsigned*)orow)[64 * j + lane] = (unsigned)w; }
}
__device__ __forceinline__ void norm_mod_row(const float* xrow, const float* g, const float* sh, const float* sc, bf16_t* orow, bool to_lds, LAS unsigned char* ldst, int lane) {
    f32x4 v[4];
#pragma unroll
    for (int j = 0; j < 4; ++j) v[j] = ((const f32x4*)xrow)[64 * j + lane];
    norm_mod_vals(v, g, sh, sc, orow, to_lds, ldst, lane);
}
__device__ __forceinline__ void combine_row(f32x4 (&v)[4], const float* xrow, const float* ga2, const bf16_t* shrow, const unsigned char* o8, int lane) {
    u32x2 sq[4]; unsigned oq[8][4]; f32x4 gq[4];
#pragma unroll
    for (int j = 0; j < 4; ++j) { v[j] = ((const f32x4*)xrow)[64 * j + lane]; gq[j] = ((const f32x4*)ga2)[64 * j + lane]; sq[j] = ((const u32x2*)shrow)[64 * j + lane]; }
#pragma unroll
    for (int k = 0; k < 8; ++k)
#pragma unroll
        for (int j = 0; j < 4; ++j) oq[k][j] = ((const unsigned*)(o8 + (size_t)k * 1024))[64 * j + lane];
    asm volatile("" :: "v"(v[0]), "v"(v[1]), "v"(v[2]), "v"(v[3]), "v"(gq[0]), "v"(gq[1]), "v"(gq[2]), "v"(gq[3]) : "memory");
#pragma unroll
    for (int j = 0; j < 4; ++j) { f32x4 t = (f32x4){lo16(sq[j].x), hi16(sq[j].x), lo16(sq[j].y), hi16(sq[j].y)};
#pragma unroll
        for (int k = 0; k < 8; ++k) { const int w = (int)oq[k][j];
            t[0] += __builtin_amdgcn_cvt_f32_fp8(w, 0); t[1] += __builtin_amdgcn_cvt_f32_fp8(w, 1); t[2] += __builtin_amdgcn_cvt_f32_fp8(w, 2); t[3] += __builtin_amdgcn_cvt_f32_fp8(w, 3); }
        v[j] += gq[j] * t; }
}

constexpr int RT_TILE = 0, RT_PITCH = 2064, RT_LG = 64 * RT_PITCH  , RT_BIAS = RT_LG + 64 * 65 * 4  , RT_LCNT = RT_BIAS + 256, RT_LBASE = RT_LCNT + 256,
              RT_SELE = RT_LBASE + 256  , RT_SELW = RT_SELE + 2048, RT_SELR = RT_SELW + 2048, RT_END = RT_SELR + 2048;
static_assert(RT_END <= LDS_BYTES, "router LDS");
#ifdef TIMING
#define RSTAMP(k) do { if (stamp && tid == 0) ((volatile LAS unsigned long long*)(lds + LDS_BYTES - 16 - 512))[24 + (k)] = __builtin_amdgcn_s_memrealtime(); } while (0)
#else
#define RSTAMP(k) do { } while (0)
#endif
__device__ __forceinline__ void router_unit(const Params& p, LAS unsigned char* lds, int l, int u, const float* xl, const float* xc, int tid, bool commit, bool stamp = false) {
    const int wave = __builtin_amdgcn_readfirstlane(tid >> 6), lane = tid & 63, g4 = lane >> 4, row0 = u * 64;
    const bool lat = row0 < NL;
    const float* mr = (const float*)(p.ws + WS_MOD) + (size_t)l * 9 * 6144 + (size_t)(lat ? (row0 >> 11) : 8) * 6144;
    const float* xbase = lat ? xl + (size_t)row0 * D : xc + (size_t)(row0 - NL) * D;
    unsigned char* H2 = (unsigned char*)(p.ws + WS_H) + (size_t)row0 * D;
    LAS float* lg = (LAS float*)(lds + RT_LG); LAS float* bias = (LAS float*)(lds + RT_BIAS);
    LAS int* lcnt = (LAS int*)(lds + RT_LCNT); LAS int* lbase = (LAS int*)(lds + RT_LBASE);
    LAS int* sele = (LAS int*)(lds + RT_SELE); LAS float* selw = (LAS float*)(lds + RT_SELW); LAS int* selr = (LAS int*)(lds + RT_SELR);
    RSTAMP(0);
    if (tid < 64) { lcnt[tid] = 0; bias[tid] = kin(I_RB)[l * 64 + tid]; }
    const int rb = wave >> 1, eb0 = (wave & 1) * 2;
    const bf16_t* w0 = (const bf16_t*)(p.ws + WS_WM + (size_t)l * WM_STRIDE + WM_RT) + launder((eb0 * 16 + (lane & 15)) * 1024 + g4 * 8); const bf16_t* w1 = w0 + launder(16 * 1024);
    bf16x8 qa0[4], qa1[4];
#pragma unroll
    for (int ks = 0; ks < 4; ++ks) { qa0[ks] = *(const bf16x8*)(w0 + ks * 32); qa1[ks] = *(const bf16x8*)(w1 + ks * 32); }
    { f32x4 gg[4], s_h[4], s_c[4];
#pragma unroll
      for (int j = 0; j < 4; ++j) { gg[j] = ((const f32x4*)(kin(I_NFG) + l * 1024))[64 * j + lane]; s_h[j] = ((const f32x4*)(mr + 3072))[64 * j + lane]; s_c[j] = ((const f32x4*)(mr + 4096))[64 * j + lane] + 1.0f; }
#pragma unroll
      for (int hb = 0; hb < 2; ++hb) { f32x4 v[4][4];
#pragma unroll
          for (int i = 0; i < 4; ++i)
#pragma unroll
              for (int j = 0; j < 4; ++j) v[i][j] = ((const f32x4*)(xbase + (size_t)(wave * 8 + hb * 4 + i) * D))[64 * j + lane];
#pragma unroll
          for (int i = 0; i < 4; ++i) { const int rl = wave * 8 + hb * 4 + i; float ss = 0.f;
#pragma unroll
              for (int j = 0; j < 4; ++j) ss += (v[i][j][0] * v[i][j][0] + v[i][j][1] * v[i][j][1]) + (v[i][j][2] * v[i][j][2] + v[i][j][3] * v[i][j][3]);
              const float rstd = rsqrtf(wave_sum(ss, lane) * (1.0f / 1024.0f) + EPS);
#pragma unroll
              for (int j = 0; j < 4; ++j) { const f32x4 y = v[i][j] * rstd * gg[j] * s_c[j] + s_h[j];
                  u32x2 o; o.x = pk2(y[0], y[1]); o.y = pk2(y[2], y[3]);
                  int q8 = 0; q8 = __builtin_amdgcn_cvt_pk_fp8_f32(y[0], y[1], q8, false); q8 = __builtin_amdgcn_cvt_pk_fp8_f32(y[2], y[3], q8, true);
                  ((unsigned*)(H2 + (size_t)rl * D))[64 * j + lane] = (unsigned)q8; *(LAS u32x2*)(lds + RT_TILE + rl * RT_PITCH + (64 * j + lane) * 8) = o; } } } }
    __syncthreads();
    RSTAMP(1);
    { f32x4 a0 = (f32x4){0.f, 0.f, 0.f, 0.f}, a1 = a0;
      const LAS unsigned char* hrow = lds + RT_TILE + (rb * 16 + (lane & 15)) * RT_PITCH + g4 * 16;
      bf16x8 qb0[4], qb1[4];
      sfor<0, 4>([&](auto it_) { constexpr int it = decltype(it_)::value;
#pragma unroll
          for (int ks = 0; ks < 4; ++ks) { qb0[ks] = *(const bf16x8*)(w0 + ((2 * it + 1) * 4 + ks) * 32); qb1[ks] = *(const bf16x8*)(w1 + ((2 * it + 1) * 4 + ks) * 32); }
#pragma unroll
          for (int ks = 0; ks < 4; ++ks) { const bf16x8 bq = *(const LAS bf16x8*)(hrow + ((2 * it) * 4 + ks) * 64); a0 = mfma16(qa0[ks], bq, a0); a1 = mfma16(qa1[ks], bq, a1); }
          if constexpr (it < 3) {
#pragma unroll
              for (int ks = 0; ks < 4; ++ks) { qa0[ks] = *(const bf16x8*)(w0 + ((2 * it + 2) * 4 + ks) * 32); qa1[ks] = *(const bf16x8*)(w1 + ((2 * it + 2) * 4 + ks) * 32); } }
#pragma unroll
          for (int ks = 0; ks < 4; ++ks) { const bf16x8 bq = *(const LAS bf16x8*)(hrow + ((2 * it + 1) * 4 + ks) * 64); a0 = mfma16(qb0[ks], bq, a0); a1 = mfma16(qb1[ks], bq, a1); } });
      const int rr = rb * 16 + (lane & 15);
#pragma unroll
      for (int r = 0; r < 4; ++r) { lg[rr * 65 + eb0 * 16 + 4 * g4 + r] = sigmoidf_(a0[r]); lg[rr * 65 + (eb0 + 1) * 16 + 4 * g4 + r] = sigmoidf_(a1[r]); } }
    __syncthreads();
    RSTAMP(2);
    { const int row = tid >> 3, g = tid & 7;
      float sv[8]; unsigned key[8];
#pragma unroll
      for (int j = 0; j < 8; ++j) { sv[j] = lg[row * 65 + 8 * g + j]; const unsigned ub = __float_as_uint(sv[j] + bias[8 * g + j]);
          key[j] = ((ub ^ ((ub >> 31) ? 0xffffffffu : 0x80000000u)) & ~63u) | (unsigned)(63 - (8 * g + j)); }
      float m1 = -3e38f, m2 = -3e38f;
#pragma unroll
      for (int j = 0; j < 8; ++j) { const float c = sv[j] + bias[8 * g + j]; if (c > m1) { m2 = m1; m1 = c; } else if (c > m2) m2 = c; }
      const unsigned ug = __float_as_uint(m1 + m2); const unsigned gkey = ((ug ^ ((ug >> 31) ? 0xffffffffu : 0x80000000u)) & ~7u) | (unsigned)(7 - g);
      int grank = 0;
      sfor<1, 8>([&](auto d_) { constexpr int d = decltype(d_)::value; grank += (int)((unsigned)shxi((int)gkey, d, lane) > gkey); });
      const bool gsel = grank < 4;
#pragma unroll
      for (int j = 0; j < 8; ++j) if (!gsel) key[j] = (unsigned)(63 - (8 * g + j));
      int rk[8];
#pragma unroll
      for (int j = 0; j < 8; ++j) { int r = 0;
#pragma unroll
          for (int j2 = 0; j2 < 8; ++j2) r += (int)(key[j2] > key[j]);
          rk[j] = r; }
      sfor<1, 8>([&](auto d_) { constexpr int d = decltype(d_)::value;
          sfor<0, 8>([&](auto j2_) { constexpr int j2 = decltype(j2_)::value; const unsigned ok = (unsigned)shxi((int)key[j2], d, lane);
#pragma unroll
              for (int j = 0; j < 8; ++j) rk[j] += (int)(ok > key[j]); });
          __builtin_amdgcn_sched_barrier(0); });
      float wsum = 0.f;
#pragma unroll
      for (int j = 0; j < 8; ++j) if (gsel && rk[j] < 8) wsum += sv[j];
      wsum += shx(wsum, 1, lane); wsum += shx(wsum, 2, lane); wsum += shx(wsum, 4, lane);
      const float sc = 2.5f / wsum;
#pragma unroll
      for (int j = 0; j < 8; ++j) if (gsel && rk[j] < 8) { const int e = 8 * g + j, k = rk[j];
          sele[row * 8 + k] = e; selw[row * 8 + k] = sv[j] * sc; selr[row * 8 + k] = __hip_atomic_fetch_add(&lcnt[e], 1, __ATOMIC_RELAXED, __HIP_MEMORY_SCOPE_WORKGROUP); } }
    __syncthreads();
    RSTAMP(3);
    if (tid < 64) { const int n = lcnt[tid]; int base = 0; if (n > 0 && commit) base = (int)atomicAdd((unsigned*)(p.ws + WS_CTL) + CW_CNT + l * 2048 + tid * 16, (unsigned)n); lbase[tid] = base; }
    __syncthreads();
    RSTAMP(4);
    { const int rl = tid >> 3, k = tid & 7, e = sele[rl * 8 + k], pos = lbase[e] + selr[rl * 8 + k];
      if (commit) { ((unsigned*)(p.ws + WS_LIST))[(size_t)e * NT + pos] = (unsigned)((row0 + rl) * 8 + k); ((float*)(p.ws + WS_WL))[(size_t)e * NT + pos] = selw[rl * 8 + k]; } }
    __syncthreads();
    RSTAMP(5);
}

__device__ __forceinline__ void mixA_unit(const Params& p, LAS unsigned char* lds, int l, int ch, int g, int tid) {
    const int wave = __builtin_amdgcn_readfirstlane(tid >> 6), lane = tid & 63, g4 = lane >> 4, rows0 = ch * 128;
    const bf16_t* Z = (const bf16_t*)(p.ws + WS_R + R_Z); bf16_t* BR = (bf16_t*)(p.ws + WS_R + R_BR);
    const bf16_t* WCM = (const bf16_t*)(p.ws + WS_WM + (size_t)l * WM_STRIDE + WM_CM);
    LAS unsigned char* vn = lds + 1024;
    { const int q = tid >> 2, cs = (tid & 3) * 32; const f32x2 st2 = *(const f32x2*)((const float*)(p.ws + WS_R + R_STAT) + (size_t)(rows0 + q) * 2); const float mean = st2[0], rstd = st2[1];
      const float* lg = kin(I_CMLNG) + l * 512 + g * 128 + cs; const float* lb = kin(I_CMLNB) + l * 512 + g * 128 + cs;
#pragma unroll
      for (int j = 0; j < 4; ++j) { const u32x4 v = *(const u32x4*)(Z + (size_t)(rows0 + q) * ZW + ZC_AV + g * 128 + cs + 8 * j);
          const f32x4 ga = *(const f32x4*)(lg + 8 * j), gb = *(const f32x4*)(lg + 8 * j + 4), ba = *(const f32x4*)(lb + 8 * j), bb = *(const f32x4*)(lb + 8 * j + 4);
          u32x4 o;
          o.x = pk2((geluf_(lo16(v.x)) - mean) * rstd * ga[0] + ba[0], (geluf_(hi16(v.x)) - mean) * rstd * ga[1] + ba[1]);
          o.y = pk2((geluf_(lo16(v.y)) - mean) * rstd * ga[2] + ba[2], (geluf_(hi16(v.y)) - mean) * rstd * ga[3] + ba[3]);
          o.z = pk2((geluf_(lo16(v.z)) - mean) * rstd * gb[0] + bb[0], (geluf_(hi16(v.z)) - mean) * rstd * gb[1] + bb[1]);
          o.w = pk2((geluf_(lo16(v.w)) - mean) * rstd * gb[2] + bb[2], (geluf_(hi16(v.w)) - mean) * rstd * gb[3] + bb[3]);
          *(LAS u32x4*)(vn + q * 272 + (cs + 8 * j) * 2) = o; } }
    __syncthreads();
    { const int pb = wave, pp = pb * 16 + (lane & 15);
      bf16x8 bfr[4];
#pragma unroll
      for (int ks = 0; ks < 4; ++ks) bfr[ks] = *(const bf16x8*)(WCM + (size_t)(g * 128 + pp) * 128 + 32 * ks + 8 * g4);
      const unsigned vna = tr_lane(lds_addr(vn), 272, 8, lane);
      const float bs = kin(I_CMBS)[l * 512 + g * 128 + pp];
      const size_t row = (size_t)(rows0 + pp);
      u32x2 uq[8];
#pragma unroll
      for (int i = 0; i < 8; ++i) uq[i] = *(const u32x2*)(Z + row * ZW + ZC_AU + g * 128 + 16 * i + 4 * g4);
      sfor<0, 2>([&](auto cg_) { constexpr int cg = decltype(cg_)::value; f32x4 acc[4];
#pragma unroll
          for (int i = 0; i < 4; ++i) acc[i] = (f32x4){0.f, 0.f, 0.f, 0.f};
          sfor<0, 4>([&](auto ks_) { constexpr int ks = decltype(ks_)::value; bf16x8 af[4]; tr_frag4_i<32 * ks * 272 + 128 * cg, 4 * 272>(vna, af);
#pragma unroll
              for (int i = 0; i < 4; ++i) acc[i] = mfma16(af[i], bfr[ks], acc[i]); });
#pragma unroll
          for (int i = 0; i < 4; ++i) { const int c = 16 * (4 * cg + i) + 4 * g4;
          const u32x2 uu = uq[4 * cg + i];
          u32x2 o; o.x = pk2(geluf_(lo16(uu.x)) * (acc[i][0] + bs), geluf_(hi16(uu.x)) * (acc[i][1] + bs)); o.y = pk2(geluf_(lo16(uu.y)) * (acc[i][2] + bs), geluf_(hi16(uu.y)) * (acc[i][3] + bs));
          *(u32x2*)(BR + row * BRW + g * 128 + c) = o; } }); }
    __syncthreads();
}

__device__ __forceinline__ void ret_stage_qk(const bf16_t* src  , const float* rope, bool do_rope, int tpos0, int mask  , LAS unsigned char* t0, LAS unsigned char* t1, LAS unsigned char* t2,
                                             float sc0, float l2a, float offa, float siga, float l2b, float offb, float sigb, int tid) {
    const int pp = tid >> 2, half = (tid >> 1) & 1, sub = tid & 1;
    const bf16_t* s = src + (size_t)pp * ZW + 32 * half + 8 * sub;
    const u32x4 a = *(const u32x4*)s, b = *(const u32x4*)(s + 16);
    float x1[8] = {lo16(a.x), hi16(a.x), lo16(a.y), hi16(a.y), lo16(a.z), hi16(a.z), lo16(a.w), hi16(a.w)};
    float x2[8] = {lo16(b.x), hi16(b.x), lo16(b.y), hi16(b.y), lo16(b.z), hi16(b.z), lo16(b.w), hi16(b.w)};
    float o1[8], o2[8];
    if (do_rope) { const int t = tpos0 + pp, pos = half ? (t & 63) : (t >> 6); const f32x4* tb = (const f32x4*)(rope + (size_t)(pos * 16 + 8 * sub) * 2);
#pragma unroll
        for (int j = 0; j < 4; ++j) { const f32x4 cs = tb[j];
            o1[2 * j] = x1[2 * j] * cs[0] - x2[2 * j] * cs[1]; o2[2 * j] = x1[2 * j] * cs[1] + x2[2 * j] * cs[0];
            o1[2 * j + 1] = x1[2 * j + 1] * cs[2] - x2[2 * j + 1] * cs[3]; o2[2 * j + 1] = x1[2 * j + 1] * cs[3] + x2[2 * j + 1] * cs[2]; } }
    else {
#pragma unroll
        for (int j = 0; j < 8; ++j) { o1[j] = x1[j]; o2[j] = x2[j]; } }
    const int off = pp * 144 + (32 * half + 8 * sub) * 2;
    const float fp = (float)pp;
    const float sA = sc0 * __builtin_amdgcn_exp2f((offa + siga * fp) * l2a), sB = sc0 * __builtin_amdgcn_exp2f((offb + sigb * fp) * l2b);
    if (mask & 1) { u32x4 w; w.x = pk2(o1[0] * sc0, o1[1] * sc0); w.y = pk2(o1[2] * sc0, o1[3] * sc0); w.z = pk2(o1[4] * sc0, o1[5] * sc0); w.w = pk2(o1[6] * sc0, o1[7] * sc0); *(LAS u32x4*)(t0 + off) = w;
              w.x = pk2(o2[0] * sc0, o2[1] * sc0); w.y = pk2(o2[2] * sc0, o2[3] * sc0); w.z = pk2(o2[4] * sc0, o2[5] * sc0); w.w = pk2(o2[6] * sc0, o2[7] * sc0); *(LAS u32x4*)(t0 + off + 32) = w; }
    if (mask & 2) { u32x4 w; w.x = pk2(o1[0] * sA, o1[1] * sA); w.y = pk2(o1[2] * sA, o1[3] * sA); w.z = pk2(o1[4] * sA, o1[5] * sA); w.w = pk2(o1[6] * sA, o1[7] * sA); *(LAS u32x4*)(t1 + off) = w;
              w.x = pk2(o2[0] * sA, o2[1] * sA); w.y = pk2(o2[2] * sA, o2[3] * sA); w.z = pk2(o2[4] * sA, o2[5] * sA); w.w = pk2(o2[6] * sA, o2[7] * sA); *(LAS u32x4*)(t1 + off + 32) = w; }
    if (mask & 4) { u32x4 w; w.x = pk2(o1[0] * sB, o1[1] * sB); w.y = pk2(o1[2] * sB, o1[3] * sB); w.z = pk2(o1[4] * sB, o1[5] * sB); w.w = pk2(o1[6] * sB, o1[7] * sB); *(LAS u32x4*)(t2 + off) = w;
              w.x = pk2(o2[0] * sB, o2[1] * sB); w.y = pk2(o2[2] * sB, o2[3] * sB); w.z = pk2(o2[4] * sB, o2[5] * sB); w.w = pk2(o2[6] * sB, o2[7] * sB); *(LAS u32x4*)(t2 + off + 32) = w; }
}
__device__ __forceinline__ void ret_stage_v(const bf16_t* src  , LAS unsigned char* tv, int tid) {
    const int pp = tid >> 2, seg = (tid & 3) * 32;
#pragma unroll
    for (int j = 0; j < 4; ++j) *(LAS u32x4*)(tv + pp * 272 + (seg + 8 * j) * 2) = *(const u32x4*)(src + (size_t)pp * ZW + seg + 8 * j);
}
__device__ __forceinline__ float log2_gamma(const Params& p, int l, int dir, int h) { const float x = kin(I_DECAY)[(l * 2 + dir) * 4 + h]; return -log2f(1.0f + expf(-x)); }
__device__ __forceinline__ int ret_row0(int b, int cc) { return cc < 2 ? NL + b * 256 + cc * 128 : b * 2048 + (cc - 2) * 128; }

__device__ __forceinline__ void retkv_unit(const Params& p, LAS unsigned char* lds, int l, int b, int h, int cc, int tid) {
    const int wave = __builtin_amdgcn_readfirstlane(tid >> 6), lane = tid & 63, g4 = lane >> 4, row0 = ret_row0(b, cc);
    const bf16_t* Z = (const bf16_t*)(p.ws + WS_R + R_Z); float* KV = (float*)(p.ws + WS_R + R_KV);
    const float l2f = log2_gamma(p, l, 0, h), l2b = log2_gamma(p, l, 1, h);
    LAS unsigned char* kf = lds; LAS unsigned char* kb = lds + 18432; LAS unsigned char* vv = lds + 36864;
    ret_stage_qk(Z + (size_t)row0 * ZW + ZC_RK + h * 64, (const float*)(p.ws + WS_ROPE), cc >= 2, (cc - 2) * 128, 6, kf, kf, kb, 0.125f, l2f, 127.f, -1.f, l2b, 0.f, 1.f, tid);
    ret_stage_v(Z + (size_t)row0 * ZW + ZC_RV + h * 128, vv, tid);
    __syncthreads();
    { const int dir = wave >> 2, db = wave & 3; const unsigned ka = tr_lane(lds_addr(dir ? kb : kf), 144, 8, lane) + 32 * db, va = tr_lane(lds_addr(vv), 272, 8, lane);
      bf16x8 afr[4];
      sfor<0, 4>([&](auto ks_) { constexpr int ks = decltype(ks_)::value; afr[ks] = tr_frag_i<32 * ks * 144, 32 * ks * 144 + 4 * 144>(ka); });
      float* dst = KV + ((((size_t)b * 4 + h) * NCHUNK + cc) * 2 + dir) * 8192;
      sfor<0, 2>([&](auto eg_) { constexpr int eg = decltype(eg_)::value; f32x4 acc[4];
#pragma unroll
          for (int i = 0; i < 4; ++i) acc[i] = (f32x4){0.f, 0.f, 0.f, 0.f};
          sfor<0, 4>([&](auto ks_) { constexpr int ks = decltype(ks_)::value; bf16x8 bf[4]; tr_frag4_i<32 * ks * 272 + 128 * eg, 4 * 272>(va, bf);
#pragma unroll
              for (int i = 0; i < 4; ++i) acc[i] = mfma16(afr[ks], bf[i], acc[i]); });
#pragma unroll
          for (int i = 0; i < 4; ++i)
#pragma unroll
              for (int r = 0; r < 4; ++r) dst[(16 * db + 4 * g4 + r) * 128 + 16 * (4 * eg + i) + (lane & 15)] = acc[i][r]; }); }
    __syncthreads();
}

__device__ __forceinline__ void retout_unit(const Params& p, LAS unsigned char* lds, int l, int b, int h, int cc, int tid) {
    const int wave = __builtin_amdgcn_readfirstlane(tid >> 6), lane = tid & 63, g4 = lane >> 4, row0 = ret_row0(b, cc);
    const bf16_t* Z = (const bf16_t*)(p.ws + WS_R + R_Z); bf16_t* BR = (bf16_t*)(p.ws + WS_R + R_BR);
    const float l2f = log2_gamma(p, l, 0, h), l2b = log2_gamma(p, l, 1, h);
    LAS unsigned char* tq = lds; LAS unsigned char* tqf = lds + 18432; LAS unsigned char* tqb = lds + 36864; LAS unsigned char* tk = lds + 55296;
    LAS unsigned char* tv = lds + 73728; LAS unsigned char* st = lds + 108544;
    { const u32x4* src = (const u32x4*)((const bf16_t*)(p.ws + WS_R + R_ST) + (((size_t)b * 4 + h) * NCHUNK + cc) * 2 * 8192);
#pragma unroll
      for (int j = 0; j < 4; ++j) { const int c = tid + 512 * j; *(LAS u32x4*)(st + (c >> 4) * 272 + (c & 15) * 16) = src[c]; } }
    const float* rope = (const float*)(p.ws + WS_ROPE);
    ret_stage_qk(Z + (size_t)row0 * ZW + ZC_RQ + h * 64, rope, cc >= 2, (cc - 2) * 128, 7, tq, tqf, tqb, 1.0f, l2f, 1.f, 1.f, l2b, 128.f, -1.f, tid);
    ret_stage_qk(Z + (size_t)row0 * ZW + ZC_RK + h * 64, rope, cc >= 2, (cc - 2) * 128, 1, tk, tk, tk, 0.125f, 0.f, 0.f, 0.f, 0.f, 0.f, 0.f, tid);
    ret_stage_v(Z + (size_t)row0 * ZW + ZC_RV + h * 128, tv, tid);
    __syncthreads();
    const int ib = wave, ti = ib * 16 + (lane & 15);
    f32x4 oacc[8];
#pragma unroll
    for (int eb = 0; eb < 8; ++eb) oacc[eb] = (f32x4){0.f, 0.f, 0.f, 0.f};
    { bf16x8 bq[4];
#pragma unroll
      for (int ks = 0; ks < 4; ++ks) bq[ks] = *(const LAS bf16x8*)((ks < 2 ? tqf : tqb) + ti * 144 + (32 * (ks & 1) + 8 * g4) * 2);
      const unsigned sa = tr_lane(lds_addr(st), 272, 8, lane);
      sfor<0, 4>([&](auto ks_) { constexpr int ks = decltype(ks_)::value;
          sfor<0, 2>([&](auto eg_) { constexpr int eg = decltype(eg_)::value; bf16x8 af[4]; tr_frag4_i<32 * ks * 272 + 128 * eg, 4 * 272>(sa, af);
#pragma unroll
              for (int i = 0; i < 4; ++i) oacc[4 * eg + i] = mfma16(af[i], bq[ks], oacc[4 * eg + i]); }); }); }
    { bf16x8 bq[2];
#pragma unroll
      for (int ks = 0; ks < 2; ++ks) bq[ks] = *(const LAS bf16x8*)(tq + ti * 144 + (32 * ks + 8 * g4) * 2);
      f32x4 sacc[8];
#pragma unroll
      for (int jb = 0; jb < 8; ++jb) { sacc[jb] = (f32x4){0.f, 0.f, 0.f, 0.f};
#pragma unroll
          for (int ks = 0; ks < 2; ++ks) { const bf16x8 a = *(const LAS bf16x8*)(tk + (16 * jb + (lane & 15)) * 144 + (32 * ks + 8 * g4) * 2); sacc[jb] = mfma16(a, bq[ks], sacc[jb]); }
#pragma unroll
          for (int r = 0; r < 4; ++r) { const int dist = ti - (16 * jb + 4 * g4 + r);
              sacc[jb][r] *= dist >= 0 ? __builtin_amdgcn_exp2f((float)dist * l2f) : __builtin_amdgcn_exp2f((float)(-dist) * l2b); } }
      const unsigned va = tr_lane(lds_addr(tv), 272, 4, lane);
      sfor<0, 4>([&](auto kk_) { constexpr int kk = decltype(kk_)::value;
          u32x4 pw; pw.x = pk2(sacc[2 * kk][0], sacc[2 * kk][1]); pw.y = pk2(sacc[2 * kk][2], sacc[2 * kk][3]); pw.z = pk2(sacc[2 * kk + 1][0], sacc[2 * kk + 1][1]); pw.w = pk2(sacc[2 * kk + 1][2], sacc[2 * kk + 1][3]);
          const bf16x8 bp = as_frag(pw);
          sfor<0, 2>([&](auto eg_) { constexpr int eg = decltype(eg_)::value; bf16x8 af[4]; tr_frag4_i<32 * kk * 272 + 128 * eg, 16 * 272>(va, af);
#pragma unroll
              for (int i = 0; i < 4; ++i) oacc[4 * eg + i] = mfma16(af[i], bp, oacc[4 * eg + i]); }); }); }
    { float ss = 0.f;
#pragma unroll
      for (int eb = 0; eb < 8; ++eb) ss += (oacc[eb][0] * oacc[eb][0] + oacc[eb][1] * oacc[eb][1]) + (oacc[eb][2] * oacc[eb][2] + oacc[eb][3] * oacc[eb][3]);
      ss += shx(ss, 16, lane); ss += shx(ss, 32, lane);
      const float rstd = rsqrtf(ss * (1.0f / 128.0f) + EPS);
      const size_t row = (size_t)(row0 + ti);
      u32x2 gq[8];
#pragma unroll
      for (int eb = 0; eb < 8; ++eb) gq[eb] = *(const u32x2*)(Z + row * ZW + ZC_RG + h * 128 + 16 * eb + 4 * g4);
#pragma unroll
      for (int eb = 0; eb < 8; ++eb) { const int e = 16 * eb + 4 * g4; const u32x2 gg = gq[eb];
          u32x2 o; o.x = pk2(oacc[eb][0] * rstd * siluf_(lo16(gg.x)), oacc[eb][1] * rstd * siluf_(hi16(gg.x))); o.y = pk2(oacc[eb][2] * rstd * siluf_(lo16(gg.y)), oacc[eb][3] * rstd * siluf_(hi16(gg.y)));
          *(u32x2*)(BR + row * BRW + 1024 + h * 128 + e) = o; } }
    __syncthreads();
}

constexpr int NA_V = 0, NA_PITCH = 144, NA_CTXROW = 576, NA_TAB = (576 + 256) * NA_PITCH  , NA_MB = NA_TAB + 2048  , NA_MB_SZ = 18432;
static_assert(NA_MB + NA_MB_SZ <= LDS_BYTES - 1024, "NA LDS");
__device__ __forceinline__ void na_unit(const Params& p, LAS unsigned char* lds, int l, int b, int h, int rp, bool local, int tid) {
    const int wave = __builtin_amdgcn_readfirstlane(tid >> 6), lane = tid & 63, g4 = lane >> 4, qb = wave >> 1, half = wave & 1;
    const bf16_t* Z = (const bf16_t*)(p.ws + WS_R + R_Z); bf16_t* BR = (bf16_t*)(p.ws + WS_R + R_BR);
    LAS unsigned char* vl = lds + NA_V; LAS float* tab = (LAS float*)(lds + NA_TAB);
    const int qc = 16 * qb + (lane & 15);
    const int r0 = 2 * rp, rsA = min(max(r0 - 4, 0), 24), nwr = min(9, 32 - rsA);
    const int kbs = min(max(16 * qb - 8, 0), 32), cst = min(max(qc - 8, 0), 48);
    if (local) {
        for (int key = tid; key < nwr * 64; key += NTHREADS) { const size_t krow = (size_t)b * 2048 + (rsA + (key >> 6)) * 64 + (key & 63);
            const u32x4* vs_ = (const u32x4*)(Z + krow * ZW + ZC_NV + h * 64);
#pragma unroll
            for (int j = 0; j < 8; ++j) *(LAS u32x4*)(vl + key * NA_PITCH + 16 * j) = vs_[j]; }
        if (tid < 465) tab[tid] = kin(I_RPB)[(size_t)(l * 8 + h) * 465 + tid]; }
    { const int key = tid >> 1, hb = (tid & 1) * 4; const u32x4* vs_ = (const u32x4*)(Z + ((size_t)NL + b * 256 + key) * ZW + ZC_NV + h * 64) + hb;
#pragma unroll
      for (int j = 0; j < 4; ++j) *(LAS u32x4*)(vl + (NA_CTXROW + key) * NA_PITCH + 16 * (hb + j)) = vs_[j]; }
    __syncthreads();
    const float L2E = 1.44269504089f;
    const unsigned vla = lds_addr(vl);
    const unsigned lane_off = (unsigned)((4 * g4 + ((lane & 15) >> 2)) * NA_PITCH + (lane & 3) * 8);
#pragma unroll 1
    for (int jr = 0; jr < 2; ++jr) {
        const int r = r0 + jr, rs = min(max(r - 4, 0), 24), wofs = rs - rsA;
        const size_t qrow = local ? (size_t)b * 2048 + r * 64 + qc : (size_t)NL + b * 256 + r * 64 + qc;
        bf16x8 bq[2];
#pragma unroll
        for (int ks = 0; ks < 2; ++ks) bq[ks] = *(const bf16x8*)(Z + qrow * ZW + ZC_NQ + h * 64 + 32 * ks + 8 * g4);
        bf16x8 kf[16];
        if (local) {
#pragma unroll
            for (int blk = 0; blk < 8; ++blk) { const size_t krow = (size_t)b * 2048 + (rs + 4 * half + (blk >> 1)) * 64 + kbs + 16 * (blk & 1) + (lane & 15);
#pragma unroll
                for (int ks = 0; ks < 2; ++ks) kf[blk * 2 + ks] = *(const bf16x8*)(Z + krow * ZW + ZC_NK + h * 64 + 32 * ks + 8 * g4); } }
        f32x4 s[16]; float mx = -1e30f;
        if (local) {
#pragma unroll
            for (int blk = 0; blk < 8; ++blk) { const int i = 4 * half + (blk >> 1), cb = blk & 1;
                f32x4 a = (f32x4){0.f, 0.f, 0.f, 0.f};
#pragma unroll
                for (int ks = 0; ks < 2; ++ks) a = mfma16(kf[blk * 2 + ks], bq[ks], a);
                const int ro = rs + i - r + 7;
#pragma unroll
                for (int rg = 0; rg < 4; ++rg) { const int kc = kbs + 16 * cb + 4 * g4 + rg; const bool valid = kc >= cst && kc < cst + 16;
                    const int co = min(max(kc - qc, -15), 15) + 15;
                    const float bv = tab[ro * 31 + co];
                const float v = valid ? a[rg] * 0.125f + bv : -1e30f; s[blk][rg] = v; mx = fmaxf(mx, v); } }
        } else {
#pragma unroll
            for (int blk = 0; blk < 8; ++blk) s[blk] = (f32x4){-1e30f, -1e30f, -1e30f, -1e30f};
        }
#pragma unroll
        for (int blk = 0; blk < 8; ++blk) { const size_t krow = (size_t)NL + b * 256 + half * 128 + 16 * blk + (lane & 15);
#pragma unroll
            for (int ks = 0; ks < 2; ++ks) kf[blk * 2 + ks] = *(const bf16x8*)(Z + krow * ZW + ZC_NK + h * 64 + 32 * ks + 8 * g4); }
#pragma unroll
        for (int blk = 0; blk < 8; ++blk) { f32x4 a = (f32x4){0.f, 0.f, 0.f, 0.f};
#pragma unroll
            for (int ks = 0; ks < 2; ++ks) a = mfma16(kf[blk * 2 + ks], bq[ks], a);
#pragma unroll
            for (int rg = 0; rg < 4; ++rg) { const float v = a[rg] * 0.125f; s[8 + blk][rg] = v; mx = fmaxf(mx, v); } }
        mx = fmaxf(mx, shx(mx, 16, lane)); mx = fmaxf(mx, shx(mx, 32, lane));
        float ls = 0.f;
#pragma unroll
        for (int blk = 0; blk < 16; ++blk)
#pragma unroll
            for (int rg = 0; rg < 4; ++rg) { const float e = __builtin_amdgcn_exp2f((s[blk][rg] - mx) * L2E); s[blk][rg] = e; ls += e; }
        ls += shx(ls, 16, lane); ls += shx(ls, 32, lane);
        f32x4 oacc[4];
#pragma unroll
        for (int db = 0; db < 4; ++db) oacc[db] = (f32x4){0.f, 0.f, 0.f, 0.f};
        if (local) { const unsigned va = vla + (unsigned)(((wofs + 4 * half) * 64 + kbs) * NA_PITCH) + lane_off;
            sfor<0, 4>([&](auto kk_) { constexpr int kk = decltype(kk_)::value;
                u32x4 pw; pw.x = pk2(s[2 * kk][0], s[2 * kk][1]); pw.y = pk2(s[2 * kk][2], s[2 * kk][3]); pw.z = pk2(s[2 * kk + 1][0], s[2 * kk + 1][1]); pw.w = pk2(s[2 * kk + 1][2], s[2 * kk + 1][3]);
                const bf16x8 bp = as_frag(pw); bf16x8 vf[4]; tr_frag4_i<kk * 64 * NA_PITCH, 16 * NA_PITCH>(va, vf);
#pragma unroll
                for (int db = 0; db < 4; ++db) oacc[db] = mfma16(vf[db], bp, oacc[db]); }); }
        { const unsigned va = vla + (unsigned)((NA_CTXROW + half * 128) * NA_PITCH) + lane_off;
          sfor<0, 4>([&](auto kk_) { constexpr int kk = decltype(kk_)::value;
              u32x4 pw; pw.x = pk2(s[8 + 2 * kk][0], s[8 + 2 * kk][1]); pw.y = pk2(s[8 + 2 * kk][2], s[8 + 2 * kk][3]); pw.z = pk2(s[9 + 2 * kk][0], s[9 + 2 * kk][1]); pw.w = pk2(s[9 + 2 * kk][2], s[9 + 2 * kk][3]);
              const bf16x8 bp = as_frag(pw); bf16x8 vf[4]; tr_frag4_i<kk * 32 * NA_PITCH, 16 * NA_PITCH>(va, vf);
#pragma unroll
              for (int db = 0; db < 4; ++db) oacc[db] = mfma16(vf[db], bp, oacc[db]); }); }
        LAS float* mb = (LAS float*)(lds + NA_MB) + (qb * 64 + lane) * 18;
        if (half == 1) { mb[0] = mx; mb[1] = ls;
#pragma unroll
            for (int db = 0; db < 4; ++db)
#pragma unroll
                for (int rg = 0; rg < 4; ++rg) mb[2 + db * 4 + rg] = oacc[db][rg]; }
        __syncthreads();
        if (half == 0) { const float m1 = mb[0], l1 = mb[1], M = fmaxf(mx, m1), a0 = __builtin_amdgcn_exp2f((mx - M) * L2E), a1 = __builtin_amdgcn_exp2f((m1 - M) * L2E);
            const float inv = 1.0f / (ls * a0 + l1 * a1);
#pragma unroll
            for (int db = 0; db < 4; ++db) { float o[4];
#pragma unroll
                for (int rg = 0; rg < 4; ++rg) o[rg] = (oacc[db][rg] * a0 + mb[2 + db * 4 + rg] * a1) * inv;
                u32x2 w; w.x = pk2(o[0], o[1]); w.y = pk2(o[2], o[3]);
                *(u32x2*)(BR + qrow * BRW + 512 + h * 64 + 16 * db + 4 * g4) = w; } }
        __syncthreads();
    }
}

#ifndef STAMP_PHASE
#define STAMP_PHASE -1
#endif
constexpr int PH_PER_LAYER = 10, PH_FINAL = 1 + 2 * PH_PER_LAYER, NPHASES = PH_FINAL + 1;
__device__ __forceinline__ void moe_tables(const Params& p, LAS unsigned char* lds, int l, int tid, int nsplit, int nMs, int G, int c) {
    LAS int* tb = (LAS int*)(lds + MOE_TAB_OFF); LAS int* cn = tb + 128;
    if (tid < 64) { const unsigned c = ((const unsigned*)(p.ws + WS_CTL))[CW_CNT + l * 2048 + tid * 16]; cn[tid] = (int)(c < (unsigned)NT ? c : (unsigned)NT); }
    __syncthreads();
    if (tid == 0) { int s = 0; for (int e = 0; e < 64; ++e) { tb[e] = s; s += (cn[e] + 255) >> 8; } tb[64] = s; }
    __syncthreads();
    if (tid < MOE_UL_MAX) { LAS int* ul = (LAS int*)(lds + MOE_UL_OFF) + tid * 8; const int ntr = tb[64];
        const int idx = tid * G + ((G & 7) == 0 ? (c & 7) * (G >> 3) + (c >> 3) : c);
        if (idx >= nsplit * (ntr + nMs)) ul[0] = -1;
        else if (idx < nsplit * ntr) { const int mt = idx / nsplit, pn = idx % nsplit; int lo = 0, hi = 63;
            for (int it = 0; it < 6; ++it) { const int mid = (lo + hi + 1) >> 1; if (tb[mid] <= mt) lo = mid; else hi = mid - 1; }
            ul[0] = lo; ul[1] = pn; ul[2] = (mt - tb[lo]) * 256; ul[3] = mt; ul[4] = cn[lo]; }
        else { const int s_ = idx - nsplit * ntr; ul[0] = 64; ul[1] = s_ % nsplit; ul[2] = 0; ul[3] = s_ / nsplit; ul[4] = 0; } }
    __syncthreads();
}

__global__ void __launch_bounds__(NTHREADS, 2) fwd_kernel(Params p0) {
    extern __shared__ __attribute__((aligned(16))) unsigned char lds_raw[];
    LAS unsigned char* const lds0 = (LAS unsigned char*)lds_raw;
    const int tid0 = threadIdx.x, G = gridDim.x, bid = blockIdx.x, NGW = G * NWAVES;
    const int wave0 = __builtin_amdgcn_readfirstlane(tid0 >> 6);
#define PHASE_IDS const int tid = launder(wave0 * 64 + lane_id_here()), wave = __builtin_amdgcn_readfirstlane(tid >> 6), lane = tid & 63, gw = bid * NWAVES + wave; (void)lane; (void)gw; \
    Params p = p0; p.ws = kws_ptr(); p.out = kout_ptr(); \
    LAS unsigned char* lds; { unsigned la_ = (unsigned)(size_t)lds0; asm volatile("" : "+s"(la_)); lds = (LAS unsigned char*)(size_t)la_; }
    volatile LAS unsigned* xbw = (volatile LAS unsigned*)(lds0 + LDS_BYTES - 16);
    if (tid0 == 0) { xbw[0] = 0u; xbw[1] = 0u; xbw[2] = 0u; xbw[3] = 0u; }
    __syncthreads();
    XcdBarrier bar = xcd_barrier_post((unsigned*)(p0.ws + WS_CTL) + CW_BAR + p0.li * XCD_BAR_WORDS, xbw);
#ifdef TEST_PHASE
#define IN(k) ((((k) - 1) % PH_PER_LAYER == TEST_PHASE - 1 && (k) >= 1 && (k) < PH_FINAL && TEST_PHASE >= 1) || ((k) == 0 && TEST_PHASE == 0) || ((k) == PH_FINAL && TEST_PHASE == 99)) && (launder_s(p0.ph_lo) <= (k) && (k) < launder_s(p0.ph_hi))
#else
#define IN(k) (launder_s(p0.ph_lo) <= (k) && (k) < launder_s(p0.ph_hi))
#endif
#ifndef DUP_PHASE
#define DUP_PHASE -1
#endif
#define DUP(k) for (int rep_ = 0; rep_ < ((DUP_PHASE) == (k) ? 2 : 1); ++rep_)
#ifdef TIMING
    volatile LAS unsigned long long* tst = (volatile LAS unsigned long long*)(lds0 + LDS_BYTES - 16 - 512);
    if (wave0 == 0 && lane_id_here() == 0) tst[0] = __builtin_amdgcn_s_memrealtime();
#define SEAM(k) do { if (IN(k) && IN((k) + 1)) { xcd_barrier(bar, wave0 == 0 && lane_id_here() == 0); if (wave0 == 0 && lane_id_here() == 0) tst[(k) + 1] = __builtin_amdgcn_s_memrealtime(); } } while (0)
#else
#define SEAM(k) do { if (IN(k) && IN((k) + 1)) xcd_barrier(bar, wave0 == 0 && lane_id_here() == 0); } while (0)
#endif
#define Hb ((bf16_t*)(p.ws + WS_H))
#define Zb ((bf16_t*)(p.ws + WS_R + R_Z))
#define BRb ((bf16_t*)(p.ws + WS_R + R_BR))
#define XC ((float*)(p.ws + WS_XC))
#define xl (l == 0 ? kin(I_X) : (const float*)p.out)
#define xc (l == 0 ? kin(I_CTX) : (const float*)XC)
#define mod ((const float*)(p.ws + WS_MOD) + (size_t)l * 9 * 6144)
#define wm (p.ws + WS_WM + (size_t)l * WM_STRIDE)

    if (IN(0)) { DUP(100) {
        PHASE_IDS;
        for (int u = bid; u < 192; u += G) mod_unit(p, lds, u, tid);
        if (bid == G - 1) { float* rope = (float*)(p.ws + WS_ROPE);
            for (int idx = tid; idx < 1024; idx += NTHREADS) { const int pos = idx >> 4, f = idx & 15; const float inv = exp2f(-(float)f * (13.287712379549449f / 16.0f));
                float x = (float)pos * inv * 0.15915494309189535f; x -= floorf(x);
                rope[idx * 2] = __builtin_amdgcn_cosf(x); rope[idx * 2 + 1] = __builtin_amdgcn_sinf(x); } }
        __syncthreads();
        LAS float* scr = (LAS float*)(lds + wave * 8448);
        for (int it = gw; it < 2 * MISC_ITEMS; it += NGW) {
            if (it < MISC_ITEMS) misc_item(p, 0, it, scr, lane);
            else misc_item(p, 1, it - MISC_ITEMS, scr, lane); }
        __syncthreads();
    } }
    SEAM(0);

    for (int l = 0; l < DEPTH; ++l) {
        const int base = 1 + PH_PER_LAYER * l;
        const bool need_ctx = l < DEPTH - 1;
        const int Mrows = need_ctx ? NT : NL;

        if (IN(base + 0)) { DUP(0) {
            PHASE_IDS;
            const float* const nmg = kin(I_NMG) + l * 1024; const float* const xin = kin(I_X); const float* const cin = kin(I_CTX);
            for (int row = gw; row < NT; row += NGW) { const bool lat = row < NL;
                const float* mr = mod + (size_t)(lat ? (row >> 11) : 8) * 6144;
                f32x4 v[4];
                if (l == 0) { const float* xr = lat ? xin + (size_t)row * D : cin + (size_t)(row - NL) * D;
#pragma unroll
                    for (int j = 0; j < 4; ++j) v[j] = ((const f32x4*)xr)[64 * j + lane]; }
                else { float* xr = lat ? p.out + (size_t)row * D : XC + (size_t)(row - NL) * D;
                    combine_row(v, xr, mr - 9 * 6144 + 5120, Hb + (size_t)row * D, (const unsigned char*)(p.ws + WS_R + R_O) + (size_t)row * 8 * 1024, lane);
#pragma unroll
                    for (int j = 0; j < 4; ++j) ((f32x4*)xr)[64 * j + lane] = v[j]; }
                norm_mod_vals_f8(v, nmg, mr, mr + 1024, (unsigned char*)Hb + (size_t)row * D, lane); }
        } }
        SEAM(base + 0);
        if (IN(base + 1)) { DUP(1) {
            PHASE_IDS;
            DenseSchedT<1> S{(const char*)Hb, (const char*)(wm + WM_IN), 1024, 1024, NT / 256, INW / 256, G, bid, 1, 0, 0};
            EpiStoreBf16 E{Zb, ZW, 16, (unsigned char*)(p.ws + WS_R + R_G8), 0.03125f};
            pg8::gemm_phase<true>(lds, tid, 1024, 1024, S, E, (STAMP_PHASE == 2 && l == 0 && bid == 0) ? 25 : -1);
        } }
        SEAM(base + 1);
        if (IN(base + 2)) { DUP(2) {
            PHASE_IDS;
#ifndef DUP_SUB
#define DUP_SUB -1
#endif
            for (int rs_ = 0; rs_ < (DUP_SUB == 0 ? 2 : 1); ++rs_) for (int u = bid; u < 1024; u += G) na_unit(p, lds, l, u >> 7, (u >> 4) & 7, u & 15, true, tid);
            if (need_ctx) for (int u = bid; u < 128; u += G) na_unit(p, lds, l, u >> 4, (u >> 1) & 7, u & 1, false, tid);
            for (int rs_ = 0; rs_ < (DUP_SUB == 1 ? 2 : 1); ++rs_) for (int u = (bid + 64) % G; u < 576; u += G) retkv_unit(p, lds, l, u / 72, (u / 18) % 4, u % 18, tid);
        } }
        SEAM(base + 2);
        if (IN(base + 3)) { DUP(3) {
            PHASE_IDS;
            const float* KV = (const float*)(p.ws + WS_R + R_KV); bf16_t* ST = (bf16_t*)(p.ws + WS_R + R_ST);
            for (int gi = bid * NTHREADS + tid; gi < 64 * 2048; gi += G * NTHREADS) {
                const int combo = gi >> 11, e4 = (gi & 2047) * 4, bh = combo >> 1, dir = combo & 1, h = bh & 3;
                const float dec = __builtin_amdgcn_exp2f(128.f * log2_gamma(p, l, dir, h));
                const float* kv = KV + (size_t)bh * NCHUNK * 2 * 8192 + (size_t)dir * 8192 + e4; bf16_t* st = ST + (size_t)bh * NCHUNK * 2 * 8192 + (size_t)dir * 8192 + e4;
                f32x4 q[NCHUNK];
#pragma unroll
                for (int y = 0; y < NCHUNK; ++y) q[y] = *(const f32x4*)(kv + (size_t)y * 2 * 8192);
                f32x4 sacc = (f32x4){0.f, 0.f, 0.f, 0.f};
#pragma unroll
                for (int i = 0; i < NCHUNK; ++i) { const int y = dir == 0 ? i : (i == 0 ? 1 : (i == 1 ? 0 : 19 - i));
                    u32x2 o; o.x = pk2(sacc[0], sacc[1]); o.y = pk2(sacc[2], sacc[3]); *(u32x2*)(st + (size_t)y * 2 * 8192) = o;
                    f32x4 kvy = q[0];
#pragma unroll
                    for (int j = 1; j < NCHUNK; ++j) kvy = (j == y) ? q[j] : kvy;
                    sacc = sacc * dec + kvy; } }
            { const bf16_t* Z = (const bf16_t*)(p.ws + WS_R + R_Z); float* STAT = (float*)(p.ws + WS_R + R_STAT);
              for (int row = gw; row < Mrows; row += NGW) { const u32x4 v = *(const u32x4*)(Z + (size_t)row * ZW + ZC_AV + lane * 8);
                  const float x0 = geluf_(lo16(v.x)), x1 = geluf_(hi16(v.x)), x2 = geluf_(lo16(v.y)), x3 = geluf_(hi16(v.y)), x4 = geluf_(lo16(v.z)), x5 = geluf_(hi16(v.z)), x6 = geluf_(lo16(v.w)), x7 = geluf_(hi16(v.w));
                  const float mean = wave_sum(((x0 + x1) + (x2 + x3)) + ((x4 + x5) + (x6 + x7)), lane) * (1.0f / 512.0f);
                  const float d0 = x0 - mean, d1 = x1 - mean, d2 = x2 - mean, d3 = x3 - mean, d4 = x4 - mean, d5 = x5 - mean, d6 = x6 - mean, d7 = x7 - mean;
                  const float s2 = wave_sum(((d0 * d0 + d1 * d1) + (d2 * d2 + d3 * d3)) + ((d4 * d4 + d5 * d5) + (d6 * d6 + d7 * d7)), lane);
                  if (lane == 0) *(f32x2*)(STAT + (size_t)row * 2) = (f32x2){mean, rsqrtf(s2 * (1.0f / 512.0f) + EPS)}; } }
        } }
        SEAM(base + 3);
        if (IN(base + 4)) { DUP(4) {
            PHASE_IDS;
            const int cc_lo = need_ctx ? 0 : 2, ncc = NCHUNK - cc_lo, total = 32 * ncc;
            for (int u = bid; u < total; u += G) retout_unit(p, lds, l, u / (4 * ncc), (u / ncc) % 4, cc_lo + u % ncc, tid);
            const int nA = (Mrows / 128) * 4;
            for (int rs_ = 0; rs_ < (DUP_SUB == 2 ? 2 : 1); ++rs_) for (int u = (bid + 64) % G; u < nA; u += G) mixA_unit(p, lds, l, u >> 2, u & 3, tid);
        } }
        SEAM(base + 4);
        if (IN(base + 5)) { DUP(5) {
            PHASE_IDS;
            DenseSched S{(const char*)BRb, (const char*)(wm + WM_BR), BRW, 512, Mrows / 256, 4, G, bid, 3, 512 * 2, (size_t)1024 * 512 * 2};
#ifdef MERGE_PLAIN_DUP
            if (rep_ == 1) { EpiStoreBf16 E2{(bf16_t*)(p.ws + WS_R + R_KV), 1024, 1000, (unsigned char*)0, 1.0f}; pg8::gemm_phase(lds, tid, 512, 512, S, E2); } else
#endif
            { EpiMerge E{Hb, (const unsigned char*)(p.ws + WS_R + R_G8)};
            pg8::gemm_phase(lds, tid, 512, 512, S, E, (STAMP_PHASE == 6 && l == 0 && bid == 0) ? 25 : -1); }
            if (l == 0 && rep_ == 0 && G == 256 && bid >= 32) { LAS float* scr = (LAS float*)(lds + wave * 8448); const int fw = (bid - 32) * NWAVES + wave;
                for (int it = fw; it < FILL_SPLIT; it += 224 * NWAVES) expert_item(p, it / EXP_ITEMS, it % EXP_ITEMS, scr, lane); }
            if (l == 0 && rep_ == 0 && G != 256) { LAS float* scr = (LAS float*)(lds + wave * 8448);
                for (int it = gw; it < 2 * EXP_ITEMS; it += NGW) expert_item(p, it / EXP_ITEMS, it % EXP_ITEMS, scr, lane); }
        } }
        SEAM(base + 5);
        if (IN(base + 6)) { DUP(6) {
            PHASE_IDS;
            DenseSched S{(const char*)Hb, (const char*)(wm + WM_OUT), 1024, 1024, Mrows / 256, 4, G, bid, 1, 0, 0};
            float* const dummy = (float*)(p.ws + WS_R + R_ACT);
            EpiResid E{xl, xc, rep_ == 0 ? p.out : dummy, rep_ == 0 ? XC : dummy + (size_t)NL * D, mod + 2048};
            pg8::gemm_phase(lds, tid, 1024, 1024, S, E, (STAMP_PHASE == 7 && l == 0 && bid == 0) ? 25 : -1);
            if (l == 0 && rep_ == 0 && G == 256 && bid >= 32) { LAS float* scr = (LAS float*)(lds + wave * 8448); const int fw = (bid - 32) * NWAVES + wave;
                for (int it = FILL_SPLIT + fw; it < 2 * EXP_ITEMS; it += 224 * NWAVES) expert_item(p, it / EXP_ITEMS, it % EXP_ITEMS, scr, lane); }
        } }
        SEAM(base + 6);
        if (IN(base + 7)) { DUP(7) {
            PHASE_IDS;
            for (int u = bid; u < Mrows / 64; u += G) router_unit(p, lds, l, u, p.out, XC, tid, rep_ == 0, l == 0 && u == 0);
        } }
        SEAM(base + 7);
        if (IN(base + 8)) { DUP(8) {
            PHASE_IDS;
            moe_tables(p, lds, l, tid, 2, Mrows / 256, G, bid);
            MoeGuSched S{(const char*)Hb, (const char*)(p.ws + WS_WE + (size_t)l * WE_LAYER + WE_GU), (const char*)(wm + WM_SGU), (const unsigned*)(p.ws + WS_LIST),
                         (const LAS int*)(lds + MOE_TAB_OFF), (const LAS int*)(lds + MOE_TAB_OFF) + 128, Mrows / 256, G, bid};
            EpiGateUp E{(bf16_t*)(p.ws + WS_R + R_ACT), (bf16_t*)(p.ws + WS_R + R_ACTS), (const float*)(p.ws + WS_WL)};
            pg8::gemm_phase<true>(lds, tid, 1024, 1024, S, E, (STAMP_PHASE == 9 && l == 0 && bid == 0) ? 25 : -1);
        } }
        SEAM(base + 8);
        if (IN(base + 9)) { DUP(9) {
            PHASE_IDS;
            moe_tables(p, lds, l, tid, 4, Mrows / 256, G, bid);
            MoeDownSched S{(const char*)(p.ws + WS_R + R_ACT), (const char*)(p.ws + WS_WE + (size_t)l * WE_LAYER + WE_D), (const char*)(p.ws + WS_R + R_ACTS), (const char*)(wm + WM_SD),
                           (const LAS int*)(lds + MOE_TAB_OFF), (const LAS int*)(lds + MOE_TAB_OFF) + 128, Mrows / 256, G, bid};
            EpiDown E{(bf16_t*)(p.ws + WS_R + R_O), (const unsigned*)(p.ws + WS_LIST), Hb};
            pg8::gemm_phase<true>(lds, tid, launder_s(256), 256, S, E, (STAMP_PHASE == 10 && l == 0 && bid == 0) ? 25 : -1);
        } }
        SEAM(base + 9);
    }
#ifdef EXTRA_BARRIERS
    if (IN(PH_FINAL) && IN(PH_FINAL - 1)) for (int xb_ = 0; xb_ < EXTRA_BARRIERS; ++xb_) xcd_barrier(bar, wave0 == 0 && lane_id_here() == 0);
#endif
#ifdef TIMING
    float t_scale = 1.0f, t_add = 0.0f;
    { float* tw = (float*)(p0.ws + WS_CTL) + 1024;
      if (bid == 0 && wave0 == 0 && lane_id_here() == 0) { tw[0] = (float)(tst[TA_HI] - tst[TA_LO]) * 0.01f; }
      xcd_barrier(bar, wave0 == 0 && lane_id_here() == 0);
      t_scale = 1.0f + tw[0] / (float)(TA_DIV); t_add = 0.0f; }
#endif
    if (IN(PH_FINAL)) {
        PHASE_IDS;
        const int l = DEPTH - 1;
        f32x4 fg[4];
#pragma unroll
        for (int j = 0; j < 4; ++j) fg[j] = ((const f32x4*)kin(I_FG))[64 * j + lane];
        for (int row = gw; row < NL; row += NGW) { float* xr = p.out + (size_t)row * D;
            f32x4 v[4]; float ss = 0.f;
            combine_row(v, xr, mod + (size_t)(row >> 11) * 6144 + 5120, Hb + (size_t)row * D, (const unsigned char*)(p.ws + WS_R + R_O) + (size_t)row * 8 * 1024, lane);
#pragma unroll
            for (int j = 0; j < 4; ++j) ss += (v[j][0] * v[j][0] + v[j][1] * v[j][1]) + (v[j][2] * v[j][2] + v[j][3] * v[j][3]);
            const float rstd = rsqrtf(wave_sum(ss, lane) * (1.0f / 1024.0f) + EPS);
#pragma unroll
            for (int j = 0; j < 4; ++j) { f32x4 ov = v[j] * rstd * fg[j];
#ifdef TIMING
                ov = ov * t_scale; if (row == 0 && j == 0 && lane == 0) ov[0] += t_add;
#endif
                ((f32x4*)xr)[64 * j + lane] = ov; } }
    }
#undef IN
#undef SEAM
#undef Hb
#undef Zb
#undef BRb
#undef XC
#undef xl
#undef xc
#undef mod
#undef wm
}

#ifndef STAMP_PHASE_DEFINED
#endif
#ifndef MK_PER_PHASE
#define MK_PER_PHASE 0
#endif
extern "C" void kernel_launch(void* const* d_in, const int* in_sizes, int n_in, void* d_out, int out_size, void* d_ws, size_t ws_size, hipStream_t stream) {
    static int grid = 0;
    if (grid == 0) {
        if (n_in != 26 || out_size != NL * D || ws_size < WS_END) { fprintf(stderr, "kernel_launch: unexpected shapes (n_in %d out %d ws %zu, need %zu)\n", n_in, out_size, ws_size, (size_t)WS_END); grid = -1; return; }
        int dev = 0, cus = 0;
        if (hipGetDevice(&dev) != hipSuccess || hipDeviceGetAttribute(&cus, hipDeviceAttributeMultiprocessorCount, dev) != hipSuccess) { grid = -1; return; }
        if (hipFuncSetAttribute((const void*)fwd_kernel, hipFuncAttributeMaxDynamicSharedMemorySize, LDS_BYTES) != hipSuccess) { fprintf(stderr, "kernel_launch: hipFuncSetAttribute failed\n"); grid = -1; return; }
        int per_cu = 0;
        if (hipOccupancyMaxActiveBlocksPerMultiprocessor(&per_cu, (const void*)fwd_kernel, NTHREADS, LDS_BYTES) != hipSuccess || per_cu < 1) { fprintf(stderr, "kernel_launch: occupancy query says %d\n", per_cu); }
        (void)hipGetLastError();
        grid = cus;
    }
    if (grid < 0) return;
    (void)hipMemsetAsync((char*)d_ws + WS_CTL, 0, CTL_BYTES, stream);
    Params p{};
    for (int i = 0; i < 26; ++i) p.in[i] = (const float*)d_in[i];
    p.out = (float*)d_out; p.ws = (unsigned char*)d_ws;
#if MK_PER_PHASE
    for (int k = 0; k < NPHASES; ++k) { p.ph_lo = k; p.ph_hi = k + 1; p.li = k;
        hipLaunchKernelGGL(fwd_kernel, dim3(grid), dim3(NTHREADS), LDS_BYTES, stream, p); }
#else
    p.ph_lo = 0; p.ph_hi = NPHASES; p.li = 0;
    hipLaunchKernelGGL(fwd_kernel, dim3(grid), dim3(NTHREADS), LDS_BYTES, stream, p);
#endif
}
```

```cpp
#include <hip/hip_runtime.h>
#include <stdint.h>
#include <stdio.h>

#define LAS __attribute__((address_space(3)))
#define GAS __attribute__((address_space(1)))
template <class T> __device__ __forceinline__ T* as_global(T* q) { return (T*)(GAS T*)q; }
typedef unsigned short bf16_t;
typedef short bf16x8 __attribute__((ext_vector_type(8)));
typedef short bf16x4 __attribute__((ext_vector_type(4)));
typedef float f32x4 __attribute__((ext_vector_type(4)));
typedef float f32x2 __attribute__((ext_vector_type(2)));
typedef unsigned u32x4 __attribute__((ext_vector_type(4)));
typedef unsigned u32x2 __attribute__((ext_vector_type(2)));
typedef long i64x2 __attribute__((ext_vector_type(2)));

constexpr int D = 1024, NB = 8, SEQ = 2048, CTXL = 256, DEPTH = 2;
constexpr int NL = NB * SEQ;
constexpr int NC = NB * CTXL;
constexpr int NT = NL + NC;
constexpr int INW = 7168;
constexpr int ZW = 4096;
constexpr int ZC_AU = 0, ZC_AV = 512, ZC_NQ = 1024, ZC_NK = 1536, ZC_NV = 2048, ZC_RQ = 2560, ZC_RK = 2816, ZC_RV = 3072, ZC_RG = 3584,
              ZC_GA = 4096;
constexpr int BRW = 1536;
constexpr int NEXP = 64, TOPK = 8, EXPW = 256;
constexpr int NCHUNK = 18;
constexpr float EPS = 1e-6f;
constexpr int NTHREADS = 512, NWAVES = 8;
constexpr int LDS_BYTES = 159744;

constexpr size_t MiB = 1u << 20;
constexpr size_t WS_CTL = 0, CTL_BYTES = 1 * MiB;
constexpr size_t WS_MOD = 1 * MiB;
constexpr size_t WS_ROPE = 1 * MiB + 512 * 1024;
constexpr size_t WS_WM = 2 * MiB, WM_STRIDE = 21 * MiB;
constexpr size_t WM_IN = 0, WM_BR = 14680064, WM_OUT = WM_BR + 3145728, WM_SGU = WM_OUT + 2097152, WM_SD = WM_SGU + 1048576,
                 WM_RT = WM_SD + 524288, WM_CM = WM_RT + 131072, WM_END = WM_CM + 131072;
static_assert(WM_END <= WM_STRIDE, "misc weights");
constexpr size_t WS_WE = 44 * MiB;
constexpr size_t WE_GU = 0, WE_D = 33554432, WE_LAYER = 50331648;
constexpr size_t WS_XC = 140 * MiB;
constexpr size_t WS_H = 148 * MiB;
constexpr size_t WS_LIST = 184 * MiB, WS_WL = 189 * MiB;
constexpr size_t WS_R = 194 * MiB;
constexpr size_t R_Z = 0, R_G8 = 144 * MiB, R_BR = 252 * MiB, R_KV = 306 * MiB, R_ST = 342 * MiB, R_STAT = 360 * MiB;
constexpr size_t R_O = 0, R_ACT = 288 * MiB, R_ACTS = 368 * MiB;
constexpr size_t WS_END = WS_R + 377 * MiB;
static_assert(R_KV + 37748736 <= 377 * MiB && R_ACTS + 9437184 <= 377 * MiB && R_Z + 150994944 <= R_G8 && R_G8 + 56623104 <= R_BR && R_BR + 56623104 <= R_KV, "region map");
static_assert(R_O + 301989888 <= R_ACT && R_ACT + 83886080 <= R_ACTS, "region map 2");
constexpr int CW_BAR = 4096;
constexpr int CW_CNT = 200000;

__device__ __forceinline__ float bf2f(unsigned short b) { return __uint_as_float(((unsigned)b) << 16); }
__device__ __forceinline__ unsigned f2bf(float f) { unsigned u = __float_as_uint(f); return (u + 0x7fffu + ((u >> 16) & 1u)) >> 16; }
__device__ __forceinline__ unsigned pk2(float lo, float hi) { unsigned r; asm("v_cvt_pk_bf16_f32 %0, %1, %2" : "=v"(r) : "v"(lo), "v"(hi)); return r; }
__device__ __forceinline__ float lo16(unsigned w) { return __uint_as_float(w << 16); }
__device__ __forceinline__ float hi16(unsigned w) { return __uint_as_float(w & 0xffff0000u); }
__device__ __forceinline__ float shx(float v, int o, int lane) { return __int_as_float(__builtin_amdgcn_ds_bpermute((lane ^ o) << 2, __float_as_int(v))); }
__device__ __forceinline__ int shxi(int v, int o, int lane) { return __builtin_amdgcn_ds_bpermute((lane ^ o) << 2, v); }
__device__ __forceinline__ float dpp_f(float v, const int ctrl_tag) {
    const int x = __float_as_int(v);
    switch (ctrl_tag) {
        case 0: return __int_as_float(__builtin_amdgcn_update_dpp(x, x, 0xB1, 0xF, 0xF, false));
        case 1: return __int_as_float(__builtin_amdgcn_update_dpp(x, x, 0x4E, 0xF, 0xF, false));
        case 2: return __int_as_float(__builtin_amdgcn_update_dpp(x, x, 0x141, 0xF, 0xF, false));
        default: return __int_as_float(__builtin_amdgcn_update_dpp(x, x, 0x140, 0xF, 0xF, false));
    }
}
__device__ __forceinline__ float wave_sum(float v, int  ) {
    v += dpp_f(v, 0); v += dpp_f(v, 1); v += dpp_f(v, 2); v += dpp_f(v, 3);
    const int x = __float_as_int(v);
    return (__int_as_float(__builtin_amdgcn_readlane(x, 0)) + __int_as_float(__builtin_amdgcn_readlane(x, 16))) + (__int_as_float(__builtin_amdgcn_readlane(x, 32)) + __int_as_float(__builtin_amdgcn_readlane(x, 48)));
}
__device__ __forceinline__ float fast_exp(float x) { return __builtin_amdgcn_exp2f(x * 1.44269504089f); }
__device__ __forceinline__ float sigmoidf_(float x) { return __builtin_amdgcn_rcpf(1.0f + fast_exp(-x)); }
__device__ __forceinline__ float siluf_(float x) { return x * sigmoidf_(x); }
__device__ __forceinline__ float geluf_(float x) { const float u = 0.7978845608f * (x + 0.044715f * x * x * x); return x * sigmoidf_(2.0f * u); }
__device__ __forceinline__ f32x4 mfma16(bf16x8 a, bf16x8 b, f32x4 c) { return __builtin_amdgcn_mfma_f32_16x16x32_bf16(a, b, c, 0, 0, 0); }
__device__ __forceinline__ bf16x8 as_frag(u32x4 v) { return __builtin_bit_cast(bf16x8, v); }
__device__ __forceinline__ int launder(int v) { asm volatile("" : "+v"(v)); return v; }
__device__ __forceinline__ int lane_id_here() { unsigned m = ~0u; asm volatile("" : "+s"(m)); return (int)__builtin_amdgcn_mbcnt_hi(m, __builtin_amdgcn_mbcnt_lo(m, 0u)); }
__device__ __forceinline__ int launder_s(int v) { asm volatile("" : "+s"(v)); return v; }
template <class T> __device__ __forceinline__ T* launder_p(T* q) { asm volatile("" : "+s"(q)); return q; }
template <class T> __device__ __forceinline__ T* launder_vp(T* q) { asm volatile("" : "+v"(q)); return q; }
#define LDS_WAIT() asm volatile("s_waitcnt lgkmcnt(0)" ::: "memory")
#define VM_WAIT() asm volatile("s_waitcnt vmcnt(0)" ::: "memory")

__device__ __forceinline__ bf16x8 tr_frag(unsigned base, int stride, int r0, int r1, int c0, int lane) {
    const int q = (lane & 15) >> 2, p = lane & 3;
    const unsigned a0 = base + (unsigned)((r0 + q) * stride + (c0 + 4 * p) * 2), a1 = base + (unsigned)((r1 + q) * stride + (c0 + 4 * p) * 2);
    bf16x4 lo, hi;
    asm volatile("ds_read_b64_tr_b16 %0, %2\n\tds_read_b64_tr_b16 %1, %3\n\ts_waitcnt lgkmcnt(0)" : "=&v"(lo), "=&v"(hi) : "v"(a0), "v"(a1) : "memory");
    bf16x8 r; r[0] = lo[0]; r[1] = lo[1]; r[2] = lo[2]; r[3] = lo[3]; r[4] = hi[0]; r[5] = hi[1]; r[6] = hi[2]; r[7] = hi[3];
    return r;
}
__device__ __forceinline__ unsigned lds_addr(LAS unsigned char* p) { return (unsigned)(size_t)p; }
template <int O0, int O1> __device__ __forceinline__ bf16x8 tr_frag_i(unsigned a) {
    static_assert(O0 >= 0 && O0 < 65536 && O1 >= 0 && O1 < 65536, "ds offset field");
    bf16x4 lo, hi;
    asm volatile("ds_read_b64_tr_b16 %0, %2 offset:%3\n\tds_read_b64_tr_b16 %1, %2 offset:%4\n\ts_waitcnt lgkmcnt(0)" : "=&v"(lo), "=&v"(hi) : "v"(a), "n"(O0), "n"(O1) : "memory");
    bf16x8 r; r[0] = lo[0]; r[1] = lo[1]; r[2] = lo[2]; r[3] = lo[3]; r[4] = hi[0]; r[5] = hi[1]; r[6] = hi[2]; r[7] = hi[3];
    return r;
}
template <int OB, int R1> __device__ __forceinline__ void tr_frag4_i(unsigned a, bf16x8 (&f)[4]) {
    static_assert(OB >= 0 && OB + R1 + 96 < 65536, "ds offset field");
    bf16x4 l0, h0, l1, h1, l2, h2, l3, h3;
    asm volatile("ds_read_b64_tr_b16 %0, %8 offset:%9\n\tds_read_b64_tr_b16 %1, %8 offset:%10\n\tds_read_b64_tr_b16 %2, %8 offset:%11\n\tds_read_b64_tr_b16 %3, %8 offset:%12\n\t"
                 "ds_read_b64_tr_b16 %4, %8 offset:%13\n\tds_read_b64_tr_b16 %5, %8 offset:%14\n\tds_read_b64_tr_b16 %6, %8 offset:%15\n\tds_read_b64_tr_b16 %7, %8 offset:%16\n\ts_waitcnt lgkmcnt(0)"
                 : "=&v"(l0), "=&v"(h0), "=&v"(l1), "=&v"(h1), "=&v"(l2), "=&v"(h2), "=&v"(l3), "=&v"(h3)
                 : "v"(a), "n"(OB), "n"(OB + R1), "n"(OB + 32), "n"(OB + 32 + R1), "n"(OB + 64), "n"(OB + 64 + R1), "n"(OB + 96), "n"(OB + 96 + R1) : "memory");
    f[0][0] = l0[0]; f[0][1] = l0[1]; f[0][2] = l0[2]; f[0][3] = l0[3]; f[0][4] = h0[0]; f[0][5] = h0[1]; f[0][6] = h0[2]; f[0][7] = h0[3];
    f[1][0] = l1[0]; f[1][1] = l1[1]; f[1][2] = l1[2]; f[1][3] = l1[3]; f[1][4] = h1[0]; f[1][5] = h1[1]; f[1][6] = h1[2]; f[1][7] = h1[3];
    f[2][0] = l2[0]; f[2][1] = l2[1]; f[2][2] = l2[2]; f[2][3] = l2[3]; f[2][4] = h2[0]; f[2][5] = h2[1]; f[2][6] = h2[2]; f[2][7] = h2[3];
    f[3][0] = l3[0]; f[3][1] = l3[1]; f[3][2] = l3[2]; f[3][3] = l3[3]; f[3][4] = h3[0]; f[3][5] = h3[1]; f[3][6] = h3[2]; f[3][7] = h3[3];
}
__device__ __forceinline__ unsigned tr_lane(unsigned base, int stride, int rmul, int lane) { return base + (unsigned)((rmul * (lane >> 4) + ((lane & 15) >> 2)) * stride + (lane & 3) * 8); }
template <int V> struct IC { static constexpr int value = V; };
template <int I, int N, class F> __device__ __forceinline__ void sfor(F&& f) { if constexpr (I < N) { f(IC<I>{}); sfor<I + 1, N>(f); } }


#define XB_TMO      128
#define XB_XCNT(j)  (256  + 64 * (j))
#define XB_XSUB(j)  (1280 + 64 * (j))
#define XB_XGEN(j)  (2304 + 64 * (j))
#define XB_TOP      3328
#define XB_TOPGEN   3392
#define XCD_BAR_WORDS 3456
#define XB_SPIN_CAP (1u << 21)
__device__ __forceinline__ unsigned xb_ld(unsigned* p)              { return __hip_atomic_load(p, __ATOMIC_RELAXED, __HIP_MEMORY_SCOPE_AGENT); }
__device__ __forceinline__ unsigned xb_add(unsigned* p, unsigned v) { return __hip_atomic_fetch_add(p, v, __ATOMIC_RELAXED, __HIP_MEMORY_SCOPE_AGENT); }
__device__ __forceinline__ unsigned xb_xcc_id() { return (unsigned)__builtin_amdgcn_s_getreg((3 << 11) | 20) & 0xFu; }
#define XB_SPIN(cond, bar) do { unsigned _sp = 0; while (cond) { __builtin_amdgcn_s_sleep(1); \
    if ((++_sp & 255u) == 0u) { if (xb_ld(&(bar)[XB_TMO])) break; if (_sp > XB_SPIN_CAP) { atomicAdd(&(bar)[XB_TMO], 1u); break; } } } } while (0)
struct XcdBarrier { unsigned* bar; unsigned x; volatile LAS unsigned* st; };
__device__ __forceinline__ XcdBarrier xcd_barrier_post(unsigned* bar, volatile LAS unsigned* st) {
    XcdBarrier b; b.bar = bar; b.x = xb_xcc_id(); b.st = st;
    if (threadIdx.x == 0) (void)xb_add(&bar[XB_XCNT(b.x)], 1u);
    return b;
}
__device__ __forceinline__ void xcd_barrier_complete(unsigned* bar, unsigned x, unsigned& nloc, unsigned& nx) {
    const unsigned G = gridDim.x * gridDim.y * gridDim.z;
    unsigned sum, cnt, mine, sp = 0u;
    for (;;) {
        sum = 0u; cnt = 0u; mine = 0u;
#pragma unroll
        for (unsigned j = 0; j < 16; ++j) { const unsigned c = xb_ld(&bar[XB_XCNT(j)]); sum += c; cnt += (c > 0u) ? 1u : 0u; mine = (j == x) ? c : mine; }
        if (sum == G) break;
        __builtin_amdgcn_s_sleep(1);
        if ((++sp & 255u) == 0u) { if (xb_ld(&bar[XB_TMO])) break; if (sp > XB_SPIN_CAP) { atomicAdd(&bar[XB_TMO], 1u); break; } }
    }
    nloc = mine > 0u ? mine : 1u; nx = cnt > 0u ? cnt : 1u;
}
__device__ __forceinline__ void xcd_barrier(const XcdBarrier& b, const bool leader) {
    asm volatile("s_waitcnt vmcnt(0)" ::: "memory");
    __syncthreads();
    if (leader) {
        unsigned* bar = b.bar;
        __builtin_amdgcn_s_waitcnt(0);
        unsigned nloc = b.st[0], nx = b.st[1];
        if (nloc == 0u) { xcd_barrier_complete(bar, b.x, nloc, nx); b.st[0] = nloc; b.st[1] = nx; }
        const unsigned old = xb_add(&bar[XB_XSUB(b.x)], 1u);
        const unsigned gen = old / nloc;
        if (old + 1u == (gen + 1u) * nloc) {
            __builtin_amdgcn_fence(__ATOMIC_RELEASE, "agent");
            asm volatile("s_waitcnt vmcnt(0)" ::: "memory");
            const unsigned og = xb_add(&bar[XB_TOP], 1u);
            const unsigned tg = og / nx;
            if (og + 1u == (tg + 1u) * nx) xb_add(&bar[XB_TOPGEN], 1u);
            else XB_SPIN(xb_ld(&bar[XB_TOPGEN]) == tg, bar);
            __builtin_amdgcn_fence(__ATOMIC_ACQUIRE, "agent");
            xb_add(&bar[XB_XGEN(b.x)], 1u);
            asm volatile("s_waitcnt vmcnt(0)" ::: "memory");
        } else {
            XB_SPIN(xb_ld(&bar[XB_XGEN(b.x)]) == gen, bar);
            __builtin_amdgcn_fence(__ATOMIC_ACQUIRE, "agent");
            asm volatile("s_waitcnt vmcnt(0)" ::: "memory");
        }
    }
    __syncthreads();
}

namespace pg8 {
constexpr int BM = 256, BK = 64, HALF = 128, HTB = HALF * BK * 2, STAGE_BYTES = 8 * HTB, NXCD = 8, WGM = 8;
constexpr int ROWTAB_OFF = 149504;
constexpr int GATHER_SLOT_OFF = 133120;
__device__ __forceinline__ int lds_byte(int r, int c) { const int st = (r >> 4) * 2 + (c >> 5), rr = r & 15, cc = c & 31, ob = rr * 64 + cc * 2; return st * 1024 + (ob ^ (((ob >> 9) & 1) << 5)); }
__device__ __forceinline__ void stage_rc(int b, int& R, int& C) { const int st = b / 1024, sb = b % 1024, swz = sb ^ (((sb >> 9) & 1) << 5); R = (st >> 1) * 16 + swz / 64; C = (st & 1) * 32 + (swz % 64) / 2; }
__device__ __forceinline__ int perm32(int rho) { const int n = rho >> 4, i = rho & 15; return 8 * (i >> 2) + 4 * n + (i & 3); }

struct Unit { const char* A; const char* B; int e0, e1, e2, e3, e4; };

__device__ __forceinline__ bool static_tile(int i, int G, int c, int nM, int nN, int& pm, int& pn) {
    const int nwg = nM * nN; const long L = (long)i * G + c; if (L >= nwg) return false;
    int wgid = (int)L; { const int q = nwg / NXCD, r = nwg % NXCD, xcd = wgid % NXCD, off = wgid / NXCD; wgid = (xcd < r ? xcd * (q + 1) : r * (q + 1) + (xcd - r) * q) + off; }
    const int nig = WGM * nN, gid = wgid / nig, fm = gid * WGM, gsz = (nM - fm) < WGM ? (nM - fm) : WGM;
    pm = fm + ((wgid % nig) % gsz); pn = (wgid % nig) / gsz; return true;
}

template <bool F8 = false, class Epi, class Sched>
__device__ __forceinline__ void gemm_phase(LAS unsigned char* lds, const int tid, const int K, const int ldb  , const Sched& S, const Epi& E, const int stamp_base = -1) {
#ifdef TIMING
#define GSTAMP(k) do { if (stamp_base >= 0 && tid == 0 && (k) < 31) ((volatile LAS unsigned long long*)(lds + LDS_BYTES - 16 - 512))[stamp_base + (k)] = __builtin_amdgcn_s_memrealtime(); } while (0)
#else
#define GSTAMP(k) do { } while (0)
#endif
    GSTAMP(-1);
    const int wid = __builtin_amdgcn_readfirstlane(tid >> 6), lane = tid & 63, wr = wid >> 2, wc = wid & 3, fr = lane & 15, fq = lane >> 4;
    const int nt = K / (F8 ? 2 * BK : BK);
    unsigned voffB[2];
#pragma unroll
    for (int i = 0; i < 2; ++i) { int R, C; stage_rc(tid * 16 + i * 8192, R, C); const int Rb = Epi::PERM256 ? (64 * (R >> 5) + 16 * ((R >> 2) & 3) + 4 * ((R >> 4) & 1) + (R & 3)) : Epi::PERM ? ((R & ~31) + perm32(R & 31)) : R; voffB[i] = F8 ? (unsigned)(Rb * ldb + C * 2) : (unsigned)(Rb * ldb + C) * 2u; }
    const size_t kstep = (size_t)(BK * 2);
    const size_t hstepB = (size_t)(Epi::PERM256 ? 8 : HALF) * ldb * (F8 ? 1 : 2);
    const unsigned ldsw = (unsigned)wid * 1024u;
    const int aoff = lds_byte(wr * 64 + fr, fq * 8), boff = lds_byte(wc * 32 + fr, fq * 8);
#define PG8_SA(b, h) (((b) * 2 + (h)) * HTB)
#define PG8_SB(b, h) ((4 + (b) * 2 + (h)) * HTB)
#define PG8_STAGE(bufoff, gbase, voff) do { _Pragma("unroll") for (int _i = 0; _i < 2; ++_i) \
        __builtin_amdgcn_global_load_lds((const unsigned*)((const char*)(gbase) + (voff)[_i]), (LAS unsigned*)(lds + (bufoff) + ldsw + _i * 8192), 16, 0, 0); } while (0)
#define PG8_LDA(dst, b, h) do { _Pragma("unroll") for (int m = 0; m < 4; ++m) _Pragma("unroll") for (int k = 0; k < 2; ++k) dst[m][k] = *(const LAS bf16x8*)(lds + PG8_SA(b, h) + aoff + m * 2048 + k * 1024); } while (0)
#define PG8_LDB(dst, b, h) do { _Pragma("unroll") for (int n = 0; n < 2; ++n) _Pragma("unroll") for (int k = 0; k < 2; ++k) dst[n][k] = *(const LAS bf16x8*)(lds + PG8_SB(b, h) + boff + n * 2048 + k * 1024); } while (0)
#define PG8_MMA(ai, bj, At, Bt) do { __builtin_amdgcn_s_setprio(1); _Pragma("unroll") for (int m = 0; m < 4; ++m) _Pragma("unroll") for (int n = 0; n < 2; ++n) _Pragma("unroll") for (int k = 0; k < 2; ++k) { \
        if constexpr (F8) { const i64x2 b2_ = __builtin_bit_cast(i64x2, Bt[n][k]), a2_ = __builtin_bit_cast(i64x2, At[m][k]); \
            acc[ai][bj][m][n] = __builtin_amdgcn_mfma_f32_16x16x32_fp8_fp8(b2_[0], a2_[0], acc[ai][bj][m][n], 0, 0, 0); \
            acc[ai][bj][m][n] = __builtin_amdgcn_mfma_f32_16x16x32_fp8_fp8(b2_[1], a2_[1], acc[ai][bj][m][n], 0, 0, 0); } \
        else acc[ai][bj][m][n] = __builtin_amdgcn_mfma_f32_16x16x32_bf16(Bt[n][k], At[m][k], acc[ai][bj][m][n], 0, 0, 0); } __builtin_amdgcn_s_setprio(0); } while (0)
#define PG8_WAIT_V(n) asm volatile("s_waitcnt vmcnt(" #n ")" ::: "memory")
#define PG8_WAIT_L(n) asm volatile("s_waitcnt lgkmcnt(" #n ")" ::: "memory")
#define PG8_BAR __builtin_amdgcn_s_barrier()
#define PG8_SCHED __builtin_amdgcn_sched_barrier(0)
    Unit cur, nxt; int ui = 0;
    if (!S.next(0, cur)) return;
    unsigned cvA[2][2], nvA[2][2];
    S.a_offs(cur, tid, cvA);
    LAS unsigned* const gslot = (LAS unsigned*)(lds + GATHER_SLOT_OFF) + tid * 4;
    if constexpr (Sched::GATHER) { *(LAS u32x4*)gslot = (u32x4){cvA[0][0], cvA[0][1], cvA[1][0], cvA[1][1]}; }
    f32x4 acc[2][2][4][2];
#pragma unroll
    for (int a = 0; a < 2; ++a)
#pragma unroll
        for (int b = 0; b < 2; ++b)
#pragma unroll
            for (int m = 0; m < 4; ++m)
#pragma unroll
                for (int n = 0; n < 2; ++n) acc[a][b][m][n] = (f32x4){0.f, 0.f, 0.f, 0.f};
    bf16x8 At[4][2], B0[2][2], B1[2][2];
    const char* cA = cur.A; const char* cB = cur.B;
    PG8_STAGE(PG8_SB(0, 0), cB, voffB); PG8_STAGE(PG8_SA(0, 0), cA, cvA[0]); PG8_STAGE(PG8_SB(0, 1), cB + hstepB, voffB); PG8_STAGE(PG8_SA(0, 1), cA, cvA[1]);
    if (wr == 1) PG8_BAR;
    PG8_WAIT_V(4); PG8_BAR;
    PG8_STAGE(PG8_SB(1, 0), cB + kstep, voffB); PG8_STAGE(PG8_SA(1, 0), cA + kstep, cvA[0]); PG8_STAGE(PG8_SB(1, 1), cB + hstepB + kstep, voffB);
    PG8_WAIT_V(6); PG8_BAR;
    for (;;) {
        if constexpr (Epi::STAGES) { if (wid < 4) E.stage(cur, (LAS unsigned*)(lds + ROWTAB_OFF) + (ui & 1) * 256 + wid * 64, wid * 64 + lane); }
        const bool has_next = S.next(ui + 1, nxt);
        if (has_next) S.a_offs(nxt, tid, nvA);
        else {
#pragma unroll
            for (int h = 0; h < 2; ++h)
#pragma unroll
                for (int i = 0; i < 2; ++i) nvA[h][i] = cvA[h][i];
        }
        if constexpr (Sched::GATHER) { *(LAS u32x4*)(gslot + ((ui + 1) & 1) * 2048) = (u32x4){nvA[0][0], nvA[0][1], nvA[1][0], nvA[1][1]}; }
        const char* nA = has_next ? nxt.A : cA; const char* nB = has_next ? nxt.B : cB;
#pragma unroll 1
        for (int t = 0; t < nt; t += 2) {
            const bool last = (t == nt - 2);
            const char* a1 = cA + (size_t)(t + 1) * kstep;
            const char* a2 = last ? nA : cA + (size_t)(t + 2) * kstep; const char* b2 = last ? nB : cB + (size_t)(t + 2) * kstep;
            const char* a3 = a2 + kstep; const char* b3 = b2 + kstep;
            unsigned sA[2][2];
            if constexpr (Sched::GATHER) {
                const u32x4 cv = *(const LAS u32x4*)(gslot + (ui & 1) * 2048), sv = *(const LAS u32x4*)(gslot + ((ui + (last ? 1 : 0)) & 1) * 2048);
                cvA[0][0] = cv.x; cvA[0][1] = cv.y; cvA[1][0] = cv.z; cvA[1][1] = cv.w; sA[0][0] = sv.x; sA[0][1] = sv.y; sA[1][0] = sv.z; sA[1][1] = sv.w;
            } else {
#pragma unroll
                for (int h = 0; h < 2; ++h)
#pragma unroll
                    for (int i = 0; i < 2; ++i) sA[h][i] = last ? nvA[h][i] : cvA[h][i];
            }
            PG8_LDB(B0, 0, 0); PG8_SCHED; PG8_LDA(At, 0, 0); PG8_STAGE(PG8_SA(1, 1), a1, cvA[1]);
            PG8_WAIT_L(8); PG8_BAR; PG8_WAIT_L(0); PG8_MMA(0, 0, At, B0); PG8_BAR; PG8_SCHED;
            PG8_LDB(B1, 0, 1); PG8_STAGE(PG8_SB(0, 0), b2, voffB);
            PG8_BAR; PG8_WAIT_L(0); PG8_MMA(0, 1, At, B1); PG8_BAR;
            PG8_LDA(At, 0, 1); PG8_STAGE(PG8_SA(0, 0), a2, sA[0]);
            PG8_BAR; PG8_WAIT_L(0); PG8_MMA(1, 0, At, B0); PG8_BAR; PG8_SCHED;
            PG8_STAGE(PG8_SB(0, 1), b2 + hstepB, voffB);
            PG8_WAIT_V(6); PG8_BAR; PG8_MMA(1, 1, At, B1); PG8_BAR;
            PG8_LDB(B0, 1, 0); PG8_SCHED; PG8_LDA(At, 1, 0); PG8_STAGE(PG8_SA(0, 1), a2, sA[1]);
            PG8_WAIT_L(8); PG8_BAR; PG8_WAIT_L(0); PG8_MMA(0, 0, At, B0); PG8_BAR; PG8_SCHED;
            PG8_LDB(B1, 1, 1); PG8_STAGE(PG8_SB(1, 0), b3, voffB);
            PG8_BAR; PG8_WAIT_L(0); PG8_MMA(0, 1, At, B1); PG8_BAR;
            PG8_LDA(At, 1, 1); PG8_STAGE(PG8_SA(1, 0), a3, sA[0]);
            PG8_BAR; PG8_WAIT_L(0); PG8_MMA(1, 0, At, B0); PG8_BAR; PG8_SCHED;
            PG8_STAGE(PG8_SB(1, 1), b3 + hstepB, voffB);
            PG8_WAIT_V(6); PG8_BAR; PG8_MMA(1, 1, At, B1); PG8_BAR;
        }
        GSTAMP(2 * ui);
        if constexpr (Epi::STAGES) E(acc, cur, wr, wc, fr, fq, (const LAS unsigned*)(lds + ROWTAB_OFF) + (ui & 1) * 256); else E(acc, cur, wr, wc, fr, fq);
        GSTAMP(2 * ui + 1);
        if (!has_next) break;
        if (!(Epi::KEEPS && E.keep(cur))) {
#pragma unroll
        for (int a = 0; a < 2; ++a)
#pragma unroll
            for (int b = 0; b < 2; ++b)
#pragma unroll
                for (int m = 0; m < 4; ++m)
#pragma unroll
                    for (int n = 0; n < 2; ++n) acc[a][b][m][n] = (f32x4){0.f, 0.f, 0.f, 0.f};
        }
        cur = nxt; cA = nA; cB = nB; ++ui;
        if constexpr (!Sched::GATHER) {
#pragma unroll
            for (int h = 0; h < 2; ++h)
#pragma unroll
                for (int i = 0; i < 2; ++i) cvA[h][i] = nvA[h][i];
        }
    }
    PG8_WAIT_V(0);
    if (wr == 0) PG8_BAR;
    PG8_BAR;
#undef PG8_SA
#undef PG8_SB
#undef PG8_STAGE
#undef PG8_LDA
#undef PG8_LDB
#undef PG8_MMA
#undef PG8_WAIT_V
#undef PG8_WAIT_L
#undef PG8_BAR
#undef PG8_SCHED
}
}

using pg8::Unit;
template <int ES = 2  > struct DenseSchedT {
    static constexpr bool GATHER = false;
    const char* A; const char* B; int lda, ldb, nM, nN, G, c, nsub; size_t asub, bsub;
    __device__ __forceinline__ bool next(int i, Unit& u) const {
        const int sub = i % nsub, ti = i / nsub; int pm, pn;
        if (!pg8::static_tile(ti, G, c, nM, nN, pm, pn)) return false;
        u.A = A + (size_t)pm * 256 * lda * ES + (size_t)sub * asub; u.B = B + (size_t)pn * 256 * ldb * ES + (size_t)sub * bsub;
        u.e0 = pm; u.e1 = pn; u.e2 = sub; u.e3 = 0; u.e4 = 0; return true;
    }
    __device__ __forceinline__ void a_offs(const Unit&, int tid, unsigned (&vo)[2][2]) const {
#pragma unroll
        for (int i = 0; i < 2; ++i) { int R, C; pg8::stage_rc(tid * 16 + i * 8192, R, C);
#pragma unroll
            for (int h = 0; h < 2; ++h) vo[h][i] = ES == 2 ? (unsigned)((h * 128 + R) * lda + C) * 2u : (unsigned)((h * 128 + R) * lda + C * 2); }
    }
};
using DenseSched = DenseSchedT<2>;
constexpr int MOE_TAB_OFF = 131072;
constexpr int MOE_UL_OFF = MOE_TAB_OFF + 1024, MOE_UL_MAX = 24;
#define RFL(x) __builtin_amdgcn_readfirstlane(x)
__device__ __forceinline__ int moe_find_expert(const LAS int* tbase, int mt) {
    int lo = 0, hi = 63;
#pragma unroll
    for (int it = 0; it < 6; ++it) { const int mid = (lo + hi + 1) >> 1; if (RFL(tbase[mid]) <= mt) lo = mid; else hi = mid - 1; }
    return lo;
}
struct MoeGuSched {
    static constexpr bool GATHER = true;
    const char* H2; const char* WGU; const char* WSGU; const unsigned* list; const LAS int* tbase; const LAS int* cnt; int nMs, G, c;
    __device__ __forceinline__ bool next(int i, Unit& u) const {
        if (i >= MOE_UL_MAX) return false;
        const LAS int* ul = tbase + (MOE_UL_OFF - MOE_TAB_OFF) / 4 + i * 8;
        const int e = RFL(ul[0]), nt = RFL(ul[1]), p0 = RFL(ul[2]), t3 = RFL(ul[3]), cn_ = RFL(ul[4]);
        if (e < 0) return false;
        u.e0 = e; u.e1 = nt; u.e2 = p0; u.e3 = t3; u.e4 = cn_;
        if (e != 64) { u.A = H2; u.B = WGU + (size_t)e * (512 * 1024) + (size_t)nt * (256 * 1024); }
        else { u.A = H2 + (size_t)t3 * 256 * 1024; u.B = WSGU + (size_t)nt * (256 * 1024); }
        return true;
    }
    __device__ __forceinline__ void a_offs(const Unit& u, int tid, unsigned (&vo)[2][2]) const {
#pragma unroll
        for (int i = 0; i < 2; ++i) { int R, C; pg8::stage_rc(tid * 16 + i * 8192, R, C); R = launder(R);
#pragma unroll
            for (int h = 0; h < 2; ++h) {
                if (u.e0 == 64) vo[h][i] = (unsigned)((h * 128 + R) * 1024 + C * 2);
                else { const int pos = u.e2 + h * 128 + R; const unsigned tv = list[(size_t)u.e0 * NT + pos] >> 3;
                    vo[h][i] = (pos < u.e4 ? tv : 0u) * 1024u + (unsigned)C * 2u; } } }
    }
};
struct MoeDownSched {
    static constexpr bool GATHER = false;
    const char* ACT; const char* WD; const char* ACTS; const char* WSD; const LAS int* tbase; const LAS int* cnt; int nMs, G, c;
    __device__ __forceinline__ bool next(int i, Unit& u) const {
        if (i >= MOE_UL_MAX) return false;
        const LAS int* ul = tbase + (MOE_UL_OFF - MOE_TAB_OFF) / 4 + i * 8;
        const int e = RFL(ul[0]), pn = RFL(ul[1]), p0 = RFL(ul[2]), t3 = RFL(ul[3]), cn_ = RFL(ul[4]);
        if (e < 0) return false;
        u.e0 = e; u.e1 = pn; u.e2 = p0; u.e3 = t3; u.e4 = cn_;
        if (e != 64) { u.A = ACT + (size_t)t3 * (256 * 256); u.B = WD + (size_t)e * (1024 * 256) + (size_t)pn * (256 * 256); }
        else { u.A = ACTS + (size_t)t3 * (256 * 256); u.B = WSD + (size_t)pn * (256 * 256); }
        return true;
    }
    __device__ __forceinline__ void a_offs(const Unit&, int tid, unsigned (&vo)[2][2]) const {
#pragma unroll
        for (int i = 0; i < 2; ++i) { int R, C; pg8::stage_rc(tid * 16 + i * 8192, R, C);
#pragma unroll
            for (int h = 0; h < 2; ++h) vo[h][i] = (unsigned)((h * 128 + R) * 256 + C * 2); }
    }
};

struct EpiStoreBf16 {
    static constexpr bool STAGES = false;
    static constexpr bool KEEPS = false; __device__ __forceinline__ bool keep(const Unit&) const { return false; }
    static constexpr bool PERM = true, PERM256 = false;
    bf16_t* O; int ldc; int gate_tile0; unsigned char* G8; float sc;
    __device__ __forceinline__ void operator()(const f32x4 (&acc)[2][2][4][2], const Unit& u, int wr, int wc, int fr, int fq) const {
        const int row0 = u.e0 * 256 + launder(wr * 64 + fr), col0 = u.e1 * 256 + wc * 32 + 8 * fq;
        if (u.e1 >= gate_tile0) {
            const int gi = (u.e1 - gate_tile0) >> 2, pn = (u.e1 - gate_tile0) & 3, tidx = launder(((wr * 4 + wc) * 64) + fq * 16 + fr);
            unsigned char* gp = G8 + ((size_t)((u.e0 * 4 + pn) * 3 + gi) * 65536) + (size_t)tidx * 128;
#pragma unroll
            for (int ai = 0; ai < 2; ++ai)
#pragma unroll
                for (int m = 0; m < 4; ++m) { u32x4 w;
#pragma unroll
                    for (int bj = 0; bj < 2; ++bj) { const f32x4 v0 = acc[ai][bj][m][0] * sc, v1 = acc[ai][bj][m][1] * sc;
                        float q[8] = {v0[0], v0[1], v0[2], v0[3], v1[0], v1[1], v1[2], v1[3]}; unsigned qb[8];
#pragma unroll
                        for (int j = 0; j < 8; ++j) { const float t = fminf(fmaxf(sigmoidf_(q[j]) * 255.0f + 0.5f, 1.0f), 255.0f); qb[j] = (unsigned)t; }
                        const unsigned lo = qb[0] | (qb[1] << 8) | (qb[2] << 16) | (qb[3] << 24), hi = qb[4] | (qb[5] << 8) | (qb[6] << 16) | (qb[7] << 24);
                        if (bj == 0) { w.x = lo; w.y = hi; } else { w.z = lo; w.w = hi; } }
                    *(u32x4*)(gp + (ai * 4 + m) * 16) = w; }
            return;
        }
#pragma unroll
        for (int ai = 0; ai < 2; ++ai)
#pragma unroll
            for (int m = 0; m < 4; ++m) { bf16_t* rowp = O + (size_t)(row0 + ai * 128 + m * 16) * ldc + col0;
#pragma unroll
                for (int bj = 0; bj < 2; ++bj) { const f32x4 v0 = acc[ai][bj][m][0] * sc, v1 = acc[ai][bj][m][1] * sc;
                    u32x4 w; w.x = pk2(v0[0], v0[1]); w.y = pk2(v0[2], v0[3]); w.z = pk2(v1[0], v1[1]); w.w = pk2(v1[2], v1[3]);
                    *(u32x4*)(rowp + bj * 128) = w; } }
    }
};
struct EpiMerge {
    static constexpr bool PERM = true, PERM256 = false, KEEPS = true, STAGES = false;
    bf16_t* Mo; const unsigned char* G8;
    __device__ __forceinline__ bool keep(const Unit& u) const { return u.e2 < 2; }
    __device__ __forceinline__ void operator()(f32x4 (&acc)[2][2][4][2], const Unit& u, int wr, int wc, int fr, int fq) const {
        const int row0 = u.e0 * 256 + launder(wr * 64 + fr), col0 = u.e1 * 256 + wc * 32 + 8 * fq, sub = u.e2, tidx = launder(((wr * 4 + wc) * 64) + fq * 16 + fr);
        const unsigned char* gp = G8 + ((size_t)((u.e0 * 4 + u.e1) * 3 + sub) * 65536) + (size_t)tidx * 128;
        u32x4 gq[8], hq[8];
        const unsigned char* hp = gp + (sub < 2 ? 65536 : 0);
#pragma unroll
        for (int k = 0; k < 8; ++k) { gq[k] = *(const u32x4*)(gp + k * 16); hq[k] = *(const u32x4*)(hp + k * 16); }
        if (sub < 2) {
#pragma unroll
            for (int ai = 0; ai < 2; ++ai)
#pragma unroll
                for (int m = 0; m < 4; ++m)
#pragma unroll
                    for (int bj = 0; bj < 2; ++bj) { const u32x4 g4v = gq[ai * 4 + m], h4v = hq[ai * 4 + m];
                        const unsigned g0 = bj ? g4v.z : g4v.x, g1 = bj ? g4v.w : g4v.y, h0 = bj ? h4v.z : h4v.x, h1 = bj ? h4v.w : h4v.y;
                        float f[8];
#pragma unroll
                        for (int j = 0; j < 8; ++j) { const float qg = (float)(((j < 4 ? g0 : g1) >> (8 * (j & 3))) & 255u), qh = (float)(((j < 4 ? h0 : h1) >> (8 * (j & 3))) & 255u);
                            f[j] = qg * __builtin_amdgcn_rcpf(qh); }
                        acc[ai][bj][m][0] = acc[ai][bj][m][0] * (f32x4){f[0], f[1], f[2], f[3]}; acc[ai][bj][m][1] = acc[ai][bj][m][1] * (f32x4){f[4], f[5], f[6], f[7]}; }
        } else {
#pragma unroll
            for (int ai = 0; ai < 2; ++ai)
#pragma unroll
                for (int m = 0; m < 4; ++m)
#pragma unroll
                    for (int bj = 0; bj < 2; ++bj) { const u32x4 g4v = gq[ai * 4 + m];
                        const unsigned g0 = bj ? g4v.z : g4v.x, g1 = bj ? g4v.w : g4v.y;
                        float f[8];
#pragma unroll
                        for (int j = 0; j < 8; ++j) f[j] = (float)(((j < 4 ? g0 : g1) >> (8 * (j & 3))) & 255u) * (1.0f / 255.0f);
                        const f32x4 v0 = acc[ai][bj][m][0] * (f32x4){f[0], f[1], f[2], f[3]}, v1 = acc[ai][bj][m][1] * (f32x4){f[4], f[5], f[6], f[7]};
                        const size_t row = (size_t)(row0 + ai * 128 + m * 16);
                        u32x4 w; w.x = pk2(v0[0], v0[1]); w.y = pk2(v0[2], v0[3]); w.z = pk2(v1[0], v1[1]); w.w = pk2(v1[2], v1[3]);
                        *(u32x4*)(Mo + row * 1024 + col0 + bj * 128) = w; }
        }
    }
};
struct EpiResid {
    static constexpr bool STAGES = false;
    static constexpr bool KEEPS = false; __device__ __forceinline__ bool keep(const Unit&) const { return false; }
    static constexpr bool PERM = false, PERM256 = false;
    const float* src_l; const float* src_c; float* dst_l; float* dst_c; const float* gate;
    __device__ __forceinline__ void operator()(const f32x4 (&acc)[2][2][4][2], const Unit& u, int wr, int wc, int fr, int fq) const {
        const int g0 = u.e0 * 256; const bool lat = g0 < NL;
        const float* src = lat ? src_l + (size_t)g0 * D : src_c + (size_t)(g0 - NL) * D;
        float* dst = lat ? dst_l + (size_t)g0 * D : dst_c + (size_t)(g0 - NL) * D;
        const float* gp = gate + (size_t)(lat ? (g0 >> 11) : 8) * 6144;
        const int row0 = launder(wr * 64 + fr), col0 = u.e1 * 256 + wc * 32 + 4 * fq;
        f32x4 gv[2][2];
#pragma unroll
        for (int bj = 0; bj < 2; ++bj)
#pragma unroll
            for (int n = 0; n < 2; ++n) gv[bj][n] = *(const f32x4*)(gp + col0 + bj * 128 + n * 16);
#pragma unroll
        for (int am = 0; am < 4; ++am) { const int ai = am >> 1, mh = (am & 1) * 2;
            f32x4 sq[2][2][2];
#pragma unroll
            for (int mm = 0; mm < 2; ++mm)
#pragma unroll
                for (int bj = 0; bj < 2; ++bj)
#pragma unroll
                    for (int n = 0; n < 2; ++n) sq[mm][bj][n] = *(const f32x4*)(src + (size_t)(row0 + ai * 128 + (mh + mm) * 16) * D + col0 + bj * 128 + n * 16);
#pragma unroll
            for (int mm = 0; mm < 2; ++mm)
#pragma unroll
                for (int bj = 0; bj < 2; ++bj)
#pragma unroll
                    for (int n = 0; n < 2; ++n) *(f32x4*)(dst + (size_t)(row0 + ai * 128 + (mh + mm) * 16) * D + col0 + bj * 128 + n * 16) = sq[mm][bj][n] + gv[bj][n] * acc[ai][bj][mh + mm][n];
            if (am == 1) asm volatile("" ::: "memory");
        }
    }
};
struct EpiGateUp {
    static constexpr bool KEEPS = false; __device__ __forceinline__ bool keep(const Unit&) const { return false; }
    static constexpr bool PERM = true, PERM256 = false, STAGES = true;
    bf16_t* ACT; bf16_t* ACTS; const float* wl;
    __device__ __forceinline__ void stage(const Unit& u, LAS unsigned* dst_wave, int entry) const {
        if (u.e0 != 64) __builtin_amdgcn_global_load_lds((const unsigned*)(wl + (size_t)u.e0 * NT + u.e2 + entry), dst_wave, 4, 0, 0);
    }
    __device__ __forceinline__ void operator()(const f32x4 (&acc)[2][2][4][2], const Unit& u, int wr, int wc, int fr, int fq, const LAS unsigned* tab) const {
        const int row0 = launder(wr * 64 + fr), col0 = u.e1 * 128 + wc * 32 + 8 * fq;
        unsigned char* base = (unsigned char*)(u.e0 == 64 ? ACTS : ACT) + (size_t)u.e3 * 256 * 256;
#pragma unroll
        for (int ai = 0; ai < 2; ++ai)
#pragma unroll
            for (int m = 0; m < 4; ++m) { const int row = row0 + ai * 128 + m * 16; const float tw = __uint_as_float(tab[row]);
                const float w = u.e0 == 64 ? 1.0f : (u.e2 + row < u.e4 ? tw : 0.0f);
                const f32x4 g0 = acc[ai][0][m][0] * 0.03125f, g1 = acc[ai][0][m][1] * 0.03125f, u0 = acc[ai][1][m][0] * (0.03125f * 8.0f * w), u1 = acc[ai][1][m][1] * (0.03125f * 8.0f * w);
                int lo = 0, hi = 0;
                lo = __builtin_amdgcn_cvt_pk_fp8_f32(siluf_(g0[0]) * u0[0], siluf_(g0[1]) * u0[1], lo, false); lo = __builtin_amdgcn_cvt_pk_fp8_f32(siluf_(g0[2]) * u0[2], siluf_(g0[3]) * u0[3], lo, true);
                hi = __builtin_amdgcn_cvt_pk_fp8_f32(siluf_(g1[0]) * u1[0], siluf_(g1[1]) * u1[1], hi, false); hi = __builtin_amdgcn_cvt_pk_fp8_f32(siluf_(g1[2]) * u1[2], siluf_(g1[3]) * u1[3], hi, true);
                *(u32x2*)(base + (size_t)row * 256 + col0) = (u32x2){(unsigned)lo, (unsigned)hi}; }
    }
};
struct EpiDown {
    static constexpr bool KEEPS = false; __device__ __forceinline__ bool keep(const Unit&) const { return false; }
    static constexpr bool PERM = true, PERM256 = true, STAGES = true;
    bf16_t* O; const unsigned* list; bf16_t* Hs;
    __device__ __forceinline__ void stage(const Unit& u, LAS unsigned* dst_wave, int entry) const {
        if (u.e0 != 64) __builtin_amdgcn_global_load_lds(list + (size_t)u.e0 * NT + u.e2 + entry, dst_wave, 4, 0, 0);
    }
    __device__ __forceinline__ void operator()(const f32x4 (&acc)[2][2][4][2], const Unit& u, int wr, int wc, int fr, int fq, const LAS unsigned* tab) const {
        const int row0 = launder(wr * 64 + fr), col0 = u.e1 * 256 + wc * 64 + 16 * fq;
        if (u.e0 == 64) {
#pragma unroll
            for (int ai = 0; ai < 2; ++ai)
#pragma unroll
                for (int m = 0; m < 4; ++m) { bf16_t* rowp = Hs + (size_t)(u.e3 * 256 + row0 + ai * 128 + m * 16) * 1024 + col0;
#pragma unroll
                    for (int bj = 0; bj < 2; ++bj) { const f32x4 v0 = acc[ai][bj][m][0] * 0.0078125f, v1 = acc[ai][bj][m][1] * 0.0078125f;
                        u32x4 w; w.x = pk2(v0[0], v0[1]); w.y = pk2(v0[2], v0[3]); w.z = pk2(v1[0], v1[1]); w.w = pk2(v1[2], v1[3]);
                        *(u32x4*)(rowp + bj * 8) = w; } }
        } else {
            unsigned dq[2][4];
#pragma unroll
            for (int ai = 0; ai < 2; ++ai)
#pragma unroll
                for (int m = 0; m < 4; ++m) dq[ai][m] = tab[row0 + ai * 128 + m * 16];
#pragma unroll
            for (int ai = 0; ai < 2; ++ai)
#pragma unroll
                for (int m = 0; m < 4; ++m) {
                    if (u.e2 + row0 + ai * 128 + m * 16 < u.e4) { unsigned char* rowp = (unsigned char*)O + (size_t)dq[ai][m] * 1024 + col0;
                        int q[4];
#pragma unroll
                        for (int bj = 0; bj < 2; ++bj)
#pragma unroll
                            for (int n = 0; n < 2; ++n) { const f32x4 v = acc[ai][bj][m][n] * 0.0078125f; int t = 0;
                                t = __builtin_amdgcn_cvt_pk_fp8_f32(v[0], v[1], t, false); t = __builtin_amdgcn_cvt_pk_fp8_f32(v[2], v[3], t, true); q[bj * 2 + n] = t; }
                        *(u32x4*)rowp = (u32x4){(unsigned)q[0], (unsigned)q[1], (unsigned)q[2], (unsigned)q[3]}; } }
        }
    }
};

struct Params {
    const float* in[26];
    float* out; unsigned char* ws;
    int ph_lo, ph_hi, li, pad;
};
enum { I_X = 0, I_C, I_CTX, I_CCTX, I_WADA, I_BADA, I_NMG, I_NFG, I_WIN, I_CMLNG, I_CMLNB, I_CMWS, I_CMBS, I_RPB, I_DECAY, I_WBR, I_WOUT, I_RW, I_RB,
       I_EG, I_EU, I_ED, I_SG, I_SU, I_SD, I_FG };

__device__ __forceinline__ const float* kin(int i) {
    unsigned off = (unsigned)i * 8u; asm volatile("" : "+s"(off));
    const __attribute__((address_space(4))) char* ka = (const __attribute__((address_space(4))) char*)__builtin_amdgcn_kernarg_segment_ptr();
    return (const float*)*(GAS const float* const __attribute__((address_space(4)))*)(ka + off);
}
__device__ __forceinline__ float* kout_ptr() { unsigned off = 208u; asm volatile("" : "+s"(off));
    const __attribute__((address_space(4))) char* ka = (const __attribute__((address_space(4))) char*)__builtin_amdgcn_kernarg_segment_ptr();
    return (float*)*(GAS float* const __attribute__((address_space(4)))*)(ka + off); }
__device__ __forceinline__ unsigned char* kws_ptr() { unsigned off = 216u; asm volatile("" : "+s"(off));
    const __attribute__((address_space(4))) char* ka = (const __attribute__((address_space(4))) char*)__builtin_amdgcn_kernarg_segment_ptr();
    return (unsigned char*)*(GAS unsigned char* const __attribute__((address_space(4)))*)(ka + off); }
static_assert(__builtin_offsetof(Params, out) == 208 && __builtin_offsetof(Params, ws) == 216, "kernarg offsets");
static_assert(__builtin_offsetof(Params, in) == 0, "kin() reads Params::in at kernarg offset 0");
__device__ __forceinline__ void transpose_item(const float* W, int N, bf16_t* WT, int ldk, int extra, LAS float* scr, int kb, int nb, int lane) {
    const int k0 = 64 * kb, n0 = 32 * nb;
    float wv[32];
#pragma unroll
    for (int i = 0; i < 32; ++i) wv[i] = W[(size_t)(k0 + 2 * i + (lane >> 5)) * N + n0 + (lane & 31)];
#pragma unroll
    for (int i = 0; i < 32; ++i) scr[(2 * i + (lane >> 5)) * 33 + (lane & 31)] = wv[i];
    LDS_WAIT(); asm volatile("" ::: "memory");
    const int c = lane & 7;
#pragma unroll
    for (int j = 0; j < 4; ++j) { const int n = (lane >> 3) + 8 * j; const LAS float* s = scr + (8 * c) * 33 + n;
        u32x4 o; o.x = pk2(s[0 * 33], s[1 * 33]); o.y = pk2(s[2 * 33], s[3 * 33]); o.z = pk2(s[4 * 33], s[5 * 33]); o.w = pk2(s[6 * 33], s[7 * 33]);
        *(u32x4*)(WT + (size_t)(n0 + n + extra) * ldk + k0 + 8 * c) = o; }
    LDS_WAIT(); asm volatile("" ::: "memory");
}
__device__ __forceinline__ void transpose_item_f8(const float* W, int N, unsigned char* WT, int ldk, int extra, float scale, LAS float* scr, int kb, int nb, int lane) {
    const int k0 = 64 * kb, n0 = 32 * nb;
    float wv[32];
#pragma unroll
    for (int i = 0; i < 32; ++i) wv[i] = W[(size_t)(k0 + 2 * i + (lane >> 5)) * N + n0 + (lane & 31)];
#pragma unroll
    for (int i = 0; i < 32; ++i) scr[(2 * i + (lane >> 5)) * 33 + (lane & 31)] = wv[i];
    LDS_WAIT(); asm volatile("" ::: "memory");
    const int c = lane & 7;
#pragma unroll
    for (int j = 0; j < 4; ++j) { const int n = (lane >> 3) + 8 * j; const LAS float* s = scr + (8 * c) * 33 + n;
        int lo = 0, hi = 0;
        lo = __builtin_amdgcn_cvt_pk_fp8_f32(s[0 * 33] * scale, s[1 * 33] * scale, lo, false); lo = __builtin_amdgcn_cvt_pk_fp8_f32(s[2 * 33] * scale, s[3 * 33] * scale, lo, true);
        hi = __builtin_amdgcn_cvt_pk_fp8_f32(s[4 * 33] * scale, s[5 * 33] * scale, hi, false); hi = __builtin_amdgcn_cvt_pk_fp8_f32(s[6 * 33] * scale, s[7 * 33] * scale, hi, true);
        *(u32x2*)(WT + (size_t)(n0 + n + extra) * ldk + k0 + 8 * c) = (u32x2){(unsigned)lo, (unsigned)hi}; }
    LDS_WAIT(); asm volatile("" ::: "memory");
}
constexpr int IT_IN = 16 * 224, IT_BR = 3 * 8 * 32, IT_OUT = 16 * 32, IT_SG = 16 * 8, IT_SD = 4 * 32, IT_RT = 16 * 2, IT_CM = 128;
constexpr int MISC_ITEMS = IT_IN + IT_BR + IT_OUT + 2 * IT_SG + IT_SD + IT_RT + IT_CM;
__device__ __forceinline__ void misc_item(const Params& p, int l, int r, LAS float* scr, int lane) {
    unsigned char* wm = p.ws + WS_WM + (size_t)l * WM_STRIDE;
    if (r < IT_IN) { transpose_item_f8(kin(I_WIN) + (size_t)l * 1024 * 7168, 7168, (unsigned char*)(wm + WM_IN), 1024, 0, 32.0f, scr, r / 224, r % 224, lane); return; } r -= IT_IN;
    if (r < IT_BR) { const int i = r / 256, q = r % 256; transpose_item(kin(I_WBR) + ((size_t)l * 3 + i) * 512 * 1024, 1024, (bf16_t*)(wm + WM_BR) + (size_t)i * 1024 * 512, 512, 0, scr, q / 32, q % 32, lane); return; } r -= IT_BR;
    if (r < IT_OUT) { transpose_item(kin(I_WOUT) + (size_t)l * 1024 * 1024, 1024, (bf16_t*)(wm + WM_OUT), 1024, 0, scr, r / 32, r % 32, lane); return; } r -= IT_OUT;
    if (r < 2 * IT_SG) { const int up = r / IT_SG, q = r % IT_SG, nb = q % 8;
        transpose_item_f8(kin(up ? I_SU : I_SG) + (size_t)l * 1024 * 256, 256, (unsigned char*)(wm + WM_SGU), 1024, ((32 * nb) / 128) * 128 + up * 128, 32.0f, scr, q / 8, nb, lane); return; } r -= 2 * IT_SG;
    if (r < IT_SD) { transpose_item_f8(kin(I_SD) + (size_t)l * 256 * 1024, 1024, (unsigned char*)(wm + WM_SD), 256, 0, 16.0f, scr, r / 32, r % 32, lane); return; } r -= IT_SD;
    if (r < IT_RT) { transpose_item(kin(I_RW) + (size_t)l * 1024 * 64, 64, (bf16_t*)(wm + WM_RT), 1024, 0, scr, r / 2, r % 2, lane); return; } r -= IT_RT;
    { const float* src = kin(I_CMWS) + (size_t)l * 65536 + (size_t)r * 512 + lane * 8; const f32x4 a = *(const f32x4*)src, b = *(const f32x4*)(src + 4);
      u32x4 o; o.x = pk2(a[0], a[1]); o.y = pk2(a[2], a[3]); o.z = pk2(b[0], b[1]); o.w = pk2(b[2], b[3]);
      *(u32x4*)((bf16_t*)(wm + WM_CM) + (size_t)r * 512 + lane * 8) = o; }
}
constexpr int EXP_ITEMS = 3 * 64 * 128;
constexpr int FILL_SPLIT = 34000;
__device__ __forceinline__ void expert_item(const Params& p, int l, int r, LAS float* scr, int lane) {
    unsigned char* we = p.ws + WS_WE + (size_t)l * WE_LAYER;
    const int which = r / 8192, q = r % 8192, e = q / 128, it = q % 128;
    if (which < 2) { const int kb = it / 8, nb = it % 8;
        transpose_item_f8(kin(which ? I_EU : I_EG) + ((size_t)l * 64 + e) * 1024 * 256, 256, (unsigned char*)(we + WE_GU) + (size_t)e * 512 * 1024, 1024, ((32 * nb) / 128) * 128 + which * 128, 32.0f, scr, kb, nb, lane); }
    else { const int kb = it / 32, nb = it % 32;
        transpose_item_f8(kin(I_ED) + ((size_t)l * 64 + e) * 256 * 1024, 1024, (unsigned char*)(we + WE_D) + (size_t)e * 1024 * 256, 256, 0, 16.0f, scr, kb, nb, lane); }
}
__device__ __forceinline__ void mod_unit(const Params& p, LAS unsigned char* lds, int u, int tid) {
    const int l = u / 96, cb = u % 96, wave = __builtin_amdgcn_readfirstlane(tid >> 6), lane = tid & 63;
    LAS float* sil = (LAS float*)lds;
    LAS float* part = (LAS float*)(lds + 36864);
    for (int idx = tid; idx < 9 * 1024; idx += NTHREADS) { const int r = idx >> 10, k = idx & 1023; const float v = r < 8 ? kin(I_C)[r * 1024 + k] : kin(I_CCTX)[k]; sil[idx] = v / (1.0f + expf(-v)); }
    __syncthreads();
    float acc[9];
#pragma unroll
    for (int r = 0; r < 9; ++r) acc[r] = 0.f;
    const float* wp = kin(I_WADA) + ((size_t)l * 1024 + wave * 128) * 6144 + cb * 64 + lane;
#pragma unroll 4
    for (int k = 0; k < 128; ++k) { const float wv = wp[(size_t)k * 6144];
#pragma unroll
        for (int r = 0; r < 9; ++r) acc[r] += sil[r * 1024 + wave * 128 + k] * wv; }
#pragma unroll
    for (int r = 0; r < 9; ++r) part[(wave * 9 + r) * 64 + lane] = acc[r];
    __syncthreads();
    for (int idx = tid; idx < 576; idx += NTHREADS) { const int r = idx >> 6, ln = idx & 63; float s = kin(I_BADA)[l * 6144 + cb * 64 + ln];
#pragma unroll
        for (int w = 0; w < 8; ++w) s += part[(w * 9 + r) * 64 + ln];
        ((float*)(p.ws + WS_MOD))[((size_t)l * 9 + r) * 6144 + cb * 64 + ln] = s; }
    __syncthreads();
}

__device__ __forceinline__ void norm_mod_vals(const f32x4 (&v)[4], const float* g, const float* sh, const float* sc, bf16_t* orow, bool to_lds, LAS unsigned char* ldst, int lane) {
    f32x4 gq[4], hq[4], cq[4];
#pragma unroll
    for (int j = 0; j < 4; ++j) { gq[j] = ((const f32x4*)g)[64 * j + lane]; hq[j] = ((const f32x4*)sh)[64 * j + lane]; cq[j] = ((const f32x4*)sc)[64 * j + lane]; }
    float ss = 0.f;
#pragma unroll
    for (int j = 0; j < 4; ++j) ss += (v[j][0] * v[j][0] + v[j][1] * v[j][1]) + (v[j][2] * v[j][2] + v[j][3] * v[j][3]);
    const float rstd = rsqrtf(wave_sum(ss, lane) * (1.0f / 1024.0f) + EPS);
#pragma unroll
    for (int j = 0; j < 4; ++j) { const f32x4 gg = gq[j], s_h = hq[j], s_c = cq[j];
        const f32x4 y = v[j] * rstd * gg * (s_c + 1.0f) + s_h;
        u32x2 o; o.x = pk2(y[0], y[1]); o.y = pk2(y[2], y[3]);
        ((u32x2*)orow)[64 * j + lane] = o;
        if (to_lds) *(LAS u32x2*)(ldst + (64 * j + lane) * 8) = o; }
}
__device__ __forceinline__ void norm_mod_vals_f8(const f32x4 (&v)[4], const float* g, const float* sh, const float* sc, unsigned char* orow, int lane) {
    f32x4 gq[4], hq[4], cq[4];
#pragma unroll
    for (int j = 0; j < 4; ++j) { gq[j] = ((const f32x4*)g)[64 * j + lane]; hq[j] = ((const f32x4*)sh)[64 * j + lane]; cq[j] = ((const f32x4*)sc)[64 * j + lane]; }
    float ss = 0.f;
#pragma unroll
    for (int j = 0; j < 4; ++j) ss += (v[j][0] * v[j][0] + v[j][1] * v[j][1]) + (v[j][2] * v[j][2] + v[j][3] * v[j][3]);
    const float rstd = rsqrtf(wave_sum(ss, lane) * (1.0f / 1024.0f) + EPS);
#pragma unroll
    for (int j = 0; j < 4; ++j) { const f32x4 y = v[j] * rstd * gq[j] * (cq[j] + 1.0f) + hq[j];
        int w = 0; w = __builtin_amdgcn_cvt_pk_fp8_f32(y[0], y[1], w, false); w = __builtin_amdgcn_cvt_pk_fp8_f32(y[2], y[3], w, true);
        ((unsigned*)orow)[64 * j + lane] = (unsigned)w; }
}
__device__ __forceinline__ void norm_mod_row(const float* xrow, const float* g, const float* sh, const float* sc, bf16_t* orow, bool to_lds, LAS unsigned char* ldst, int lane) {
    f32x4 v[4];
#pragma unroll
    for (int j = 0; j < 4; ++j) v[j] = ((const f32x4*)xrow)[64 * j + lane];
    norm_mod_vals(v, g, sh, sc, orow, to_lds, ldst, lane);
}
__device__ __forceinline__ void combine_row(f32x4 (&v)[4], const float* xrow, const float* ga2, const bf16_t* shrow, const unsigned char* o8, int lane) {
    u32x2 sq[4]; unsigned oq[8][4]; f32x4 gq[4];
#pragma unroll
    for (int j = 0; j < 4; ++j) { v[j] = ((const f32x4*)xrow)[64 * j + lane]; gq[j] = ((const f32x4*)ga2)[64 * j + lane]; sq[j] = ((const u32x2*)shrow)[64 * j + lane]; }
#pragma unroll
    for (int k = 0; k < 8; ++k)
#pragma unroll
        for (int j = 0; j < 4; ++j) oq[k][j] = ((const unsigned*)(o8 + (size_t)k * 1024))[64 * j + lane];
    asm volatile("" :: "v"(v[0]), "v"(v[1]), "v"(v[2]), "v"(v[3]), "v"(gq[0]), "v"(gq[1]), "v"(gq[2]), "v"(gq[3]) : "memory");
#pragma unroll
    for (int j = 0; j < 4; ++j) { f32x4 t = (f32x4){lo16(sq[j].x), hi16(sq[j].x), lo16(sq[j].y), hi16(sq[j].y)};
#pragma unroll
        for (int k = 0; k < 8; ++k) { const int w = (int)oq[k][j];
            t[0] += __builtin_amdgcn_cvt_f32_fp8(w, 0); t[1] += __builtin_amdgcn_cvt_f32_fp8(w, 1); t[2] += __builtin_amdgcn_cvt_f32_fp8(w, 2); t[3] += __builtin_amdgcn_cvt_f32_fp8(w, 3); }
        v[j] += gq[j] * t; }
}

constexpr int RT_TILE = 0, RT_PITCH = 2064, RT_LG = 64 * RT_PITCH  , RT_BIAS = RT_LG + 64 * 65 * 4  , RT_LCNT = RT_BIAS + 256, RT_LBASE = RT_LCNT + 256,
              RT_SELE = RT_LBASE + 256  , RT_SELW = RT_SELE + 2048, RT_SELR = RT_SELW + 2048, RT_END = RT_SELR + 2048;
static_assert(RT_END <= LDS_BYTES, "router LDS");
#ifdef TIMING
#define RSTAMP(k) do { if (stamp && tid == 0) ((volatile LAS unsigned long long*)(lds + LDS_BYTES - 16 - 512))[24 + (k)] = __builtin_amdgcn_s_memrealtime(); } while (0)
#else
#define RSTAMP(k) do { } while (0)
#endif
__device__ __forceinline__ void router_unit(const Params& p, LAS unsigned char* lds, int l, int u, const float* xl, const float* xc, int tid, bool commit, bool stamp = false) {
    const int wave = __builtin_amdgcn_readfirstlane(tid >> 6), lane = tid & 63, g4 = lane >> 4, row0 = u * 64;
    const bool lat = row0 < NL;
    const float* mr = (const float*)(p.ws + WS_MOD) + (size_t)l * 9 * 6144 + (size_t)(lat ? (row0 >> 11) : 8) * 6144;
    const float* xbase = lat ? xl + (size_t)row0 * D : xc + (size_t)(row0 - NL) * D;
    unsigned char* H2 = (unsigned char*)(p.ws + WS_H) + (size_t)row0 * D;
    LAS float* lg = (LAS float*)(lds + RT_LG); LAS float* bias = (LAS float*)(lds + RT_BIAS);
    LAS int* lcnt = (LAS int*)(lds + RT_LCNT); LAS int* lbase = (LAS int*)(lds + RT_LBASE);
    LAS int* sele = (LAS int*)(lds + RT_SELE); LAS float* selw = (LAS float*)(lds + RT_SELW); LAS int* selr = (LAS int*)(lds + RT_SELR);
    RSTAMP(0);
    if (tid < 64) { lcnt[tid] = 0; bias[tid] = kin(I_RB)[l * 64 + tid]; }
    const int rb = wave >> 1, eb0 = (wave & 1) * 2;
    const bf16_t* w0 = (const bf16_t*)(p.ws + WS_WM + (size_t)l * WM_STRIDE + WM_RT) + launder((eb0 * 16 + (lane & 15)) * 1024 + g4 * 8); const bf16_t* w1 = w0 + launder(16 * 1024);
    bf16x8 qa0[4], qa1[4];
#pragma unroll
    for (int ks = 0; ks < 4; ++ks) { qa0[ks] = *(const bf16x8*)(w0 + ks * 32); qa1[ks] = *(const bf16x8*)(w1 + ks * 32); }
    { f32x4 gg[4], s_h[4], s_c[4];
#pragma unroll
      for (int j = 0; j < 4; ++j) { gg[j] = ((const f32x4*)(kin(I_NFG) + l * 1024))[64 * j + lane]; s_h[j] = ((const f32x4*)(mr + 3072))[64 * j + lane]; s_c[j] = ((const f32x4*)(mr + 4096))[64 * j + lane] + 1.0f; }
#pragma unroll
      for (int hb = 0; hb < 2; ++hb) { f32x4 v[4][4];
#pragma unroll
          for (int i = 0; i < 4; ++i)
#pragma unroll
              for (int j = 0; j < 4; ++j) v[i][j] = ((const f32x4*)(xbase + (size_t)(wave * 8 + hb * 4 + i) * D))[64 * j + lane];
#pragma unroll
          for (int i = 0; i < 4; ++i) { const int rl = wave * 8 + hb * 4 + i; float ss = 0.f;
#pragma unroll
              for (int j = 0; j < 4; ++j) ss += (v[i][j][0] * v[i][j][0] + v[i][j][1] * v[i][j][1]) + (v[i][j][2] * v[i][j][2] + v[i][j][3] * v[i][j][3]);
              const float rstd = rsqrtf(wave_sum(ss, lane) * (1.0f / 1024.0f) + EPS);
#pragma unroll
              for (int j = 0; j < 4; ++j) { const f32x4 y = v[i][j] * rstd * gg[j] * s_c[j] + s_h[j];
                  u32x2 o; o.x = pk2(y[0], y[1]); o.y = pk2(y[2], y[3]);
                  int q8 = 0; q8 = __builtin_amdgcn_cvt_pk_fp8_f32(y[0], y[1], q8, false); q8 = __builtin_amdgcn_cvt_pk_fp8_f32(y[2], y[3], q8, true);
                  ((unsigned*)(H2 + (size_t)rl * D))[64 * j + lane] = (unsigned)q8; *(LAS u32x2*)(lds + RT_TILE + rl * RT_PITCH + (64 * j + lane) * 8) = o; } } } }
    __syncthreads();
    RSTAMP(1);
    { f32x4 a0 = (f32x4){0.f, 0.f, 0.f, 0.f}, a1 = a0;
      const LAS unsigned char* hrow = lds + RT_TILE + (rb * 16 + (lane & 15)) * RT_PITCH + g4 * 16;
      bf16x8 qb0[4], qb1[4];
      sfor<0, 4>([&](auto it_) { constexpr int it = decltype(it_)::value;
#pragma unroll
          for (int ks = 0; ks < 4; ++ks) { qb0[ks] = *(const bf16x8*)(w0 + ((2 * it + 1) * 4 + ks) * 32); qb1[ks] = *(const bf16x8*)(w1 + ((2 * it + 1) * 4 + ks) * 32); }
#pragma unroll
          for (int ks = 0; ks < 4; ++ks) { const bf16x8 bq = *(const LAS bf16x8*)(hrow + ((2 * it) * 4 + ks) * 64); a0 = mfma16(qa0[ks], bq, a0); a1 = mfma16(qa1[ks], bq, a1); }
          if constexpr (it < 3) {
#pragma unroll
              for (int ks = 0; ks < 4; ++ks) { qa0[ks] = *(const bf16x8*)(w0 + ((2 * it + 2) * 4 + ks) * 32); qa1[ks] = *(const bf16x8*)(w1 + ((2 * it + 2) * 4 + ks) * 32); } }
#pragma unroll
          for (int ks = 0; ks < 4; ++ks) { const bf16x8 bq = *(const LAS bf16x8*)(hrow + ((2 * it + 1) * 4 + ks) * 64); a0 = mfma16(qb0[ks], bq, a0); a1 = mfma16(qb1[ks], bq, a1); } });
      const int rr = rb * 16 + (lane & 15);
#pragma unroll
      for (int r = 0; r < 4; ++r) { lg[rr * 65 + eb0 * 16 + 4 * g4 + r] = sigmoidf_(a0[r]); lg[rr * 65 + (eb0 + 1) * 16 + 4 * g4 + r] = sigmoidf_(a1[r]); } }
    __syncthreads();
    RSTAMP(2);
    { const int row = tid >> 3, g = tid & 7;
      float sv[8]; unsigned key[8];
#pragma unroll
      for (int j = 0; j < 8; ++j) { sv[j] = lg[row * 65 + 8 * g + j]; const unsigned ub = __float_as_uint(sv[j] + bias[8 * g + j]);
          key[j] = ((ub ^ ((ub >> 31) ? 0xffffffffu : 0x80000000u)) & ~63u) | (unsigned)(63 - (8 * g + j)); }
      float m1 = -3e38f, m2 = -3e38f;
#pragma unroll
      for (int j = 0; j < 8; ++j) { const float c = sv[j] + bias[8 * g + j]; if (c > m1) { m2 = m1; m1 = c; } else if (c > m2) m2 = c; }
      const unsigned ug = __float_as_uint(m1 + m2); const unsigned gkey = ((ug ^ ((ug >> 31) ? 0xffffffffu : 0x80000000u)) & ~7u) | (unsigned)(7 - g);
      int grank = 0;
      sfor<1, 8>([&](auto d_) { constexpr int d = decltype(d_)::value; grank += (int)((unsigned)shxi((int)gkey, d, lane) > gkey); });
      const bool gsel = grank < 4;
#pragma unroll
      for (int j = 0; j < 8; ++j) if (!gsel) key[j] = (unsigned)(63 - (8 * g + j));
      int rk[8];
#pragma unroll
      for (int j = 0; j < 8; ++j) { int r = 0;
#pragma unroll
          for (int j2 = 0; j2 < 8; ++j2) r += (int)(key[j2] > key[j]);
          rk[j] = r; }
      sfor<1, 8>([&](auto d_) { constexpr int d = decltype(d_)::value;
          sfor<0, 8>([&](auto j2_) { constexpr int j2 = decltype(j2_)::value; const unsigned ok = (unsigned)shxi((int)key[j2], d, lane);
#pragma unroll
              for (int j = 0; j < 8; ++j) rk[j] += (int)(ok > key[j]); });
          __builtin_amdgcn_sched_barrier(0); });
      float wsum = 0.f;
#pragma unroll
      for (int j = 0; j < 8; ++j) if (gsel && rk[j] < 8) wsum += sv[j];
      wsum += shx(wsum, 1, lane); wsum += shx(wsum, 2, lane); wsum += shx(wsum, 4, lane);
      const float sc = 2.5f / wsum;
#pragma unroll
      for (int j = 0; j < 8; ++j) if (gsel && rk[j] < 8) { const int e = 8 * g + j, k = rk[j];
          sele[row * 8 + k] = e; selw[row * 8 + k] = sv[j] * sc; selr[row * 8 + k] = __hip_atomic_fetch_add(&lcnt[e], 1, __ATOMIC_RELAXED, __HIP_MEMORY_SCOPE_WORKGROUP); } }
    __syncthreads();
    RSTAMP(3);
    if (tid < 64) { const int n = lcnt[tid]; int base = 0; if (n > 0 && commit) base = (int)atomicAdd((unsigned*)(p.ws + WS_CTL) + CW_CNT + l * 2048 + tid * 16, (unsigned)n); lbase[tid] = base; }
    __syncthreads();
    RSTAMP(4);
    { const int rl = tid >> 3, k = tid & 7, e = sele[rl * 8 + k], pos = lbase[e] + selr[rl * 8 + k];
      if (commit) { ((unsigned*)(p.ws + WS_LIST))[(size_t)e * NT + pos] = (unsigned)((row0 + rl) * 8 + k); ((float*)(p.ws + WS_WL))[(size_t)e * NT + pos] = selw[rl * 8 + k]; } }
    __syncthreads();
    RSTAMP(5);
}

__device__ __forceinline__ void mixA_unit(const Params& p, LAS unsigned char* lds, int l, int ch, int g, int tid) {
    const int wave = __builtin_amdgcn_readfirstlane(tid >> 6), lane = tid & 63, g4 = lane >> 4, rows0 = ch * 128;
    const bf16_t* Z = (const bf16_t*)(p.ws + WS_R + R_Z); bf16_t* BR = (bf16_t*)(p.ws + WS_R + R_BR);
    const bf16_t* WCM = (const bf16_t*)(p.ws + WS_WM + (size_t)l * WM_STRIDE + WM_CM);
    LAS unsigned char* vn = lds + 1024;
    { const int q = tid >> 2, cs = (tid & 3) * 32; const f32x2 st2 = *(const f32x2*)((const float*)(p.ws + WS_R + R_STAT) + (size_t)(rows0 + q) * 2); const float mean = st2[0], rstd = st2[1];
      const float* lg = kin(I_CMLNG) + l * 512 + g * 128 + cs; const float* lb = kin(I_CMLNB) + l * 512 + g * 128 + cs;
#pragma unroll
      for (int j = 0; j < 4; ++j) { const u32x4 v = *(const u32x4*)(Z + (size_t)(rows0 + q) * ZW + ZC_AV + g * 128 + cs + 8 * j);
          const f32x4 ga = *(const f32x4*)(lg + 8 * j), gb = *(const f32x4*)(lg + 8 * j + 4), ba = *(const f32x4*)(lb + 8 * j), bb = *(const f32x4*)(lb + 8 * j + 4);
          u32x4 o;
          o.x = pk2((geluf_(lo16(v.x)) - mean) * rstd * ga[0] + ba[0], (geluf_(hi16(v.x)) - mean) * rstd * ga[1] + ba[1]);
          o.y = pk2((geluf_(lo16(v.y)) - mean) * rstd * ga[2] + ba[2], (geluf_(hi16(v.y)) - mean) * rstd * ga[3] + ba[3]);
          o.z = pk2((geluf_(lo16(v.z)) - mean) * rstd * gb[0] + bb[0], (geluf_(hi16(v.z)) - mean) * rstd * gb[1] + bb[1]);
          o.w = pk2((geluf_(lo16(v.w)) - mean) * rstd * gb[2] + bb[2], (geluf_(hi16(v.w)) - mean) * rstd * gb[3] + bb[3]);
          *(LAS u32x4*)(vn + q * 272 + (cs + 8 * j) * 2) = o; } }
    __syncthreads();
    { const int pb = wave, pp = pb * 16 + (lane & 15);
      bf16x8 bfr[4];
#pragma unroll
      for (int ks = 0; ks < 4; ++ks) bfr[ks] = *(const bf16x8*)(WCM + (size_t)(g * 128 + pp) * 128 + 32 * ks + 8 * g4);
      const unsigned vna = tr_lane(lds_addr(vn), 272, 8, lane);
      const float bs = kin(I_CMBS)[l * 512 + g * 128 + pp];
      const size_t row = (size_t)(rows0 + pp);
      u32x2 uq[8];
#pragma unroll
      for (int i = 0; i < 8; ++i) uq[i] = *(const u32x2*)(Z + row * ZW + ZC_AU + g * 128 + 16 * i + 4 * g4);
      sfor<0, 2>([&](auto cg_) { constexpr int cg = decltype(cg_)::value; f32x4 acc[4];
#pragma unroll
          for (int i = 0; i < 4; ++i) acc[i] = (f32x4){0.f, 0.f, 0.f, 0.f};
          sfor<0, 4>([&](auto ks_) { constexpr int ks = decltype(ks_)::value; bf16x8 af[4]; tr_frag4_i<32 * ks * 272 + 128 * cg, 4 * 272>(vna, af);
#pragma unroll
              for (int i = 0; i < 4; ++i) acc[i] = mfma16(af[i], bfr[ks], acc[i]); });
#pragma unroll
          for (int i = 0; i < 4; ++i) { const int c = 16 * (4 * cg + i) + 4 * g4;
          const u32x2 uu = uq[4 * cg + i];
          u32x2 o; o.x = pk2(geluf_(lo16(uu.x)) * (acc[i][0] + bs), geluf_(hi16(uu.x)) * (acc[i][1] + bs)); o.y = pk2(geluf_(lo16(uu.y)) * (acc[i][2] + bs), geluf_(hi16(uu.y)) * (acc[i][3] + bs));
          *(u32x2*)(BR + row * BRW + g * 128 + c) = o; } }); }
    __syncthreads();
}

__device__ __forceinline__ void ret_stage_qk(const bf16_t* src  , const float* rope, bool do_rope, int tpos0, int mask  , LAS unsigned char* t0, LAS unsigned char* t1, LAS unsigned char* t2,
                                             float sc0, float l2a, float offa, float siga, float l2b, float offb, float sigb, int tid) {
    const int pp = tid >> 2, half = (tid >> 1) & 1, sub = tid & 1;
    const bf16_t* s = src + (size_t)pp * ZW + 32 * half + 8 * sub;
    const u32x4 a = *(const u32x4*)s, b = *(const u32x4*)(s + 16);
    float x1[8] = {lo16(a.x), hi16(a.x), lo16(a.y), hi16(a.y), lo16(a.z), hi16(a.z), lo16(a.w), hi16(a.w)};
    float x2[8] = {lo16(b.x), hi16(b.x), lo16(b.y), hi16(b.y), lo16(b.z), hi16(b.z), lo16(b.w), hi16(b.w)};
    float o1[8], o2[8];
    if (do_rope) { const int t = tpos0 + pp, pos = half ? (t & 63) : (t >> 6); const f32x4* tb = (const f32x4*)(rope + (size_t)(pos * 16 + 8 * sub) * 2);
#pragma unroll
        for (int j = 0; j < 4; ++j) { const f32x4 cs = tb[j];
            o1[2 * j] = x1[2 * j] * cs[0] - x2[2 * j] * cs[1]; o2[2 * j] = x1[2 * j] * cs[1] + x2[2 * j] * cs[0];
            o1[2 * j + 1] = x1[2 * j + 1] * cs[2] - x2[2 * j + 1] * cs[3]; o2[2 * j + 1] = x1[2 * j + 1] * cs[3] + x2[2 * j + 1] * cs[2]; } }
    else {
#pragma unroll
        for (int j = 0; j < 8; ++j) { o1[j] = x1[j]; o2[j] = x2[j]; } }
    const int off = pp * 144 + (32 * half + 8 * sub) * 2;
    const float fp = (float)pp;
    const float sA = sc0 * __builtin_amdgcn_exp2f((offa + siga * fp) * l2a), sB = sc0 * __builtin_amdgcn_exp2f((offb + sigb * fp) * l2b);
    if (mask & 1) { u32x4 w; w.x = pk2(o1[0] * sc0, o1[1] * sc0); w.y = pk2(o1[2] * sc0, o1[3] * sc0); w.z = pk2(o1[4] * sc0, o1[5] * sc0); w.w = pk2(o1[6] * sc0, o1[7] * sc0); *(LAS u32x4*)(t0 + off) = w;
              w.x = pk2(o2[0] * sc0, o2[1] * sc0); w.y = pk2(o2[2] * sc0, o2[3] * sc0); w.z = pk2(o2[4] * sc0, o2[5] * sc0); w.w = pk2(o2[6] * sc0, o2[7] * sc0); *(LAS u32x4*)(t0 + off + 32) = w; }
    if (mask & 2) { u32x4 w; w.x = pk2(o1[0] * sA, o1[1] * sA); w.y = pk2(o1[2] * sA, o1[3] * sA); w.z = pk2(o1[4] * sA, o1[5] * sA); w.w = pk2(o1[6] * sA, o1[7] * sA); *(LAS u32x4*)(t1 + off) = w;
              w.x = pk2(o2[0] * sA, o2[1] * sA); w.y = pk2(o2[2] * sA, o2[3] * sA); w.z = pk2(o2[4] * sA, o2[5] * sA); w.w = pk2(o2[6] * sA, o2[7] * sA); *(LAS u32x4*)(t1 + off + 32) = w; }
    if (mask & 4) { u32x4 w; w.x = pk2(o1[0] * sB, o1[1] * sB); w.y = pk2(o1[2] * sB, o1[3] * sB); w.z = pk2(o1[4] * sB, o1[5] * sB); w.w = pk2(o1[6] * sB, o1[7] * sB); *(LAS u32x4*)(t2 + off) = w;
              w.x = pk2(o2[0] * sB, o2[1] * sB); w.y = pk2(o2[2] * sB, o2[3] * sB); w.z = pk2(o2[4] * sB, o2[5] * sB); w.w = pk2(o2[6] * sB, o2[7] * sB); *(LAS u32x4*)(t2 + off + 32) = w; }
}
__device__ __forceinline__ void ret_stage_v(const bf16_t* src  , LAS unsigned char* tv, int tid) {
    const int pp = tid >> 2, seg = (tid & 3) * 32;
#pragma unroll
    for (int j = 0; j < 4; ++j) *(LAS u32x4*)(tv + pp * 272 + (seg + 8 * j) * 2) = *(const u32x4*)(src + (size_t)pp * ZW + seg + 8 * j);
}
__device__ __forceinline__ float log2_gamma(const Params& p, int l, int dir, int h) { const float x = kin(I_DECAY)[(l * 2 + dir) * 4 + h]; return -log2f(1.0f + expf(-x)); }
__device__ __forceinline__ int ret_row0(int b, int cc) { return cc < 2 ? NL + b * 256 + cc * 128 : b * 2048 + (cc - 2) * 128; }

__device__ __forceinline__ void retkv_unit(const Params& p, LAS unsigned char* lds, int l, int b, int h, int cc, int tid) {
    const int wave = __builtin_amdgcn_readfirstlane(tid >> 6), lane = tid & 63, g4 = lane >> 4, row0 = ret_row0(b, cc);
    const bf16_t* Z = (const bf16_t*)(p.ws + WS_R + R_Z); float* KV = (float*)(p.ws + WS_R + R_KV);
    const float l2f = log2_gamma(p, l, 0, h), l2b = log2_gamma(p, l, 1, h);
    LAS unsigned char* kf = lds; LAS unsigned char* kb = lds + 18432; LAS unsigned char* vv = lds + 36864;
    ret_stage_qk(Z + (size_t)row0 * ZW + ZC_RK + h * 64, (const float*)(p.ws + WS_ROPE), cc >= 2, (cc - 2) * 128, 6, kf, kf, kb, 0.125f, l2f, 127.f, -1.f, l2b, 0.f, 1.f, tid);
    ret_stage_v(Z + (size_t)row0 * ZW + ZC_RV + h * 128, vv, tid);
    __syncthreads();
    { const int dir = wave >> 2, db = wave & 3; const unsigned ka = tr_lane(lds_addr(dir ? kb : kf), 144, 8, lane) + 32 * db, va = tr_lane(lds_addr(vv), 272, 8, lane);
      bf16x8 afr[4];
      sfor<0, 4>([&](auto ks_) { constexpr int ks = decltype(ks_)::value; afr[ks] = tr_frag_i<32 * ks * 144, 32 * ks * 144 + 4 * 144>(ka); });
      float* dst = KV + ((((size_t)b * 4 + h) * NCHUNK + cc) * 2 + dir) * 8192;
      sfor<0, 2>([&](auto eg_) { constexpr int eg = decltype(eg_)::value; f32x4 acc[4];
#pragma unroll
          for (int i = 0; i < 4; ++i) acc[i] = (f32x4){0.f, 0.f, 0.f, 0.f};
          sfor<0, 4>([&](auto ks_) { constexpr int ks = decltype(ks_)::value; bf16x8 bf[4]; tr_frag4_i<32 * ks * 272 + 128 * eg, 4 * 272>(va, bf);
#pragma unroll
              for (int i = 0; i < 4; ++i) acc[i] = mfma16(afr[ks], bf[i], acc[i]); });
#pragma unroll
          for (int i = 0; i < 4; ++i)
#pragma unroll
              for (int r = 0; r < 4; ++r) dst[(16 * db + 4 * g4 + r) * 128 + 16 * (4 * eg + i) + (lane & 15)] = acc[i][r]; }); }
    __syncthreads();
}

__device__ __forceinline__ void retout_unit(const Params& p, LAS unsigned char* lds, int l, int b, int h, int cc, int tid) {
    const int wave = __builtin_amdgcn_readfirstlane(tid >> 6), lane = tid & 63, g4 = lane >> 4, row0 = ret_row0(b, cc);
    const bf16_t* Z = (const bf16_t*)(p.ws + WS_R + R_Z); bf16_t* BR = (bf16_t*)(p.ws + WS_R + R_BR);
    const float l2f = log2_gamma(p, l, 0, h), l2b = log2_gamma(p, l, 1, h);
    LAS unsigned char* tq = lds; LAS unsigned char* tqf = lds + 18432; LAS unsigned char* tqb = lds + 36864; LAS unsigned char* tk = lds + 55296;
    LAS unsigned char* tv = lds + 73728; LAS unsigned char* st = lds + 108544;
    { const u32x4* src = (const u32x4*)((const bf16_t*)(p.ws + WS_R + R_ST) + (((size_t)b * 4 + h) * NCHUNK + cc) * 2 * 8192);
#pragma unroll
      for (int j = 0; j < 4; ++j) { const int c = tid + 512 * j; *(LAS u32x4*)(st + (c >> 4) * 272 + (c & 15) * 16) = src[c]; } }
    const float* rope = (const float*)(p.ws + WS_ROPE);
    ret_stage_qk(Z + (size_t)row0 * ZW + ZC_RQ + h * 64, rope, cc >= 2, (cc - 2) * 128, 7, tq, tqf, tqb, 1.0f, l2f, 1.f, 1.f, l2b, 128.f, -1.f, tid);
    ret_stage_qk(Z + (size_t)row0 * ZW + ZC_RK + h * 64, rope, cc >= 2, (cc - 2) * 128, 1, tk, tk, tk, 0.125f, 0.f, 0.f, 0.f, 0.f, 0.f, 0.f, tid);
    ret_stage_v(Z + (size_t)row0 * ZW + ZC_RV + h * 128, tv, tid);
    __syncthreads();
    const int ib = wave, ti = ib * 16 + (lane & 15);
    f32x4 oacc[8];
#pragma unroll
    for (int eb = 0; eb < 8; ++eb) oacc[eb] = (f32x4){0.f, 0.f, 0.f, 0.f};
    { bf16x8 bq[4];
#pragma unroll
      for (int ks = 0; ks < 4; ++ks) bq[ks] = *(const LAS bf16x8*)((ks < 2 ? tqf : tqb) + ti * 144 + (32 * (ks & 1) + 8 * g4) * 2);
      const unsigned sa = tr_lane(lds_addr(st), 272, 8, lane);
      sfor<0, 4>([&](auto ks_) { constexpr int ks = decltype(ks_)::value;
          sfor<0, 2>([&](auto eg_) { constexpr int eg = decltype(eg_)::value; bf16x8 af[4]; tr_frag4_i<32 * ks * 272 + 128 * eg, 4 * 272>(sa, af);
#pragma unroll
              for (int i = 0; i < 4; ++i) oacc[4 * eg + i] = mfma16(af[i], bq[ks], oacc[4 * eg + i]); }); }); }
    { bf16x8 bq[2];
#pragma unroll
      for (int ks = 0; ks < 2; ++ks) bq[ks] = *(const LAS bf16x8*)(tq + ti * 144 + (32 * ks + 8 * g4) * 2);
      f32x4 sacc[8];
#pragma unroll
      for (int jb = 0; jb < 8; ++jb) { sacc[jb] = (f32x4){0.f, 0.f, 0.f, 0.f};
#pragma unroll
          for (int ks = 0; ks < 2; ++ks) { const bf16x8 a = *(const LAS bf16x8*)(tk + (16 * jb + (lane & 15)) * 144 + (32 * ks + 8 * g4) * 2); sacc[jb] = mfma16(a, bq[ks], sacc[jb]); }
#pragma unroll
          for (int r = 0; r < 4; ++r) { const int dist = ti - (16 * jb + 4 * g4 + r);
              sacc[jb][r] *= dist >= 0 ? __builtin_amdgcn_exp2f((float)dist * l2f) : __builtin_amdgcn_exp2f((float)(-dist) * l2b); } }
      const unsigned va = tr_lane(lds_addr(tv), 272, 4, lane);
      sfor<0, 4>([&](auto kk_) { constexpr int kk = decltype(kk_)::value;
          u32x4 pw; pw.x = pk2(sacc[2 * kk][0], sacc[2 * kk][1]); pw.y = pk2(sacc[2 * kk][2], sacc[2 * kk][3]); pw.z = pk2(sacc[2 * kk + 1][0], sacc[2 * kk + 1][1]); pw.w = pk2(sacc[2 * kk + 1][2], sacc[2 * kk + 1][3]);
          const bf16x8 bp = as_frag(pw);
          sfor<0, 2>([&](auto eg_) { constexpr int eg = decltype(eg_)::value; bf16x8 af[4]; tr_frag4_i<32 * kk * 272 + 128 * eg, 16 * 272>(va, af);
#pragma unroll
              for (int i = 0; i < 4; ++i) oacc[4 * eg + i] = mfma16(af[i], bp, oacc[4 * eg + i]); }); }); }
    { float ss = 0.f;
#pragma unroll
      for (int eb = 0; eb < 8; ++eb) ss += (oacc[eb][0] * oacc[eb][0] + oacc[eb][1] * oacc[eb][1]) + (oacc[eb][2] * oacc[eb][2] + oacc[eb][3] * oacc[eb][3]);
      ss += shx(ss, 16, lane); ss += shx(ss, 32, lane);
      const float rstd = rsqrtf(ss * (1.0f / 128.0f) + EPS);
      const size_t row = (size_t)(row0 + ti);
      u32x2 gq[8];
#pragma unroll
      for (int eb = 0; eb < 8; ++eb) gq[eb] = *(const u32x2*)(Z + row * ZW + ZC_RG + h * 128 + 16 * eb + 4 * g4);
#pragma unroll
      for (int eb = 0; eb < 8; ++eb) { const int e = 16 * eb + 4 * g4; const u32x2 gg = gq[eb];
          u32x2 o; o.x = pk2(oacc[eb][0] * rstd * siluf_(lo16(gg.x)), oacc[eb][1] * rstd * siluf_(hi16(gg.x))); o.y = pk2(oacc[eb][2] * rstd * siluf_(lo16(gg.y)), oacc[eb][3] * rstd * siluf_(hi16(gg.y)));
          *(u32x2*)(BR + row * BRW + 1024 + h * 128 + e) = o; } }
    __syncthreads();
}

constexpr int NA_V = 0, NA_PITCH = 144, NA_CTXROW = 576, NA_TAB = (576 + 256) * NA_PITCH  , NA_MB = NA_TAB + 2048  , NA_MB_SZ = 18432;
static_assert(NA_MB + NA_MB_SZ <= LDS_BYTES - 1024, "NA LDS");
__device__ __forceinline__ void na_unit(const Params& p, LAS unsigned char* lds, int l, int b, int h, int rp, bool local, int tid) {
    const int wave = __builtin_amdgcn_readfirstlane(tid >> 6), lane = tid & 63, g4 = lane >> 4, qb = wave >> 1, half = wave & 1;
    const bf16_t* Z = (const bf16_t*)(p.ws + WS_R + R_Z); bf16_t* BR = (bf16_t*)(p.ws + WS_R + R_BR);
    LAS unsigned char* vl = lds + NA_V; LAS float* tab = (LAS float*)(lds + NA_TAB);
    const int qc = 16 * qb + (lane & 15);
    const int r0 = 2 * rp, rsA = min(max(r0 - 4, 0), 24), nwr = min(9, 32 - rsA);
    const int kbs = min(max(16 * qb - 8, 0), 32), cst = min(max(qc - 8, 0), 48);
    if (local) {
        for (int key = tid; key < nwr * 64; key += NTHREADS) { const size_t krow = (size_t)b * 2048 + (rsA + (key >> 6)) * 64 + (key & 63);
            const u32x4* vs_ = (const u32x4*)(Z + krow * ZW + ZC_NV + h * 64);
#pragma unroll
            for (int j = 0; j < 8; ++j) *(LAS u32x4*)(vl + key * NA_PITCH + 16 * j) = vs_[j]; }
        if (tid < 465) tab[tid] = kin(I_RPB)[(size_t)(l * 8 + h) * 465 + tid]; }
    { const int key = tid >> 1, hb = (tid & 1) * 4; const u32x4* vs_ = (const u32x4*)(Z + ((size_t)NL + b * 256 + key) * ZW + ZC_NV + h * 64) + hb;
#pragma unroll
      for (int j = 0; j < 4; ++j) *(LAS u32x4*)(vl + (NA_CTXROW + key) * NA_PITCH + 16 * (hb + j)) = vs_[j]; }
    __syncthreads();
    const float L2E = 1.44269504089f;
    const unsigned vla = lds_addr(vl);
    const unsigned lane_off = (unsigned)((4 * g4 + ((lane & 15) >> 2)) * NA_PITCH + (lane & 3) * 8);
#pragma unroll 1
    for (int jr = 0; jr < 2; ++jr) {
        const int r = r0 + jr, rs = min(max(r - 4, 0), 24), wofs = rs - rsA;
        const size_t qrow = local ? (size_t)b * 2048 + r * 64 + qc : (size_t)NL + b * 256 + r * 64 + qc;
        bf16x8 bq[2];
#pragma unroll
        for (int ks = 0; ks < 2; ++ks) bq[ks] = *(const bf16x8*)(Z + qrow * ZW + ZC_NQ + h * 64 + 32 * ks + 8 * g4);
        bf16x8 kf[16];
        if (local) {
#pragma unroll
            for (int blk = 0; blk < 8; ++blk) { const size_t krow = (size_t)b * 2048 + (rs + 4 * half + (blk >> 1)) * 64 + kbs + 16 * (blk & 1) + (lane & 15);
#pragma unroll
                for (int ks = 0; ks < 2; ++ks) kf[blk * 2 + ks] = *(const bf16x8*)(Z + krow * ZW + ZC_NK + h * 64 + 32 * ks + 8 * g4); } }
        f32x4 s[16]; float mx = -1e30f;
        if (local) {
#pragma unroll
            for (int blk = 0; blk < 8; ++blk) { const int i = 4 * half + (blk >> 1), cb = blk & 1;
                f32x4 a = (f32x4){0.f, 0.f, 0.f, 0.f};
#pragma unroll
                for (int ks = 0; ks < 2; ++ks) a = mfma16(kf[blk * 2 + ks], bq[ks], a);
                const int ro = rs + i - r + 7;
#pragma unroll
                for (int rg = 0; rg < 4; ++rg) { const int kc = kbs + 16 * cb + 4 * g4 + rg; const bool valid = kc >= cst && kc < cst + 16;
                    const int co = min(max(kc - qc, -15), 15) + 15;
                    const float bv = tab[ro * 31 + co];
                const float v = valid ? a[rg] * 0.125f + bv : -1e30f; s[blk][rg] = v; mx = fmaxf(mx, v); } }
        } else {
#pragma unroll
            for (int blk = 0; blk < 8; ++blk) s[blk] = (f32x4){-1e30f, -1e30f, -1e30f, -1e30f};
        }
#pragma unroll
        for (int blk = 0; blk < 8; ++blk) { const size_t krow = (size_t)NL + b * 256 + half * 128 + 16 * blk + (lane & 15);
#pragma unroll
            for (int ks = 0; ks < 2; ++ks) kf[blk * 2 + ks] = *(const bf16x8*)(Z + krow * ZW + ZC_NK + h * 64 + 32 * ks + 8 * g4); }
#pragma unroll
        for (int blk = 0; blk < 8; ++blk) { f32x4 a = (f32x4){0.f, 0.f, 0.f, 0.f};
#pragma unroll
            for (int ks = 0; ks < 2; ++ks) a = mfma16(kf[blk * 2 + ks], bq[ks], a);
#pragma unroll
            for (int rg = 0; rg < 4; ++rg) { const float v = a[rg] * 0.125f; s[8 + blk][rg] = v; mx = fmaxf(mx, v); } }
        mx = fmaxf(mx, shx(mx, 16, lane)); mx = fmaxf(mx, shx(mx, 32, lane));
        float ls = 0.f;
#pragma unroll
        for (int blk = 0; blk < 16; ++blk)
#pragma unroll
            for (int rg = 0; rg < 4; ++rg) { const float e = __builtin_amdgcn_exp2f((s[blk][rg] - mx) * L2E); s[blk][rg] = e; ls += e; }
        ls += shx(ls, 16, lane); ls += shx(ls, 32, lane);
        f32x4 oacc[4];
#pragma unroll
        for (int db = 0; db < 4; ++db) oacc[db] = (f32x4){0.f, 0.f, 0.f, 0.f};
        if (local) { const unsigned va = vla + (unsigned)(((wofs + 4 * half) * 64 + kbs) * NA_PITCH) + lane_off;
            sfor<0, 4>([&](auto kk_) { constexpr int kk = decltype(kk_)::value;
                u32x4 pw; pw.x = pk2(s[2 * kk][0], s[2 * kk][1]); pw.y = pk2(s[2 * kk][2], s[2 * kk][3]); pw.z = pk2(s[2 * kk + 1][0], s[2 * kk + 1][1]); pw.w = pk2(s[2 * kk + 1][2], s[2 * kk + 1][3]);
                const bf16x8 bp = as_frag(pw); bf16x8 vf[4]; tr_frag4_i<kk * 64 * NA_PITCH, 16 * NA_PITCH>(va, vf);
#pragma unroll
                for (int db = 0; db < 4; ++db) oacc[db] = mfma16(vf[db], bp, oacc[db]); }); }
        { const unsigned va = vla + (unsigned)((NA_CTXROW + half * 128) * NA_PITCH) + lane_off;
          sfor<0, 4>([&](auto kk_) { constexpr int kk = decltype(kk_)::value;
              u32x4 pw; pw.x = pk2(s[8 + 2 * kk][0], s[8 + 2 * kk][1]); pw.y = pk2(s[8 + 2 * kk][2], s[8 + 2 * kk][3]); pw.z = pk2(s[9 + 2 * kk][0], s[9 + 2 * kk][1]); pw.w = pk2(s[9 + 2 * kk][2], s[9 + 2 * kk][3]);
              const bf16x8 bp = as_frag(pw); bf16x8 vf[4]; tr_frag4_i<kk * 32 * NA_PITCH, 16 * NA_PITCH>(va, vf);
#pragma unroll
              for (int db = 0; db < 4; ++db) oacc[db] = mfma16(vf[db], bp, oacc[db]); }); }
        LAS float* mb = (LAS float*)(lds + NA_MB) + (qb * 64 + lane) * 18;
        if (half == 1) { mb[0] = mx; mb[1] = ls;
#pragma unroll
            for (int db = 0; db < 4; ++db)
#pragma unroll
                for (int rg = 0; rg < 4; ++rg) mb[2 + db * 4 + rg] = oacc[db][rg]; }
        __syncthreads();
        if (half == 0) { const float m1 = mb[0], l1 = mb[1], M = fmaxf(mx, m1), a0 = __builtin_amdgcn_exp2f((mx - M) * L2E), a1 = __builtin_amdgcn_exp2f((m1 - M) * L2E);
            const float inv = 1.0f / (ls * a0 + l1 * a1);
#pragma unroll
            for (int db = 0; db < 4; ++db) { float o[4];
#pragma unroll
                for (int rg = 0; rg < 4; ++rg) o[rg] = (oacc[db][rg] * a0 + mb[2 + db * 4 + rg] * a1) * inv;
                u32x2 w; w.x = pk2(o[0], o[1]); w.y = pk2(o[2], o[3]);
                *(u32x2*)(BR + qrow * BRW + 512 + h * 64 + 16 * db + 4 * g4) = w; } }
        __syncthreads();
    }
}

#ifndef STAMP_PHASE
#define STAMP_PHASE -1
#endif
constexpr int PH_PER_LAYER = 10, PH_FINAL = 1 + 2 * PH_PER_LAYER, NPHASES = PH_FINAL + 1;
__device__ __forceinline__ void moe_tables(const Params& p, LAS unsigned char* lds, int l, int tid, int nsplit, int nMs, int G, int c) {
    LAS int* tb = (LAS int*)(lds + MOE_TAB_OFF); LAS int* cn = tb + 128;
    if (tid < 64) { const unsigned c = ((const unsigned*)(p.ws + WS_CTL))[CW_CNT + l * 2048 + tid * 16]; cn[tid] = (int)(c < (unsigned)NT ? c : (unsigned)NT); }
    __syncthreads();
    if (tid == 0) { int s = 0; for (int e = 0; e < 64; ++e) { tb[e] = s; s += (cn[e] + 255) >> 8; } tb[64] = s; }
    __syncthreads();
    if (tid < MOE_UL_MAX) { LAS int* ul = (LAS int*)(lds + MOE_UL_OFF) + tid * 8; const int ntr = tb[64];
        const int idx = tid * G + ((G & 7) == 0 ? (c & 7) * (G >> 3) + (c >> 3) : c);
        if (idx >= nsplit * (ntr + nMs)) ul[0] = -1;
        else if (idx < nsplit * ntr) { const int mt = idx / nsplit, pn = idx % nsplit; int lo = 0, hi = 63;
            for (int it = 0; it < 6; ++it) { const int mid = (lo + hi + 1) >> 1; if (tb[mid] <= mt) lo = mid; else hi = mid - 1; }
            ul[0] = lo; ul[1] = pn; ul[2] = (mt - tb[lo]) * 256; ul[3] = mt; ul[4] = cn[lo]; }
        else { const int s_ = idx - nsplit * ntr; ul[0] = 64; ul[1] = s_ % nsplit; ul[2] = 0; ul[3] = s_ / nsplit; ul[4] = 0; } }
    __syncthreads();
}

__global__ void __launch_bounds__(NTHREADS, 2) fwd_kernel(Params p0) {
    extern __shared__ __attribute__((aligned(16))) unsigned char lds_raw[];
    LAS unsigned char* const lds0 = (LAS unsigned char*)lds_raw;
    const int tid0 = threadIdx.x, G = gridDim.x, bid = blockIdx.x, NGW = G * NWAVES;
    const int wave0 = __builtin_amdgcn_readfirstlane(tid0 >> 6);
#ifndef STAG_IN
#define STAG_IN 0
#endif
#define STAGGER(q) do { if ((q) > 0) { const unsigned long long t0_ = __builtin_amdgcn_s_memrealtime(); const unsigned d_ = (unsigned)((bid >> 3) & 3) * (unsigned)(q); \
    while (__builtin_amdgcn_s_memrealtime() - t0_ < d_) __builtin_amdgcn_s_sleep(8); } } while (0)
#define PHASE_IDS const int tid = launder(wave0 * 64 + lane_id_here()), wave = __builtin_amdgcn_readfirstlane(tid >> 6), lane = tid & 63, gw = bid * NWAVES + wave; (void)lane; (void)gw; \
    Params p = p0; p.ws = kws_ptr(); p.out = kout_ptr(); \
    LAS unsigned char* lds; { unsigned la_ = (unsigned)(size_t)lds0; asm volatile("" : "+s"(la_)); lds = (LAS unsigned char*)(size_t)la_; }
    volatile LAS unsigned* xbw = (volatile LAS unsigned*)(lds0 + LDS_BYTES - 16);
    if (tid0 == 0) { xbw[0] = 0u; xbw[1] = 0u; xbw[2] = 0u; xbw[3] = 0u; }
    __syncthreads();
    XcdBarrier bar = xcd_barrier_post((unsigned*)(p0.ws + WS_CTL) + CW_BAR + p0.li * XCD_BAR_WORDS, xbw);
#ifdef TEST_PHASE
#define IN(k) ((((k) - 1) % PH_PER_LAYER == TEST_PHASE - 1 && (k) >= 1 && (k) < PH_FINAL && TEST_PHASE >= 1) || ((k) == 0 && TEST_PHASE == 0) || ((k) == PH_FINAL && TEST_PHASE == 99)) && (launder_s(p0.ph_lo) <= (k) && (k) < launder_s(p0.ph_hi))
#else
#define IN(k) (launder_s(p0.ph_lo) <= (k) && (k) < launder_s(p0.ph_hi))
#endif
#ifndef DUP_PHASE
#define DUP_PHASE -1
#endif
#define DUP(k) for (int rep_ = 0; rep_ < ((DUP_PHASE) == (k) ? 2 : 1); ++rep_)
#ifdef TIMING
    volatile LAS unsigned long long* tst = (volatile LAS unsigned long long*)(lds0 + LDS_BYTES - 16 - 512);
    if (wave0 == 0 && lane_id_here() == 0) tst[0] = __builtin_amdgcn_s_memrealtime();
#define SEAM(k) do { if (IN(k) && IN((k) + 1)) { xcd_barrier(bar, wave0 == 0 && lane_id_here() == 0); if (wave0 == 0 && lane_id_here() == 0) tst[(k) + 1] = __builtin_amdgcn_s_memrealtime(); } } while (0)
#else
#define SEAM(k) do { if (IN(k) && IN((k) + 1)) xcd_barrier(bar, wave0 == 0 && lane_id_here() == 0); } while (0)
#endif
#define Hb ((bf16_t*)(p.ws + WS_H))
#define Zb ((bf16_t*)(p.ws + WS_R + R_Z))
#define BRb ((bf16_t*)(p.ws + WS_R + R_BR))
#define XC ((float*)(p.ws + WS_XC))
#define xl (l == 0 ? kin(I_X) : (const float*)p.out)
#define xc (l == 0 ? kin(I_CTX) : (const float*)XC)
#define mod ((const float*)(p.ws + WS_MOD) + (size_t)l * 9 * 6144)
#define wm (p.ws + WS_WM + (size_t)l * WM_STRIDE)

    if (IN(0)) { DUP(100) {
        PHASE_IDS;
        for (int u = bid; u < 192; u += G) mod_unit(p, lds, u, tid);
        if (bid == G - 1) { float* rope = (float*)(p.ws + WS_ROPE);
            for (int idx = tid; idx < 1024; idx += NTHREADS) { const int pos = idx >> 4, f = idx & 15; const float inv = exp2f(-(float)f * (13.287712379549449f / 16.0f));
                float x = (float)pos * inv * 0.15915494309189535f; x -= floorf(x);
                rope[idx * 2] = __builtin_amdgcn_cosf(x); rope[idx * 2 + 1] = __builtin_amdgcn_sinf(x); } }
        __syncthreads();
        LAS float* scr = (LAS float*)(lds + wave * 8448);
        for (int it = gw; it < 2 * MISC_ITEMS; it += NGW) {
            if (it < MISC_ITEMS) misc_item(p, 0, it, scr, lane);
            else misc_item(p, 1, it - MISC_ITEMS, scr, lane); }
        __syncthreads();
    } }
    SEAM(0);

    for (int l = 0; l < DEPTH; ++l) {
        const int base = 1 + PH_PER_LAYER * l;
        const bool need_ctx = l < DEPTH - 1;
        const int Mrows = need_ctx ? NT : NL;

        if (IN(base + 0)) { DUP(0) {
            PHASE_IDS;
            const float* const nmg = kin(I_NMG) + l * 1024; const float* const xin = kin(I_X); const float* const cin = kin(I_CTX);
            for (int row = gw; row < NT; row += NGW) { const bool lat = row < NL;
                const float* mr = mod + (size_t)(lat ? (row >> 11) : 8) * 6144;
                f32x4 v[4];
                if (l == 0) { const float* xr = lat ? xin + (size_t)row * D : cin + (size_t)(row - NL) * D;
#pragma unroll
                    for (int j = 0; j < 4; ++j) v[j] = ((const f32x4*)xr)[64 * j + lane]; }
                else { float* xr = lat ? p.out + (size_t)row * D : XC + (size_t)(row - NL) * D;
                    combine_row(v, xr, mr - 9 * 6144 + 5120, Hb + (size_t)row * D, (const unsigned char*)(p.ws + WS_R + R_O) + (size_t)row * 8 * 1024, lane);
#pragma unroll
                    for (int j = 0; j < 4; ++j) ((f32x4*)xr)[64 * j + lane] = v[j]; }
                norm_mod_vals_f8(v, nmg, mr, mr + 1024, (unsigned char*)Hb + (size_t)row * D, lane); }
        } }
        SEAM(base + 0);
        if (IN(base + 1)) { DUP(1) {
            PHASE_IDS;
            DenseSchedT<1> S{(const char*)Hb, (const char*)(wm + WM_IN), 1024, 1024, NT / 256, INW / 256, G, bid, 1, 0, 0};
            EpiStoreBf16 E{Zb, ZW, 16, (unsigned char*)(p.ws + WS_R + R_G8), 0.03125f};
            STAGGER(STAG_IN);
            pg8::gemm_phase<true>(lds, tid, 1024, 1024, S, E, (STAMP_PHASE == 2 && l == 0 && bid == 0) ? 25 : -1);
        } }
        SEAM(base + 1);
        if (IN(base + 2)) { DUP(2) {
            PHASE_IDS;
#ifndef DUP_SUB
#define DUP_SUB -1
#endif
            for (int rs_ = 0; rs_ < (DUP_SUB == 0 ? 2 : 1); ++rs_) for (int u = bid; u < 1024; u += G) na_unit(p, lds, l, u >> 7, (u >> 4) & 7, u & 15, true, tid);
            if (need_ctx) for (int u = bid; u < 128; u += G) na_unit(p, lds, l, u >> 4, (u >> 1) & 7, u & 1, false, tid);
            for (int rs_ = 0; rs_ < (DUP_SUB == 1 ? 2 : 1); ++rs_) for (int u = (bid + 64) % G; u < 576; u += G) retkv_unit(p, lds, l, u / 72, (u / 18) % 4, u % 18, tid);
        } }
        SEAM(base + 2);
        if (IN(base + 3)) { DUP(3) {
            PHASE_IDS;
            const float* KV = (const float*)(p.ws + WS_R + R_KV); bf16_t* ST = (bf16_t*)(p.ws + WS_R + R_ST);
            for (int gi = bid * NTHREADS + tid; gi < 64 * 2048; gi += G * NTHREADS) {
                const int combo = gi >> 11, e4 = (gi & 2047) * 4, bh = combo >> 1, dir = combo & 1, h = bh & 3;
                const float dec = __builtin_amdgcn_exp2f(128.f * log2_gamma(p, l, dir, h));
                const float* kv = KV + (size_t)bh * NCHUNK * 2 * 8192 + (size_t)dir * 8192 + e4; bf16_t* st = ST + (size_t)bh * NCHUNK * 2 * 8192 + (size_t)dir * 8192 + e4;
                f32x4 q[NCHUNK];
#pragma unroll
                for (int y = 0; y < NCHUNK; ++y) q[y] = *(const f32x4*)(kv + (size_t)y * 2 * 8192);
                f32x4 sacc = (f32x4){0.f, 0.f, 0.f, 0.f};
#pragma unroll
                for (int i = 0; i < NCHUNK; ++i) { const int y = dir == 0 ? i : (i == 0 ? 1 : (i == 1 ? 0 : 19 - i));
                    u32x2 o; o.x = pk2(sacc[0], sacc[1]); o.y = pk2(sacc[2], sacc[3]); *(u32x2*)(st + (size_t)y * 2 * 8192) = o;
                    f32x4 kvy = q[0];
#pragma unroll
                    for (int j = 1; j < NCHUNK; ++j) kvy = (j == y) ? q[j] : kvy;
                    sacc = sacc * dec + kvy; } }
            { const bf16_t* Z = (const bf16_t*)(p.ws + WS_R + R_Z); float* STAT = (float*)(p.ws + WS_R + R_STAT);
              for (int row = gw; row < Mrows; row += NGW) { const u32x4 v = *(const u32x4*)(Z + (size_t)row * ZW + ZC_AV + lane * 8);
                  const float x0 = geluf_(lo16(v.x)), x1 = geluf_(hi16(v.x)), x2 = geluf_(lo16(v.y)), x3 = geluf_(hi16(v.y)), x4 = geluf_(lo16(v.z)), x5 = geluf_(hi16(v.z)), x6 = geluf_(lo16(v.w)), x7 = geluf_(hi16(v.w));
                  const float mean = wave_sum(((x0 + x1) + (x2 + x3)) + ((x4 + x5) + (x6 + x7)), lane) * (1.0f / 512.0f);
                  const float d0 = x0 - mean, d1 = x1 - mean, d2 = x2 - mean, d3 = x3 - mean, d4 = x4 - mean, d5 = x5 - mean, d6 = x6 - mean, d7 = x7 - mean;
                  const float s2 = wave_sum(((d0 * d0 + d1 * d1) + (d2 * d2 + d3 * d3)) + ((d4 * d4 + d5 * d5) + (d6 * d6 + d7 * d7)), lane);
                  if (lane == 0) *(f32x2*)(STAT + (size_t)row * 2) = (f32x2){mean, rsqrtf(s2 * (1.0f / 512.0f) + EPS)}; } }
        } }
        SEAM(base + 3);
        if (IN(base + 4)) { DUP(4) {
            PHASE_IDS;
            const int cc_lo = need_ctx ? 0 : 2, ncc = NCHUNK - cc_lo, total = 32 * ncc;
            for (int u = bid; u < total; u += G) retout_unit(p, lds, l, u / (4 * ncc), (u / ncc) % 4, cc_lo + u % ncc, tid);
            const int nA = (Mrows / 128) * 4;
            for (int rs_ = 0; rs_ < (DUP_SUB == 2 ? 2 : 1); ++rs_) for (int u = (bid + 64) % G; u < nA; u += G) mixA_unit(p, lds, l, u >> 2, u & 3, tid);
        } }
        SEAM(base + 4);
        if (IN(base + 5)) { DUP(5) {
            PHASE_IDS;
            DenseSched S{(const char*)BRb, (const char*)(wm + WM_BR), BRW, 512, Mrows / 256, 4, G, bid, 3, 512 * 2, (size_t)1024 * 512 * 2};
#ifdef MERGE_PLAIN_DUP
            if (rep_ == 1) { EpiStoreBf16 E2{(bf16_t*)(p.ws + WS_R + R_KV), 1024, 1000, (unsigned char*)0, 1.0f}; pg8::gemm_phase(lds, tid, 512, 512, S, E2); } else
#endif
            { EpiMerge E{Hb, (const unsigned char*)(p.ws + WS_R + R_G8)};
            pg8::gemm_phase(lds, tid, 512, 512, S, E, (STAMP_PHASE == 6 && l == 0 && bid == 0) ? 25 : -1); }
            if (l == 0 && rep_ == 0 && G == 256 && bid >= 32) { LAS float* scr = (LAS float*)(lds + wave * 8448); const int fw = (bid - 32) * NWAVES + wave;
                for (int it = fw; it < FILL_SPLIT; it += 224 * NWAVES) expert_item(p, it / EXP_ITEMS, it % EXP_ITEMS, scr, lane); }
            if (l == 0 && rep_ == 0 && G != 256) { LAS float* scr = (LAS float*)(lds + wave * 8448);
                for (int it = gw; it < 2 * EXP_ITEMS; it += NGW) expert_item(p, it / EXP_ITEMS, it % EXP_ITEMS, scr, lane); }
        } }
        SEAM(base + 5);
        if (IN(base + 6)) { DUP(6) {
            PHASE_IDS;
            DenseSched S{(const char*)Hb, (const char*)(wm + WM_OUT), 1024, 1024, Mrows / 256, 4, G, bid, 1, 0, 0};
            float* const dummy = (float*)(p.ws + WS_R + R_ACT);
            EpiResid E{xl, xc, rep_ == 0 ? p.out : dummy, rep_ == 0 ? XC : dummy + (size_t)NL * D, mod + 2048};
            pg8::gemm_phase(lds, tid, 1024, 1024, S, E, (STAMP_PHASE == 7 && l == 0 && bid == 0) ? 25 : -1);
            if (l == 0 && rep_ == 0 && G == 256 && bid >= 32) { LAS float* scr = (LAS float*)(lds + wave * 8448); const int fw = (bid - 32) * NWAVES + wave;
                for (int it = FILL_SPLIT + fw; it < 2 * EXP_ITEMS; it += 224 * NWAVES) expert_item(p, it / EXP_ITEMS, it % EXP_ITEMS, scr, lane); }
        } }
        SEAM(base + 6);
        if (IN(base + 7)) { DUP(7) {
            PHASE_IDS;
            for (int u = bid; u < Mrows / 64; u += G) router_unit(p, lds, l, u, p.out, XC, tid, rep_ == 0, l == 0 && u == 0);
        } }
        SEAM(base + 7);
        if (IN(base + 8)) { DUP(8) {
            PHASE_IDS;
            moe_tables(p, lds, l, tid, 2, Mrows / 256, G, bid);
            MoeGuSched S{(const char*)Hb, (const char*)(p.ws + WS_WE + (size_t)l * WE_LAYER + WE_GU), (const char*)(wm + WM_SGU), (const unsigned*)(p.ws + WS_LIST),
                         (const LAS int*)(lds + MOE_TAB_OFF), (const LAS int*)(lds + MOE_TAB_OFF) + 128, Mrows / 256, G, bid};
            EpiGateUp E{(bf16_t*)(p.ws + WS_R + R_ACT), (bf16_t*)(p.ws + WS_R + R_ACTS), (const float*)(p.ws + WS_WL)};
            pg8::gemm_phase<true>(lds, tid, 1024, 1024, S, E, (STAMP_PHASE == 9 && l == 0 && bid == 0) ? 25 : -1);
        } }
        SEAM(base + 8);
        if (IN(base + 9)) { DUP(9) {
            PHASE_IDS;
            moe_tables(p, lds, l, tid, 4, Mrows / 256, G, bid);
            MoeDownSched S{(const char*)(p.ws + WS_R + R_ACT), (const char*)(p.ws + WS_WE + (size_t)l * WE_LAYER + WE_D), (const char*)(p.ws + WS_R + R_ACTS), (const char*)(wm + WM_SD),
                           (const LAS int*)(lds + MOE_TAB_OFF), (const LAS int*)(lds + MOE_TAB_OFF) + 128, Mrows / 256, G, bid};
            EpiDown E{(bf16_t*)(p.ws + WS_R + R_O), (const unsigned*)(p.ws + WS_LIST), Hb};
            pg8::gemm_phase<true>(lds, tid, launder_s(256), 256, S, E, (STAMP_PHASE == 10 && l == 0 && bid == 0) ? 25 : -1);
        } }
        SEAM(base + 9);
    }
#ifdef EXTRA_BARRIERS
    if (IN(PH_FINAL) && IN(PH_FINAL - 1)) for (int xb_ = 0; xb_ < EXTRA_BARRIERS; ++xb_) xcd_barrier(bar, wave0 == 0 && lane_id_here() == 0);
#endif
#ifdef TIMING
    float t_scale = 1.0f, t_add = 0.0f;
    { float* tw = (float*)(p0.ws + WS_CTL) + 1024;
      if (bid == 0 && wave0 == 0 && lane_id_here() == 0) { tw[0] = (float)(tst[TA_HI] - tst[TA_LO]) * 0.01f; }
      xcd_barrier(bar, wave0 == 0 && lane_id_here() == 0);
      t_scale = 1.0f + tw[0] / (float)(TA_DIV); t_add = 0.0f; }
#endif
    if (IN(PH_FINAL)) {
        PHASE_IDS;
        const int l = DEPTH - 1;
        f32x4 fg[4];
#pragma unroll
        for (int j = 0; j < 4; ++j) fg[j] = ((const f32x4*)kin(I_FG))[64 * j + lane];
        for (int row = gw; row < NL; row += NGW) { float* xr = p.out + (size_t)row * D;
            f32x4 v[4]; float ss = 0.f;
            combine_row(v, xr, mod + (size_t)(row >> 11) * 6144 + 5120, Hb + (size_t)row * D, (const unsigned char*)(p.ws + WS_R + R_O) + (size_t)row * 8 * 1024, lane);
#pragma unroll
            for (int j = 0; j < 4; ++j) ss += (v[j][0] * v[j][0] + v[j][1] * v[j][1]) + (v[j][2] * v[j][2] + v[j][3] * v[j][3]);
            const float rstd = rsqrtf(wave_sum(ss, lane) * (1.0f / 1024.0f) + EPS);
#pragma unroll
            for (int j = 0; j < 4; ++j) { f32x4 ov = v[j] * rstd * fg[j];
#ifdef TIMING
                ov = ov * t_scale; if (row == 0 && j == 0 && lane == 0) ov[0] += t_add;
#endif
                ((f32x4*)xr)[64 * j + lane] = ov; } }
    }
#undef IN
#undef SEAM
#undef Hb
#undef Zb
#undef BRb
#undef XC
#undef xl
#undef xc
#undef mod
#undef wm
}

#ifndef STAMP_PHASE_DEFINED
#endif
#ifndef MK_PER_PHASE
#define MK_PER_PHASE 0
#endif
extern "C" void kernel_launch(void* const* d_in, const int* in_sizes, int n_in, void* d_out, int out_size, void* d_ws, size_t ws_size, hipStream_t stream) {
    static int grid = 0;
    if (grid == 0) {
        if (n_in != 26 || out_size != NL * D || ws_size < WS_END) { fprintf(stderr, "kernel_launch: unexpected shapes (n_in %d out %d ws %zu, need %zu)\n", n_in, out_size, ws_size, (size_t)WS_END); grid = -1; return; }
        int dev = 0, cus = 0;
        if (hipGetDevice(&dev) != hipSuccess || hipDeviceGetAttribute(&cus, hipDeviceAttributeMultiprocessorCount, dev) != hipSuccess) { grid = -1; return; }
        if (hipFuncSetAttribute((const void*)fwd_kernel, hipFuncAttributeMaxDynamicSharedMemorySize, LDS_BYTES) != hipSuccess) { fprintf(stderr, "kernel_launch: hipFuncSetAttribute failed\n"); grid = -1; return; }
        int per_cu = 0;
        if (hipOccupancyMaxActiveBlocksPerMultiprocessor(&per_cu, (const void*)fwd_kernel, NTHREADS, LDS_BYTES) != hipSuccess || per_cu < 1) { fprintf(stderr, "kernel_launch: occupancy query says %d\n", per_cu); }
        (void)hipGetLastError();
        grid = cus;
    }
    if (grid < 0) return;
    (void)hipMemsetAsync((char*)d_ws + WS_CTL, 0, CTL_BYTES, stream);
    Params p{};
    for (int i = 0; i < 26; ++i) p.in[i] = (const float*)d_in[i];
    p.out = (float*)d_out; p.ws = (unsigned char*)d_ws;
#if MK_PER_PHASE
    for (int k = 0; k < NPHASES; ++k) { p.ph_lo = k; p.ph_hi = k + 1; p.li = k;
        hipLaunchKernelGGL(fwd_kernel, dim3(grid), dim3(NTHREADS), LDS_BYTES, stream, p); }
#else
    p.ph_lo = 0; p.ph_hi = NPHASES; p.li = 0;
    hipLaunchKernelGGL(fwd_kernel, dim3(grid), dim3(NTHREADS), LDS_BYTES, stream, p);
#endif
}
```

```cpp
#include <hip/hip_runtime.h>
#include <stdint.h>
#include <stdio.h>

#define LAS __attribute__((address_space(3)))
#define GAS __attribute__((address_space(1)))
template <class T> __device__ __forceinline__ T* as_global(T* q) { return (T*)(GAS T*)q; }
typedef unsigned short bf16_t;
typedef short bf16x8 __attribute__((ext_vector_type(8)));
typedef short bf16x4 __attribute__((ext_vector_type(4)));
typedef float f32x4 __attribute__((ext_vector_type(4)));
typedef float f32x2 __attribute__((ext_vector_type(2)));
typedef unsigned u32x4 __attribute__((ext_vector_type(4)));
typedef unsigned u32x2 __attribute__((ext_vector_type(2)));
typedef long i64x2 __attribute__((ext_vector_type(2)));

constexpr int D = 1024, NB = 8, SEQ = 2048, CTXL = 256, DEPTH = 2;
constexpr int NL = NB * SEQ;
constexpr int NC = NB * CTXL;
constexpr int NT = NL + NC;
constexpr int INW = 7168;
constexpr int ZW = 4096;
constexpr int ZC_AU = 0, ZC_AV = 512, ZC_NQ = 1024, ZC_NK = 1536, ZC_NV = 2048, ZC_RQ = 2560, ZC_RK = 2816, ZC_RV = 3072, ZC_RG = 3584,
              ZC_GA = 4096;
constexpr int BRW = 1536;
constexpr int NEXP = 64, TOPK = 8, EXPW = 256;
constexpr int NCHUNK = 18;
constexpr float EPS = 1e-6f;
constexpr int NTHREADS = 512, NWAVES = 8;
constexpr int LDS_BYTES = 159744;

constexpr size_t MiB = 1u << 20;
constexpr size_t WS_CTL = 0, CTL_BYTES = 1 * MiB;
constexpr size_t WS_MOD = 1 * MiB;
constexpr size_t WS_ROPE = 1 * MiB + 512 * 1024;
constexpr size_t WS_WM = 2 * MiB, WM_STRIDE = 21 * MiB;
constexpr size_t WM_IN = 0, WM_BR = 14680064, WM_OUT = WM_BR + 3145728, WM_SGU = WM_OUT + 2097152, WM_SD = WM_SGU + 1048576,
                 WM_RT = WM_SD + 524288, WM_CM = WM_RT + 131072, WM_END = WM_CM + 131072;
static_assert(WM_END <= WM_STRIDE, "misc weights");
constexpr size_t WS_WE = 44 * MiB;
constexpr size_t WE_GU = 0, WE_D = 33554432, WE_LAYER = 50331648;
constexpr size_t WS_XC = 140 * MiB;
constexpr size_t WS_H = 148 * MiB;
constexpr size_t WS_LIST = 184 * MiB, WS_WL = 189 * MiB;
constexpr size_t WS_R = 194 * MiB;
constexpr size_t R_XB = 198 * MiB, R_H8 = 234 * MiB;
constexpr size_t R_Z = 0, R_G8 = 144 * MiB, R_BR = 252 * MiB, R_KV = 306 * MiB, R_ST = 342 * MiB, R_STAT = 360 * MiB;
constexpr size_t R_O = 0, R_ACT = 288 * MiB, R_ACTS = 368 * MiB;
constexpr size_t WS_END = WS_R + 377 * MiB;
static_assert(R_KV + 37748736 <= 377 * MiB && R_ACTS + 9437184 <= 377 * MiB && R_Z + 150994944 <= R_G8 && R_G8 + 56623104 <= R_BR && R_BR + 56623104 <= R_KV, "region map");
static_assert(R_O + 301989888 <= R_ACT && R_ACT + 83886080 <= R_ACTS, "region map 2");
constexpr int CW_BAR = 4096;
constexpr int CW_CNT = 200000;

__device__ __forceinline__ float bf2f(unsigned short b) { return __uint_as_float(((unsigned)b) << 16); }
__device__ __forceinline__ unsigned f2bf(float f) { unsigned u = __float_as_uint(f); return (u + 0x7fffu + ((u >> 16) & 1u)) >> 16; }
__device__ __forceinline__ unsigned pk2(float lo, float hi) { unsigned r; asm("v_cvt_pk_bf16_f32 %0, %1, %2" : "=v"(r) : "v"(lo), "v"(hi)); return r; }
__device__ __forceinline__ float lo16(unsigned w) { return __uint_as_float(w << 16); }
__device__ __forceinline__ float hi16(unsigned w) { return __uint_as_float(w & 0xffff0000u); }
__device__ __forceinline__ float shx(float v, int o, int lane) { return __int_as_float(__builtin_amdgcn_ds_bpermute((lane ^ o) << 2, __float_as_int(v))); }
__device__ __forceinline__ int shxi(int v, int o, int lane) { return __builtin_amdgcn_ds_bpermute((lane ^ o) << 2, v); }
__device__ __forceinline__ int pair16_off(int g4) { return 16 * (g4 & 1) + 4 * (g4 & ~1); }
__device__ __forceinline__ void pair16_unpack(u32x4 L, u32x2& a, u32x2& b) {
    const auto rx = __builtin_amdgcn_permlane16_swap(L.x, L.z, false, false), ry = __builtin_amdgcn_permlane16_swap(L.y, L.w, false, false);
    a = (u32x2){rx[0], ry[0]}; b = (u32x2){rx[1], ry[1]};
}
__device__ __forceinline__ void pair16_store(bf16_t* base, int g4, u32x2 a, u32x2 b) {
    const auto rx = __builtin_amdgcn_permlane16_swap(a.x, b.x, false, false), ry = __builtin_amdgcn_permlane16_swap(a.y, b.y, false, false);
    *(u32x4*)(base + pair16_off(g4)) = (u32x4){rx[0], ry[0], rx[1], ry[1]};
}
__device__ __forceinline__ float dpp_f(float v, const int ctrl_tag) {
    const int x = __float_as_int(v);
    switch (ctrl_tag) {
        case 0: return __int_as_float(__builtin_amdgcn_update_dpp(x, x, 0xB1, 0xF, 0xF, false));
        case 1: return __int_as_float(__builtin_amdgcn_update_dpp(x, x, 0x4E, 0xF, 0xF, false));
        case 2: return __int_as_float(__builtin_amdgcn_update_dpp(x, x, 0x141, 0xF, 0xF, false));
        default: return __int_as_float(__builtin_amdgcn_update_dpp(x, x, 0x140, 0xF, 0xF, false));
    }
}
__device__ __forceinline__ float wave_sum(float v, int  ) {
    v += dpp_f(v, 0); v += dpp_f(v, 1); v += dpp_f(v, 2); v += dpp_f(v, 3);
    const int x = __float_as_int(v);
    return (__int_as_float(__builtin_amdgcn_readlane(x, 0)) + __int_as_float(__builtin_amdgcn_readlane(x, 16))) + (__int_as_float(__builtin_amdgcn_readlane(x, 32)) + __int_as_float(__builtin_amdgcn_readlane(x, 48)));
}
__device__ __forceinline__ float fast_exp(float x) { return __builtin_amdgcn_exp2f(x * 1.44269504089f); }
__device__ __forceinline__ float sigmoidf_(float x) { return __builtin_amdgcn_rcpf(1.0f + fast_exp(-x)); }
__device__ __forceinline__ float siluf_(float x) { return x * sigmoidf_(x); }
__device__ __forceinline__ float geluf_(float x) { const float u = 0.7978845608f * (x + 0.044715f * x * x * x); return x * sigmoidf_(2.0f * u); }
__device__ __forceinline__ f32x4 mfma16(bf16x8 a, bf16x8 b, f32x4 c) { return __builtin_amdgcn_mfma_f32_16x16x32_bf16(a, b, c, 0, 0, 0); }
__device__ __forceinline__ bf16x8 as_frag(u32x4 v) { return __builtin_bit_cast(bf16x8, v); }
__device__ __forceinline__ int launder(int v) { asm volatile("" : "+v"(v)); return v; }
__device__ __forceinline__ int lane_id_here() { unsigned m = ~0u; asm volatile("" : "+s"(m)); return (int)__builtin_amdgcn_mbcnt_hi(m, __builtin_amdgcn_mbcnt_lo(m, 0u)); }
__device__ __forceinline__ int launder_s(int v) { asm volatile("" : "+s"(v)); return v; }
template <class T> __device__ __forceinline__ T* launder_p(T* q) { asm volatile("" : "+s"(q)); return q; }
template <class T> __device__ __forceinline__ T* launder_vp(T* q) { asm volatile("" : "+v"(q)); return q; }
#define LDS_WAIT() asm volatile("s_waitcnt lgkmcnt(0)" ::: "memory")
#define VM_WAIT() asm volatile("s_waitcnt vmcnt(0)" ::: "memory")

__device__ __forceinline__ bf16x8 tr_frag(unsigned base, int stride, int r0, int r1, int c0, int lane) {
    const int q = (lane & 15) >> 2, p = lane & 3;
    const unsigned a0 = base + (unsigned)((r0 + q) * stride + (c0 + 4 * p) * 2), a1 = base + (unsigned)((r1 + q) * stride + (c0 + 4 * p) * 2);
    bf16x4 lo, hi;
    asm volatile("ds_read_b64_tr_b16 %0, %2\n\tds_read_b64_tr_b16 %1, %3\n\ts_waitcnt lgkmcnt(0)" : "=&v"(lo), "=&v"(hi) : "v"(a0), "v"(a1) : "memory");
    bf16x8 r; r[0] = lo[0]; r[1] = lo[1]; r[2] = lo[2]; r[3] = lo[3]; r[4] = hi[0]; r[5] = hi[1]; r[6] = hi[2]; r[7] = hi[3];
    return r;
}
__device__ __forceinline__ unsigned lds_addr(LAS unsigned char* p) { return (unsigned)(size_t)p; }
template <int O0, int O1> __device__ __forceinline__ bf16x8 tr_frag_i(unsigned a) {
    static_assert(O0 >= 0 && O0 < 65536 && O1 >= 0 && O1 < 65536, "ds offset field");
    bf16x4 lo, hi;
    asm volatile("ds_read_b64_tr_b16 %0, %2 offset:%3\n\tds_read_b64_tr_b16 %1, %2 offset:%4\n\ts_waitcnt lgkmcnt(0)" : "=&v"(lo), "=&v"(hi) : "v"(a), "n"(O0), "n"(O1) : "memory");
    bf16x8 r; r[0] = lo[0]; r[1] = lo[1]; r[2] = lo[2]; r[3] = lo[3]; r[4] = hi[0]; r[5] = hi[1]; r[6] = hi[2]; r[7] = hi[3];
    return r;
}
template <int OB, int R1> __device__ __forceinline__ void tr_frag4_i(unsigned a, bf16x8 (&f)[4]) {
    static_assert(OB >= 0 && OB + R1 + 96 < 65536, "ds offset field");
    bf16x4 l0, h0, l1, h1, l2, h2, l3, h3;
    asm volatile("ds_read_b64_tr_b16 %0, %8 offset:%9\n\tds_read_b64_tr_b16 %1, %8 offset:%10\n\tds_read_b64_tr_b16 %2, %8 offset:%11\n\tds_read_b64_tr_b16 %3, %8 offset:%12\n\t"
                 "ds_read_b64_tr_b16 %4, %8 offset:%13\n\tds_read_b64_tr_b16 %5, %8 offset:%14\n\tds_read_b64_tr_b16 %6, %8 offset:%15\n\tds_read_b64_tr_b16 %7, %8 offset:%16\n\ts_waitcnt lgkmcnt(0)"
                 : "=&v"(l0), "=&v"(h0), "=&v"(l1), "=&v"(h1), "=&v"(l2), "=&v"(h2), "=&v"(l3), "=&v"(h3)
                 : "v"(a), "n"(OB), "n"(OB + R1), "n"(OB + 32), "n"(OB + 32 + R1), "n"(OB + 64), "n"(OB + 64 + R1), "n"(OB + 96), "n"(OB + 96 + R1) : "memory");
    f[0][0] = l0[0]; f[0][1] = l0[1]; f[0][2] = l0[2]; f[0][3] = l0[3]; f[0][4] = h0[0]; f[0][5] = h0[1]; f[0][6] = h0[2]; f[0][7] = h0[3];
    f[1][0] = l1[0]; f[1][1] = l1[1]; f[1][2] = l1[2]; f[1][3] = l1[3]; f[1][4] = h1[0]; f[1][5] = h1[1]; f[1][6] = h1[2]; f[1][7] = h1[3];
    f[2][0] = l2[0]; f[2][1] = l2[1]; f[2][2] = l2[2]; f[2][3] = l2[3]; f[2][4] = h2[0]; f[2][5] = h2[1]; f[2][6] = h2[2]; f[2][7] = h2[3];
    f[3][0] = l3[0]; f[3][1] = l3[1]; f[3][2] = l3[2]; f[3][3] = l3[3]; f[3][4] = h3[0]; f[3][5] = h3[1]; f[3][6] = h3[2]; f[3][7] = h3[3];
}
__device__ __forceinline__ unsigned tr_lane(unsigned base, int stride, int rmul, int lane) { return base + (unsigned)((rmul * (lane >> 4) + ((lane & 15) >> 2)) * stride + (lane & 3) * 8); }
template <int V> struct IC { static constexpr int value = V; };
template <int I, int N, class F> __device__ __forceinline__ void sfor(F&& f) { if constexpr (I < N) { f(IC<I>{}); sfor<I + 1, N>(f); } }


#define XB_TMO      128
#define XB_XCNT(j)  (256  + 64 * (j))
#define XB_XSUB(j)  (1280 + 64 * (j))
#define XB_XGEN(j)  (2304 + 64 * (j))
#define XB_TOP      3328
#define XB_TOPGEN   3392
#define XCD_BAR_WORDS 3456
#define XB_SPIN_CAP (1u << 21)
__device__ __forceinline__ unsigned xb_ld(unsigned* p)              { return __hip_atomic_load(p, __ATOMIC_RELAXED, __HIP_MEMORY_SCOPE_AGENT); }
__device__ __forceinline__ unsigned xb_add(unsigned* p, unsigned v) { return __hip_atomic_fetch_add(p, v, __ATOMIC_RELAXED, __HIP_MEMORY_SCOPE_AGENT); }
__device__ __forceinline__ unsigned xb_xcc_id() { return (unsigned)__builtin_amdgcn_s_getreg((3 << 11) | 20) & 0xFu; }
#define XB_SPIN(cond, bar) do { unsigned _sp = 0; while (cond) { __builtin_amdgcn_s_sleep(1); \
    if ((++_sp & 255u) == 0u) { if (xb_ld(&(bar)[XB_TMO])) break; if (_sp > XB_SPIN_CAP) { atomicAdd(&(bar)[XB_TMO], 1u); break; } } } } while (0)
struct XcdBarrier { unsigned* bar; unsigned x; volatile LAS unsigned* st; };
__device__ __forceinline__ XcdBarrier xcd_barrier_post(unsigned* bar, volatile LAS unsigned* st) {
    XcdBarrier b; b.bar = bar; b.x = xb_xcc_id(); b.st = st;
    if (threadIdx.x == 0) (void)xb_add(&bar[XB_XCNT(b.x)], 1u);
    return b;
}
__device__ __forceinline__ void xcd_barrier_complete(unsigned* bar, unsigned x, unsigned& nloc, unsigned& nx) {
    const unsigned G = gridDim.x * gridDim.y * gridDim.z;
    unsigned sum, cnt, mine, sp = 0u;
    for (;;) {
        sum = 0u; cnt = 0u; mine = 0u;
#pragma unroll
        for (unsigned j = 0; j < 16; ++j) { const unsigned c = xb_ld(&bar[XB_XCNT(j)]); sum += c; cnt += (c > 0u) ? 1u : 0u; mine = (j == x) ? c : mine; }
        if (sum == G) break;
        __builtin_amdgcn_s_sleep(1);
        if ((++sp & 255u) == 0u) { if (xb_ld(&bar[XB_TMO])) break; if (sp > XB_SPIN_CAP) { atomicAdd(&bar[XB_TMO], 1u); break; } }
    }
    nloc = mine > 0u ? mine : 1u; nx = cnt > 0u ? cnt : 1u;
}
__device__ __forceinline__ void xcd_barrier(const XcdBarrier& b, const bool leader) {
    asm volatile("s_waitcnt vmcnt(0)" ::: "memory");
    __syncthreads();
    if (leader) {
        unsigned* bar = b.bar;
        __builtin_amdgcn_s_waitcnt(0);
        unsigned nloc = b.st[0], nx = b.st[1];
        if (nloc == 0u) { xcd_barrier_complete(bar, b.x, nloc, nx); b.st[0] = nloc; b.st[1] = nx; }
        const unsigned old = xb_add(&bar[XB_XSUB(b.x)], 1u);
        const unsigned gen = old / nloc;
        if (old + 1u == (gen + 1u) * nloc) {
            __builtin_amdgcn_fence(__ATOMIC_RELEASE, "agent");
            asm volatile("s_waitcnt vmcnt(0)" ::: "memory");
            const unsigned og = xb_add(&bar[XB_TOP], 1u);
            const unsigned tg = og / nx;
            if (og + 1u == (tg + 1u) * nx) xb_add(&bar[XB_TOPGEN], 1u);
            else XB_SPIN(xb_ld(&bar[XB_TOPGEN]) == tg, bar);
            __builtin_amdgcn_fence(__ATOMIC_ACQUIRE, "agent");
            xb_add(&bar[XB_XGEN(b.x)], 1u);
            asm volatile("s_waitcnt vmcnt(0)" ::: "memory");
        } else {
            XB_SPIN(xb_ld(&bar[XB_XGEN(b.x)]) == gen, bar);
            __builtin_amdgcn_fence(__ATOMIC_ACQUIRE, "agent");
            asm volatile("s_waitcnt vmcnt(0)" ::: "memory");
        }
    }
    __syncthreads();
}

namespace pg8 {
constexpr int BM = 256, BK = 64, HALF = 128, HTB = HALF * BK * 2, STAGE_BYTES = 8 * HTB, NXCD = 8, WGM = 8;
constexpr int ROWTAB_OFF = 149504;
constexpr int GATHER_SLOT_OFF = 133120;
__device__ __forceinline__ int lds_byte(int r, int c) { const int st = (r >> 4) * 2 + (c >> 5), rr = r & 15, cc = c & 31, ob = rr * 64 + cc * 2; return st * 1024 + (ob ^ (((ob >> 9) & 1) << 5)); }
__device__ __forceinline__ void stage_rc(int b, int& R, int& C) { const int st = b / 1024, sb = b % 1024, swz = sb ^ (((sb >> 9) & 1) << 5); R = (st >> 1) * 16 + swz / 64; C = (st & 1) * 32 + (swz % 64) / 2; }
__device__ __forceinline__ int perm32(int rho) { const int n = rho >> 4, i = rho & 15; return 8 * (i >> 2) + 4 * n + (i & 3); }

struct Unit { const char* A; const char* B; int e0, e1, e2, e3, e4; };

__device__ __forceinline__ bool static_tile(int i, int G, int c, int nM, int nN, int& pm, int& pn) {
    const int nwg = nM * nN; const long L = (long)i * G + c; if (L >= nwg) return false;
    int wgid = (int)L; { const int q = nwg / NXCD, r = nwg % NXCD, xcd = wgid % NXCD, off = wgid / NXCD; wgid = (xcd < r ? xcd * (q + 1) : r * (q + 1) + (xcd - r) * q) + off; }
    const int nig = WGM * nN, gid = wgid / nig, fm = gid * WGM, gsz = (nM - fm) < WGM ? (nM - fm) : WGM;
    pm = fm + ((wgid % nig) % gsz); pn = (wgid % nig) / gsz; return true;
}

template <bool F8 = false, class Epi, class Sched>
__device__ __forceinline__ void gemm_phase(LAS unsigned char* lds, const int tid, const int K, const int ldb  , const Sched& S, const Epi& E, const int stamp_base = -1) {
#ifdef TIMING
#define GSTAMP(k) do { if (stamp_base >= 0 && tid == 0 && (k) < 31) ((volatile LAS unsigned long long*)(lds + LDS_BYTES - 16 - 512))[stamp_base + (k)] = __builtin_amdgcn_s_memrealtime(); } while (0)
#else
#define GSTAMP(k) do { } while (0)
#endif
    GSTAMP(-1);
    const int wid = __builtin_amdgcn_readfirstlane(tid >> 6), lane = tid & 63, wr = wid >> 2, wc = wid & 3, fr = lane & 15, fq = lane >> 4;
    const int nt = K / (F8 ? 2 * BK : BK);
    unsigned voffB[2];
#pragma unroll
    for (int i = 0; i < 2; ++i) { int R, C; stage_rc(tid * 16 + i * 8192, R, C); const int Rb = Epi::PERM256 ? (64 * (R >> 5) + 16 * ((R >> 2) & 3) + 4 * ((R >> 4) & 1) + (R & 3)) : Epi::PERM ? ((R & ~31) + perm32(R & 31)) : R; voffB[i] = F8 ? (unsigned)(Rb * ldb + C * 2) : (unsigned)(Rb * ldb + C) * 2u; }
    const size_t kstep = (size_t)(BK * 2);
    const size_t hstepB = (size_t)(Epi::PERM256 ? 8 : HALF) * ldb * (F8 ? 1 : 2);
    const unsigned ldsw = (unsigned)wid * 1024u;
    const int aoff = lds_byte(wr * 64 + fr, fq * 8), boff = lds_byte(wc * 32 + fr, fq * 8);
#define PG8_SA(b, h) (((b) * 2 + (h)) * HTB)
#define PG8_SB(b, h) ((4 + (b) * 2 + (h)) * HTB)
#define PG8_STAGE(bufoff, gbase, voff) do { _Pragma("unroll") for (int _i = 0; _i < 2; ++_i) \
        __builtin_amdgcn_global_load_lds((const unsigned*)((const char*)(gbase) + (voff)[_i]), (LAS unsigned*)(lds + (bufoff) + ldsw + _i * 8192), 16, 0, 0); } while (0)
#define PG8_LDA(dst, b, h) do { _Pragma("unroll") for (int m = 0; m < 4; ++m) _Pragma("unroll") for (int k = 0; k < 2; ++k) dst[m][k] = *(const LAS bf16x8*)(lds + PG8_SA(b, h) + aoff + m * 2048 + k * 1024); } while (0)
#define PG8_LDB(dst, b, h) do { _Pragma("unroll") for (int n = 0; n < 2; ++n) _Pragma("unroll") for (int k = 0; k < 2; ++k) dst[n][k] = *(const LAS bf16x8*)(lds + PG8_SB(b, h) + boff + n * 2048 + k * 1024); } while (0)
#define PG8_MMA(ai, bj, At, Bt) do { __builtin_amdgcn_s_setprio(1); _Pragma("unroll") for (int m = 0; m < 4; ++m) _Pragma("unroll") for (int n = 0; n < 2; ++n) _Pragma("unroll") for (int k = 0; k < 2; ++k) { \
        if constexpr (F8) { const i64x2 b2_ = __builtin_bit_cast(i64x2, Bt[n][k]), a2_ = __builtin_bit_cast(i64x2, At[m][k]); \
            acc[ai][bj][m][n] = __builtin_amdgcn_mfma_f32_16x16x32_fp8_fp8(b2_[0], a2_[0], acc[ai][bj][m][n], 0, 0, 0); \
            acc[ai][bj][m][n] = __builtin_amdgcn_mfma_f32_16x16x32_fp8_fp8(b2_[1], a2_[1], acc[ai][bj][m][n], 0, 0, 0); } \
        else acc[ai][bj][m][n] = __builtin_amdgcn_mfma_f32_16x16x32_bf16(Bt[n][k], At[m][k], acc[ai][bj][m][n], 0, 0, 0); } __builtin_amdgcn_s_setprio(0); } while (0)
#define PG8_WAIT_V(n) asm volatile("s_waitcnt vmcnt(" #n ")" ::: "memory")
#define PG8_WAIT_L(n) asm volatile("s_waitcnt lgkmcnt(" #n ")" ::: "memory")
#define PG8_BAR __builtin_amdgcn_s_barrier()
#define PG8_SCHED __builtin_amdgcn_sched_barrier(0)
    Unit cur, nxt; int ui = 0;
    if (!S.next(0, cur)) return;
    unsigned cvA[2][2], nvA[2][2];
    S.a_offs(cur, tid, cvA);
    LAS unsigned* const gslot = (LAS unsigned*)(lds + GATHER_SLOT_OFF) + tid * 4;
    if constexpr (Sched::GATHER) { *(LAS u32x4*)gslot = (u32x4){cvA[0][0], cvA[0][1], cvA[1][0], cvA[1][1]}; }
    f32x4 acc[2][2][4][2];
#pragma unroll
    for (int a = 0; a < 2; ++a)
#pragma unroll
        for (int b = 0; b < 2; ++b)
#pragma unroll
            for (int m = 0; m < 4; ++m)
#pragma unroll
                for (int n = 0; n < 2; ++n) acc[a][b][m][n] = (f32x4){0.f, 0.f, 0.f, 0.f};
    bf16x8 At[4][2], B0[2][2], B1[2][2];
    const char* cA = cur.A; const char* cB = cur.B;
    PG8_STAGE(PG8_SB(0, 0), cB, voffB); PG8_STAGE(PG8_SA(0, 0), cA, cvA[0]); PG8_STAGE(PG8_SB(0, 1), cB + hstepB, voffB); PG8_STAGE(PG8_SA(0, 1), cA, cvA[1]);
    if (wr == 1) PG8_BAR;
    PG8_WAIT_V(4); PG8_BAR;
    PG8_STAGE(PG8_SB(1, 0), cB + kstep, voffB); PG8_STAGE(PG8_SA(1, 0), cA + kstep, cvA[0]); PG8_STAGE(PG8_SB(1, 1), cB + hstepB + kstep, voffB);
    PG8_WAIT_V(6); PG8_BAR;
    for (;;) {
        if constexpr (Epi::STAGES) { if (wid < 4) E.stage(cur, (LAS unsigned*)(lds + ROWTAB_OFF) + (ui & 1) * 256 + wid * 64, wid * 64 + lane); }
        const bool has_next = S.next(ui + 1, nxt);
        if (has_next) S.a_offs(nxt, tid, nvA);
        else {
#pragma unroll
            for (int h = 0; h < 2; ++h)
#pragma unroll
                for (int i = 0; i < 2; ++i) nvA[h][i] = cvA[h][i];
        }
        if constexpr (Sched::GATHER) { *(LAS u32x4*)(gslot + ((ui + 1) & 1) * 2048) = (u32x4){nvA[0][0], nvA[0][1], nvA[1][0], nvA[1][1]}; }
        const char* nA = has_next ? nxt.A : cA; const char* nB = has_next ? nxt.B : cB;
#pragma unroll 1
        for (int t = 0; t < nt; t += 2) {
            const bool last = (t == nt - 2);
            const char* a1 = cA + (size_t)(t + 1) * kstep;
            const char* a2 = last ? nA : cA + (size_t)(t + 2) * kstep; const char* b2 = last ? nB : cB + (size_t)(t + 2) * kstep;
            const char* a3 = a2 + kstep; const char* b3 = b2 + kstep;
            unsigned sA[2][2];
            if constexpr (Sched::GATHER) {
                const u32x4 cv = *(const LAS u32x4*)(gslot + (ui & 1) * 2048), sv = *(const LAS u32x4*)(gslot + ((ui + (last ? 1 : 0)) & 1) * 2048);
                cvA[0][0] = cv.x; cvA[0][1] = cv.y; cvA[1][0] = cv.z; cvA[1][1] = cv.w; sA[0][0] = sv.x; sA[0][1] = sv.y; sA[1][0] = sv.z; sA[1][1] = sv.w;
            } else {
#pragma unroll
                for (int h = 0; h < 2; ++h)
#pragma unroll
                    for (int i = 0; i < 2; ++i) sA[h][i] = last ? nvA[h][i] : cvA[h][i];
            }
            PG8_LDB(B0, 0, 0); PG8_SCHED; PG8_LDA(At, 0, 0); PG8_STAGE(PG8_SA(1, 1), a1, cvA[1]);
            PG8_WAIT_L(8); PG8_BAR; PG8_WAIT_L(0); PG8_MMA(0, 0, At, B0); PG8_BAR; PG8_SCHED;
            PG8_LDB(B1, 0, 1); PG8_STAGE(PG8_SB(0, 0), b2, voffB);
            PG8_BAR; PG8_WAIT_L(0); PG8_MMA(0, 1, At, B1); PG8_BAR;
            PG8_LDA(At, 0, 1); PG8_STAGE(PG8_SA(0, 0), a2, sA[0]);
            PG8_BAR; PG8_WAIT_L(0); PG8_MMA(1, 0, At, B0); PG8_BAR; PG8_SCHED;
            PG8_STAGE(PG8_SB(0, 1), b2 + hstepB, voffB);
            PG8_WAIT_V(6); PG8_BAR; PG8_MMA(1, 1, At, B1); PG8_BAR;
            PG8_LDB(B0, 1, 0); PG8_SCHED; PG8_LDA(At, 1, 0); PG8_STAGE(PG8_SA(0, 1), a2, sA[1]);
            PG8_WAIT_L(8); PG8_BAR; PG8_WAIT_L(0); PG8_MMA(0, 0, At, B0); PG8_BAR; PG8_SCHED;
            PG8_LDB(B1, 1, 1); PG8_STAGE(PG8_SB(1, 0), b3, voffB);
            PG8_BAR; PG8_WAIT_L(0); PG8_MMA(0, 1, At, B1); PG8_BAR;
            PG8_LDA(At, 1, 1); PG8_STAGE(PG8_SA(1, 0), a3, sA[0]);
            PG8_BAR; PG8_WAIT_L(0); PG8_MMA(1, 0, At, B0); PG8_BAR; PG8_SCHED;
            PG8_STAGE(PG8_SB(1, 1), b3 + hstepB, voffB);
            PG8_WAIT_V(6); PG8_BAR; PG8_MMA(1, 1, At, B1); PG8_BAR;
        }
        GSTAMP(2 * ui);
        if constexpr (Epi::STAGES) E(acc, cur, wr, wc, fr, fq, (const LAS unsigned*)(lds + ROWTAB_OFF) + (ui & 1) * 256); else E(acc, cur, wr, wc, fr, fq);
        GSTAMP(2 * ui + 1);
        if (!has_next) break;
        if (!(Epi::KEEPS && E.keep(cur))) {
#pragma unroll
        for (int a = 0; a < 2; ++a)
#pragma unroll
            for (int b = 0; b < 2; ++b)
#pragma unroll
                for (int m = 0; m < 4; ++m)
#pragma unroll
                    for (int n = 0; n < 2; ++n) acc[a][b][m][n] = (f32x4){0.f, 0.f, 0.f, 0.f};
        }
        cur = nxt; cA = nA; cB = nB; ++ui;
        if constexpr (!Sched::GATHER) {
#pragma unroll
            for (int h = 0; h < 2; ++h)
#pragma unroll
                for (int i = 0; i < 2; ++i) cvA[h][i] = nvA[h][i];
        }
    }
    PG8_WAIT_V(0);
    if (wr == 0) PG8_BAR;
    PG8_BAR;
#undef PG8_SA
#undef PG8_SB
#undef PG8_STAGE
#undef PG8_LDA
#undef PG8_LDB
#undef PG8_MMA
#undef PG8_WAIT_V
#undef PG8_WAIT_L
#undef PG8_BAR
#undef PG8_SCHED
}
}

using pg8::Unit;
template <int ES = 2  > struct DenseSchedT {
    static constexpr bool GATHER = false;
    const char* A; const char* B; int lda, ldb, nM, nN, G, c, nsub; size_t asub, bsub;
    __device__ __forceinline__ bool next(int i, Unit& u) const {
        const int sub = i % nsub, ti = i / nsub; int pm, pn;
        if (!pg8::static_tile(ti, G, c, nM, nN, pm, pn)) return false;
        u.A = A + (size_t)pm * 256 * lda * ES + (size_t)sub * asub; u.B = B + (size_t)pn * 256 * ldb * ES + (size_t)sub * bsub;
        u.e0 = pm; u.e1 = pn; u.e2 = sub; u.e3 = 0; u.e4 = 0; return true;
    }
    __device__ __forceinline__ void a_offs(const Unit&, int tid, unsigned (&vo)[2][2]) const {
#pragma unroll
        for (int i = 0; i < 2; ++i) { int R, C; pg8::stage_rc(tid * 16 + i * 8192, R, C);
#pragma unroll
            for (int h = 0; h < 2; ++h) vo[h][i] = ES == 2 ? (unsigned)((h * 128 + R) * lda + C) * 2u : (unsigned)((h * 128 + R) * lda + C * 2); }
    }
};
using DenseSched = DenseSchedT<2>;
constexpr int MOE_TAB_OFF = 131072;
constexpr int MOE_UL_OFF = MOE_TAB_OFF + 1024, MOE_UL_MAX = 24;
#define RFL(x) __builtin_amdgcn_readfirstlane(x)
__device__ __forceinline__ int moe_find_expert(const LAS int* tbase, int mt) {
    int lo = 0, hi = 63;
#pragma unroll
    for (int it = 0; it < 6; ++it) { const int mid = (lo + hi + 1) >> 1; if (RFL(tbase[mid]) <= mt) lo = mid; else hi = mid - 1; }
    return lo;
}
struct MoeGuSched {
    static constexpr bool GATHER = true;
    const char* H2; const char* WGU; const char* WSGU; const unsigned* list; const LAS int* tbase; const LAS int* cnt; int nMs, G, c;
    __device__ __forceinline__ bool next(int i, Unit& u) const {
        if (i >= MOE_UL_MAX) return false;
        const LAS int* ul = tbase + (MOE_UL_OFF - MOE_TAB_OFF) / 4 + i * 8;
        const int e = RFL(ul[0]), nt = RFL(ul[1]), p0 = RFL(ul[2]), t3 = RFL(ul[3]), cn_ = RFL(ul[4]);
        if (e < 0) return false;
        u.e0 = e; u.e1 = nt; u.e2 = p0; u.e3 = t3; u.e4 = cn_;
        if (e != 64) { u.A = H2; u.B = WGU + (size_t)e * (512 * 1024) + (size_t)nt * (256 * 1024); }
        else { u.A = H2 + (size_t)t3 * 256 * 1024; u.B = WSGU + (size_t)nt * (256 * 1024); }
        return true;
    }
    __device__ __forceinline__ void a_offs(const Unit& u, int tid, unsigned (&vo)[2][2]) const {
        const bool shared = u.e0 == 64; const unsigned* lp = list + (size_t)(shared ? 0 : u.e0) * NT + u.e2;
        int Rr[2], Cc[2]; unsigned tv[2][2];
#pragma unroll
        for (int i = 0; i < 2; ++i) { pg8::stage_rc(tid * 16 + i * 8192, Rr[i], Cc[i]); Rr[i] = launder(Rr[i]); }
#pragma unroll
        for (int i = 0; i < 2; ++i)
#pragma unroll
            for (int h = 0; h < 2; ++h) tv[h][i] = lp[h * 128 + Rr[i]];
#pragma unroll
        for (int i = 0; i < 2; ++i)
#pragma unroll
            for (int h = 0; h < 2; ++h) { const int pos = u.e2 + h * 128 + Rr[i];
                const unsigned row = shared ? (unsigned)(h * 128 + Rr[i]) : (pos < u.e4 ? tv[h][i] >> 3 : 0u);
                vo[h][i] = row * 1024u + (unsigned)Cc[i] * 2u; }
    }
};
struct MoeDownSched {
    static constexpr bool GATHER = false;
    const char* ACT; const char* WD; const char* ACTS; const char* WSD; const LAS int* tbase; const LAS int* cnt; int nMs, G, c;
    __device__ __forceinline__ bool next(int i, Unit& u) const {
        if (i >= MOE_UL_MAX) return false;
        const LAS int* ul = tbase + (MOE_UL_OFF - MOE_TAB_OFF) / 4 + i * 8;
        const int e = RFL(ul[0]), pn = RFL(ul[1]), p0 = RFL(ul[2]), t3 = RFL(ul[3]), cn_ = RFL(ul[4]);
        if (e < 0) return false;
        u.e0 = e; u.e1 = pn; u.e2 = p0; u.e3 = t3; u.e4 = cn_;
        if (e != 64) { u.A = ACT + (size_t)t3 * (256 * 256); u.B = WD + (size_t)e * (1024 * 256) + (size_t)pn * (256 * 256); }
        else { u.A = ACTS + (size_t)t3 * (256 * 256); u.B = WSD + (size_t)pn * (256 * 256); }
        return true;
    }
    __device__ __forceinline__ void a_offs(const Unit&, int tid, unsigned (&vo)[2][2]) const {
#pragma unroll
        for (int i = 0; i < 2; ++i) { int R, C; pg8::stage_rc(tid * 16 + i * 8192, R, C);
#pragma unroll
            for (int h = 0; h < 2; ++h) vo[h][i] = (unsigned)((h * 128 + R) * 256 + C * 2); }
    }
};

struct EpiStoreBf16 {
    static constexpr bool STAGES = false;
    static constexpr bool KEEPS = false; __device__ __forceinline__ bool keep(const Unit&) const { return false; }
    static constexpr bool PERM = true, PERM256 = false;
    bf16_t* O; int ldc; int gate_tile0; unsigned char* G8; float sc;
    __device__ __forceinline__ void operator()(const f32x4 (&acc)[2][2][4][2], const Unit& u, int wr, int wc, int fr, int fq) const {
        const int row0 = u.e0 * 256 + launder(wr * 64 + fr), col0 = u.e1 * 256 + wc * 32 + 8 * fq;
        if (u.e1 >= gate_tile0) {
            const int gi = (u.e1 - gate_tile0) >> 2, pn = (u.e1 - gate_tile0) & 3, tidx = launder(((wr * 4 + wc) * 64) + fq * 16 + fr);
            unsigned char* gp = G8 + ((size_t)((u.e0 * 4 + pn) * 3 + gi) * 65536) + (size_t)tidx * 128;
#pragma unroll
            for (int ai = 0; ai < 2; ++ai)
#pragma unroll
                for (int m = 0; m < 4; ++m) { u32x4 w;
#pragma unroll
                    for (int bj = 0; bj < 2; ++bj) { const f32x4 v0 = acc[ai][bj][m][0] * sc, v1 = acc[ai][bj][m][1] * sc;
                        float q[8] = {v0[0], v0[1], v0[2], v0[3], v1[0], v1[1], v1[2], v1[3]}; unsigned qb[8];
#pragma unroll
                        for (int j = 0; j < 8; ++j) { const float t = fminf(fmaxf(sigmoidf_(q[j]) * 255.0f + 0.5f, 1.0f), 255.0f); qb[j] = (unsigned)t; }
                        const unsigned lo = qb[0] | (qb[1] << 8) | (qb[2] << 16) | (qb[3] << 24), hi = qb[4] | (qb[5] << 8) | (qb[6] << 16) | (qb[7] << 24);
                        if (bj == 0) { w.x = lo; w.y = hi; } else { w.z = lo; w.w = hi; } }
                    *(u32x4*)(gp + (ai * 4 + m) * 16) = w; }
            return;
        }
#pragma unroll
        for (int ai = 0; ai < 2; ++ai)
#pragma unroll
            for (int m = 0; m < 4; ++m) { bf16_t* rowp = O + (size_t)(row0 + ai * 128 + m * 16) * ldc + col0;
#pragma unroll
                for (int bj = 0; bj < 2; ++bj) { const f32x4 v0 = acc[ai][bj][m][0] * sc, v1 = acc[ai][bj][m][1] * sc;
                    u32x4 w; w.x = pk2(v0[0], v0[1]); w.y = pk2(v0[2], v0[3]); w.z = pk2(v1[0], v1[1]); w.w = pk2(v1[2], v1[3]);
                    *(u32x4*)(rowp + bj * 128) = w; } }
    }
};
struct EpiMerge {
    static constexpr bool PERM = true, PERM256 = false, KEEPS = true, STAGES = false;
    bf16_t* Mo; const unsigned char* G8;
    __device__ __forceinline__ bool keep(const Unit& u) const { return u.e2 < 2; }
    __device__ __forceinline__ void operator()(f32x4 (&acc)[2][2][4][2], const Unit& u, int wr, int wc, int fr, int fq) const {
        const int row0 = u.e0 * 256 + launder(wr * 64 + fr), col0 = u.e1 * 256 + wc * 32 + 8 * fq, sub = u.e2, tidx = launder(((wr * 4 + wc) * 64) + fq * 16 + fr);
        const unsigned char* gp = G8 + ((size_t)((u.e0 * 4 + u.e1) * 3 + sub) * 65536) + (size_t)tidx * 128;
        u32x4 gq[8], hq[8];
        const unsigned char* hp = gp + (sub < 2 ? 65536 : 0);
#pragma unroll
        for (int k = 0; k < 8; ++k) { gq[k] = *(const u32x4*)(gp + k * 16); hq[k] = *(const u32x4*)(hp + k * 16); }
        if (sub < 2) {
#pragma unroll
            for (int ai = 0; ai < 2; ++ai)
#pragma unroll
                for (int m = 0; m < 4; ++m)
#pragma unroll
                    for (int bj = 0; bj < 2; ++bj) { const u32x4 g4v = gq[ai * 4 + m], h4v = hq[ai * 4 + m];
                        const unsigned g0 = bj ? g4v.z : g4v.x, g1 = bj ? g4v.w : g4v.y, h0 = bj ? h4v.z : h4v.x, h1 = bj ? h4v.w : h4v.y;
                        float f[8];
#pragma unroll
                        for (int j = 0; j < 8; ++j) { const float qg = (float)(((j < 4 ? g0 : g1) >> (8 * (j & 3))) & 255u), qh = (float)(((j < 4 ? h0 : h1) >> (8 * (j & 3))) & 255u);
                            f[j] = qg * __builtin_amdgcn_rcpf(qh); }
                        acc[ai][bj][m][0] = acc[ai][bj][m][0] * (f32x4){f[0], f[1], f[2], f[3]}; acc[ai][bj][m][1] = acc[ai][bj][m][1] * (f32x4){f[4], f[5], f[6], f[7]}; }
        } else {
#pragma unroll
            for (int ai = 0; ai < 2; ++ai)
#pragma unroll
                for (int m = 0; m < 4; ++m)
#pragma unroll
                    for (int bj = 0; bj < 2; ++bj) { const u32x4 g4v = gq[ai * 4 + m];
                        const unsigned g0 = bj ? g4v.z : g4v.x, g1 = bj ? g4v.w : g4v.y;
                        float f[8];
#pragma unroll
                        for (int j = 0; j < 8; ++j) f[j] = (float)(((j < 4 ? g0 : g1) >> (8 * (j & 3))) & 255u) * (1.0f / 255.0f);
                        const f32x4 v0 = acc[ai][bj][m][0] * (f32x4){f[0], f[1], f[2], f[3]}, v1 = acc[ai][bj][m][1] * (f32x4){f[4], f[5], f[6], f[7]};
                        const size_t row = (size_t)(row0 + ai * 128 + m * 16);
                        u32x4 w; w.x = pk2(v0[0], v0[1]); w.y = pk2(v0[2], v0[3]); w.z = pk2(v1[0], v1[1]); w.w = pk2(v1[2], v1[3]);
                        *(u32x4*)(Mo + row * 1024 + col0 + bj * 128) = w; }
        }
    }
};
struct EpiResid {
    static constexpr bool STAGES = false;
    static constexpr bool KEEPS = false; __device__ __forceinline__ bool keep(const Unit&) const { return false; }
    static constexpr bool PERM = true, PERM256 = false;
    bf16_t* X; const float* gate;
    __device__ __forceinline__ void operator()(const f32x4 (&acc)[2][2][4][2], const Unit& u, int wr, int wc, int fr, int fq) const {
        const int g0 = u.e0 * 256; const bool lat = g0 < NL;
        const float* gp = gate + (size_t)(lat ? (g0 >> 11) : 8) * 6144;
        const int row0 = launder(wr * 64 + fr), col0 = u.e1 * 256 + wc * 32 + 8 * fq;
        f32x4 gv[2][2];
#pragma unroll
        for (int bj = 0; bj < 2; ++bj)
#pragma unroll
            for (int n = 0; n < 2; ++n) gv[bj][n] = *(const f32x4*)(gp + col0 + bj * 128 + n * 4);
#pragma unroll
        for (int ai = 0; ai < 2; ++ai) {
            u32x4 sq[4][2];
#pragma unroll
            for (int m = 0; m < 4; ++m)
#pragma unroll
                for (int bj = 0; bj < 2; ++bj) sq[m][bj] = *(const u32x4*)(X + (size_t)(g0 + row0 + ai * 128 + m * 16) * D + col0 + bj * 128);
#pragma unroll
            for (int m = 0; m < 4; ++m)
#pragma unroll
                for (int bj = 0; bj < 2; ++bj) { const u32x4 q = sq[m][bj];
                    const f32x4 v0 = (f32x4){lo16(q.x), hi16(q.x), lo16(q.y), hi16(q.y)} + gv[bj][0] * acc[ai][bj][m][0], v1 = (f32x4){lo16(q.z), hi16(q.z), lo16(q.w), hi16(q.w)} + gv[bj][1] * acc[ai][bj][m][1];
                    u32x4 w; w.x = pk2(v0[0], v0[1]); w.y = pk2(v0[2], v0[3]); w.z = pk2(v1[0], v1[1]); w.w = pk2(v1[2], v1[3]);
                    *(u32x4*)(X + (size_t)(g0 + row0 + ai * 128 + m * 16) * D + col0 + bj * 128) = w; }
            if (ai == 0) asm volatile("" ::: "memory");
        }
    }
};
struct EpiGateUp {
    static constexpr bool KEEPS = false; __device__ __forceinline__ bool keep(const Unit&) const { return false; }
    static constexpr bool PERM = true, PERM256 = false, STAGES = true;
    bf16_t* ACT; bf16_t* ACTS; const float* wl;
    __device__ __forceinline__ void stage(const Unit& u, LAS unsigned* dst_wave, int entry) const {
        if (u.e0 != 64) __builtin_amdgcn_global_load_lds((const unsigned*)(wl + (size_t)u.e0 * NT + u.e2 + entry), dst_wave, 4, 0, 0);
    }
    __device__ __forceinline__ void operator()(const f32x4 (&acc)[2][2][4][2], const Unit& u, int wr, int wc, int fr, int fq, const LAS unsigned* tab) const {
        const int row0 = launder(wr * 64 + fr), col0 = u.e1 * 128 + wc * 32 + 8 * (fq & ~1);
        unsigned char* base = (unsigned char*)(u.e0 == 64 ? ACTS : ACT) + (size_t)u.e3 * 256 * 256;
#pragma unroll
        for (int ai = 0; ai < 2; ++ai)
#pragma unroll
            for (int mp = 0; mp < 2; ++mp) { unsigned lo2[2], hi2[2];
#pragma unroll
                for (int q = 0; q < 2; ++q) { const int m = 2 * mp + q; const int row = row0 + ai * 128 + m * 16; const float tw = __uint_as_float(tab[row]);
                    const float w = u.e0 == 64 ? 1.0f : (u.e2 + row < u.e4 ? tw : 0.0f);
                    const f32x4 g0 = acc[ai][0][m][0] * 0.03125f, g1 = acc[ai][0][m][1] * 0.03125f, u0 = acc[ai][1][m][0] * (0.03125f * 8.0f * w), u1 = acc[ai][1][m][1] * (0.03125f * 8.0f * w);
                    int lo = 0, hi = 0;
                    lo = __builtin_amdgcn_cvt_pk_fp8_f32(siluf_(g0[0]) * u0[0], siluf_(g0[1]) * u0[1], lo, false); lo = __builtin_amdgcn_cvt_pk_fp8_f32(siluf_(g0[2]) * u0[2], siluf_(g0[3]) * u0[3], lo, true);
                    hi = __builtin_amdgcn_cvt_pk_fp8_f32(siluf_(g1[0]) * u1[0], siluf_(g1[1]) * u1[1], hi, false); hi = __builtin_amdgcn_cvt_pk_fp8_f32(siluf_(g1[2]) * u1[2], siluf_(g1[3]) * u1[3], hi, true);
                    lo2[q] = (unsigned)lo; hi2[q] = (unsigned)hi; }
                const auto rl = __builtin_amdgcn_permlane16_swap(lo2[0], lo2[1], false, false), rh = __builtin_amdgcn_permlane16_swap(hi2[0], hi2[1], false, false);
                const int row = row0 + ai * 128 + (2 * mp + (fq & 1)) * 16;
                *(u32x4*)(base + (size_t)row * 256 + col0) = (u32x4){rl[0], rh[0], rl[1], rh[1]}; }
    }
};
struct EpiDown {
    static constexpr bool KEEPS = false; __device__ __forceinline__ bool keep(const Unit&) const { return false; }
    static constexpr bool PERM = true, PERM256 = true, STAGES = true;
    bf16_t* O; const unsigned* list; bf16_t* Hs;
    __device__ __forceinline__ void stage(const Unit& u, LAS unsigned* dst_wave, int entry) const {
        if (u.e0 != 64) __builtin_amdgcn_global_load_lds(list + (size_t)u.e0 * NT + u.e2 + entry, dst_wave, 4, 0, 0);
    }
    __device__ __forceinline__ void operator()(const f32x4 (&acc)[2][2][4][2], const Unit& u, int wr, int wc, int fr, int fq, const LAS unsigned* tab) const {
        const int row0 = launder(wr * 64 + fr), col0 = u.e1 * 256 + wc * 64 + 16 * fq;
        if (u.e0 == 64) {
#pragma unroll
            for (int ai = 0; ai < 2; ++ai)
#pragma unroll
                for (int m = 0; m < 4; ++m) { bf16_t* rowp = Hs + (size_t)(u.e3 * 256 + row0 + ai * 128 + m * 16) * 1024 + col0;
#pragma unroll
                    for (int bj = 0; bj < 2; ++bj) { const f32x4 v0 = acc[ai][bj][m][0] * 0.0078125f, v1 = acc[ai][bj][m][1] * 0.0078125f;
                        u32x4 w; w.x = pk2(v0[0], v0[1]); w.y = pk2(v0[2], v0[3]); w.z = pk2(v1[0], v1[1]); w.w = pk2(v1[2], v1[3]);
                        *(u32x4*)(rowp + bj * 8) = w; } }
        } else {
            unsigned dq[2][4];
#pragma unroll
            for (int ai = 0; ai < 2; ++ai)
#pragma unroll
                for (int m = 0; m < 4; ++m) dq[ai][m] = tab[row0 + ai * 128 + m * 16];
#pragma unroll
            for (int ai = 0; ai < 2; ++ai)
#pragma unroll
                for (int m = 0; m < 4; ++m) {
                    if (u.e2 + row0 + ai * 128 + m * 16 < u.e4) { unsigned char* rowp = (unsigned char*)O + (size_t)dq[ai][m] * 1024 + col0;
                        int q[4];
#pragma unroll
                        for (int bj = 0; bj < 2; ++bj)
#pragma unroll
                            for (int n = 0; n < 2; ++n) { const f32x4 v = acc[ai][bj][m][n] * 0.0078125f; int t = 0;
                                t = __builtin_amdgcn_cvt_pk_fp8_f32(v[0], v[1], t, false); t = __builtin_amdgcn_cvt_pk_fp8_f32(v[2], v[3], t, true); q[bj * 2 + n] = t; }
                        *(u32x4*)rowp = (u32x4){(unsigned)q[0], (unsigned)q[1], (unsigned)q[2], (unsigned)q[3]}; } }
        }
    }
};

struct Params {
    const float* in[26];
    float* out; unsigned char* ws;
    int ph_lo, ph_hi, li, pad;
};
enum { I_X = 0, I_C, I_CTX, I_CCTX, I_WADA, I_BADA, I_NMG, I_NFG, I_WIN, I_CMLNG, I_CMLNB, I_CMWS, I_CMBS, I_RPB, I_DECAY, I_WBR, I_WOUT, I_RW, I_RB,
       I_EG, I_EU, I_ED, I_SG, I_SU, I_SD, I_FG };

__device__ __forceinline__ const float* kin(int i) {
    unsigned off = (unsigned)i * 8u; asm volatile("" : "+s"(off));
    const __attribute__((address_space(4))) char* ka = (const __attribute__((address_space(4))) char*)__builtin_amdgcn_kernarg_segment_ptr();
    return (const float*)*(GAS const float* const __attribute__((address_space(4)))*)(ka + off);
}
__device__ __forceinline__ float* kout_ptr() { unsigned off = 208u; asm volatile("" : "+s"(off));
    const __attribute__((address_space(4))) char* ka = (const __attribute__((address_space(4))) char*)__builtin_amdgcn_kernarg_segment_ptr();
    return (float*)*(GAS float* const __attribute__((address_space(4)))*)(ka + off); }
__device__ __forceinline__ unsigned char* kws_ptr() { unsigned off = 216u; asm volatile("" : "+s"(off));
    const __attribute__((address_space(4))) char* ka = (const __attribute__((address_space(4))) char*)__builtin_amdgcn_kernarg_segment_ptr();
    return (unsigned char*)*(GAS unsigned char* const __attribute__((address_space(4)))*)(ka + off); }
static_assert(__builtin_offsetof(Params, out) == 208 && __builtin_offsetof(Params, ws) == 216, "kernarg offsets");
static_assert(__builtin_offsetof(Params, in) == 0, "kin() reads Params::in at kernarg offset 0");
__device__ __forceinline__ void transpose_item(const float* W, int N, bf16_t* WT, int ldk, int extra, LAS float* scr, int kb, int nb, int lane) {
    const int k0 = 64 * kb, n0 = 32 * nb;
    float wv[32];
#pragma unroll
    for (int i = 0; i < 32; ++i) wv[i] = W[(size_t)(k0 + 2 * i + (lane >> 5)) * N + n0 + (lane & 31)];
#pragma unroll
    for (int i = 0; i < 32; ++i) scr[(2 * i + (lane >> 5)) * 33 + (lane & 31)] = wv[i];
    LDS_WAIT(); asm volatile("" ::: "memory");
    const int c = lane & 7;
#pragma unroll
    for (int j = 0; j < 4; ++j) { const int n = (lane >> 3) + 8 * j; const LAS float* s = scr + (8 * c) * 33 + n;
        u32x4 o; o.x = pk2(s[0 * 33], s[1 * 33]); o.y = pk2(s[2 * 33], s[3 * 33]); o.z = pk2(s[4 * 33], s[5 * 33]); o.w = pk2(s[6 * 33], s[7 * 33]);
        *(u32x4*)(WT + (size_t)(n0 + n + extra) * ldk + k0 + 8 * c) = o; }
    LDS_WAIT(); asm volatile("" ::: "memory");
}
__device__ __forceinline__ void transpose_item_f8(const float* W, int N, unsigned char* WT, int ldk, int extra, float scale, LAS float* scr, int kb, int nb, int lane) {
    const int k0 = 64 * kb, n0 = 32 * nb;
    float wv[32];
#pragma unroll
    for (int i = 0; i < 32; ++i) wv[i] = W[(size_t)(k0 + 2 * i + (lane >> 5)) * N + n0 + (lane & 31)];
#pragma unroll
    for (int i = 0; i < 32; ++i) scr[(2 * i + (lane >> 5)) * 33 + (lane & 31)] = wv[i];
    LDS_WAIT(); asm volatile("" ::: "memory");
    const int c = lane & 7;
#pragma unroll
    for (int j = 0; j < 4; ++j) { const int n = (lane >> 3) + 8 * j; const LAS float* s = scr + (8 * c) * 33 + n;
        int lo = 0, hi = 0;
        lo = __builtin_amdgcn_cvt_pk_fp8_f32(s[0 * 33] * scale, s[1 * 33] * scale, lo, false); lo = __builtin_amdgcn_cvt_pk_fp8_f32(s[2 * 33] * scale, s[3 * 33] * scale, lo, true);
        hi = __builtin_amdgcn_cvt_pk_fp8_f32(s[4 * 33] * scale, s[5 * 33] * scale, hi, false); hi = __builtin_amdgcn_cvt_pk_fp8_f32(s[6 * 33] * scale, s[7 * 33] * scale, hi, true);
        *(u32x2*)(WT + (size_t)(n0 + n + extra) * ldk + k0 + 8 * c) = (u32x2){(unsigned)lo, (unsigned)hi}; }
    LDS_WAIT(); asm volatile("" ::: "memory");
}
constexpr int IT_IN = 16 * 224, IT_BR = 3 * 8 * 32, IT_OUT = 16 * 32, IT_SG = 16 * 8, IT_SD = 4 * 32, IT_RT = 16 * 2, IT_CM = 128;
constexpr int MISC_ITEMS = IT_IN + IT_BR + IT_OUT + 2 * IT_SG + IT_SD + IT_RT + IT_CM;
__device__ __forceinline__ void misc_item(const Params& p, int l, int r, LAS float* scr, int lane) {
    unsigned char* wm = p.ws + WS_WM + (size_t)l * WM_STRIDE;
    if (r < IT_IN) { transpose_item_f8(kin(I_WIN) + (size_t)l * 1024 * 7168, 7168, (unsigned char*)(wm + WM_IN), 1024, 0, 32.0f, scr, r / 224, r % 224, lane); return; } r -= IT_IN;
    if (r < IT_BR) { const int i = r / 256, q = r % 256; transpose_item(kin(I_WBR) + ((size_t)l * 3 + i) * 512 * 1024, 1024, (bf16_t*)(wm + WM_BR) + (size_t)i * 1024 * 512, 512, 0, scr, q / 32, q % 32, lane); return; } r -= IT_BR;
    if (r < IT_OUT) { transpose_item(kin(I_WOUT) + (size_t)l * 1024 * 1024, 1024, (bf16_t*)(wm + WM_OUT), 1024, 0, scr, r / 32, r % 32, lane); return; } r -= IT_OUT;
    if (r < 2 * IT_SG) { const int up = r / IT_SG, q = r % IT_SG, nb = q % 8;
        transpose_item_f8(kin(up ? I_SU : I_SG) + (size_t)l * 1024 * 256, 256, (unsigned char*)(wm + WM_SGU), 1024, ((32 * nb) / 128) * 128 + up * 128, 32.0f, scr, q / 8, nb, lane); return; } r -= 2 * IT_SG;
    if (r < IT_SD) { transpose_item_f8(kin(I_SD) + (size_t)l * 256 * 1024, 1024, (unsigned char*)(wm + WM_SD), 256, 0, 16.0f, scr, r / 32, r % 32, lane); return; } r -= IT_SD;
    if (r < IT_RT) { transpose_item(kin(I_RW) + (size_t)l * 1024 * 64, 64, (bf16_t*)(wm + WM_RT), 1024, 0, scr, r / 2, r % 2, lane); return; } r -= IT_RT;
    { const float* src = kin(I_CMWS) + (size_t)l * 65536 + (size_t)r * 512 + lane * 8; const f32x4 a = *(const f32x4*)src, b = *(const f32x4*)(src + 4);
      u32x4 o; o.x = pk2(a[0], a[1]); o.y = pk2(a[2], a[3]); o.z = pk2(b[0], b[1]); o.w = pk2(b[2], b[3]);
      *(u32x4*)((bf16_t*)(wm + WM_CM) + (size_t)r * 512 + lane * 8) = o; }
}
constexpr int EXP_ITEMS = 3 * 64 * 128;
#ifndef FILL_A
#define FILL_A 24000
#endif
#ifndef FILL_B
#define FILL_B 33000
#endif
#ifndef FILL_C
#define FILL_C 43152
#endif
constexpr int FILL_SPLIT3 = FILL_C;
static_assert(FILL_C >= EXP_ITEMS, "only layer-1 items may wait for the gate/up phase of layer 0");
constexpr int FILL_SPLIT = FILL_A, FILL_SPLIT2 = FILL_B;
__device__ __forceinline__ void expert_item(const Params& p, int l, int r, LAS float* scr, int lane) {
    unsigned char* we = p.ws + WS_WE + (size_t)l * WE_LAYER;
    const int which = r / 8192, q = r % 8192, e = q / 128, it = q % 128;
    if (which < 2) { const int kb = it / 8, nb = it % 8;
        transpose_item_f8(kin(which ? I_EU : I_EG) + ((size_t)l * 64 + e) * 1024 * 256, 256, (unsigned char*)(we + WE_GU) + (size_t)e * 512 * 1024, 1024, ((32 * nb) / 128) * 128 + which * 128, 32.0f, scr, kb, nb, lane); }
    else { const int kb = it / 32, nb = it % 32;
        transpose_item_f8(kin(I_ED) + ((size_t)l * 64 + e) * 256 * 1024, 1024, (unsigned char*)(we + WE_D) + (size_t)e * 1024 * 256, 256, 0, 16.0f, scr, kb, nb, lane); }
}
__device__ __forceinline__ void mod_unit(const Params& p, LAS unsigned char* lds, int u, int tid) {
    const int l = u / 96, cb = u % 96, wave = __builtin_amdgcn_readfirstlane(tid >> 6), lane = tid & 63;
    LAS float* sil = (LAS float*)lds;
    LAS float* part = (LAS float*)(lds + 36864);
    for (int idx = tid; idx < 9 * 1024; idx += NTHREADS) { const int r = idx >> 10, k = idx & 1023; const float v = r < 8 ? kin(I_C)[r * 1024 + k] : kin(I_CCTX)[k]; sil[idx] = v / (1.0f + expf(-v)); }
    __syncthreads();
    float acc[9];
#pragma unroll
    for (int r = 0; r < 9; ++r) acc[r] = 0.f;
    const float* wp = kin(I_WADA) + ((size_t)l * 1024 + wave * 128) * 6144 + cb * 64 + lane;
#pragma unroll 4
    for (int k = 0; k < 128; ++k) { const float wv = wp[(size_t)k * 6144];
#pragma unroll
        for (int r = 0; r < 9; ++r) acc[r] += sil[r * 1024 + wave * 128 + k] * wv; }
#pragma unroll
    for (int r = 0; r < 9; ++r) part[(wave * 9 + r) * 64 + lane] = acc[r];
    __syncthreads();
    for (int idx = tid; idx < 576; idx += NTHREADS) { const int r = idx >> 6, ln = idx & 63; float s = kin(I_BADA)[l * 6144 + cb * 64 + ln];
#pragma unroll
        for (int w = 0; w < 8; ++w) s += part[(w * 9 + r) * 64 + ln];
        ((float*)(p.ws + WS_MOD))[((size_t)l * 9 + r) * 6144 + cb * 64 + ln] = s; }
    __syncthreads();
}

__device__ __forceinline__ void norm_mod_vals(const f32x4 (&v)[4], const float* g, const float* sh, const float* sc, bf16_t* orow, bool to_lds, LAS unsigned char* ldst, int lane) {
    f32x4 gq[4], hq[4], cq[4];
#pragma unroll
    for (int j = 0; j < 4; ++j) { gq[j] = ((const f32x4*)g)[64 * j + lane]; hq[j] = ((const f32x4*)sh)[64 * j + lane]; cq[j] = ((const f32x4*)sc)[64 * j + lane]; }
    float ss = 0.f;
#pragma unroll
    for (int j = 0; j < 4; ++j) ss += (v[j][0] * v[j][0] + v[j][1] * v[j][1]) + (v[j][2] * v[j][2] + v[j][3] * v[j][3]);
    const float rstd = rsqrtf(wave_sum(ss, lane) * (1.0f / 1024.0f) + EPS);
#pragma unroll
    for (int j = 0; j < 4; ++j) { const f32x4 gg = gq[j], s_h = hq[j], s_c = cq[j];
        const f32x4 y = v[j] * rstd * gg * (s_c + 1.0f) + s_h;
        u32x2 o; o.x = pk2(y[0], y[1]); o.y = pk2(y[2], y[3]);
        ((u32x2*)orow)[64 * j + lane] = o;
        if (to_lds) *(LAS u32x2*)(ldst + (64 * j + lane) * 8) = o; }
}
__device__ __forceinline__ void norm_mod_vals_f8(const f32x4 (&v)[4], const float* g, const float* sh, const float* sc, unsigned char* orow, int lane) {
    f32x4 gq[4], hq[4], cq[4];
#pragma unroll
    for (int j = 0; j < 4; ++j) { gq[j] = ((const f32x4*)g)[64 * j + lane]; hq[j] = ((const f32x4*)sh)[64 * j + lane]; cq[j] = ((const f32x4*)sc)[64 * j + lane]; }
    float ss = 0.f;
#pragma unroll
    for (int j = 0; j < 4; ++j) ss += (v[j][0] * v[j][0] + v[j][1] * v[j][1]) + (v[j][2] * v[j][2] + v[j][3] * v[j][3]);
    const float rstd = rsqrtf(wave_sum(ss, lane) * (1.0f / 1024.0f) + EPS);
#pragma unroll
    for (int j = 0; j < 4; ++j) { const f32x4 y = v[j] * rstd * gq[j] * (cq[j] + 1.0f) + hq[j];
        int w = 0; w = __builtin_amdgcn_cvt_pk_fp8_f32(y[0], y[1], w, false); w = __builtin_amdgcn_cvt_pk_fp8_f32(y[2], y[3], w, true);
        ((unsigned*)orow)[64 * j + lane] = (unsigned)w; }
}
__device__ __forceinline__ void norm_mod_row(const float* xrow, const float* g, const float* sh, const float* sc, bf16_t* orow, bool to_lds, LAS unsigned char* ldst, int lane) {
    f32x4 v[4];
#pragma unroll
    for (int j = 0; j < 4; ++j) v[j] = ((const f32x4*)xrow)[64 * j + lane];
    norm_mod_vals(v, g, sh, sc, orow, to_lds, ldst, lane);
}
__device__ __forceinline__ f32x4 bf4(u32x2 w) { return (f32x4){lo16(w.x), hi16(w.x), lo16(w.y), hi16(w.y)}; }
__device__ __forceinline__ void combine_row(f32x4 (&v)[4], const bf16_t* xrow, const float* ga2, const bf16_t* shrow, const unsigned char* o8, int lane) {
    u32x2 sq[4], xq[4]; unsigned oq[8][4]; f32x4 gq[4];
#pragma unroll
    for (int j = 0; j < 4; ++j) { xq[j] = ((const u32x2*)xrow)[64 * j + lane]; gq[j] = ((const f32x4*)ga2)[64 * j + lane]; sq[j] = ((const u32x2*)shrow)[64 * j + lane]; }
#pragma unroll
    for (int k = 0; k < 8; ++k)
#pragma unroll
        for (int j = 0; j < 4; ++j) oq[k][j] = ((const unsigned*)(o8 + (size_t)k * 1024))[64 * j + lane];
    asm volatile("" :: "v"(xq[0]), "v"(xq[1]), "v"(xq[2]), "v"(xq[3]), "v"(gq[0]), "v"(gq[1]), "v"(gq[2]), "v"(gq[3]) : "memory");
#pragma unroll
    for (int j = 0; j < 4; ++j) { f32x4 t = (f32x4){lo16(sq[j].x), hi16(sq[j].x), lo16(sq[j].y), hi16(sq[j].y)};
#pragma unroll
        for (int k = 0; k < 8; ++k) { const int w = (int)oq[k][j];
            t[0] += __builtin_amdgcn_cvt_f32_fp8(w, 0); t[1] += __builtin_amdgcn_cvt_f32_fp8(w, 1); t[2] += __builtin_amdgcn_cvt_f32_fp8(w, 2); t[3] += __builtin_amdgcn_cvt_f32_fp8(w, 3); }
        v[j] = bf4(xq[j]) + gq[j] * t; }
}

constexpr int RT_TILE = 0, RT_PITCH = 2064, RT_LG = 64 * RT_PITCH  , RT_BIAS = RT_LG + 64 * 65 * 4  , RT_LCNT = RT_BIAS + 256, RT_LBASE = RT_LCNT + 256,
              RT_SELE = RT_LBASE + 256  , RT_SELW = RT_SELE + 2048, RT_SELR = RT_SELW + 2048, RT_END = RT_SELR + 2048;
static_assert(RT_END <= LDS_BYTES, "router LDS");
#ifdef TIMING
#define RSTAMP(k) do { if (stamp && tid == 0) ((volatile LAS unsigned long long*)(lds + LDS_BYTES - 16 - 512))[24 + (k)] = __builtin_amdgcn_s_memrealtime(); } while (0)
#else
#define RSTAMP(k) do { } while (0)
#endif
__device__ __forceinline__ void router_unit(const Params& p, LAS unsigned char* lds, int l, int u, const bf16_t* xb, int tid, bool commit, bool stamp = false) {
    const int wave = __builtin_amdgcn_readfirstlane(tid >> 6), lane = tid & 63, g4 = lane >> 4, row0 = u * 64;
    const bool lat = row0 < NL;
    const float* mr = (const float*)(p.ws + WS_MOD) + (size_t)l * 9 * 6144 + (size_t)(lat ? (row0 >> 11) : 8) * 6144;
    const bf16_t* xbase = xb + (size_t)row0 * D;
    unsigned char* H2 = (unsigned char*)(p.ws + WS_H) + (size_t)row0 * D;
    LAS float* lg = (LAS float*)(lds + RT_LG); LAS float* bias = (LAS float*)(lds + RT_BIAS);
    LAS int* lcnt = (LAS int*)(lds + RT_LCNT); LAS int* lbase = (LAS int*)(lds + RT_LBASE);
    LAS int* sele = (LAS int*)(lds + RT_SELE); LAS float* selw = (LAS float*)(lds + RT_SELW); LAS int* selr = (LAS int*)(lds + RT_SELR);
    RSTAMP(0);
    if (tid < 64) { lcnt[tid] = 0; bias[tid] = kin(I_RB)[l * 64 + tid]; }
    const int rb = wave >> 1, eb0 = (wave & 1) * 2;
    const bf16_t* w0 = (const bf16_t*)(p.ws + WS_WM + (size_t)l * WM_STRIDE + WM_RT) + launder((eb0 * 16 + (lane & 15)) * 1024 + g4 * 8); const bf16_t* w1 = w0 + launder(16 * 1024);
    bf16x8 qa0[4], qa1[4];
#pragma unroll
    for (int ks = 0; ks < 4; ++ks) { qa0[ks] = *(const bf16x8*)(w0 + ks * 32); qa1[ks] = *(const bf16x8*)(w1 + ks * 32); }
    { f32x4 gg[4], s_h[4], s_c[4];
#pragma unroll
      for (int j = 0; j < 4; ++j) { gg[j] = ((const f32x4*)(kin(I_NFG) + l * 1024))[64 * j + lane]; s_h[j] = ((const f32x4*)(mr + 3072))[64 * j + lane]; s_c[j] = ((const f32x4*)(mr + 4096))[64 * j + lane] + 1.0f; }
#pragma unroll
      for (int hb = 0; hb < 2; ++hb) { f32x4 v[4][4];
#pragma unroll
          for (int i = 0; i < 4; ++i)
#pragma unroll
              for (int j = 0; j < 4; ++j) v[i][j] = bf4(((const u32x2*)(xbase + (size_t)(wave * 8 + hb * 4 + i) * D))[64 * j + lane]);
#pragma unroll
          for (int i = 0; i < 4; ++i) { const int rl = wave * 8 + hb * 4 + i; float ss = 0.f;
#pragma unroll
              for (int j = 0; j < 4; ++j) ss += (v[i][j][0] * v[i][j][0] + v[i][j][1] * v[i][j][1]) + (v[i][j][2] * v[i][j][2] + v[i][j][3] * v[i][j][3]);
              const float rstd = rsqrtf(wave_sum(ss, lane) * (1.0f / 1024.0f) + EPS);
#pragma unroll
              for (int j = 0; j < 4; ++j) { const f32x4 y = v[i][j] * rstd * gg[j] * s_c[j] + s_h[j];
                  u32x2 o; o.x = pk2(y[0], y[1]); o.y = pk2(y[2], y[3]);
                  int q8 = 0; q8 = __builtin_amdgcn_cvt_pk_fp8_f32(y[0], y[1], q8, false); q8 = __builtin_amdgcn_cvt_pk_fp8_f32(y[2], y[3], q8, true);
                  ((unsigned*)(H2 + (size_t)rl * D))[64 * j + lane] = (unsigned)q8; *(LAS u32x2*)(lds + RT_TILE + rl * RT_PITCH + (64 * j + lane) * 8) = o; } } } }
    __syncthreads();
    RSTAMP(1);
    { f32x4 a0 = (f32x4){0.f, 0.f, 0.f, 0.f}, a1 = a0;
      const LAS unsigned char* hrow = lds + RT_TILE + (rb * 16 + (lane & 15)) * RT_PITCH + g4 * 16;
      bf16x8 qb0[4], qb1[4];
      sfor<0, 4>([&](auto it_) { constexpr int it = decltype(it_)::value;
#pragma unroll
          for (int ks = 0; ks < 4; ++ks) { qb0[ks] = *(const bf16x8*)(w0 + ((2 * it + 1) * 4 + ks) * 32); qb1[ks] = *(const bf16x8*)(w1 + ((2 * it + 1) * 4 + ks) * 32); }
#pragma unroll
          for (int ks = 0; ks < 4; ++ks) { const bf16x8 bq = *(const LAS bf16x8*)(hrow + ((2 * it) * 4 + ks) * 64); a0 = mfma16(qa0[ks], bq, a0); a1 = mfma16(qa1[ks], bq, a1); }
          if constexpr (it < 3) {
#pragma unroll
              for (int ks = 0; ks < 4; ++ks) { qa0[ks] = *(const bf16x8*)(w0 + ((2 * it + 2) * 4 + ks) * 32); qa1[ks] = *(const bf16x8*)(w1 + ((2 * it + 2) * 4 + ks) * 32); } }
#pragma unroll
          for (int ks = 0; ks < 4; ++ks) { const bf16x8 bq = *(const LAS bf16x8*)(hrow + ((2 * it + 1) * 4 + ks) * 64); a0 = mfma16(qb0[ks], bq, a0); a1 = mfma16(qb1[ks], bq, a1); } });
      const int rr = rb * 16 + (lane & 15);
#pragma unroll
      for (int r = 0; r < 4; ++r) { lg[rr * 65 + eb0 * 16 + 4 * g4 + r] = sigmoidf_(a0[r]); lg[rr * 65 + (eb0 + 1) * 16 + 4 * g4 + r] = sigmoidf_(a1[r]); } }
    __syncthreads();
    RSTAMP(2);
    { const int row = tid >> 3, g = tid & 7;
      float sv[8]; unsigned key[8];
#pragma unroll
      for (int j = 0; j < 8; ++j) { sv[j] = lg[row * 65 + 8 * g + j]; const unsigned ub = __float_as_uint(sv[j] + bias[8 * g + j]);
          key[j] = ((ub ^ ((ub >> 31) ? 0xffffffffu : 0x80000000u)) & ~63u) | (unsigned)(63 - (8 * g + j)); }
      float m1 = -3e38f, m2 = -3e38f;
#pragma unroll
      for (int j = 0; j < 8; ++j) { const float c = sv[j] + bias[8 * g + j]; if (c > m1) { m2 = m1; m1 = c; } else if (c > m2) m2 = c; }
      const unsigned ug = __float_as_uint(m1 + m2); const unsigned gkey = ((ug ^ ((ug >> 31) ? 0xffffffffu : 0x80000000u)) & ~7u) | (unsigned)(7 - g);
      int grank = 0;
      sfor<1, 8>([&](auto d_) { constexpr int d = decltype(d_)::value; grank += (int)((unsigned)shxi((int)gkey, d, lane) > gkey); });
      const bool gsel = grank < 4;
#pragma unroll
      for (int j = 0; j < 8; ++j) if (!gsel) key[j] = (unsigned)(63 - (8 * g + j));
      int rk[8];
#pragma unroll
      for (int j = 0; j < 8; ++j) { int r = 0;
#pragma unroll
          for (int j2 = 0; j2 < 8; ++j2) r += (int)(key[j2] > key[j]);
          rk[j] = r; }
      sfor<1, 8>([&](auto d_) { constexpr int d = decltype(d_)::value;
          sfor<0, 8>([&](auto j2_) { constexpr int j2 = decltype(j2_)::value; const unsigned ok = (unsigned)shxi((int)key[j2], d, lane);
#pragma unroll
              for (int j = 0; j < 8; ++j) rk[j] += (int)(ok > key[j]); });
          __builtin_amdgcn_sched_barrier(0); });
      float wsum = 0.f;
#pragma unroll
      for (int j = 0; j < 8; ++j) if (gsel && rk[j] < 8) wsum += sv[j];
      wsum += shx(wsum, 1, lane); wsum += shx(wsum, 2, lane); wsum += shx(wsum, 4, lane);
      const float sc = 2.5f / wsum;
#pragma unroll
      for (int j = 0; j < 8; ++j) if (gsel && rk[j] < 8) { const int e = 8 * g + j, k = rk[j];
          sele[row * 8 + k] = e; selw[row * 8 + k] = sv[j] * sc; selr[row * 8 + k] = __hip_atomic_fetch_add(&lcnt[e], 1, __ATOMIC_RELAXED, __HIP_MEMORY_SCOPE_WORKGROUP); } }
    __syncthreads();
    RSTAMP(3);
    if (tid < 64) { const int n = lcnt[tid]; int base = 0; if (n > 0 && commit) base = (int)atomicAdd((unsigned*)(p.ws + WS_CTL) + CW_CNT + l * 2048 + tid * 16, (unsigned)n); lbase[tid] = base; }
    __syncthreads();
    RSTAMP(4);
    { const int rl = tid >> 3, k = tid & 7, e = sele[rl * 8 + k], pos = lbase[e] + selr[rl * 8 + k];
      if (commit) { ((unsigned*)(p.ws + WS_LIST))[(size_t)e * NT + pos] = (unsigned)((row0 + rl) * 8 + k); ((float*)(p.ws + WS_WL))[(size_t)e * NT + pos] = selw[rl * 8 + k]; } }
    __syncthreads();
    RSTAMP(5);
}

__device__ __forceinline__ void mixA_unit(const Params& p, LAS unsigned char* lds, int l, int ch, int g, int tid) {
    const int wave = __builtin_amdgcn_readfirstlane(tid >> 6), lane = tid & 63, g4 = lane >> 4, rows0 = ch * 128;
    const bf16_t* Z = (const bf16_t*)(p.ws + WS_R + R_Z); bf16_t* BR = (bf16_t*)(p.ws + WS_R + R_BR);
    const bf16_t* WCM = (const bf16_t*)(p.ws + WS_WM + (size_t)l * WM_STRIDE + WM_CM);
    LAS unsigned char* vn = lds + 1024;
    { const int q = tid >> 2, c0 = (tid & 3) * 8; const f32x2 st2 = *(const f32x2*)((const float*)(p.ws + WS_R + R_STAT) + (size_t)(rows0 + q) * 2); const float mean = st2[0], rstd = st2[1];
      const float* lg = kin(I_CMLNG) + l * 512 + g * 128; const float* lb = kin(I_CMLNB) + l * 512 + g * 128;
      u32x4 vq[4];
#pragma unroll
      for (int j = 0; j < 4; ++j) vq[j] = *(const u32x4*)(Z + (size_t)(rows0 + q) * ZW + ZC_AV + g * 128 + c0 + 32 * j);
#pragma unroll
      for (int j = 0; j < 4; ++j) { const int cs = c0 + 32 * j; const u32x4 v = vq[j];
          const f32x4 ga = *(const f32x4*)(lg + cs), gb = *(const f32x4*)(lg + cs + 4), ba = *(const f32x4*)(lb + cs), bb = *(const f32x4*)(lb + cs + 4);
          u32x4 o;
          o.x = pk2((geluf_(lo16(v.x)) - mean) * rstd * ga[0] + ba[0], (geluf_(hi16(v.x)) - mean) * rstd * ga[1] + ba[1]);
          o.y = pk2((geluf_(lo16(v.y)) - mean) * rstd * ga[2] + ba[2], (geluf_(hi16(v.y)) - mean) * rstd * ga[3] + ba[3]);
          o.z = pk2((geluf_(lo16(v.z)) - mean) * rstd * gb[0] + bb[0], (geluf_(hi16(v.z)) - mean) * rstd * gb[1] + bb[1]);
          o.w = pk2((geluf_(lo16(v.w)) - mean) * rstd * gb[2] + bb[2], (geluf_(hi16(v.w)) - mean) * rstd * gb[3] + bb[3]);
          *(LAS u32x4*)(vn + q * 272 + cs * 2) = o; } }
    __syncthreads();
    { const int pb = wave, pp = pb * 16 + (lane & 15);
      bf16x8 bfr[4];
#pragma unroll
      for (int ks = 0; ks < 4; ++ks) bfr[ks] = *(const bf16x8*)(WCM + (size_t)(g * 128 + pp) * 128 + 32 * ks + 8 * g4);
      const unsigned vna = tr_lane(lds_addr(vn), 272, 8, lane);
      const float bs = kin(I_CMBS)[l * 512 + g * 128 + pp];
      const size_t row = (size_t)(rows0 + pp);
      u32x4 uL[4];
#pragma unroll
      for (int k = 0; k < 4; ++k) uL[k] = *(const u32x4*)(Z + row * ZW + ZC_AU + g * 128 + 32 * k + pair16_off(g4));
      sfor<0, 2>([&](auto cg_) { constexpr int cg = decltype(cg_)::value; f32x4 acc[4];
#pragma unroll
          for (int i = 0; i < 4; ++i) acc[i] = (f32x4){0.f, 0.f, 0.f, 0.f};
          sfor<0, 4>([&](auto ks_) { constexpr int ks = decltype(ks_)::value; bf16x8 af[4]; tr_frag4_i<32 * ks * 272 + 128 * cg, 4 * 272>(vna, af);
#pragma unroll
              for (int i = 0; i < 4; ++i) acc[i] = mfma16(af[i], bfr[ks], acc[i]); });
#pragma unroll
          for (int ip = 0; ip < 2; ++ip) { u32x2 uu[2], o[2]; pair16_unpack(uL[2 * cg + ip], uu[0], uu[1]);
#pragma unroll
              for (int q = 0; q < 2; ++q) { const int i = 2 * ip + q;
                  o[q].x = pk2(geluf_(lo16(uu[q].x)) * (acc[i][0] + bs), geluf_(hi16(uu[q].x)) * (acc[i][1] + bs)); o[q].y = pk2(geluf_(lo16(uu[q].y)) * (acc[i][2] + bs), geluf_(hi16(uu[q].y)) * (acc[i][3] + bs)); }
              pair16_store(BR + row * BRW + g * 128 + 32 * (2 * cg + ip), g4, o[0], o[1]); } }); }
    __syncthreads();
}

struct RetRaw { u32x4 a, b; };
struct RetRope { f32x4 cs[4]; };
struct RetV { u32x4 q[4]; };
__device__ __forceinline__ RetRaw ret_qk_load(const bf16_t* src  , int tid) {
    const int pp = tid >> 2, half = (tid >> 1) & 1, sub = tid & 1; const bf16_t* s = src + (size_t)pp * ZW + 32 * half + 8 * sub;
    RetRaw r; r.a = *(const u32x4*)s; r.b = *(const u32x4*)(s + 16); return r;
}
__device__ __forceinline__ RetRope ret_rope_load(const float* rope, bool do_rope, int tpos0, int tid) {
    const int pp = tid >> 2, half = (tid >> 1) & 1, sub = tid & 1, t = tpos0 + pp, pos = do_rope ? (half ? (t & 63) : (t >> 6)) : 0;
    const f32x4* tb = (const f32x4*)(rope + (size_t)(pos * 16 + 8 * sub) * 2); RetRope r;
#pragma unroll
    for (int j = 0; j < 4; ++j) r.cs[j] = tb[j];
    return r;
}
__device__ __forceinline__ void ret_stage_qk(const RetRaw& raw, const RetRope& rp, int mask  , LAS unsigned char* t0, LAS unsigned char* t1, LAS unsigned char* t2,
                                             float sc0, float l2a, float offa, float siga, float l2b, float offb, float sigb, int tid) {
    const int pp = tid >> 2, half = (tid >> 1) & 1, sub = tid & 1;
    const u32x4 a = raw.a, b = raw.b;
    float x1[8] = {lo16(a.x), hi16(a.x), lo16(a.y), hi16(a.y), lo16(a.z), hi16(a.z), lo16(a.w), hi16(a.w)};
    float x2[8] = {lo16(b.x), hi16(b.x), lo16(b.y), hi16(b.y), lo16(b.z), hi16(b.z), lo16(b.w), hi16(b.w)};
    float o1[8], o2[8];
#pragma unroll
    for (int j = 0; j < 4; ++j) { const f32x4 cs = rp.cs[j];
        o1[2 * j] = x1[2 * j] * cs[0] - x2[2 * j] * cs[1]; o2[2 * j] = x1[2 * j] * cs[1] + x2[2 * j] * cs[0];
        o1[2 * j + 1] = x1[2 * j + 1] * cs[2] - x2[2 * j + 1] * cs[3]; o2[2 * j + 1] = x1[2 * j + 1] * cs[3] + x2[2 * j + 1] * cs[2]; }
    const int off = pp * 144 + (32 * half + 8 * sub) * 2;
    const float fp = (float)pp;
    const float sA = sc0 * __builtin_amdgcn_exp2f((offa + siga * fp) * l2a), sB = sc0 * __builtin_amdgcn_exp2f((offb + sigb * fp) * l2b);
    if (mask & 1) { u32x4 w; w.x = pk2(o1[0] * sc0, o1[1] * sc0); w.y = pk2(o1[2] * sc0, o1[3] * sc0); w.z = pk2(o1[4] * sc0, o1[5] * sc0); w.w = pk2(o1[6] * sc0, o1[7] * sc0); *(LAS u32x4*)(t0 + off) = w;
              w.x = pk2(o2[0] * sc0, o2[1] * sc0); w.y = pk2(o2[2] * sc0, o2[3] * sc0); w.z = pk2(o2[4] * sc0, o2[5] * sc0); w.w = pk2(o2[6] * sc0, o2[7] * sc0); *(LAS u32x4*)(t0 + off + 32) = w; }
    if (mask & 2) { u32x4 w; w.x = pk2(o1[0] * sA, o1[1] * sA); w.y = pk2(o1[2] * sA, o1[3] * sA); w.z = pk2(o1[4] * sA, o1[5] * sA); w.w = pk2(o1[6] * sA, o1[7] * sA); *(LAS u32x4*)(t1 + off) = w;
              w.x = pk2(o2[0] * sA, o2[1] * sA); w.y = pk2(o2[2] * sA, o2[3] * sA); w.z = pk2(o2[4] * sA, o2[5] * sA); w.w = pk2(o2[6] * sA, o2[7] * sA); *(LAS u32x4*)(t1 + off + 32) = w; }
    if (mask & 4) { u32x4 w; w.x = pk2(o1[0] * sB, o1[1] * sB); w.y = pk2(o1[2] * sB, o1[3] * sB); w.z = pk2(o1[4] * sB, o1[5] * sB); w.w = pk2(o1[6] * sB, o1[7] * sB); *(LAS u32x4*)(t2 + off) = w;
              w.x = pk2(o2[0] * sB, o2[1] * sB); w.y = pk2(o2[2] * sB, o2[3] * sB); w.z = pk2(o2[4] * sB, o2[5] * sB); w.w = pk2(o2[6] * sB, o2[7] * sB); *(LAS u32x4*)(t2 + off + 32) = w; }
}
__device__ __forceinline__ RetV ret_v_load(const bf16_t* src  , int tid) {
    const int pp = tid >> 2, sg = (tid & 3) * 8; RetV r;
#pragma unroll
    for (int j = 0; j < 4; ++j) r.q[j] = *(const u32x4*)(src + (size_t)pp * ZW + sg + 32 * j);
    return r;
}
__device__ __forceinline__ void ret_stage_v(const RetV& r, LAS unsigned char* tv, int tid) {
    const int pp = tid >> 2, sg = (tid & 3) * 8;
#pragma unroll
    for (int j = 0; j < 4; ++j) *(LAS u32x4*)(tv + pp * 272 + (sg + 32 * j) * 2) = r.q[j];
}
__device__ __forceinline__ float log2_gamma(const Params& p, int l, int dir, int h) { const float x = kin(I_DECAY)[(l * 2 + dir) * 4 + h]; return -log2f(1.0f + expf(-x)); }
__device__ __forceinline__ int ret_row0(int b, int cc) { return cc < 2 ? NL + b * 256 + cc * 128 : b * 2048 + (cc - 2) * 128; }

__device__ __forceinline__ void retkv_unit(const Params& p, LAS unsigned char* lds, int l, int b, int h, int cc, int tid) {
    const int wave = __builtin_amdgcn_readfirstlane(tid >> 6), lane = tid & 63, g4 = lane >> 4, row0 = ret_row0(b, cc);
    const bf16_t* Z = (const bf16_t*)(p.ws + WS_R + R_Z); float* KV = (float*)(p.ws + WS_R + R_KV);
    const float l2f = log2_gamma(p, l, 0, h), l2b = log2_gamma(p, l, 1, h);
    LAS unsigned char* kf = lds; LAS unsigned char* kb = lds + 18432; LAS unsigned char* vv = lds + 36864;
    { const RetRaw kr = ret_qk_load(Z + (size_t)row0 * ZW + ZC_RK + h * 64, tid); const RetRope rr = ret_rope_load((const float*)(p.ws + WS_ROPE), cc >= 2, (cc - 2) * 128, tid);
      const RetV vr = ret_v_load(Z + (size_t)row0 * ZW + ZC_RV + h * 128, tid);
      ret_stage_qk(kr, rr, 6, kf, kf, kb, 0.125f, l2f, 127.f, -1.f, l2b, 0.f, 1.f, tid);
      ret_stage_v(vr, vv, tid); }
    __syncthreads();
    { const int dir = wave >> 2, db = wave & 3; const unsigned ka = tr_lane(lds_addr(dir ? kb : kf), 144, 8, lane) + 32 * db, va = tr_lane(lds_addr(vv), 272, 8, lane);
      bf16x8 afr[4];
      sfor<0, 4>([&](auto ks_) { constexpr int ks = decltype(ks_)::value; afr[ks] = tr_frag_i<32 * ks * 144, 32 * ks * 144 + 4 * 144>(ka); });
      float* dst = KV + ((((size_t)b * 4 + h) * NCHUNK + cc) * 2 + dir) * 8192;
      sfor<0, 2>([&](auto eg_) { constexpr int eg = decltype(eg_)::value; f32x4 acc[4];
#pragma unroll
          for (int i = 0; i < 4; ++i) acc[i] = (f32x4){0.f, 0.f, 0.f, 0.f};
          sfor<0, 4>([&](auto ks_) { constexpr int ks = decltype(ks_)::value; bf16x8 bf[4]; tr_frag4_i<32 * ks * 272 + 128 * eg, 4 * 272>(va, bf);
#pragma unroll
              for (int i = 0; i < 4; ++i) acc[i] = mfma16(afr[ks], bf[i], acc[i]); });
#pragma unroll
          for (int i = 0; i < 4; ++i)
#pragma unroll
              for (int r = 0; r < 4; ++r) dst[(16 * db + 4 * g4 + r) * 128 + 16 * (4 * eg + i) + (lane & 15)] = acc[i][r]; }); }
    __syncthreads();
}

__device__ __forceinline__ void retout_unit(const Params& p, LAS unsigned char* lds, int l, int b, int h, int cc, int tid) {
    const int wave = __builtin_amdgcn_readfirstlane(tid >> 6), lane = tid & 63, g4 = lane >> 4, row0 = ret_row0(b, cc);
    const bf16_t* Z = (const bf16_t*)(p.ws + WS_R + R_Z); bf16_t* BR = (bf16_t*)(p.ws + WS_R + R_BR);
    const float l2f = log2_gamma(p, l, 0, h), l2b = log2_gamma(p, l, 1, h);
    LAS unsigned char* tq = lds; LAS unsigned char* tqf = lds + 18432; LAS unsigned char* tqb = lds + 36864; LAS unsigned char* tk = lds + 55296;
    LAS unsigned char* tv = lds + 73728; LAS unsigned char* st = lds + 108544;
    { const u32x4* src = (const u32x4*)((const bf16_t*)(p.ws + WS_R + R_ST) + (((size_t)b * 4 + h) * NCHUNK + cc) * 2 * 8192);
      u32x4 sraw[4];
#pragma unroll
      for (int j = 0; j < 4; ++j) sraw[j] = src[tid + 512 * j];
      const RetRaw qr = ret_qk_load(Z + (size_t)row0 * ZW + ZC_RQ + h * 64, tid), kr = ret_qk_load(Z + (size_t)row0 * ZW + ZC_RK + h * 64, tid);
      const RetRope rr = ret_rope_load((const float*)(p.ws + WS_ROPE), cc >= 2, (cc - 2) * 128, tid);
      const RetV vr = ret_v_load(Z + (size_t)row0 * ZW + ZC_RV + h * 128, tid);
#pragma unroll
      for (int j = 0; j < 4; ++j) { const int c = tid + 512 * j; *(LAS u32x4*)(st + (c >> 4) * 272 + (c & 15) * 16) = sraw[j]; }
      ret_stage_qk(qr, rr, 7, tq, tqf, tqb, 1.0f, l2f, 1.f, 1.f, l2b, 128.f, -1.f, tid);
      ret_stage_qk(kr, rr, 1, tk, tk, tk, 0.125f, 0.f, 0.f, 0.f, 0.f, 0.f, 0.f, tid);
      ret_stage_v(vr, tv, tid); }
    __syncthreads();
    const int ib = wave, ti = ib * 16 + (lane & 15);
    f32x4 oacc[8];
#pragma unroll
    for (int eb = 0; eb < 8; ++eb) oacc[eb] = (f32x4){0.f, 0.f, 0.f, 0.f};
    { bf16x8 bq[4];
#pragma unroll
      for (int ks = 0; ks < 4; ++ks) bq[ks] = *(const LAS bf16x8*)((ks < 2 ? tqf : tqb) + ti * 144 + (32 * (ks & 1) + 8 * g4) * 2);
      const unsigned sa = tr_lane(lds_addr(st), 272, 8, lane);
      sfor<0, 4>([&](auto ks_) { constexpr int ks = decltype(ks_)::value;
          sfor<0, 2>([&](auto eg_) { constexpr int eg = decltype(eg_)::value; bf16x8 af[4]; tr_frag4_i<32 * ks * 272 + 128 * eg, 4 * 272>(sa, af);
#pragma unroll
              for (int i = 0; i < 4; ++i) oacc[4 * eg + i] = mfma16(af[i], bq[ks], oacc[4 * eg + i]); }); }); }
    { bf16x8 bq[2];
#pragma unroll
      for (int ks = 0; ks < 2; ++ks) bq[ks] = *(const LAS bf16x8*)(tq + ti * 144 + (32 * ks + 8 * g4) * 2);
      f32x4 sacc[8];
#pragma unroll
      for (int jb = 0; jb < 8; ++jb) { sacc[jb] = (f32x4){0.f, 0.f, 0.f, 0.f};
#pragma unroll
          for (int ks = 0; ks < 2; ++ks) { const bf16x8 a = *(const LAS bf16x8*)(tk + (16 * jb + (lane & 15)) * 144 + (32 * ks + 8 * g4) * 2); sacc[jb] = mfma16(a, bq[ks], sacc[jb]); }
#pragma unroll
          for (int r = 0; r < 4; ++r) { const int dist = ti - (16 * jb + 4 * g4 + r);
              sacc[jb][r] *= dist >= 0 ? __builtin_amdgcn_exp2f((float)dist * l2f) : __builtin_amdgcn_exp2f((float)(-dist) * l2b); } }
      const unsigned va = tr_lane(lds_addr(tv), 272, 4, lane);
      sfor<0, 4>([&](auto kk_) { constexpr int kk = decltype(kk_)::value;
          u32x4 pw; pw.x = pk2(sacc[2 * kk][0], sacc[2 * kk][1]); pw.y = pk2(sacc[2 * kk][2], sacc[2 * kk][3]); pw.z = pk2(sacc[2 * kk + 1][0], sacc[2 * kk + 1][1]); pw.w = pk2(sacc[2 * kk + 1][2], sacc[2 * kk + 1][3]);
          const bf16x8 bp = as_frag(pw);
          sfor<0, 2>([&](auto eg_) { constexpr int eg = decltype(eg_)::value; bf16x8 af[4]; tr_frag4_i<32 * kk * 272 + 128 * eg, 16 * 272>(va, af);
#pragma unroll
              for (int i = 0; i < 4; ++i) oacc[4 * eg + i] = mfma16(af[i], bp, oacc[4 * eg + i]); }); }); }
    { float ss = 0.f;
#pragma unroll
      for (int eb = 0; eb < 8; ++eb) ss += (oacc[eb][0] * oacc[eb][0] + oacc[eb][1] * oacc[eb][1]) + (oacc[eb][2] * oacc[eb][2] + oacc[eb][3] * oacc[eb][3]);
      ss += shx(ss, 16, lane); ss += shx(ss, 32, lane);
      const float rstd = rsqrtf(ss * (1.0f / 128.0f) + EPS);
      const size_t row = (size_t)(row0 + ti);
      u32x4 gL[4];
#pragma unroll
      for (int k = 0; k < 4; ++k) gL[k] = *(const u32x4*)(Z + row * ZW + ZC_RG + h * 128 + 32 * k + pair16_off(g4));
#pragma unroll
      for (int k = 0; k < 4; ++k) { u32x2 gg[2], o[2]; pair16_unpack(gL[k], gg[0], gg[1]);
#pragma unroll
          for (int q = 0; q < 2; ++q) { const int eb = 2 * k + q;
              o[q].x = pk2(oacc[eb][0] * rstd * siluf_(lo16(gg[q].x)), oacc[eb][1] * rstd * siluf_(hi16(gg[q].x))); o[q].y = pk2(oacc[eb][2] * rstd * siluf_(lo16(gg[q].y)), oacc[eb][3] * rstd * siluf_(hi16(gg[q].y))); }
          pair16_store(BR + row * BRW + 1024 + h * 128 + 32 * k, g4, o[0], o[1]); } }
    __syncthreads();
}

constexpr int NA_V = 0, NA_PITCH = 144, NA_CTXROW = 576, NA_TAB = (576 + 256) * NA_PITCH  , NA_KC = NA_TAB + 2048  , NA_KC_SZ = 256 * NA_PITCH;
static_assert(NA_KC + NA_KC_SZ <= LDS_BYTES - 1024, "NA LDS");
__device__ __forceinline__ void na_unit(const Params& p, LAS unsigned char* lds, int l, int b, int h, int rp, bool local, int tid) {
    const int wave = __builtin_amdgcn_readfirstlane(tid >> 6), lane = tid & 63, g4 = lane >> 4, qb = wave >> 1, jr = wave & 1;
    const bf16_t* Z = (const bf16_t*)(p.ws + WS_R + R_Z); bf16_t* BR = (bf16_t*)(p.ws + WS_R + R_BR);
    LAS unsigned char* vl = lds + NA_V; LAS float* tab = (LAS float*)(lds + NA_TAB);
    const int qc = 16 * qb + (lane & 15);
    const int r0 = 2 * rp, rsA = min(max(r0 - 4, 0), 24), nwr = min(9, 32 - rsA);
    const int kbs = min(max(16 * qb - 8, 0), 32), cst = min(max(qc - 8, 0), 48);
    { const int piece = tid & 7, kr = tid >> 3;
      u32x4 cq[4], ckq[4];
#pragma unroll
      for (int ps = 0; ps < 4; ++ps) { cq[ps] = *((const u32x4*)(Z + ((size_t)NL + b * 256 + kr + 64 * ps) * ZW + ZC_NV + h * 64) + piece);
                                       ckq[ps] = *((const u32x4*)(Z + ((size_t)NL + b * 256 + kr + 64 * ps) * ZW + ZC_NK + h * 64) + piece); }
      if (local) {
          u32x4 vq[9];
#pragma unroll
          for (int ps = 0; ps < 9; ++ps) { const int key = min(kr + 64 * ps, nwr * 64 - 1); const size_t krow = (size_t)b * 2048 + (rsA + (key >> 6)) * 64 + (key & 63);
              vq[ps] = *((const u32x4*)(Z + krow * ZW + ZC_NV + h * 64) + piece); }
          const float tv = tid < 465 ? kin(I_RPB)[(size_t)(l * 8 + h) * 465 + tid] : 0.f;
#pragma unroll
          for (int ps = 0; ps < 9; ++ps) { const int key = kr + 64 * ps; if (key < nwr * 64) *(LAS u32x4*)(vl + key * NA_PITCH + 16 * piece) = vq[ps]; }
          if (tid < 465) tab[tid] = tv; }
#pragma unroll
      for (int ps = 0; ps < 4; ++ps) { *(LAS u32x4*)(vl + (NA_CTXROW + kr + 64 * ps) * NA_PITCH + 16 * piece) = cq[ps];
                                       *(LAS u32x4*)(lds + NA_KC + (kr + 64 * ps) * NA_PITCH + 16 * piece) = ckq[ps]; } }
    __syncthreads();
    const float L2E = 1.44269504089f;
    const unsigned vla = lds_addr(vl);
    const unsigned lane_off = (unsigned)((4 * g4 + ((lane & 15) >> 2)) * NA_PITCH + (lane & 3) * 8);
    const int r = r0 + jr, rs = min(max(r - 4, 0), 24), wofs = rs - rsA;
    const size_t qrow = local ? (size_t)b * 2048 + r * 64 + qc : (size_t)NL + b * 256 + r * 64 + qc;
    bf16x8 bq[2];
#pragma unroll
    for (int ks = 0; ks < 2; ++ks) bq[ks] = *(const bf16x8*)(Z + qrow * ZW + ZC_NQ + h * 64 + 32 * ks + 8 * g4);
    float mx0 = 0.f, ls0 = 0.f; f32x4 oa0[4];
#pragma unroll
    for (int db = 0; db < 4; ++db) oa0[db] = (f32x4){0.f, 0.f, 0.f, 0.f};
#pragma unroll 1
    for (int half = 0; half < 2; ++half) {
        bf16x8 kf[16];
        if (local) {
#pragma unroll
            for (int blk = 0; blk < 8; ++blk) { const size_t krow = (size_t)b * 2048 + (rs + 4 * half + (blk >> 1)) * 64 + kbs + 16 * (blk & 1) + (lane & 15);
#pragma unroll
                for (int ks = 0; ks < 2; ++ks) kf[blk * 2 + ks] = *(const bf16x8*)(Z + krow * ZW + ZC_NK + h * 64 + 32 * ks + 8 * g4); } }
        f32x4 s[16]; float mx = -1e30f;
        if (local) {
#pragma unroll
            for (int blk = 0; blk < 8; ++blk) { const int i = 4 * half + (blk >> 1), cb = blk & 1;
                f32x4 a = (f32x4){0.f, 0.f, 0.f, 0.f};
#pragma unroll
                for (int ks = 0; ks < 2; ++ks) a = mfma16(kf[blk * 2 + ks], bq[ks], a);
                const int ro = rs + i - r + 7;
#pragma unroll
                for (int rg = 0; rg < 4; ++rg) { const int kc = kbs + 16 * cb + 4 * g4 + rg; const bool valid = kc >= cst && kc < cst + 16;
                    const int co = min(max(kc - qc, -15), 15) + 15;
                    const float bv = tab[ro * 31 + co];
                const float v = valid ? a[rg] * 0.125f + bv : -1e30f; s[blk][rg] = v; mx = fmaxf(mx, v); } }
        } else {
#pragma unroll
            for (int blk = 0; blk < 8; ++blk) s[blk] = (f32x4){-1e30f, -1e30f, -1e30f, -1e30f};
        }
#pragma unroll
        for (int blk = 0; blk < 8; ++blk) { const LAS unsigned char* kcr = lds + NA_KC + (half * 128 + 16 * blk + (lane & 15)) * NA_PITCH + 16 * g4;
#pragma unroll
            for (int ks = 0; ks < 2; ++ks) kf[blk * 2 + ks] = *(const LAS bf16x8*)(kcr + 64 * ks); }
#pragma unroll
        for (int blk = 0; blk < 8; ++blk) { f32x4 a = (f32x4){0.f, 0.f, 0.f, 0.f};
#pragma unroll
            for (int ks = 0; ks < 2; ++ks) a = mfma16(kf[blk * 2 + ks], bq[ks], a);
#pragma unroll
            for (int rg = 0; rg < 4; ++rg) { const float v = a[rg] * 0.125f; s[8 + blk][rg] = v; mx = fmaxf(mx, v); } }
        mx = fmaxf(mx, shx(mx, 16, lane)); mx = fmaxf(mx, shx(mx, 32, lane));
        float ls = 0.f;
#pragma unroll
        for (int blk = 0; blk < 16; ++blk)
#pragma unroll
            for (int rg = 0; rg < 4; ++rg) { const float e = __builtin_amdgcn_exp2f((s[blk][rg] - mx) * L2E); s[blk][rg] = e; ls += e; }
        ls += shx(ls, 16, lane); ls += shx(ls, 32, lane);
        f32x4 oacc[4];
#pragma unroll
        for (int db = 0; db < 4; ++db) oacc[db] = (f32x4){0.f, 0.f, 0.f, 0.f};
        if (local) { const unsigned va = vla + (unsigned)(((wofs + 4 * half) * 64 + kbs) * NA_PITCH) + lane_off;
            sfor<0, 4>([&](auto kk_) { constexpr int kk = decltype(kk_)::value;
                u32x4 pw; pw.x = pk2(s[2 * kk][0], s[2 * kk][1]); pw.y = pk2(s[2 * kk][2], s[2 * kk][3]); pw.z = pk2(s[2 * kk + 1][0], s[2 * kk + 1][1]); pw.w = pk2(s[2 * kk + 1][2], s[2 * kk + 1][3]);
                const bf16x8 bp = as_frag(pw); bf16x8 vf[4]; tr_frag4_i<kk * 64 * NA_PITCH, 16 * NA_PITCH>(va, vf);
#pragma unroll
                for (int db = 0; db < 4; ++db) oacc[db] = mfma16(vf[db], bp, oacc[db]); }); }
        { const unsigned va = vla + (unsigned)((NA_CTXROW + half * 128) * NA_PITCH) + lane_off;
          sfor<0, 4>([&](auto kk_) { constexpr int kk = decltype(kk_)::value;
              u32x4 pw; pw.x = pk2(s[8 + 2 * kk][0], s[8 + 2 * kk][1]); pw.y = pk2(s[8 + 2 * kk][2], s[8 + 2 * kk][3]); pw.z = pk2(s[9 + 2 * kk][0], s[9 + 2 * kk][1]); pw.w = pk2(s[9 + 2 * kk][2], s[9 + 2 * kk][3]);
              const bf16x8 bp = as_frag(pw); bf16x8 vf[4]; tr_frag4_i<kk * 32 * NA_PITCH, 16 * NA_PITCH>(va, vf);
#pragma unroll
              for (int db = 0; db < 4; ++db) oacc[db] = mfma16(vf[db], bp, oacc[db]); }); }
        if (half == 0) { mx0 = mx; ls0 = ls;
#pragma unroll
            for (int db = 0; db < 4; ++db) oa0[db] = oacc[db]; }
        else {
            const float M = fmaxf(mx, mx0), a1 = __builtin_amdgcn_exp2f((mx - M) * L2E), a0 = __builtin_amdgcn_exp2f((mx0 - M) * L2E);
            const float inv = 1.0f / (ls * a1 + ls0 * a0);
#pragma unroll
            for (int db = 0; db < 4; ++db) { float o[4];
#pragma unroll
                for (int rg = 0; rg < 4; ++rg) o[rg] = (oacc[db][rg] * a1 + oa0[db][rg] * a0) * inv;
                u32x2 w; w.x = pk2(o[0], o[1]); w.y = pk2(o[2], o[3]);
                *(u32x2*)(BR + qrow * BRW + 512 + h * 64 + 16 * db + 4 * g4) = w; } }
    }
    __syncthreads();
}

#ifndef STAMP_PHASE
#define STAMP_PHASE -1
#endif
constexpr int PH_PER_LAYER = 10, PH_FINAL = 1 + 2 * PH_PER_LAYER, NPHASES = PH_FINAL + 1;
__device__ __forceinline__ void moe_tables(const Params& p, LAS unsigned char* lds, int l, int tid, int nsplit, int nMs, int G, int c, bool have_tables = false) {
    LAS int* tb = (LAS int*)(lds + MOE_TAB_OFF); LAS int* cn = tb + 128;
    if (!have_tables) {
    if (tid < 64) { const unsigned c = ((const unsigned*)(p.ws + WS_CTL))[CW_CNT + l * 2048 + tid * 16]; const int cnt_ = (int)(c < (unsigned)NT ? c : (unsigned)NT); cn[tid] = cnt_;
        const int np = (cnt_ + 255) >> 8; int v = np;
#pragma unroll
        for (int k = 1; k < 64; k <<= 1) { const int t = __builtin_amdgcn_ds_bpermute(((tid - k) & 63) << 2, v); if (tid >= k) v += t; }
        tb[tid] = v - np; if (tid == 63) tb[64] = v; }
    __syncthreads();
    }
    if (tid < MOE_UL_MAX) { LAS int* ul = (LAS int*)(lds + MOE_UL_OFF) + tid * 8; const int ntr = tb[64];
        const int idx = tid * G + ((G & 7) == 0 ? (c & 7) * (G >> 3) + (c >> 3) : c);
        if (idx >= nsplit * (ntr + nMs)) ul[0] = -1;
        else if (idx < nsplit * ntr) { const int mt = idx / nsplit, pn = idx % nsplit; int lo = 0, hi = 63;
            for (int it = 0; it < 6; ++it) { const int mid = (lo + hi + 1) >> 1; if (tb[mid] <= mt) lo = mid; else hi = mid - 1; }
            ul[0] = lo; ul[1] = pn; ul[2] = (mt - tb[lo]) * 256; ul[3] = mt; ul[4] = cn[lo]; }
        else { const int s_ = idx - nsplit * ntr; ul[0] = 64; ul[1] = s_ % nsplit; ul[2] = 0; ul[3] = s_ / nsplit; ul[4] = 0; } }
    __syncthreads();
}

__global__ void __launch_bounds__(NTHREADS, 2) fwd_kernel(Params p0) {
    extern __shared__ __attribute__((aligned(16))) unsigned char lds_raw[];
    LAS unsigned char* const lds0 = (LAS unsigned char*)lds_raw;
    const int tid0 = threadIdx.x, G = gridDim.x, bid = blockIdx.x, NGW = G * NWAVES;
    const int wave0 = __builtin_amdgcn_readfirstlane(tid0 >> 6);
#ifdef PAD_US
    unsigned long long padt0 = 0;
#endif
#ifndef STAG_IN
#define STAG_IN 0
#endif
#define STAGGER(q) do { if ((q) > 0) { const unsigned long long t0_ = __builtin_amdgcn_s_memrealtime(); const unsigned d_ = (unsigned)((bid >> 3) & 3) * (unsigned)(q); \
    while (__builtin_amdgcn_s_memrealtime() - t0_ < d_) __builtin_amdgcn_s_sleep(8); } } while (0)
#ifdef PAD_US
#define PAD_T0 padt0 = __builtin_amdgcn_s_memrealtime();
#else
#define PAD_T0
#endif
#define PHASE_IDS PAD_T0 const int tid = launder(wave0 * 64 + lane_id_here()), wave = __builtin_amdgcn_readfirstlane(tid >> 6), lane = tid & 63, gw = bid * NWAVES + wave; (void)lane; (void)gw; \
    Params p = p0; p.ws = kws_ptr(); p.out = kout_ptr(); \
    LAS unsigned char* lds; { unsigned la_ = (unsigned)(size_t)lds0; asm volatile("" : "+s"(la_)); lds = (LAS unsigned char*)(size_t)la_; }
    volatile LAS unsigned* xbw = (volatile LAS unsigned*)(lds0 + LDS_BYTES - 16);
    if (tid0 == 0) { xbw[0] = 0u; xbw[1] = 0u; xbw[2] = 0u; xbw[3] = 0u; }
    __syncthreads();
    XcdBarrier bar = xcd_barrier_post((unsigned*)(p0.ws + WS_CTL) + CW_BAR + p0.li * XCD_BAR_WORDS, xbw);
#ifdef TEST_PHASE
#define IN(k) ((((k) - 1) % PH_PER_LAYER == TEST_PHASE - 1 && (k) >= 1 && (k) < PH_FINAL && TEST_PHASE >= 1) || ((k) == 0 && TEST_PHASE == 0) || ((k) == PH_FINAL && TEST_PHASE == 99)) && (launder_s(p0.ph_lo) <= (k) && (k) < launder_s(p0.ph_hi))
#else
#define IN(k) (launder_s(p0.ph_lo) <= (k) && (k) < launder_s(p0.ph_hi))
#endif
#ifndef DUP_PHASE
#define DUP_PHASE -1
#endif
#define DUP(k) for (int rep_ = 0; rep_ < ((DUP_PHASE) == (k) ? 2 : 1); ++rep_)
#ifdef TIMING
    volatile LAS unsigned long long* tst = (volatile LAS unsigned long long*)(lds0 + LDS_BYTES - 16 - 512);
    if (wave0 == 0 && lane_id_here() == 0) tst[0] = __builtin_amdgcn_s_memrealtime();
#define SEAM(k) do { if (IN(k) && IN((k) + 1)) { xcd_barrier(bar, wave0 == 0 && lane_id_here() == 0); if (wave0 == 0 && lane_id_here() == 0) tst[(k) + 1] = __builtin_amdgcn_s_memrealtime(); } } while (0)
#else
#ifdef PAD_US
#define SEAM(k) do { if (IN(k) && IN((k) + 1)) { if (((k) >= 1 && ((k) - 1) % PH_PER_LAYER == PAD_PHASE) || ((k) == 0 && PAD_PHASE == 100)) { while (__builtin_amdgcn_s_memrealtime() - padt0 < (unsigned long long)(PAD_US) * 100ull) __builtin_amdgcn_s_sleep(8); } xcd_barrier(bar, wave0 == 0 && lane_id_here() == 0); } } while (0)
#else
#define SEAM(k) do { if (IN(k) && IN((k) + 1)) xcd_barrier(bar, wave0 == 0 && lane_id_here() == 0); } while (0)
#endif
#endif
#define Hb ((bf16_t*)(p.ws + WS_H))
#define Zb ((bf16_t*)(p.ws + WS_R + R_Z))
#define BRb ((bf16_t*)(p.ws + WS_R + R_BR))
#define XB ((bf16_t*)(p.ws + WS_R + R_XB))
#define mod ((const float*)(p.ws + WS_MOD) + (size_t)l * 9 * 6144)
#define wm (p.ws + WS_WM + (size_t)l * WM_STRIDE)

    if (IN(0)) { DUP(100) {
        PHASE_IDS;
#ifdef MOD_TWICE
        for (int r2_ = 0; r2_ < 2; ++r2_)
#endif
        for (int u = bid; u < 192; u += G) mod_unit(p, lds, u, tid);
        if (bid == G - 1) { float* rope = (float*)(p.ws + WS_ROPE);
            for (int idx = tid; idx < 1024; idx += NTHREADS) { const int pos = idx >> 4, f = idx & 15; const float inv = exp2f(-(float)f * (13.287712379549449f / 16.0f));
                float x = (float)pos * inv * 0.15915494309189535f; x -= floorf(x);
                rope[idx * 2] = __builtin_amdgcn_cosf(x); rope[idx * 2 + 1] = __builtin_amdgcn_sinf(x); } }
        __syncthreads();
        LAS float* scr = (LAS float*)(lds + wave * 8448);
        for (int it = gw; it < (G == 256 ? 1 : 2) * MISC_ITEMS; it += NGW) {
            if (it < MISC_ITEMS) misc_item(p, 0, it, scr, lane);
            else misc_item(p, 1, it - MISC_ITEMS, scr, lane); }
        __syncthreads();
    } }
    SEAM(0);

    for (int l = 0; l < DEPTH; ++l) {
        const int base = 1 + PH_PER_LAYER * l;
        const bool need_ctx = l < DEPTH - 1;
        const int Mrows = need_ctx ? NT : NL;

        if (IN(base + 0)) { DUP(0) {
            PHASE_IDS;
            const float* const nmg = kin(I_NMG) + l * 1024; const float* const xin = kin(I_X); const float* const cin = kin(I_CTX);
            if (l == 0) {
                for (int rp = gw; rp < NT / 2; rp += NGW) { const int row = 2 * rp; const bool lat = row < NL;
                    const float* mr = mod + (size_t)(lat ? (row >> 11) : 8) * 6144;
                    const float* xr = lat ? xin + (size_t)row * D : cin + (size_t)(row - NL) * D;
                    f32x4 va[4], vb[4], gq[4], hq[4], cq[4];
#pragma unroll
                    for (int j = 0; j < 4; ++j) { va[j] = ((const f32x4*)xr)[64 * j + lane]; vb[j] = ((const f32x4*)(xr + D))[64 * j + lane]; }
#pragma unroll
                    for (int j = 0; j < 4; ++j) { gq[j] = ((const f32x4*)nmg)[64 * j + lane]; hq[j] = ((const f32x4*)mr)[64 * j + lane]; cq[j] = ((const f32x4*)(mr + 1024))[64 * j + lane] + 1.0f; }
                    float sa = 0.f, sb = 0.f;
#pragma unroll
                    for (int j = 0; j < 4; ++j) { sa += (va[j][0] * va[j][0] + va[j][1] * va[j][1]) + (va[j][2] * va[j][2] + va[j][3] * va[j][3]);
                                                  sb += (vb[j][0] * vb[j][0] + vb[j][1] * vb[j][1]) + (vb[j][2] * vb[j][2] + vb[j][3] * vb[j][3]); }
                    const float ra = rsqrtf(wave_sum(sa, lane) * (1.0f / 1024.0f) + EPS), rb = rsqrtf(wave_sum(sb, lane) * (1.0f / 1024.0f) + EPS);
                    bf16_t* const xb = XB + (size_t)row * D; unsigned char* const hb = p.ws + WS_R + R_H8 + (size_t)row * D;
#pragma unroll
                    for (int j = 0; j < 4; ++j) { const f32x4 ya = va[j] * ra * gq[j] * cq[j] + hq[j], yb = vb[j] * rb * gq[j] * cq[j] + hq[j];
                        u32x2 oa, ob; oa.x = pk2(va[j][0], va[j][1]); oa.y = pk2(va[j][2], va[j][3]); ob.x = pk2(vb[j][0], vb[j][1]); ob.y = pk2(vb[j][2], vb[j][3]);
                        int wa = 0, wb = 0; wa = __builtin_amdgcn_cvt_pk_fp8_f32(ya[0], ya[1], wa, false); wa = __builtin_amdgcn_cvt_pk_fp8_f32(ya[2], ya[3], wa, true);
                        wb = __builtin_amdgcn_cvt_pk_fp8_f32(yb[0], yb[1], wb, false); wb = __builtin_amdgcn_cvt_pk_fp8_f32(yb[2], yb[3], wb, true);
                        ((u32x2*)xb)[64 * j + lane] = oa; ((u32x2*)(xb + D))[64 * j + lane] = ob;
                        ((unsigned*)hb)[64 * j + lane] = (unsigned)wa; ((unsigned*)(hb + D))[64 * j + lane] = (unsigned)wb; } }
            } else {
            for (int row = gw; row < NT; row += NGW) { const bool lat = row < NL;
                const float* mr = mod + (size_t)(lat ? (row >> 11) : 8) * 6144;
                f32x4 v[4], ng[4], nh[4], nc[4];
#pragma unroll
                for (int j = 0; j < 4; ++j) { ng[j] = ((const f32x4*)nmg)[64 * j + lane]; nh[j] = ((const f32x4*)mr)[64 * j + lane]; nc[j] = ((const f32x4*)(mr + 1024))[64 * j + lane]; }
                bf16_t* const xb = XB + (size_t)row * D;
                combine_row(v, xb, mr - 9 * 6144 + 5120, Hb + (size_t)row * D, (const unsigned char*)(p.ws + WS_R + R_O) + (size_t)row * 8 * 1024, lane);
                float ss = 0.f;
#pragma unroll
                for (int j = 0; j < 4; ++j) ss += (v[j][0] * v[j][0] + v[j][1] * v[j][1]) + (v[j][2] * v[j][2] + v[j][3] * v[j][3]);
                const float rstd = rsqrtf(wave_sum(ss, lane) * (1.0f / 1024.0f) + EPS);
                unsigned char* const hb = p.ws + WS_R + R_H8 + (size_t)row * D;
#pragma unroll
                for (int j = 0; j < 4; ++j) { u32x2 o; o.x = pk2(v[j][0], v[j][1]); o.y = pk2(v[j][2], v[j][3]); ((u32x2*)xb)[64 * j + lane] = o;
                    const f32x4 y = v[j] * rstd * ng[j] * (nc[j] + 1.0f) + nh[j];
                    int w = 0; w = __builtin_amdgcn_cvt_pk_fp8_f32(y[0], y[1], w, false); w = __builtin_amdgcn_cvt_pk_fp8_f32(y[2], y[3], w, true);
                    ((unsigned*)hb)[64 * j + lane] = (unsigned)w; } }
            }
        } }
        SEAM(base + 0);
        if (IN(base + 1)) { DUP(1) {
            PHASE_IDS;
            DenseSchedT<1> S{(const char*)(p.ws + WS_R + R_H8), (const char*)(wm + WM_IN), 1024, 1024, NT / 256, INW / 256, G, bid, 1, 0, 0};
            EpiStoreBf16 E{Zb, ZW, 16, (unsigned char*)(p.ws + WS_R + R_G8), 0.03125f};
            STAGGER(STAG_IN);
            pg8::gemm_phase<true>(lds, tid, 1024, 1024, S, E, (STAMP_PHASE == 2 && l == 0 && bid == 0) ? 25 : -1);
        } }
        SEAM(base + 1);
        if (IN(base + 2)) { DUP(2) {
            PHASE_IDS;
#ifndef DUP_SUB
#define DUP_SUB -1
#endif
            if (G == 256) { for (int k = 0; k < 4; ++k) { const int bh = ((k * 8 + (bid & 7)) << 1) + (bid >> 7); na_unit(p, lds, l, bh >> 3, bh & 7, (bid >> 3) & 15, true, tid); } }
            else for (int u = bid; u < 1024; u += G) na_unit(p, lds, l, u >> 7, (u >> 4) & 7, u & 15, true, tid);
            if (need_ctx) for (int u = bid; u < 128; u += G) na_unit(p, lds, l, u >> 4, (u >> 1) & 7, u & 1, false, tid);
            for (int rs_ = 0; rs_ < (DUP_SUB == 1 ? 2 : 1); ++rs_) for (int u = (bid + 64) % G; u < 576; u += G) retkv_unit(p, lds, l, u / 72, (u / 18) % 4, u % 18, tid);
        } }
        SEAM(base + 2);
        if (IN(base + 3)) { DUP(3) {
            PHASE_IDS;
            const float* KV = (const float*)(p.ws + WS_R + R_KV); bf16_t* ST = (bf16_t*)(p.ws + WS_R + R_ST);
            for (int gi = bid * NTHREADS + tid; gi < 64 * 2048; gi += G * NTHREADS) {
                const int combo = gi >> 11, e4 = (gi & 2047) * 4, bh = combo >> 1, dir = combo & 1, h = bh & 3;
                const float dec = __builtin_amdgcn_exp2f(128.f * log2_gamma(p, l, dir, h));
                const float* kv = KV + (size_t)bh * NCHUNK * 2 * 8192 + (size_t)dir * 8192 + e4; bf16_t* st = ST + (size_t)bh * NCHUNK * 2 * 8192 + (size_t)dir * 8192 + e4;
                f32x4 q[NCHUNK];
#pragma unroll
                for (int y = 0; y < NCHUNK; ++y) q[y] = *(const f32x4*)(kv + (size_t)y * 2 * 8192);
                f32x4 sacc = (f32x4){0.f, 0.f, 0.f, 0.f};
#pragma unroll
                for (int i = 0; i < NCHUNK; ++i) { const int y = dir == 0 ? i : (i == 0 ? 1 : (i == 1 ? 0 : 19 - i));
                    u32x2 o; o.x = pk2(sacc[0], sacc[1]); o.y = pk2(sacc[2], sacc[3]); *(u32x2*)(st + (size_t)y * 2 * 8192) = o;
                    f32x4 kvy = q[0];
#pragma unroll
                    for (int j = 1; j < NCHUNK; ++j) kvy = (j == y) ? q[j] : kvy;
                    sacc = sacc * dec + kvy; } }
            { const bf16_t* Z = (const bf16_t*)(p.ws + WS_R + R_Z); float* STAT = (float*)(p.ws + WS_R + R_STAT);
              for (int row = gw; row < Mrows; row += NGW) { const u32x4 v = *(const u32x4*)(Z + (size_t)row * ZW + ZC_AV + lane * 8);
                  const float x0 = geluf_(lo16(v.x)), x1 = geluf_(hi16(v.x)), x2 = geluf_(lo16(v.y)), x3 = geluf_(hi16(v.y)), x4 = geluf_(lo16(v.z)), x5 = geluf_(hi16(v.z)), x6 = geluf_(lo16(v.w)), x7 = geluf_(hi16(v.w));
                  const float mean = wave_sum(((x0 + x1) + (x2 + x3)) + ((x4 + x5) + (x6 + x7)), lane) * (1.0f / 512.0f);
                  const float d0 = x0 - mean, d1 = x1 - mean, d2 = x2 - mean, d3 = x3 - mean, d4 = x4 - mean, d5 = x5 - mean, d6 = x6 - mean, d7 = x7 - mean;
                  const float s2 = wave_sum(((d0 * d0 + d1 * d1) + (d2 * d2 + d3 * d3)) + ((d4 * d4 + d5 * d5) + (d6 * d6 + d7 * d7)), lane);
                  if (lane == 0) *(f32x2*)(STAT + (size_t)row * 2) = (f32x2){mean, rsqrtf(s2 * (1.0f / 512.0f) + EPS)}; } }
        } }
        SEAM(base + 3);
        if (IN(base + 4)) { DUP(4) {
            PHASE_IDS;
            const int cc_lo = need_ctx ? 0 : 2, ncc = NCHUNK - cc_lo, total = 32 * ncc;
            for (int u = bid; u < total; u += G) retout_unit(p, lds, l, u / (4 * ncc), (u / ncc) % 4, cc_lo + u % ncc, tid);
            const int nA = (Mrows / 128) * 4;
            for (int rs_ = 0; rs_ < (DUP_SUB == 2 ? 2 : 1); ++rs_) for (int u = (bid + 64) % G; u < nA; u += G) mixA_unit(p, lds, l, u >> 2, u & 3, tid);
        } }
        SEAM(base + 4);
        if (IN(base + 5)) { DUP(5) {
            PHASE_IDS;
            DenseSched S{(const char*)BRb, (const char*)(wm + WM_BR), BRW, 512, Mrows / 256, 4, G, bid, 3, 512 * 2, (size_t)1024 * 512 * 2};
#ifdef MERGE_PLAIN_DUP
            if (rep_ == 1) { EpiStoreBf16 E2{(bf16_t*)(p.ws + WS_R + R_KV), 1024, 1000, (unsigned char*)0, 1.0f}; pg8::gemm_phase(lds, tid, 512, 512, S, E2); } else
#endif
            { EpiMerge E{Hb, (const unsigned char*)(p.ws + WS_R + R_G8)};
            pg8::gemm_phase(lds, tid, 512, 512, S, E, (STAMP_PHASE == 6 && l == 0 && bid == 0) ? 25 : -1); }
            if (l == 0 && rep_ == 0 && G == 256 && bid >= 32) { LAS float* scr = (LAS float*)(lds + wave * 8448); const int fw = (bid - 32) * NWAVES + wave;
                for (int it = fw; it < FILL_SPLIT; it += 224 * NWAVES) expert_item(p, it / EXP_ITEMS, it % EXP_ITEMS, scr, lane); }
            if (l == 0 && rep_ == 0 && G != 256) { LAS float* scr = (LAS float*)(lds + wave * 8448);
                for (int it = gw; it < 2 * EXP_ITEMS; it += NGW) expert_item(p, it / EXP_ITEMS, it % EXP_ITEMS, scr, lane); }
        } }
        SEAM(base + 5);
        if (IN(base + 6)) { DUP(6) {
            PHASE_IDS;
            DenseSched S{(const char*)Hb, (const char*)(wm + WM_OUT), 1024, 1024, Mrows / 256, 4, G, bid, 1, 0, 0};
            EpiResid E{XB, mod + 2048};
            pg8::gemm_phase(lds, tid, 1024, 1024, S, E, (STAMP_PHASE == 7 && l == 0 && bid == 0) ? 25 : -1);
            if (l == 0 && rep_ == 0 && G == 256 && bid >= 32) { LAS float* scr = (LAS float*)(lds + wave * 8448); const int fw = (bid - 32) * NWAVES + wave;
                for (int it = FILL_SPLIT + fw; it < FILL_SPLIT2; it += 224 * NWAVES) expert_item(p, it / EXP_ITEMS, it % EXP_ITEMS, scr, lane); }
        } }
        SEAM(base + 6);
        if (IN(base + 7)) { DUP(7) {
            PHASE_IDS;
            for (int u = bid; u < Mrows / 64; u += G) router_unit(p, lds, l, u, XB, tid, rep_ == 0, l == 0 && u == 0);
            if (l == 0 && rep_ == 0 && G == 256 && bid >= 32) { __syncthreads(); LAS float* scr = (LAS float*)(lds + wave * 8448); const int fw = (bid - 32) * NWAVES + wave;
                for (int it = FILL_SPLIT2 + fw; it < FILL_SPLIT3; it += 224 * NWAVES) expert_item(p, it / EXP_ITEMS, it % EXP_ITEMS, scr, lane);
                for (int it = fw; it < MISC_ITEMS; it += 224 * NWAVES) misc_item(p, 1, it, scr, lane); }
        } }
        SEAM(base + 7);
        if (IN(base + 8)) { DUP(8) {
            PHASE_IDS;
            moe_tables(p, lds, l, tid, 2, Mrows / 256, G, bid);
            MoeGuSched S{(const char*)Hb, (const char*)(p.ws + WS_WE + (size_t)l * WE_LAYER + WE_GU), (const char*)(wm + WM_SGU), (const unsigned*)(p.ws + WS_LIST),
                         (const LAS int*)(lds + MOE_TAB_OFF), (const LAS int*)(lds + MOE_TAB_OFF) + 128, Mrows / 256, G, bid};
            EpiGateUp E{(bf16_t*)(p.ws + WS_R + R_ACT), (bf16_t*)(p.ws + WS_R + R_ACTS), (const float*)(p.ws + WS_WL)};
            pg8::gemm_phase<true>(lds, tid, 1024, 1024, S, E, (STAMP_PHASE == 9 && l == 0 && bid == 0) ? 25 : -1);
            if (l == 0 && rep_ == 0 && G == 256) { const int nu = 2 * (((const LAS int*)(lds + MOE_TAB_OFF))[64] + Mrows / 256);
                int first = nu % 256; if (nu < 256) first = 0;
                const int cm = (bid & 7) * 32 + (bid >> 3);
                if (first == 0 || cm >= first) { const int f0 = first == 0 ? 0 : first; LAS float* scr = (LAS float*)(lds + wave * 8448); const int fw = (cm - f0) * NWAVES + wave, nw = (256 - f0) * NWAVES;
                    for (int it = FILL_SPLIT3 + fw; it < 2 * EXP_ITEMS; it += nw) expert_item(p, it / EXP_ITEMS, it % EXP_ITEMS, scr, lane); } }
        } }
        SEAM(base + 8);
        if (IN(base + 9)) { DUP(9) {
            PHASE_IDS;
            moe_tables(p, lds, l, tid, 4, Mrows / 256, G, bid, IN(base + 8));
            MoeDownSched S{(const char*)(p.ws + WS_R + R_ACT), (const char*)(p.ws + WS_WE + (size_t)l * WE_LAYER + WE_D), (const char*)(p.ws + WS_R + R_ACTS), (const char*)(wm + WM_SD),
                           (const LAS int*)(lds + MOE_TAB_OFF), (const LAS int*)(lds + MOE_TAB_OFF) + 128, Mrows / 256, G, bid};
            EpiDown E{(bf16_t*)(p.ws + WS_R + R_O), (const unsigned*)(p.ws + WS_LIST), Hb};
            pg8::gemm_phase<true>(lds, tid, launder_s(256), 256, S, E, (STAMP_PHASE == 10 && l == 0 && bid == 0) ? 25 : -1);
        } }
        SEAM(base + 9);
    }
#ifdef EXTRA_BARRIERS
    if (IN(PH_FINAL) && IN(PH_FINAL - 1)) for (int xb_ = 0; xb_ < EXTRA_BARRIERS; ++xb_) xcd_barrier(bar, wave0 == 0 && lane_id_here() == 0);
#endif
#ifdef TIMING
    float t_scale = 1.0f, t_add = 0.0f;
    { float* tw = (float*)(p0.ws + WS_CTL) + 1024;
      if (bid == 0 && wave0 == 0 && lane_id_here() == 0) { tw[0] = (float)(tst[TA_HI] - tst[TA_LO]) * 0.01f; }
      xcd_barrier(bar, wave0 == 0 && lane_id_here() == 0);
      t_scale = 1.0f + tw[0] / (float)(TA_DIV); t_add = 0.0f; }
#endif
    if (IN(PH_FINAL)) {
        PHASE_IDS;
        const int l = DEPTH - 1;
        f32x4 fg[4];
#pragma unroll
        for (int j = 0; j < 4; ++j) fg[j] = ((const f32x4*)kin(I_FG))[64 * j + lane];
        for (int row = gw; row < NL; row += NGW) { float* xr = p.out + (size_t)row * D;
            f32x4 v[4]; float ss = 0.f;
            combine_row(v, XB + (size_t)row * D, mod + (size_t)(row >> 11) * 6144 + 5120, Hb + (size_t)row * D, (const unsigned char*)(p.ws + WS_R + R_O) + (size_t)row * 8 * 1024, lane);
#pragma unroll
            for (int j = 0; j < 4; ++j) ss += (v[j][0] * v[j][0] + v[j][1] * v[j][1]) + (v[j][2] * v[j][2] + v[j][3] * v[j][3]);
            const float rstd = rsqrtf(wave_sum(ss, lane) * (1.0f / 1024.0f) + EPS);
#pragma unroll
            for (int j = 0; j < 4; ++j) { f32x4 ov = v[j] * rstd * fg[j];
#ifdef TIMING
                ov = ov * t_scale; if (row == 0 && j == 0 && lane == 0) ov[0] += t_add;
#endif
                ((f32x4*)xr)[64 * j + lane] = ov; } }
    }
#undef IN
#undef SEAM
#undef Hb
#undef Zb
#undef BRb
#undef XB
#undef xl
#undef xc
#undef mod
#undef wm
}

#ifndef STAMP_PHASE_DEFINED
#endif
#ifndef MK_PER_PHASE
#define MK_PER_PHASE 0
#endif
extern "C" void kernel_launch(void* const* d_in, const int* in_sizes, int n_in, void* d_out, int out_size, void* d_ws, size_t ws_size, hipStream_t stream) {
    static int grid = 0;
    if (grid == 0) {
        if (n_in != 26 || out_size != NL * D || ws_size < WS_END) { fprintf(stderr, "kernel_launch: unexpected shapes (n_in %d out %d ws %zu, need %zu)\n", n_in, out_size, ws_size, (size_t)WS_END); grid = -1; return; }
        int dev = 0, cus = 0;
        if (hipGetDevice(&dev) != hipSuccess || hipDeviceGetAttribute(&cus, hipDeviceAttributeMultiprocessorCount, dev) != hipSuccess) { grid = -1; return; }
        if (hipFuncSetAttribute((const void*)fwd_kernel, hipFuncAttributeMaxDynamicSharedMemorySize, LDS_BYTES) != hipSuccess) { fprintf(stderr, "kernel_launch: hipFuncSetAttribute failed\n"); grid = -1; return; }
        int per_cu = 0;
        if (hipOccupancyMaxActiveBlocksPerMultiprocessor(&per_cu, (const void*)fwd_kernel, NTHREADS, LDS_BYTES) != hipSuccess || per_cu < 1) { fprintf(stderr, "kernel_launch: occupancy query says %d\n", per_cu); }
        (void)hipGetLastError();
        grid = cus;
    }
    if (grid < 0) return;
    (void)hipMemsetAsync((char*)d_ws + WS_CTL, 0, CTL_BYTES, stream);
    Params p{};
    for (int i = 0; i < 26; ++i) p.in[i] = (const float*)d_in[i];
    p.out = (float*)d_out; p.ws = (unsigned char*)d_ws;
#if MK_PER_PHASE
    for (int k = 0; k < NPHASES; ++k) { p.ph_lo = k; p.ph_hi = k + 1; p.li = k;
        hipLaunchKernelGGL(fwd_kernel, dim3(grid), dim3(NTHREADS), LDS_BYTES, stream, p); }
#else
    p.ph_lo = 0; p.ph_hi = NPHASES; p.li = 0;
    hipLaunchKernelGGL(fwd_kernel, dim3(grid), dim3(NTHREADS), LDS_BYTES, stream, p);
#endif
}
```
